# Optimizing an MI355X kernel written in HIP

```python
import math
import jax, jax.numpy as jnp
from jax import lax
import numpy as np

D_MODEL = 4096
BATCH = 2
SEQ = 4096
DEPTH = 2

N_MIXERS = 2
N_SB_LAYERS = (DEPTH + N_MIXERS - 1) // N_MIXERS
N_DIFF_LAYERS = DEPTH // N_MIXERS
SB_HEADS = 32
SB_HEAD_DIM = D_MODEL // SB_HEADS
DIFF_HEADS = 16
DIFF_HEAD_DIM = D_MODEL // (2 * DIFF_HEADS)
D_FF = 256 * ((8 * D_MODEL // 3 + 255) // 256)
CONV_WIDTH = 3
ROPE_THETA = 10000.0
Q_BLOCK = 128
RMS_EPS = 1e-6

kernel_name = "hybrid_stickbreaking_diffattn_convffn"


def rms_norm(x, g):
    xf = x.astype(jnp.float32)
    y = xf * lax.rsqrt(jnp.mean(xf * xf, axis=-1, keepdims=True) + RMS_EPS)
    return (y * g.astype(jnp.float32)).astype(x.dtype)


def rope_tables(seq, dim):
    inv_freq = ROPE_THETA ** (-jnp.arange(0, dim, 2, dtype=jnp.float32) / dim)
    ang = jnp.arange(seq, dtype=jnp.float32)[:, None] * inv_freq[None, :]
    ang = jnp.concatenate([ang, ang], axis=-1)
    return jnp.cos(ang), jnp.sin(ang)


def apply_rope(x, cos, sin):
    half = x.shape[-1] // 2
    xf = x.astype(jnp.float32)
    rot = jnp.concatenate([-xf[..., half:], xf[..., :half]], axis=-1)
    c = cos[:, None, None, :]
    s = sin[:, None, None, :]
    return (xf * c + rot * s).astype(x.dtype)


def stick_breaking_attention(h, w_qkv, w_o):
    B, S, _ = h.shape
    nb = S // Q_BLOCK
    qkv = h @ w_qkv
    q, k, v = jnp.split(qkv, 3, axis=-1)
    q = q.reshape(B, nb, Q_BLOCK, SB_HEADS, SB_HEAD_DIM).transpose(1, 0, 3, 2, 4)
    k = k.reshape(B, S, SB_HEADS, SB_HEAD_DIM).transpose(0, 2, 1, 3)
    v = v.reshape(B, S, SB_HEADS, SB_HEAD_DIM).transpose(0, 2, 1, 3)
    scale = 1.0 / math.sqrt(SB_HEAD_DIM)
    key_pos = jnp.arange(S)
    starts = jnp.arange(nb) * Q_BLOCK

    def block(args):
        q_blk, t0 = args
        z = jnp.einsum('bhqd,bhkd->bhqk', q_blk, k,
                       preferred_element_type=jnp.float32) * scale
        q_pos = t0 + jnp.arange(Q_BLOCK)
        mask = key_pos[None, :] < q_pos[:, None]
        log_beta = jax.nn.log_sigmoid(z)
        log_keep = jnp.where(mask, log_beta - z, 0.0)
        log_after = lax.cumsum(log_keep, axis=3, reverse=True) - log_keep
        a = jnp.where(mask, jnp.exp(log_beta + log_after), 0.0)
        return jnp.einsum('bhqk,bhkd->bhqd', a.astype(v.dtype), v)

    o = lax.map(block, (q, starts))
    o = o.transpose(1, 0, 3, 2, 4).reshape(B, S, D_MODEL)
    return o @ w_o


def differential_attention(h, w_qkv, w_o, q_norm_g, k_norm_g, lam_q1, lam_k1,
                           lam_q2, lam_k2, subln_g, lambda_init, cos, sin):
    B, S, _ = h.shape
    nb = S // Q_BLOCK
    qkv = h @ w_qkv
    q, k, v = jnp.split(qkv, 3, axis=-1)
    q = q.reshape(B, S, DIFF_HEADS, 2, DIFF_HEAD_DIM)
    k = k.reshape(B, S, DIFF_HEADS, 2, DIFF_HEAD_DIM)
    v = v.reshape(B, S, DIFF_HEADS, 2 * DIFF_HEAD_DIM)
    q = apply_rope(rms_norm(q, q_norm_g), cos, sin)
    k = apply_rope(rms_norm(k, k_norm_g), cos, sin)
    lam = (jnp.exp(jnp.sum(lam_q1.astype(jnp.float32) * lam_k1.astype(jnp.float32)))
           - jnp.exp(jnp.sum(lam_q2.astype(jnp.float32) * lam_k2.astype(jnp.float32)))
           + lambda_init)
    q = q.reshape(B, nb, Q_BLOCK, DIFF_HEADS, 2, DIFF_HEAD_DIM).transpose(1, 0, 3, 4, 2, 5)
    k = k.transpose(0, 2, 3, 1, 4)
    v = v.transpose(0, 2, 1, 3)
    scale = 1.0 / math.sqrt(DIFF_HEAD_DIM)
    key_pos = jnp.arange(S)
    starts = jnp.arange(nb) * Q_BLOCK

    def block(args):
        q_blk, t0 = args
        z = jnp.einsum('bhcqd,bhckd->bhcqk', q_blk, k,
                       preferred_element_type=jnp.float32) * scale
        q_pos = t0 + jnp.arange(Q_BLOCK)
        mask = key_pos[None, :] <= q_pos[:, None]
        p = jax.nn.softmax(jnp.where(mask, z, -jnp.inf), axis=-1)
        w = p[:, :, 0] - lam * p[:, :, 1]
        return jnp.einsum('bhqk,bhkv->bhqv', w.astype(v.dtype), v)

    o = lax.map(block, (q, starts))
    o = o.transpose(1, 0, 3, 2, 4).reshape(B, S, DIFF_HEADS, 2 * DIFF_HEAD_DIM)
    o = rms_norm(o, subln_g) * (1.0 - lambda_init)
    return o.reshape(B, S, D_MODEL) @ w_o


def conv_ffn(h, w_up, conv_w, conv_b, w_down):
    S = h.shape[1]
    u = h @ w_up
    up = jnp.pad(u, ((0, 0), (CONV_WIDTH - 1, 0), (0, 0)))
    c = conv_b + sum(conv_w[i] * up[:, i:i + S] for i in range(CONV_WIDTH))
    gate, val = jnp.split(c, 2, axis=-1)
    return (jax.nn.silu(gate) * val) @ w_down


def setup_inputs(seed: int = 0) -> dict:
    key = jax.random.key(seed)
    ks = jax.random.split(key, 20)
    D, F, dh = D_MODEL, D_FF, DIFF_HEAD_DIM
    f32 = jnp.float32

    def nrm(k, shape, scale):
        return jax.random.normal(k, shape, f32) * scale

    return {
        "x": nrm(ks[0], (BATCH, SEQ, D), 1.0),
        "attn_norm_g": 1.0 + nrm(ks[1], (DEPTH, D), 0.02),
        "sb_w_qkv": nrm(ks[2], (N_SB_LAYERS, D, 3 * D), D ** -0.5),
        "sb_w_o": nrm(ks[3], (N_SB_LAYERS, D, D), D ** -0.5),
        "diff_w_qkv": nrm(ks[4], (N_DIFF_LAYERS, D, 3 * D), D ** -0.5),
        "diff_w_o": nrm(ks[5], (N_DIFF_LAYERS, D, D), D ** -0.5),
        "diff_q_norm_g": 1.0 + nrm(ks[6], (N_DIFF_LAYERS, dh), 0.02),
        "diff_k_norm_g": 1.0 + nrm(ks[7], (N_DIFF_LAYERS, dh), 0.02),
        "diff_lambda_q1": nrm(ks[8], (N_DIFF_LAYERS, dh), 0.1),
        "diff_lambda_k1": nrm(ks[9], (N_DIFF_LAYERS, dh), 0.1),
        "diff_lambda_q2": nrm(ks[10], (N_DIFF_LAYERS, dh), 0.1),
        "diff_lambda_k2": nrm(ks[11], (N_DIFF_LAYERS, dh), 0.1),
        "diff_subln_g": 1.0 + nrm(ks[12], (N_DIFF_LAYERS, 2 * dh), 0.02),
        "ffn_norm_g": 1.0 + nrm(ks[13], (DEPTH, D), 0.02),
        "ffn_w_up": nrm(ks[14], (DEPTH, D, 2 * F), D ** -0.5),
        "ffn_conv_w": nrm(ks[15], (DEPTH, CONV_WIDTH, 2 * F), CONV_WIDTH ** -0.5),
        "ffn_conv_b": nrm(ks[16], (DEPTH, 2 * F), 0.02),
        "ffn_w_down": nrm(ks[17], (DEPTH, F, D), F ** -0.5),
    }


def reference(x, attn_norm_g, sb_w_qkv, sb_w_o, diff_w_qkv, diff_w_o,
              diff_q_norm_g, diff_k_norm_g, diff_lambda_q1, diff_lambda_k1,
              diff_lambda_q2, diff_lambda_k2, diff_subln_g, ffn_norm_g,
              ffn_w_up, ffn_conv_w, ffn_conv_b, ffn_w_down):
    cos, sin = rope_tables(x.shape[1], DIFF_HEAD_DIM)
    for i in range(DEPTH):
        h = rms_norm(x, attn_norm_g[i])
        j = i // N_MIXERS
        if i % N_MIXERS == 0:
            x = x + stick_breaking_attention(h, sb_w_qkv[j], sb_w_o[j])
        else:
            lambda_init = 0.8 - 0.6 * math.exp(-0.3 * i)
            x = x + differential_attention(
                h, diff_w_qkv[j], diff_w_o[j], diff_q_norm_g[j], diff_k_norm_g[j],
                diff_lambda_q1[j], diff_lambda_k1[j], diff_lambda_q2[j],
                diff_lambda_k2[j], diff_subln_g[j], lambda_init, cos, sin)
        h = rms_norm(x, ffn_norm_g[i])
        x = x + conv_ffn(h, ffn_w_up[i], ffn_conv_w[i], ffn_conv_b[i], ffn_w_down[i])
    return x
```

```cpp
#include <hip/hip_runtime.h>
#include <cstdio>
#include <cstdint>
namespace pg8 {
#define PG8_LAS __attribute__((address_space(3)))
typedef unsigned short bf16_t;
typedef short bf16x8 __attribute__((ext_vector_type(8)));
typedef float f32x4 __attribute__((ext_vector_type(4)));
typedef unsigned u32x4 __attribute__((ext_vector_type(4)));
constexpr int BM = 256, BK = 64, HALF = 128, HTB = HALF * BK * 2  , STAGE_BYTES = 8 * HTB, NXCD = 8, WGM = 8;

__host__ __device__ __forceinline__ int lds_byte(int r, int c) { const int st = (r >> 4) * 2 + (c >> 5), rr = r & 15, cc = c & 31, ob = rr * 64 + cc * 2; return st * 1024 + (ob ^ (((ob >> 9) & 1) << 5)); }
__host__ __device__ __forceinline__ void stage_rc(int b, int& R, int& C) { const int st = b / 1024, sb = b % 1024, swz = sb ^ (((sb >> 9) & 1) << 5); R = (st >> 1) * 16 + swz / 64; C = (st & 1) * 32 + (swz % 64) / 2; }
__host__ __device__ __forceinline__ int perm32(int rho) { const int n = rho >> 4, i = rho & 15; return 8 * (i >> 2) + 4 * n + (i & 3); }

struct Unit { int pm, pn; };
struct Gemm { const bf16_t* A; const bf16_t* Bt; int M, N, K; };

struct StaticOrder {
    int nM, nN, nwg, G, c;
    __host__ __device__ void init(int M, int N, int G_, int c_) { nM = M / BM; nN = N / BM; nwg = nM * nN; G = G_; c = c_; }
    __host__ __device__ bool next(int i, Unit& u) const {
        const long L = (long)i * G + c; if (L >= nwg) return false;
        int wgid = (int)L; { const int q = nwg / NXCD, r = nwg % NXCD, xcd = wgid % NXCD, off = wgid / NXCD; wgid = (xcd < r ? xcd * (q + 1) : r * (q + 1) + (xcd - r) * q) + off; }
        const int nig = WGM * nN, gid = wgid / nig, fm = gid * WGM, gsz = (nM - fm) < WGM ? (nM - fm) : WGM;
        u.pm = fm + ((wgid % nig) % gsz); u.pn = (wgid % nig) / gsz; return true;
    }
    __device__ __forceinline__ void a_ready(const Unit&) const {}
    __device__ __forceinline__ void done(const Unit&) const {}
};


__device__ __forceinline__ unsigned cvt_pk_bf16(float lo, float hi) { unsigned r; asm volatile("v_cvt_pk_bf16_f32 %0, %1, %2" : "=v"(r) : "v"(lo), "v"(hi)); return r; }

constexpr int NPART = 64;

struct EpiScale {
    static constexpr bool PERM = true, AFTER_DRAIN = false;
    bf16_t* O; int ldc; const float* part; float inv_k; float eps; int qcols; float qs;
    __device__ __forceinline__ void operator()(const f32x4 (&acc)[2][2][4][2], const Unit& u, int wr, int wc, int fr, int fq) const {
        const int row0 = u.pm * BM + wr * 64 + fr; const int col0 = u.pn * BM + wc * 32 + 8 * fq;
        const float sc = (u.pn * BM < qcols) ? qs : 1.f;
#pragma unroll
        for (int ai = 0; ai < 2; ++ai)
#pragma unroll
            for (int m = 0; m < 4; ++m) {
                const int row = row0 + ai * HALF + m * 16;
                const f32x4* pp = (const f32x4*)(part + (size_t)row * NPART + fq * 16);
                const f32x4 a = pp[0], b = pp[1], c = pp[2], d = pp[3];
                float s = ((a[0] + a[1]) + (a[2] + a[3])) + ((b[0] + b[1]) + (b[2] + b[3])) + (((c[0] + c[1]) + (c[2] + c[3])) + ((d[0] + d[1]) + (d[2] + d[3])));
                s += __shfl_xor(s, 16); s += __shfl_xor(s, 32);
                const float r = rsqrtf(s * inv_k + eps) * sc;
                bf16_t* rowp = O + (size_t)row * ldc + col0;
#pragma unroll
                for (int bj = 0; bj < 2; ++bj) { const f32x4 v0 = acc[ai][bj][m][0] * r, v1 = acc[ai][bj][m][1] * r;
                    u32x4 w; w.x = cvt_pk_bf16(v0[0], v0[1]); w.y = cvt_pk_bf16(v0[2], v0[3]); w.z = cvt_pk_bf16(v1[0], v1[1]); w.w = cvt_pk_bf16(v1[2], v1[3]);
                    *(u32x4*)(rowp + bj * HALF) = w; }
            }
    }
};

template <bool WITH_XN> struct EpiResid {
    static constexpr bool PERM = false, AFTER_DRAIN = false;
    const float* base; float* out; bf16_t* xn; float* part; int ldc;
    __device__ __forceinline__ void operator()(const f32x4 (&acc)[2][2][4][2], const Unit& u, int wr, int wc, int fr, int fq) const {
        typedef unsigned u32x2v __attribute__((ext_vector_type(2)));
        const int row0 = u.pm * BM + wr * 64 + fr; const int col0 = u.pn * BM + wc * 32 + 4 * fq;
#pragma unroll
        for (int ai = 0; ai < 2; ++ai)
#pragma unroll
            for (int m = 0; m < 4; ++m) {
                const int row = row0 + ai * HALF + m * 16; const size_t off = (size_t)row * ldc + col0; float ss = 0.f;
#pragma unroll
                for (int bj = 0; bj < 2; ++bj)
#pragma unroll
                    for (int n = 0; n < 2; ++n) { const size_t o2 = off + bj * HALF + n * 16;
                        const f32x4 bs = *(const f32x4*)(base + o2); const f32x4 o = bs + acc[ai][bj][m][n];
                        *(f32x4*)(out + o2) = o;
                        if (WITH_XN) { u32x2v w; w.x = cvt_pk_bf16(o[0], o[1]); w.y = cvt_pk_bf16(o[2], o[3]); *(u32x2v*)(xn + o2) = w;
                            ss += (o[0] * o[0] + o[1] * o[1]) + (o[2] * o[2] + o[3] * o[3]); } }
                if (WITH_XN) { ss += __shfl_xor(ss, 16); ss += __shfl_xor(ss, 32); if (fq == 0) part[(size_t)row * NPART + u.pn * 4 + wc] = ss; }
            }
    }
};

template <class Epi, class Sched, bool ALIGN_EPI = false, bool SP2 = false>
__device__ __forceinline__ void gemm_phase(PG8_LAS unsigned char* lds, const Gemm g, const Sched& S, const Epi& E) {
    const int tid = threadIdx.x, wid = __builtin_amdgcn_readfirstlane(tid >> 6), lane = tid & 63, wr = wid >> 2, wc = wid & 3, fr = lane & 15, fq = lane >> 4;
    const int K = g.K, nt = K / BK;
    unsigned voffA[2], voffB[2];
#pragma unroll
    for (int i = 0; i < 2; ++i) { int R, C; stage_rc(tid * 16 + i * 8192, R, C); const int Rb = Epi::PERM ? ((R & ~31) + perm32(R & 31)) : R;
        voffA[i] = (unsigned)(R * K + C) * 2u; voffB[i] = (unsigned)(Rb * K + C) * 2u; }
    const size_t kstep = (size_t)(BK * 2);
    const size_t hstep = (size_t)HALF * K * 2;
    const size_t tstep = 2 * hstep;
    const unsigned ldsw = (unsigned)wid * 1024u;
    const int aoff = lds_byte(wr * 64 + fr, fq * 8), boff = lds_byte(wc * 32 + fr, fq * 8);
#define PG8_SA(b, h) (((b) * 2 + (h)) * HTB)
#define PG8_SB(b, h) ((4 + (b) * 2 + (h)) * HTB)
#define PG8_STAGE(bufoff, gbase, voff) do { _Pragma("unroll") for (int _i = 0; _i < 2; ++_i) \
        __builtin_amdgcn_global_load_lds((const unsigned*)((const char*)(gbase) + (voff)[_i]), (PG8_LAS unsigned*)(lds + (bufoff) + ldsw + _i * 8192), 16, 0, 0); } while (0)
#define PG8_LDA(dst, b, h) do { _Pragma("unroll") for (int m = 0; m < 4; ++m) _Pragma("unroll") for (int k = 0; k < 2; ++k) dst[m][k] = *(const PG8_LAS bf16x8*)(lds + PG8_SA(b, h) + aoff + m * 2048 + k * 1024); } while (0)
#define PG8_LDB(dst, b, h) do { _Pragma("unroll") for (int n = 0; n < 2; ++n) _Pragma("unroll") for (int k = 0; k < 2; ++k) dst[n][k] = *(const PG8_LAS bf16x8*)(lds + PG8_SB(b, h) + boff + n * 2048 + k * 1024); } while (0)
#define PG8_MMA(ai, bj, At, Bt) do { __builtin_amdgcn_s_setprio(1); _Pragma("unroll") for (int m = 0; m < 4; ++m) _Pragma("unroll") for (int n = 0; n < 2; ++n) _Pragma("unroll") for (int k = 0; k < 2; ++k) \
        acc[ai][bj][m][n] = __builtin_amdgcn_mfma_f32_16x16x32_bf16(Bt[n][k], At[m][k], acc[ai][bj][m][n], 0, 0, 0); __builtin_amdgcn_s_setprio(0); } while (0)
#define PG8_WAIT_V(n) asm volatile("s_waitcnt vmcnt(" #n ")" ::: "memory")
#define PG8_WAIT_L(n) asm volatile("s_waitcnt lgkmcnt(" #n ")" ::: "memory")
#define PG8_BAR __builtin_amdgcn_s_barrier()
#define PG8_SCHED __builtin_amdgcn_sched_barrier(0)
    Unit cur, nxt; int ui = 0;
    if (!S.next(0, cur)) return;
    f32x4 acc[2][2][4][2];
#pragma unroll
    for (int a = 0; a < 2; ++a)
#pragma unroll
        for (int b = 0; b < 2; ++b)
#pragma unroll
            for (int m = 0; m < 4; ++m)
#pragma unroll
                for (int n = 0; n < 2; ++n) acc[a][b][m][n] = (f32x4){0.f, 0.f, 0.f, 0.f};
    bf16x8 At[4][2], B0[2][2], B1[2][2];
    const char* cA = (const char*)g.A + (size_t)cur.pm * tstep; const char* cB = (const char*)g.Bt + (size_t)cur.pn * tstep;
    S.a_ready(cur);
    if constexpr (SP2) {
        PG8_STAGE(PG8_SB(0, 0), cB, voffB); PG8_STAGE(PG8_SB(0, 1), cB + hstep, voffB); PG8_STAGE(PG8_SA(0, 0), cA, voffA); PG8_STAGE(PG8_SA(0, 1), cA + hstep, voffA);
        if (wr == 1) PG8_BAR;
        PG8_WAIT_V(2); PG8_BAR;
        PG8_STAGE(PG8_SB(1, 0), cB + kstep, voffB); PG8_STAGE(PG8_SA(1, 0), cA + kstep, voffA); PG8_STAGE(PG8_SB(1, 1), cB + hstep + kstep, voffB);
        PG8_WAIT_V(6); PG8_BAR;
    } else {
        PG8_STAGE(PG8_SB(0, 0), cB, voffB); PG8_STAGE(PG8_SA(0, 0), cA, voffA); PG8_STAGE(PG8_SB(0, 1), cB + hstep, voffB); PG8_STAGE(PG8_SA(0, 1), cA + hstep, voffA);
        if (wr == 1) PG8_BAR;
        PG8_WAIT_V(4); PG8_BAR;
        PG8_STAGE(PG8_SB(1, 0), cB + kstep, voffB); PG8_STAGE(PG8_SA(1, 0), cA + kstep, voffA); PG8_STAGE(PG8_SB(1, 1), cB + hstep + kstep, voffB);
        PG8_WAIT_V(6); PG8_BAR;
    }
    for (;;) {
        const bool has_next = S.next(ui + 1, nxt);
        const char* nA = has_next ? (const char*)g.A + (size_t)nxt.pm * tstep : cA; const char* nB = has_next ? (const char*)g.Bt + (size_t)nxt.pn * tstep : cB;
        for (int t = 0; t < nt; t += 2) {
            const bool last = (t == nt - 2);
            const char* a1 = cA + (size_t)(t + 1) * kstep;
            const char* a2 = last ? nA : cA + (size_t)(t + 2) * kstep; const char* b2 = last ? nB : cB + (size_t)(t + 2) * kstep;
            const char* a3 = a2 + kstep; const char* b3 = b2 + kstep;
            if (last && has_next) S.a_ready(nxt);
            if constexpr (SP2) {
            PG8_LDB(B0, 0, 0); PG8_LDB(B1, 0, 1); PG8_SCHED; PG8_LDA(At, 0, 0); PG8_STAGE(PG8_SA(1, 1), a1 + hstep, voffA);
            PG8_WAIT_V(8); PG8_WAIT_L(0); PG8_BAR; PG8_MMA(0, 0, At, B0); PG8_MMA(0, 1, At, B1); PG8_BAR; PG8_SCHED;
            PG8_LDA(At, 0, 1); PG8_STAGE(PG8_SB(0, 0), b2, voffB); PG8_STAGE(PG8_SB(0, 1), b2 + hstep, voffB); PG8_STAGE(PG8_SA(0, 0), a2, voffA);
            PG8_WAIT_V(8); PG8_WAIT_L(0); PG8_BAR; PG8_MMA(1, 0, At, B0); PG8_MMA(1, 1, At, B1); PG8_BAR; PG8_SCHED;
            PG8_LDB(B0, 1, 0); PG8_LDB(B1, 1, 1); PG8_SCHED; PG8_LDA(At, 1, 0); PG8_STAGE(PG8_SA(0, 1), a2 + hstep, voffA);
            PG8_WAIT_V(8); PG8_WAIT_L(0); PG8_BAR; PG8_MMA(0, 0, At, B0); PG8_MMA(0, 1, At, B1); PG8_BAR; PG8_SCHED;
            PG8_LDA(At, 1, 1); PG8_STAGE(PG8_SB(1, 0), b3, voffB); PG8_STAGE(PG8_SB(1, 1), b3 + hstep, voffB); PG8_STAGE(PG8_SA(1, 0), a3, voffA);
            PG8_WAIT_V(8); PG8_WAIT_L(0); PG8_BAR; PG8_MMA(1, 0, At, B0); PG8_MMA(1, 1, At, B1); PG8_BAR; PG8_SCHED;
            } else {
            PG8_LDB(B0, 0, 0); PG8_SCHED; PG8_LDA(At, 0, 0); PG8_STAGE(PG8_SA(1, 1), a1 + hstep, voffA);
            PG8_WAIT_L(8); PG8_BAR; PG8_WAIT_L(0); PG8_MMA(0, 0, At, B0); PG8_BAR; PG8_SCHED;
            PG8_LDB(B1, 0, 1); PG8_STAGE(PG8_SB(0, 0), b2, voffB);
            PG8_BAR; PG8_WAIT_L(0); PG8_MMA(0, 1, At, B1); PG8_BAR;
            PG8_LDA(At, 0, 1); PG8_STAGE(PG8_SA(0, 0), a2, voffA);
            PG8_BAR; PG8_WAIT_L(0); PG8_MMA(1, 0, At, B0); PG8_BAR; PG8_SCHED;
            PG8_STAGE(PG8_SB(0, 1), b2 + hstep, voffB);
            PG8_WAIT_V(6); PG8_BAR; PG8_MMA(1, 1, At, B1); PG8_BAR;
            PG8_LDB(B0, 1, 0); PG8_SCHED; PG8_LDA(At, 1, 0); PG8_STAGE(PG8_SA(0, 1), a2 + hstep, voffA);
            PG8_WAIT_L(8); PG8_BAR; PG8_WAIT_L(0); PG8_MMA(0, 0, At, B0); PG8_BAR; PG8_SCHED;
            PG8_LDB(B1, 1, 1); PG8_STAGE(PG8_SB(1, 0), b3, voffB);
            PG8_BAR; PG8_WAIT_L(0); PG8_MMA(0, 1, At, B1); PG8_BAR;
            PG8_LDA(At, 1, 1); PG8_STAGE(PG8_SA(1, 0), a3, voffA);
            PG8_BAR; PG8_WAIT_L(0); PG8_MMA(1, 0, At, B0); PG8_BAR; PG8_SCHED;
            PG8_STAGE(PG8_SB(1, 1), b3 + hstep, voffB);
            PG8_WAIT_V(6); PG8_BAR; PG8_MMA(1, 1, At, B1); PG8_BAR;
            }
        }
        if constexpr (ALIGN_EPI) { if (wr == 0) PG8_BAR; }
        if constexpr (!Epi::AFTER_DRAIN) { E(acc, cur, wr, wc, fr, fq); S.done(cur); }
        if (!has_next) break;
#pragma unroll
        for (int a = 0; a < 2; ++a)
#pragma unroll
            for (int b = 0; b < 2; ++b)
#pragma unroll
                for (int m = 0; m < 4; ++m)
#pragma unroll
                    for (int n = 0; n < 2; ++n) acc[a][b][m][n] = (f32x4){0.f, 0.f, 0.f, 0.f};
        cur = nxt; cA = nA; cB = nB; ++ui;
        if constexpr (ALIGN_EPI) { if (wr == 1) PG8_BAR; }
    }
    PG8_WAIT_V(0);
    if constexpr (!ALIGN_EPI) { if (wr == 0) PG8_BAR; }
    PG8_BAR;
    if constexpr (Epi::AFTER_DRAIN) { E.fused(acc, cur, wr, wc, fr, fq, lds, wid, lane); S.done(cur); }
#undef PG8_SA
#undef PG8_SB
#undef PG8_STAGE
#undef PG8_LDA
#undef PG8_LDB
#undef PG8_MMA
#undef PG8_WAIT_V
#undef PG8_WAIT_L
#undef PG8_BAR
#undef PG8_SCHED
}
}
namespace att {
using bf16 = unsigned short;
typedef short bf16x8 __attribute__((ext_vector_type(8)));
typedef short s16x4 __attribute__((ext_vector_type(4)));
typedef float f32x16 __attribute__((ext_vector_type(16)));
typedef float f32x4 __attribute__((ext_vector_type(4)));
typedef unsigned u32x4 __attribute__((ext_vector_type(4)));
constexpr int D = 128, NW = 8, QBLK = 32, KVBLK = 64, QB = NW * QBLK;
constexpr int SHM_V = KVBLK * D * 2, SHM_K = KVBLK * D * 2;
constexpr int LDS_BYTES = 2 * SHM_V + 2 * SHM_K + NW * 64 * 4;
#define KSWZ(row, colB) ((row) * 256 + ((colB) ^ (((row) & 7) << 4)))
#define SBAR() __builtin_amdgcn_sched_barrier(0)
__device__ __forceinline__ int v_st(int k, int c) { const int kk = (k & ~0xC) | ((k & 4) << 1) | ((k & 8) >> 1); return ((kk >> 3) * 4 + (c >> 5)) * 512 + ((kk & 7) * 32 + (c & 31)) * 2; }
__device__ __forceinline__ int v_rd_base(int lane) { return ((lane & 3) << 3) | (((lane >> 2) & 3) << 6) | (((lane >> 4) & 1) << 5) | (((lane >> 5) & 1) << 8); }
constexpr int v_rd_off(int d0, int ks, int half) { return d0 * 512 + ks * 4096 + half * 2048; }
__device__ __forceinline__ int crow(int r, int hi) { return (r & 3) + 8 * (r >> 2) + 4 * hi; }
__device__ __forceinline__ unsigned cvtpk(float lo, float hi) { unsigned r; asm volatile("v_cvt_pk_bf16_f32 %0, %1, %2" : "=v"(r) : "v"(lo), "v"(hi)); return r; }
__device__ __forceinline__ bf16x8 load8(const bf16* p) { return *reinterpret_cast<const bf16x8*>(p); }

#define PK4(P, B_, OUT) do { unsigned a0 = cvtpk(P[B_+0], P[B_+1]), a1 = cvtpk(P[B_+2], P[B_+3]);                          \
        unsigned b0 = cvtpk(P[B_+4], P[B_+5]), b1 = cvtpk(P[B_+6], P[B_+7]);                                             \
        auto r0 = __builtin_amdgcn_permlane32_swap(a0, b0, false, false); auto r1 = __builtin_amdgcn_permlane32_swap(a1, b1, false, false); \
        u32x4 w = {r0[0], r1[0], r0[1], r1[1]}; OUT = *reinterpret_cast<bf16x8*>(&w); } while (0)

__device__ __forceinline__ void qkt_rt(f32x16& p0, f32x16& p1, const char* Kt, int r32, int hi, const bf16x8* qr) {
    p0 = f32x16{}; p1 = f32x16{};
    const char* kb[4];
#pragma unroll
    for (int dd = 0; dd < 4; ++dd) kb[dd] = Kt + KSWZ(r32, (dd * 16 + hi * 8) * 2);
#pragma unroll
    for (int d0 = 0; d0 < 8; ++d0) { const char* a = kb[d0 & 3] + (d0 >> 2) * 128;
        bf16x8 b0 = *reinterpret_cast<const bf16x8*>(a);
        bf16x8 b1 = *reinterpret_cast<const bf16x8*>(a + 32 * 256);
        p0 = __builtin_amdgcn_mfma_f32_32x32x16_bf16(b0, qr[d0], p0, 0, 0, 0);
        p1 = __builtin_amdgcn_mfma_f32_32x32x16_bf16(b1, qr[d0], p1, 0, 0, 0); }
}
__device__ __forceinline__ void pv_rt(f32x16* o, int vb, bf16x8 pa0, bf16x8 pa1, bf16x8 pa2, bf16x8 pa3) {
#define TRRD(dst, off) asm volatile("ds_read_b64_tr_b16 %0, %1 offset:%2" : "=&v"(dst) : "v"(vb), "i"(off) : "memory")
#define PV_D0(d0) do { s16x4 l0, l1, l2, l3, h0, h1, h2, h3; constexpr int b_ = v_rd_off(d0, 0, 0); \
        TRRD(l0, b_); TRRD(h0, b_ + 2048); TRRD(l1, b_ + 4096); TRRD(h1, b_ + 6144); TRRD(l2, b_ + 8192); TRRD(h2, b_ + 10240); TRRD(l3, b_ + 12288); TRRD(h3, b_ + 14336); \
        asm volatile("s_waitcnt lgkmcnt(0)" ::: "memory"); SBAR();   \
        o[d0] = __builtin_amdgcn_mfma_f32_32x32x16_bf16(pa0, (bf16x8){l0[0], l0[1], l0[2], l0[3], h0[0], h0[1], h0[2], h0[3]}, o[d0], 0, 0, 0);   \
        o[d0] = __builtin_amdgcn_mfma_f32_32x32x16_bf16(pa1, (bf16x8){l1[0], l1[1], l1[2], l1[3], h1[0], h1[1], h1[2], h1[3]}, o[d0], 0, 0, 0);   \
        o[d0] = __builtin_amdgcn_mfma_f32_32x32x16_bf16(pa2, (bf16x8){l2[0], l2[1], l2[2], l2[3], h2[0], h2[1], h2[2], h2[3]}, o[d0], 0, 0, 0);   \
        o[d0] = __builtin_amdgcn_mfma_f32_32x32x16_bf16(pa3, (bf16x8){l3[0], l3[1], l3[2], l3[3], h3[0], h3[1], h3[2], h3[3]}, o[d0], 0, 0, 0); } while (0)
    PV_D0(0); PV_D0(1); PV_D0(2); PV_D0(3);
#undef PV_D0
#undef TRRD
}

constexpr float SB_DONE = 1e-30f;
__device__ __forceinline__ void sb_half(f32x16& p, float& carry, int dq, bool needmask, bool lane_hi) {
    float kp[16];
#pragma unroll
    for (int r = 0; r < 16; ++r) {
        const float zz = fminf(p[r], 100.f);
        const float e = __builtin_amdgcn_exp2f(zz);
        float k = __builtin_amdgcn_rcpf(1.f + e);
        float be = e * k;
        if (needmask) { const int c = 8 * (r >> 2) + (r & 3); const bool valid = (dq - c) > 0; k = valid ? k : 1.f; be = valid ? be : 0.f; }
        kp[r] = k; p[r] = be;
    }
    float L[4], H[4];
#pragma unroll
    for (int j = 0; j < 4; ++j) { const float g = (kp[4 * j] * kp[4 * j + 1]) * (kp[4 * j + 2] * kp[4 * j + 3]);
        auto rr = __builtin_amdgcn_permlane32_swap(__float_as_uint(g), __float_as_uint(g), false, false);
        L[j] = __uint_as_float(rr[0]); H[j] = __uint_as_float(rr[1]); }
    float U[4]; U[3] = 1.f; U[2] = L[3] * H[3]; U[1] = U[2] * (L[2] * H[2]); U[0] = U[1] * (L[1] * H[1]);
    const float tot = U[0] * (L[0] * H[0]);
#pragma unroll
    for (int j = 0; j < 4; ++j) {
        const float a3 = carry * U[j] * (lane_hi ? 1.f : H[j]);
        const float a2 = a3 * kp[4 * j + 3], a1 = a2 * kp[4 * j + 2], a0 = a1 * kp[4 * j + 1];
        p[4 * j + 3] *= a3; p[4 * j + 2] *= a2; p[4 * j + 1] *= a1; p[4 * j] *= a0;
    }
    carry *= tot;
}

template <int PQ, int PK, int PV, int PO>
__device__ __forceinline__ void sb_block(const bf16* Q, const bf16* K, const bf16* V, bf16* O, int P0, char* lds, volatile __attribute__((address_space(3))) unsigned* flags) {
    const int tid = threadIdx.x, wid = __builtin_amdgcn_readfirstlane(tid >> 6), lane = tid & 63, r32 = lane & 31, hi = lane >> 5;
    char* K_lds = lds; char* V_lds = lds + 2 * SHM_K;
    const int sr = tid >> 4, sc = (tid & 15) * 8, vst0 = v_st(sr, sc), vst1 = v_st(32 + sr, sc), kws = KSWZ(sr, sc * 2);
    const int vb0 = (int)(uintptr_t)V_lds + v_rd_base(lane);
    bf16x8 qr[8];
#pragma unroll
    for (int d0 = 0; d0 < 8; ++d0) qr[d0] = load8(Q + (size_t)(wid * QBLK + r32) * PQ + d0 * 16 + hi * 8);
    f32x16 o[4] = {};
    float carry = 1.f;
    const int qlo = P0 + wid * QBLK, qpos = qlo + r32;
    int j = P0 / KVBLK + 3;
    bf16x8 st_k0, st_k1, st_v0, st_v1;
#define SB_LOAD(jt) do { const size_t k0_ = (size_t)(jt) * KVBLK; st_k0 = load8(K + (k0_ + sr) * PK + sc); st_k1 = load8(K + (k0_ + 32 + sr) * PK + sc); \
                         st_v0 = load8(V + (k0_ + sr) * PV + sc); st_v1 = load8(V + (k0_ + 32 + sr) * PV + sc); } while (0)
#define SB_WRITE(bf) do { *(bf16x8*)(K_lds + (bf) * SHM_K + kws) = st_k0; *(bf16x8*)(K_lds + (bf) * SHM_K + kws + 32 * 256) = st_k1; \
                          *(bf16x8*)(V_lds + (bf) * SHM_V + vst0) = st_v0; *(bf16x8*)(V_lds + (bf) * SHM_V + vst1) = st_v1; } while (0)
    SB_LOAD(j); asm volatile("s_waitcnt vmcnt(0)" ::: "memory"); SB_WRITE(0);
    __syncthreads();
    int buf = 0, it = 0; bool wdone = false;
    for (;;) {
        const int kb = j * KVBLK; const bool more = j > 0;
        if (more) SB_LOAD(j - 1);
        const bool act = !wdone && (kb < qlo + QBLK - 1);
        if (act) {
            f32x16 p0, p1;
            qkt_rt(p0, p1, K_lds + buf * SHM_K, r32, hi, qr);
            const bool needmask = kb + KVBLK - 1 >= qlo;
            sb_half(p1, carry, qpos - (kb + 32) - 4 * hi, needmask, hi != 0);
            sb_half(p0, carry, qpos - kb - 4 * hi, needmask, hi != 0);
            bf16x8 pa0, pa1, pa2, pa3;
            PK4(p0, 0, pa0); PK4(p0, 8, pa1); PK4(p1, 0, pa2); PK4(p1, 8, pa3);
            SBAR();
            pv_rt(o, vb0 + buf * SHM_V, pa0, pa1, pa2, pa3);
            wdone = __all(carry < SB_DONE);
        }
        if (more) { asm volatile("s_waitcnt vmcnt(0)" ::: "memory"); SB_WRITE(buf ^ 1); }
        if (lane == 0) flags[(it & 1) * 8 + wid] = wdone ? 1u : 0u;
        __syncthreads();
        unsigned alld = 1u;
#pragma unroll
        for (int w = 0; w < NW; ++w) alld &= flags[(it & 1) * 8 + w];
        if (!more || alld) break;
        --j; buf ^= 1; ++it;
    }
#undef SB_LOAD
#undef SB_WRITE
    bf16* Ow = O + (size_t)(wid * QBLK) * PO;
#pragma unroll
    for (int r = 0; r < 16; ++r) { const int orow = crow(r, hi);
#pragma unroll
        for (int d0 = 0; d0 < 4; ++d0) { const float v = o[d0][r]; const float vn = __shfl_xor(v, 1);
            if ((r32 & 1) == 0) *(unsigned*)(Ow + (size_t)orow * PO + d0 * 32 + r32) = cvtpk(v, vn); } }
    __syncthreads();
}

constexpr float THR2 = 8.f * 1.4426950408889634f;
struct DiffRef { const bf16* Q; const bf16* K; const bf16* V; bf16* O; int P0; int mode; };
struct DiffConst { float lam; float omli; float eps; const float* gain; float* scr; };
template <int PQ, int PK, int PV, int PO>
__device__ __forceinline__ void sm_block(const DiffRef& cur, const DiffConst& C, char* lds) {
    const int tid = threadIdx.x, wid = __builtin_amdgcn_readfirstlane(tid >> 6), lane = tid & 63, r32 = lane & 31, hi = lane >> 5;
    char* K_lds = lds; char* V_lds = lds + 2 * SHM_K; float* al_l = (float*)(lds + 2 * SHM_K + 2 * SHM_V) + wid * 32;
    const int sr = tid >> 4, sc = (tid & 15) * 8, vst0 = v_st(sr, sc), vst1 = v_st(32 + sr, sc), kws = KSWZ(sr, sc * 2);
    const int vb0 = (int)(uintptr_t)V_lds + v_rd_base(lane);
    const bf16* Q = cur.Q; const bf16* K = cur.K; const bf16* V = cur.V; const int P0 = cur.P0;
    bf16x8 qr[8];
#pragma unroll
    for (int d0 = 0; d0 < 8; ++d0) qr[d0] = load8(Q + (size_t)(wid * QBLK + r32) * PQ + d0 * 16 + hi * 8);
    f32x16 o[4] = {};
    float m_reg = -1e30f, l_reg = 0.f;
    const int qlo = P0 + wid * QBLK, qm = qlo + r32 - 4 * hi;
    const int NT = P0 / KVBLK + 4;
    bf16x8 st_k0, st_k1, st_v0, st_v1;
#define SM_LOAD(jt) do { const size_t k0_ = (size_t)(jt) * KVBLK; st_k0 = load8(K + (k0_ + sr) * PK + sc); st_k1 = load8(K + (k0_ + 32 + sr) * PK + sc); \
                         st_v0 = load8(V + (k0_ + sr) * PV + sc); st_v1 = load8(V + (k0_ + 32 + sr) * PV + sc); } while (0)
#define SM_WRITE(bf) do { *(bf16x8*)(K_lds + (bf) * SHM_K + kws) = st_k0; *(bf16x8*)(K_lds + (bf) * SHM_K + kws + 32 * 256) = st_k1; \
                          *(bf16x8*)(V_lds + (bf) * SHM_V + vst0) = st_v0; *(bf16x8*)(V_lds + (bf) * SHM_V + vst1) = st_v1; } while (0)
    SM_LOAD(0); asm volatile("s_waitcnt vmcnt(0)" ::: "memory"); SM_WRITE(0);
    __syncthreads();
    int buf = 0;
    for (int t = 0; t < NT; ++t) {
        const int kb = t * KVBLK; const bool more = t + 1 < NT;
        if (more) SM_LOAD(t + 1);
        if (kb <= qlo + QBLK - 1) {
            f32x16 p0, p1;
            qkt_rt(p0, p1, K_lds + buf * SHM_K, r32, hi, qr);
            if (kb + KVBLK - 1 > qlo) {
                const int dq = qm - kb; const float NEG = -__builtin_inff();
#pragma unroll
                for (int r = 0; r < 16; ++r) { const int c = (r & 3) + 8 * (r >> 2); if ((dq - c) < 0) p0[r] = NEG; if ((dq - c - 32) < 0) p1[r] = NEG; }
            }
            float pmax = p0[0];
#pragma unroll
            for (int r = 1; r < 16; ++r) pmax = fmaxf(pmax, p0[r]);
#pragma unroll
            for (int r = 0; r < 16; ++r) pmax = fmaxf(pmax, p1[r]);
            { auto rr = __builtin_amdgcn_permlane32_swap(__float_as_uint(pmax), __float_as_uint(pmax), false, false); pmax = fmaxf(__uint_as_float(rr[0]), __uint_as_float(rr[1])); }
            float alpha = 1.f;
            if (!__all((pmax - m_reg) <= THR2)) {
                const float mn = fmaxf(m_reg, pmax); alpha = __builtin_amdgcn_exp2f(m_reg - mn); m_reg = mn;
                if (hi == 0) al_l[r32] = alpha; asm volatile("s_waitcnt lgkmcnt(0)" ::: "memory");
#pragma unroll
                for (int d_ = 0; d_ < 4; ++d_)
#pragma unroll
                    for (int r = 0; r < 16; ++r) o[d_][r] *= al_l[crow(r, hi)];
            }
            float ps = 0.f;
#pragma unroll
            for (int r = 0; r < 16; ++r) { p0[r] = __builtin_amdgcn_exp2f(p0[r] - m_reg); ps += p0[r]; }
#pragma unroll
            for (int r = 0; r < 16; ++r) { p1[r] = __builtin_amdgcn_exp2f(p1[r] - m_reg); ps += p1[r]; }
            { auto rr = __builtin_amdgcn_permlane32_swap(__float_as_uint(ps), __float_as_uint(ps), false, false); ps = __uint_as_float(rr[0]) + __uint_as_float(rr[1]); }
            l_reg = l_reg * alpha + ps;
            bf16x8 pa0, pa1, pa2, pa3;
            PK4(p0, 0, pa0); PK4(p0, 8, pa1); PK4(p1, 0, pa2); PK4(p1, 8, pa3);
            SBAR();
            pv_rt(o, vb0 + buf * SHM_V, pa0, pa1, pa2, pa3);
        }
        if (more) { asm volatile("s_waitcnt vmcnt(0)" ::: "memory"); SM_WRITE(buf ^ 1); }
        __syncthreads();
        buf ^= 1;
    }
#undef SM_LOAD
#undef SM_WRITE
    if (hi == 0) al_l[r32] = l_reg; asm volatile("s_waitcnt lgkmcnt(0)" ::: "memory");
    float rli[16];
#pragma unroll
    for (int r = 0; r < 16; ++r) rli[r] = __builtin_amdgcn_rcpf(al_l[crow(r, hi)]);
#define OPQ(v) asm volatile("" : "+v"(v))
    char* sA = (char*)C.scr; char* sB = sA + 16384;
    const unsigned lo16 = (unsigned)lane * 16u;
    const int mode = cur.mode;
    if (mode == 0 || mode == 1) { char* s = mode ? sB : sA;
#pragma unroll
        for (int r = 0; r < 16; ++r) { unsigned vo = lo16; OPQ(vo);
            const f32x4 v = {o[0][r] * rli[r], o[1][r] * rli[r], o[2][r] * rli[r], o[3][r] * rli[r]};
            *(f32x4*)(s + (size_t)(vo + r * 1024)) = v; }
    } else if (mode == 2) {
#pragma unroll
        for (int r = 0; r < 16; ++r) { unsigned vo = lo16; OPQ(vo);
            f32x4* ap = (f32x4*)(sA + (size_t)(vo + r * 1024)); const f32x4 a = *ap;
            const f32x4 v = {a[0] - C.lam * (o[0][r] * rli[r]), a[1] - C.lam * (o[1][r] * rli[r]), a[2] - C.lam * (o[2][r] * rli[r]), a[3] - C.lam * (o[3][r] * rli[r])};
            *ap = v;
            if ((r & 3) == 3) asm volatile("" ::: "memory"); }
    } else {
        float g0[4], g1[4];
#pragma unroll
        for (int d0 = 0; d0 < 4; ++d0) { g0[d0] = C.gain[d0 * 32 + r32]; g1[d0] = C.gain[128 + d0 * 32 + r32]; }
        char* Ow = (char*)(cur.O + (size_t)(wid * QBLK) * PO);
        const unsigned lo_o = (unsigned)((4 * hi) * PO + r32) * 2u;
#pragma unroll
        for (int r = 0; r < 16; ++r) { unsigned vo = lo16; OPQ(vo);
            const f32x4 a = *(const f32x4*)(sA + (size_t)(vo + r * 1024)); const f32x4 b = *(const f32x4*)(sB + (size_t)(vo + r * 1024));
            float d1[4], ss = 0.f;
#pragma unroll
            for (int d0 = 0; d0 < 4; ++d0) { d1[d0] = b[d0] - C.lam * (o[d0][r] * rli[r]); ss += d1[d0] * d1[d0] + a[d0] * a[d0]; }
            ss += __shfl_xor(ss, 1); ss += __shfl_xor(ss, 2); ss += __shfl_xor(ss, 4); ss += __shfl_xor(ss, 8); ss += __shfl_xor(ss, 16);
            const float scl = rsqrtf(ss * (1.f / 256.f) + C.eps) * C.omli;
            unsigned wo = lo_o; OPQ(wo);
            char* rowp = Ow + (size_t)(wo + (unsigned)(((r & 3) + 8 * (r >> 2)) * PO * 2));
#pragma unroll
            for (int d0 = 0; d0 < 4; ++d0) {
                const float v0 = a[d0] * scl * g0[d0], v1 = d1[d0] * scl * g1[d0];
                const float v0n = __shfl_xor(v0, 1), v1n = __shfl_xor(v1, 1);
                if ((r32 & 1) == 0) { *(unsigned*)(rowp + d0 * 64) = cvtpk(v0, v0n); *(unsigned*)(rowp + 256 + d0 * 64) = cvtpk(v1, v1n); }
            }
            if ((r & 1) == 1) asm volatile("" ::: "memory");
        }
    }
#undef OPQ
    __syncthreads();
}
}
#ifndef PG8_SP2
#define PG8_SP2 true
#endif
#ifndef PG8_ALIGN
#define PG8_ALIGN true
#endif
#ifndef MK_SPLIT
#define MK_SPLIT 0
#endif
#ifndef MK_CHECK
#define MK_CHECK 0
#endif
constexpr int NWAVES = 8;
constexpr int BATCH = 2, SEQ = 4096, DM = 4096, MROWS = BATCH * SEQ, FF = 11008, FF2 = 2 * FF, NQKV = 3 * DM;
constexpr int SB_H = 32, DF_H = 16, HD = 128;
constexpr float RMS_EPS = 1e-6f;
constexpr float LOG2E = 1.4426950408889634f;
constexpr float QSCALE = 0.08838834764831845f * LOG2E;
constexpr int NPH = 14;
constexpr size_t MiB = 1u << 20;
constexpr size_t WS_CTL = 0, CTL_ZERO_BYTES = 1 * MiB;
constexpr size_t WS_WQKV0 = 2 * MiB;
constexpr size_t WS_WO0   = WS_WQKV0 + 96 * MiB;
constexpr size_t WS_WQKV1 = WS_WO0 + 32 * MiB;
constexpr size_t WS_WO1   = WS_WQKV1 + 96 * MiB;
constexpr size_t WS_WUP0  = WS_WO1 + 32 * MiB;
constexpr size_t WS_WUP1  = WS_WUP0 + 172 * MiB;
constexpr size_t WS_WDN0  = WS_WUP1 + 172 * MiB;
constexpr size_t WS_WDN1  = WS_WDN0 + 86 * MiB;
constexpr size_t WS_XN    = WS_WDN1 + 86 * MiB;
constexpr size_t WS_PART  = WS_XN + 64 * MiB;
constexpr size_t WS_QKV   = WS_PART + 2 * MiB;
constexpr size_t WS_QKN   = WS_QKV + 192 * MiB;
constexpr size_t WS_AO    = WS_QKN + 128 * MiB;
constexpr size_t WS_U     = WS_AO + 64 * MiB;
constexpr size_t WS_ACT   = WS_U + 344 * MiB;
constexpr size_t WS_SCR   = WS_ACT + 172 * MiB;
constexpr size_t WS_X1    = WS_SCR + 64 * MiB;
constexpr size_t WS_END   = WS_X1 + (MK_CHECK ? 3 * 128 * MiB : 0);
constexpr int CW_TMO = 0, CW_CODE = 1, CW_FAIL = 2, CW_BAR = 4096;

constexpr int RING_OFF = 0, RING_BYTES = 131072;
constexpr int LDSCTL_OFF = RING_BYTES, MISC_OFF = LDSCTL_OFF + 320;
constexpr int LDS_BYTES = 147456;
static_assert(MISC_OFF + 128 <= LDS_BYTES, "LDS map");

#define GAS __attribute__((address_space(1)))
#define LAS __attribute__((address_space(3)))
typedef unsigned short bf16;
typedef unsigned v4u __attribute__((ext_vector_type(4)));
typedef unsigned v2u __attribute__((ext_vector_type(2)));
typedef float f32x4 __attribute__((ext_vector_type(4)));
typedef short bf16x8 __attribute__((ext_vector_type(8)));
typedef GAS unsigned gu32;
#define RLX_AGENT __ATOMIC_RELAXED, __HIP_MEMORY_SCOPE_AGENT
#define LDS_WAIT() asm volatile("s_waitcnt lgkmcnt(0)" ::: "memory")
#define VM_WAIT() asm volatile("s_waitcnt vmcnt(0)" ::: "memory")
__device__ __forceinline__ unsigned f2bf(float f) { unsigned u = __builtin_bit_cast(unsigned, f); return (u + 0x7fffu + ((u >> 16) & 1u)) >> 16; }
__device__ __forceinline__ unsigned pk2(float lo, float hi) { return f2bf(lo) | (f2bf(hi) << 16); }
__device__ __forceinline__ float bf2f(unsigned short b) { return __builtin_bit_cast(float, (unsigned)b << 16); }

#define XB_TMO      128
#define XB_XCNT(j)  (256  + 64 * (j))
#define XB_XSUB(j)  (1280 + 64 * (j))
#define XB_XGEN(j)  (2304 + 64 * (j))
#define XB_TOP      3328
#define XB_TOPGEN   3392
#define XCD_BAR_WORDS 3456
#define XB_SPIN_CAP (1u << 18)
__device__ __forceinline__ unsigned xb_ld(unsigned* p)              { return __hip_atomic_load(p, __ATOMIC_RELAXED, __HIP_MEMORY_SCOPE_AGENT); }
__device__ __forceinline__ unsigned xb_add(unsigned* p, unsigned v) { return __hip_atomic_fetch_add(p, v, __ATOMIC_RELAXED, __HIP_MEMORY_SCOPE_AGENT); }
__device__ __forceinline__ unsigned xb_xcc_id() { return (unsigned)__builtin_amdgcn_s_getreg((3 << 11) | 20) & 0xFu; }
#define XB_SPIN(cond, bar) do { unsigned _sp = 0; while (cond) { __builtin_amdgcn_s_sleep(1); \
    if ((++_sp & 255u) == 0u) { if (xb_ld(&(bar)[XB_TMO])) break; if (_sp > XB_SPIN_CAP) { atomicAdd(&(bar)[XB_TMO], 1u); break; } } } } while (0)
struct XcdBarrier { unsigned* bar; unsigned x; volatile LAS unsigned* st; };
__device__ __forceinline__ XcdBarrier xcd_barrier_post(unsigned* bar, volatile LAS unsigned* st) {
    XcdBarrier b; b.bar = bar; b.x = xb_xcc_id(); b.st = st;
    if (threadIdx.x == 0) (void)xb_add(&bar[XB_XCNT(b.x)], 1u);
    return b;
}
__device__ __forceinline__ void xcd_barrier_complete(unsigned* bar, unsigned x, unsigned& nloc, unsigned& nx) {
    const unsigned G = gridDim.x * gridDim.y * gridDim.z;
    unsigned sum, cnt, mine, sp = 0u;
    for (;;) {
        sum = 0u; cnt = 0u; mine = 0u;
#pragma unroll
        for (unsigned j = 0; j < 16; ++j) { const unsigned c = xb_ld(&bar[XB_XCNT(j)]); sum += c; cnt += (c > 0u) ? 1u : 0u; mine = (j == x) ? c : mine; }
        if (sum == G) break;
        __builtin_amdgcn_s_sleep(1);
        if ((++sp & 255u) == 0u) { if (xb_ld(&bar[XB_TMO])) break; if (sp > XB_SPIN_CAP) { atomicAdd(&bar[XB_TMO], 1u); break; } }
    }
    nloc = mine > 0u ? mine : 1u; nx = cnt > 0u ? cnt : 1u;
}
__device__ __forceinline__ void xcd_barrier(const XcdBarrier& b) {
    asm volatile("s_waitcnt vmcnt(0)" ::: "memory");
    __syncthreads();
    if (threadIdx.x == 0) {
        unsigned* bar = b.bar;
        __builtin_amdgcn_s_waitcnt(0);
        unsigned nloc = b.st[0], nx = b.st[1];
        if (nloc == 0u) { xcd_barrier_complete(bar, b.x, nloc, nx); b.st[0] = nloc; b.st[1] = nx; }
        const unsigned old = xb_add(&bar[XB_XSUB(b.x)], 1u);
        const unsigned gen = old / nloc;
        if (old + 1u == (gen + 1u) * nloc) {
            __builtin_amdgcn_fence(__ATOMIC_RELEASE, "agent");
            asm volatile("s_waitcnt vmcnt(0)" ::: "memory");
            const unsigned og = xb_add(&bar[XB_TOP], 1u);
            const unsigned tg = og / nx;
            if (og + 1u == (tg + 1u) * nx) xb_add(&bar[XB_TOPGEN], 1u);
            else XB_SPIN(xb_ld(&bar[XB_TOPGEN]) == tg, bar);
            __builtin_amdgcn_fence(__ATOMIC_ACQUIRE, "agent");
            xb_add(&bar[XB_XGEN(b.x)], 1u);
            asm volatile("s_waitcnt vmcnt(0)" ::: "memory");
        } else {
            XB_SPIN(xb_ld(&bar[XB_XGEN(b.x)]) == gen, bar);
            __builtin_amdgcn_fence(__ATOMIC_ACQUIRE, "agent");
            asm volatile("s_waitcnt vmcnt(0)" ::: "memory");
        }
    }
    __syncthreads();
}

__device__ __forceinline__ float wave_sum(float v) {
#pragma unroll
    for (int o = 1; o < 64; o <<= 1) v += __shfl_xor(v, o);
    return v;
}

__device__ __forceinline__ void transpose_item(const float* W, const float* gain, int K, int N, bf16* WT, LAS float* scr, int item, int lane) {
    const int nblk = N / 32, kb = item / nblk, nb = item % nblk, k0 = 64 * kb, n0 = 32 * nb;
#pragma unroll 8
    for (int i = 0; i < 32; ++i) { const int kk = 2 * i + (lane >> 5); float w = W[(size_t)(k0 + kk) * N + n0 + (lane & 31)]; if (gain) w *= gain[k0 + kk]; scr[kk * 33 + (lane & 31)] = w; }
    LDS_WAIT(); asm volatile("" ::: "memory");
    const int c = lane & 7;
#pragma unroll
    for (int j = 0; j < 4; ++j) { const int n = (lane >> 3) + 8 * j; const LAS float* s = scr + (8 * c) * 33 + n;
        v4u o; o.x = pk2(s[0 * 33], s[1 * 33]); o.y = pk2(s[2 * 33], s[3 * 33]); o.z = pk2(s[4 * 33], s[5 * 33]); o.w = pk2(s[6 * 33], s[7 * 33]);
        *(GAS v4u*)(WT + (size_t)(n0 + n) * K + k0 + 8 * c) = o; }
    LDS_WAIT(); asm volatile("" ::: "memory");
}
__device__ __forceinline__ void xrow_to_bf16(const float* xrow, bf16* orow, float* prow, int lane) {
    const GAS f32x4* xr = (const GAS f32x4*)xrow + lane;
    float s = 0.f; GAS unsigned long long* o8 = (GAS unsigned long long*)orow + lane;
#pragma unroll
    for (int j = 0; j < 16; ++j) { const f32x4 v = xr[64 * j]; s += (v.x * v.x + v.y * v.y) + (v.z * v.z + v.w * v.w);
        o8[64 * j] = (unsigned long long)pk2(v.x, v.y) | ((unsigned long long)pk2(v.z, v.w) << 32); }
    s = wave_sum(s);
    prow[lane] = lane == 0 ? s : 0.f;
}

__device__ __forceinline__ void cvt8(const v4u w, float (&f)[8]) {
    f[0] = __builtin_bit_cast(float, w.x << 16); f[1] = __builtin_bit_cast(float, w.x & 0xffff0000u); f[2] = __builtin_bit_cast(float, w.y << 16); f[3] = __builtin_bit_cast(float, w.y & 0xffff0000u);
    f[4] = __builtin_bit_cast(float, w.z << 16); f[5] = __builtin_bit_cast(float, w.z & 0xffff0000u); f[6] = __builtin_bit_cast(float, w.w << 16); f[7] = __builtin_bit_cast(float, w.w & 0xffff0000u);
}
constexpr int CG_ROWS = 32, CG_NCG = FF / 8, CG_ITEMS = (MROWS / CG_ROWS) * CG_NCG;
__device__ __forceinline__ void convgate_item(const bf16* U, const float* cw, const float* cb, bf16* ACT, int item) {
    const int chunk = item / CG_NCG, cg = item % CG_NCG, m0 = chunk * CG_ROWS, t0 = m0 % SEQ, j0 = cg * 8;
    float wg[3][8], wv[3][8], bg[8], bv[8];
#pragma unroll
    for (int i = 0; i < 3; ++i)
#pragma unroll
        for (int h = 0; h < 2; ++h) { const f32x4 a = *(const f32x4*)(cw + (size_t)i * FF2 + j0 + 4 * h), b = *(const f32x4*)(cw + (size_t)i * FF2 + FF + j0 + 4 * h);
            wg[i][4 * h] = a.x; wg[i][4 * h + 1] = a.y; wg[i][4 * h + 2] = a.z; wg[i][4 * h + 3] = a.w; wv[i][4 * h] = b.x; wv[i][4 * h + 1] = b.y; wv[i][4 * h + 2] = b.z; wv[i][4 * h + 3] = b.w; }
#pragma unroll
    for (int h = 0; h < 2; ++h) { const f32x4 a = *(const f32x4*)(cb + j0 + 4 * h), b = *(const f32x4*)(cb + FF + j0 + 4 * h);
        bg[4 * h] = a.x; bg[4 * h + 1] = a.y; bg[4 * h + 2] = a.z; bg[4 * h + 3] = a.w; bv[4 * h] = b.x; bv[4 * h + 1] = b.y; bv[4 * h + 2] = b.z; bv[4 * h + 3] = b.w; }
    float g2[8], g1[8], v2[8], v1[8];
    const v4u z4 = {0u, 0u, 0u, 0u};
    { const v4u a = t0 >= 2 ? *(const GAS v4u*)(U + (size_t)(m0 - 2) * FF2 + j0) : z4, b = t0 >= 2 ? *(const GAS v4u*)(U + (size_t)(m0 - 2) * FF2 + FF + j0) : z4; cvt8(a, g2); cvt8(b, v2); }
    { const v4u a = t0 >= 1 ? *(const GAS v4u*)(U + (size_t)(m0 - 1) * FF2 + j0) : z4, b = t0 >= 1 ? *(const GAS v4u*)(U + (size_t)(m0 - 1) * FF2 + FF + j0) : z4; cvt8(a, g1); cvt8(b, v1); }
#pragma unroll 4
    for (int r = 0; r < CG_ROWS; ++r) {
        float g0[8], v0[8]; cvt8(*(const GAS v4u*)(U + (size_t)(m0 + r) * FF2 + j0), g0); cvt8(*(const GAS v4u*)(U + (size_t)(m0 + r) * FF2 + FF + j0), v0);
        float o[8];
#pragma unroll
        for (int e = 0; e < 8; ++e) { const float cgv = bg[e] + wg[0][e] * g2[e] + wg[1][e] * g1[e] + wg[2][e] * g0[e]; const float cvv = bv[e] + wv[0][e] * v2[e] + wv[1][e] * v1[e] + wv[2][e] * v0[e];
            const float sg = cgv * __builtin_amdgcn_rcpf(1.f + __builtin_amdgcn_exp2f(-cgv * LOG2E)); o[e] = sg * cvv; g2[e] = g1[e]; g1[e] = g0[e]; v2[e] = v1[e]; v1[e] = v0[e]; }
        v4u w; w.x = pk2(o[0], o[1]); w.y = pk2(o[2], o[3]); w.z = pk2(o[4], o[5]); w.w = pk2(o[6], o[7]);
        *(GAS v4u*)(ACT + (size_t)(m0 + r) * FF + j0) = w;
    }
}

__device__ __forceinline__ void sincos_rev(float ang, float& s, float& c) {
    const float I1 = 0.15915493667125702f, I2 = 6.420638326565253e-09f;
    const float r1 = ang * I1; const float e1 = __builtin_fmaf(ang, I1, -r1); const float r2 = __builtin_fmaf(ang, I2, e1);
    const float fr = (r1 - __builtin_rintf(r1)) + r2;
    s = __builtin_amdgcn_sinf(fr); c = __builtin_amdgcn_cosf(fr);
}
__device__ __forceinline__ void qknorm_row(const bf16* qkv_row, bf16* qkn_row, const float* gq, const float* gk, int t, int lane) {
    const int lp = lane & 31, half = lane >> 5;
    float cs[2], sn[2];
#pragma unroll
    for (int e = 0; e < 2; ++e) { const int i = 2 * lp + e; const float invf = __builtin_amdgcn_exp2f(-(float)i * (13.287712379549449f / 64.f));
        sincos_rev((float)t * invf, sn[e], cs[e]); }
    const float gq0 = gq[2 * lp], gq1 = gq[2 * lp + 1], gq2 = gq[64 + 2 * lp], gq3 = gq[65 + 2 * lp];
    const float gk0 = gk[2 * lp], gk1 = gk[2 * lp + 1], gk2 = gk[64 + 2 * lp], gk3 = gk[65 + 2 * lp];
    for (int it = 0; it < 32; ++it) {
        const int g = 2 * it + half; const bool isq = g < 32; const int col = g * 128 + 2 * lp;
        const unsigned a = *(const GAS unsigned*)(qkv_row + col), b = *(const GAS unsigned*)(qkv_row + col + 64);
        const float x0 = __builtin_bit_cast(float, a << 16), x1 = __builtin_bit_cast(float, a & 0xffff0000u), x2 = __builtin_bit_cast(float, b << 16), x3 = __builtin_bit_cast(float, b & 0xffff0000u);
        float ss = (x0 * x0 + x1 * x1) + (x2 * x2 + x3 * x3);
        ss += __shfl_xor(ss, 1); ss += __shfl_xor(ss, 2); ss += __shfl_xor(ss, 4); ss += __shfl_xor(ss, 8); ss += __shfl_xor(ss, 16);
        const float inv = rsqrtf(ss * (1.f / 128.f) + RMS_EPS);
        const float y0 = x0 * inv * (isq ? gq0 : gk0), y1 = x1 * inv * (isq ? gq1 : gk1), y2 = x2 * inv * (isq ? gq2 : gk2), y3 = x3 * inv * (isq ? gq3 : gk3);
        const float sc = isq ? QSCALE : 1.f;
        const float o0 = (y0 * cs[0] - y2 * sn[0]) * sc, o1 = (y1 * cs[1] - y3 * sn[1]) * sc, o2 = (y2 * cs[0] + y0 * sn[0]) * sc, o3 = (y3 * cs[1] + y1 * sn[1]) * sc;
        *(GAS unsigned*)(qkn_row + col) = pk2(o0, o1); *(GAS unsigned*)(qkn_row + col + 64) = pk2(o2, o3);
    }
}
struct Args { const float* in[18]; float* out; unsigned char* ws; int ph_lo, ph_hi; };
static_assert(sizeof(Args) == 18 * 8 + 8 + 8 + 8, "Args has no padding");

struct MatDesc { int in_idx; size_t in_off; int gain_idx; size_t gain_off; int K, N; size_t ws_off; };
__device__ __forceinline__ MatDesc mat_desc(int i) {
    switch (i) {
    case 0: return MatDesc{2, 0, 1, 0, DM, NQKV, WS_WQKV0};
    case 1: return MatDesc{3, 0, -1, 0, DM, DM, WS_WO0};
    case 2: return MatDesc{14, 0, 13, 0, DM, FF2, WS_WUP0};
    case 3: return MatDesc{17, 0, -1, 0, FF, DM, WS_WDN0};
    case 4: return MatDesc{4, 0, 1, (size_t)DM, DM, NQKV, WS_WQKV1};
    case 5: return MatDesc{5, 0, -1, 0, DM, DM, WS_WO1};
    case 6: return MatDesc{14, (size_t)DM * FF2, 13, (size_t)DM, DM, FF2, WS_WUP1};
    default: return MatDesc{17, (size_t)FF * DM, -1, 0, FF, DM, WS_WDN1};
    }
}

__global__ void __launch_bounds__(NWAVES * 64, 2) mk_fwd(Args args) {
    extern __shared__ __attribute__((aligned(16))) unsigned char lds[];
    LAS unsigned char* ldsl = (LAS unsigned char*)lds;
    volatile LAS unsigned* MISC = (volatile LAS unsigned*)(ldsl + MISC_OFF);
    const int tid = threadIdx.x, lane = tid & 63, wave = __builtin_amdgcn_readfirstlane(tid >> 6);
    const int G = gridDim.x, bx = blockIdx.x;
    const int gw = bx * NWAVES + wave, NGW = G * NWAVES;
    unsigned char* ws = args.ws;
    gu32* ctl = (gu32*)(ws + WS_CTL);
    for (int u = tid; u < (LDS_BYTES - LDSCTL_OFF) / 4; u += NWAVES * 64) ((LAS unsigned*)(ldsl + LDSCTL_OFF))[u] = 0u;
    __syncthreads();
    XcdBarrier bar; bar.bar = (unsigned*)(ctl + CW_BAR); bar.x = 0; bar.st = nullptr;
    const int lo = args.ph_lo, hi = args.ph_hi;
    if (hi - lo > 1) bar = xcd_barrier_post((unsigned*)(ctl + CW_BAR), MISC + 8);
#ifndef PH_MASK
#define PH_MASK 0x3fff
#endif
#define IN(k) (((PH_MASK >> (k)) & 1) && lo <= (k) && (k) < hi)
#define SEAM(k) do { if (IN(k) && IN((k) + 1)) xcd_barrier(bar); } while (0)

    bf16* XN = (bf16*)(ws + WS_XN); float* PART = (float*)(ws + WS_PART);
    bf16* QKV = (bf16*)(ws + WS_QKV); bf16* QKN = (bf16*)(ws + WS_QKN); bf16* AO = (bf16*)(ws + WS_AO);
    bf16* U = (bf16*)(ws + WS_U); bf16* ACT = (bf16*)(ws + WS_ACT);
    const float* x_in = args.in[0];
#if MK_CHECK
    float* X1 = (float*)(ws + WS_X1); float* X2 = X1 + (size_t)MROWS * DM; float* X3 = X2 + (size_t)MROWS * DM;
#else
    float* X1 = args.out; float* X2 = args.out; float* X3 = args.out;
#endif

    if (IN(0)) {
        LAS float* scr = (LAS float*)(ldsl + RING_OFF + wave * 16384);
#pragma unroll 1
        for (int mi = 0; mi < 8; ++mi) { const MatDesc md = mat_desc(mi);
            const float* W = args.in[md.in_idx] + md.in_off; const float* gain = md.gain_idx >= 0 ? args.in[md.gain_idx] + md.gain_off : nullptr;
            bf16* WT = (bf16*)(ws + md.ws_off); const int nitems = (md.K / 64) * (md.N / 32);
            for (int it = gw; it < nitems; it += NGW) transpose_item(W, gain, md.K, md.N, WT, scr, it, lane); }
        for (int m = gw; m < MROWS; m += NGW) xrow_to_bf16(x_in + (size_t)m * DM, XN + (size_t)m * DM, PART + (size_t)m * pg8::NPART, lane);
    }
    SEAM(0);
    if (IN(1)) {
        pg8::Gemm g{XN, (const bf16*)(ws + WS_WQKV0), MROWS, NQKV, DM}; pg8::StaticOrder S; S.init(MROWS, NQKV, G, bx);
        pg8::EpiScale E{QKV, NQKV, PART, 1.f / DM, RMS_EPS, DM, QSCALE};
        pg8::gemm_phase<pg8::EpiScale, pg8::StaticOrder, PG8_ALIGN, PG8_SP2>(ldsl + RING_OFF, g, S, E);
    }
    SEAM(1);
    if (IN(2)) {
        constexpr int NBLK = BATCH * SB_H * (SEQ / 256);
        for (int L = bx; L < NBLK; L += G) { const int qb = L % 16, bh = L / 16, b = bh / SB_H, h = bh % SB_H;
            const bf16* kvbase = QKV + (size_t)(b * SEQ) * NQKV + h * HD;
            att::sb_block<NQKV, NQKV, NQKV, DM>(kvbase + (size_t)(qb * 256) * NQKV, kvbase + DM, kvbase + 2 * DM, AO + (size_t)(b * SEQ + qb * 256) * DM + h * HD, qb * 256, (char*)lds + RING_OFF, (volatile LAS unsigned*)(ldsl + RING_OFF + 65536)); }
    }
    SEAM(2);
    if (IN(3)) {
        pg8::Gemm g{AO, (const bf16*)(ws + WS_WO0), MROWS, DM, DM}; pg8::StaticOrder S; S.init(MROWS, DM, G, bx);
        pg8::EpiResid<true> E{x_in, X1, XN, PART, DM};
        pg8::gemm_phase<pg8::EpiResid<true>, pg8::StaticOrder, PG8_ALIGN, PG8_SP2>(ldsl + RING_OFF, g, S, E);
    }
    SEAM(3);
#define UP_PHASE(WOFF) do { pg8::Gemm g{XN, (const bf16*)(ws + (WOFF)), MROWS, FF2, DM}; pg8::StaticOrder S; S.init(MROWS, FF2, G, bx); \
        pg8::EpiScale E{U, FF2, PART, 1.f / DM, RMS_EPS, 0, 1.f}; \
        pg8::gemm_phase<pg8::EpiScale, pg8::StaticOrder, PG8_ALIGN, PG8_SP2>(ldsl + RING_OFF, g, S, E); } while (0)
#define CG_PHASE(LAYER) do { const float* cw = args.in[15] + (size_t)(LAYER) * 3 * FF2; const float* cb = args.in[16] + (size_t)(LAYER) * FF2; \
        for (int it = bx * (NWAVES * 64) + tid; it < CG_ITEMS; it += G * NWAVES * 64) convgate_item(U, cw, cb, ACT, it); } while (0)
#define DOWN_PHASE(WOFF, BASE, OUT, WITHXN) do { pg8::Gemm g{ACT, (const bf16*)(ws + (WOFF)), MROWS, DM, FF}; pg8::StaticOrder S; S.init(MROWS, DM, G, bx); \
        pg8::EpiResid<WITHXN> E{BASE, OUT, XN, PART, DM}; \
        pg8::gemm_phase<pg8::EpiResid<WITHXN>, pg8::StaticOrder, PG8_ALIGN, PG8_SP2>(ldsl + RING_OFF, g, S, E); } while (0)
    if (IN(4)) UP_PHASE(WS_WUP0);
    SEAM(4);
    if (IN(5)) CG_PHASE(0);
    SEAM(5);
    if (IN(6)) DOWN_PHASE(WS_WDN0, X1, X2, true);
    SEAM(6);
    if (IN(7)) {
        pg8::Gemm g{XN, (const bf16*)(ws + WS_WQKV1), MROWS, NQKV, DM}; pg8::StaticOrder S; S.init(MROWS, NQKV, G, bx);
        pg8::EpiScale E{QKV, NQKV, PART, 1.f / DM, RMS_EPS, 0, 1.f};
        pg8::gemm_phase<pg8::EpiScale, pg8::StaticOrder, PG8_ALIGN, PG8_SP2>(ldsl + RING_OFF, g, S, E);
    }
    SEAM(7);
    if (IN(8)) { for (int m = gw; m < MROWS; m += NGW) qknorm_row(QKV + (size_t)m * NQKV, QKN + (size_t)m * 8192, args.in[6], args.in[7], m % SEQ, lane); }
    SEAM(8);
    if (IN(9)) {
        float lam, omli;
        { const float a1 = wave_sum(args.in[8][lane] * args.in[9][lane] + args.in[8][lane + 64] * args.in[9][lane + 64]);
          const float a2 = wave_sum(args.in[10][lane] * args.in[11][lane] + args.in[10][lane + 64] * args.in[11][lane + 64]);
          const float li = 0.8f - 0.6f * 0.7408182206817179f;
          lam = __expf(a1) - __expf(a2) + li; omli = 1.f - li; }
        att::DiffConst C{lam, omli, RMS_EPS, args.in[12], (float*)(ws + WS_SCR) + ((size_t)bx * NWAVES + wave) * 8192};
        constexpr int NITEM = BATCH * DF_H * 8;
        for (int w = bx; w < NITEM; w += G) {
            const int bh = w / 8, xq = w % 8, b = bh / DF_H, h = bh % DF_H;
            const bf16* qn = QKN + (size_t)(b * SEQ) * 8192 + h * 256; const bf16* vb = QKV + (size_t)(b * SEQ) * NQKV + 2 * DM + h * 256;
#define DREF(s) att::DiffRef{ qn + (size_t)((((s) >> 2) ? 15 - xq : xq) * 256) * 8192 + (((s) >> 1) & 1) * 128, qn + 4096 + (((s) >> 1) & 1) * 128, vb + ((s) & 1) * 128, \
                              AO + (size_t)(b * SEQ + (((s) >> 2) ? 15 - xq : xq) * 256) * DM + h * 256, (((s) >> 2) ? 15 - xq : xq) * 256, (s) & 3 }
#pragma unroll 1
            for (int s = 0; s < 8; ++s) { const att::DiffRef cur = DREF(s); att::sm_block<8192, 8192, NQKV, DM>(cur, C, (char*)lds + RING_OFF); }
#undef DREF
        }
    }
    SEAM(9);
    if (IN(10)) {
        pg8::Gemm g{AO, (const bf16*)(ws + WS_WO1), MROWS, DM, DM}; pg8::StaticOrder S; S.init(MROWS, DM, G, bx);
        pg8::EpiResid<true> E{X2, X3, XN, PART, DM};
        pg8::gemm_phase<pg8::EpiResid<true>, pg8::StaticOrder, PG8_ALIGN, PG8_SP2>(ldsl + RING_OFF, g, S, E);
    }
    SEAM(10);
    if (IN(11)) UP_PHASE(WS_WUP1);
    SEAM(11);
    if (IN(12)) CG_PHASE(1);
    SEAM(12);
    if (IN(13)) DOWN_PHASE(WS_WDN1, X3, args.out, false);
#undef IN
#undef SEAM
}
#if MK_CHECK
#include "check.inc"
#endif
extern "C" void kernel_launch(void* const* d_in, const int* in_sizes, int n_in, void* d_out, int out_size, void* d_ws, size_t ws_size, hipStream_t stream) {
    static int grid = 0;
    if (grid == 0) {
        if (n_in != 18 || in_sizes[0] != MROWS * DM || out_size != MROWS * DM || ws_size < WS_END) {
            fprintf(stderr, "kernel_launch: built for 18 inputs, x/out of %d floats, >= %zu bytes of workspace; got n_in %d, in0 %d, out %d, ws %zu; nothing launched\n", MROWS * DM, (size_t)WS_END, n_in, n_in > 0 ? in_sizes[0] : -1, out_size, ws_size); grid = -1; return; }
        int dev = 0, cus = 0, per_cu = 0;
        if (hipGetDevice(&dev) != hipSuccess || hipDeviceGetAttribute(&cus, hipDeviceAttributeMultiprocessorCount, dev) != hipSuccess) { fprintf(stderr, "kernel_launch: device query failed\n"); grid = -1; return; }
        if (hipFuncSetAttribute((const void*)mk_fwd, hipFuncAttributeMaxDynamicSharedMemorySize, LDS_BYTES) != hipSuccess) { fprintf(stderr, "kernel_launch: hipFuncSetAttribute failed\n"); grid = -1; return; }
        if (hipOccupancyMaxActiveBlocksPerMultiprocessor(&per_cu, (const void*)mk_fwd, NWAVES * 64, LDS_BYTES) != hipSuccess || per_cu < 1)
            fprintf(stderr, "kernel_launch: note: occupancy query reports %d workgroups per CU\n", per_cu);
        (void)hipGetLastError();
        grid = cus;
    }
    if (grid < 0) return;
    if (hipMemsetAsync((char*)d_ws + WS_CTL, 0, CTL_ZERO_BYTES, stream) != hipSuccess) { fprintf(stderr, "kernel_launch: memset failed\n"); return; }
    Args a{};
    for (int i = 0; i < 18; ++i) a.in[i] = (const float*)d_in[i];
    a.out = (float*)d_out; a.ws = (unsigned char*)d_ws;
#if MK_CHECK
    for (int p = 0; p < NPH; ++p) { a.ph_lo = p; a.ph_hi = p + 1;
        hipLaunchKernelGGL(mk_fwd, dim3(grid), dim3(NWAVES * 64), LDS_BYTES, stream, a);
        hipLaunchKernelGGL(mk_check, dim3(256), dim3(256), 0, stream, a, p); }
    hipLaunchKernelGGL(mk_report, dim3(1), dim3(64), 0, stream, a);
#elif MK_SPLIT
    for (int p = 0; p < NPH; ++p) { a.ph_lo = p; a.ph_hi = p + 1; hipLaunchKernelGGL(mk_fwd, dim3(grid), dim3(NWAVES * 64), LDS_BYTES, stream, a); }
#else
    a.ph_lo = 0; a.ph_hi = NPH;
    hipLaunchKernelGGL(mk_fwd, dim3(grid), dim3(NWAVES * 64), LDS_BYTES, stream, a);
#endif
    const hipError_t le = hipPeekAtLastError();
    if (le != hipSuccess) fprintf(stderr, "kernel_launch: launch failed: %s\n", hipGetErrorName(le));
}
```

```cpp
#include <hip/hip_runtime.h>
#include <cstdio>
#include <cstdint>
namespace pg8 {
#define PG8_LAS __attribute__((address_space(3)))
typedef unsigned short bf16_t;
typedef short bf16x8 __attribute__((ext_vector_type(8)));
typedef float f32x4 __attribute__((ext_vector_type(4)));
typedef unsigned u32x4 __attribute__((ext_vector_type(4)));
constexpr int BM = 256, BK = 64, HALF = 128, HTB = HALF * BK * 2  , STAGE_BYTES = 8 * HTB, NXCD = 8, WGM = 8;

__host__ __device__ __forceinline__ int lds_byte(int r, int c) { const int st = (r >> 4) * 2 + (c >> 5), rr = r & 15, cc = c & 31, ob = rr * 64 + cc * 2; return st * 1024 + (ob ^ (((ob >> 9) & 1) << 5)); }
__host__ __device__ __forceinline__ void stage_rc(int b, int& R, int& C) { const int st = b / 1024, sb = b % 1024, swz = sb ^ (((sb >> 9) & 1) << 5); R = (st >> 1) * 16 + swz / 64; C = (st & 1) * 32 + (swz % 64) / 2; }
__host__ __device__ __forceinline__ int perm32(int rho) { const int n = rho >> 4, i = rho & 15; return 8 * (i >> 2) + 4 * n + (i & 3); }

struct Unit { int pm, pn; };
struct Gemm { const bf16_t* A; const bf16_t* Bt; int M, N, K; };

struct StaticOrder {
    int nM, nN, nwg, G, c;
    __host__ __device__ void init(int M, int N, int G_, int c_) { nM = M / BM; nN = N / BM; nwg = nM * nN; G = G_; c = c_; }
    __host__ __device__ bool next(int i, Unit& u) const {
        const long L = (long)i * G + c; if (L >= nwg) return false;
        int wgid = (int)L; { const int q = nwg / NXCD, r = nwg % NXCD, xcd = wgid % NXCD, off = wgid / NXCD; wgid = (xcd < r ? xcd * (q + 1) : r * (q + 1) + (xcd - r) * q) + off; }
        const int nig = WGM * nN, gid = wgid / nig, fm = gid * WGM, gsz = (nM - fm) < WGM ? (nM - fm) : WGM;
        u.pm = fm + ((wgid % nig) % gsz); u.pn = (wgid % nig) / gsz; return true;
    }
    __device__ __forceinline__ void a_ready(const Unit&) const {}
    __device__ __forceinline__ void done(const Unit&) const {}
};


__device__ __forceinline__ unsigned cvt_pk_bf16(float lo, float hi) { unsigned r; asm volatile("v_cvt_pk_bf16_f32 %0, %1, %2" : "=v"(r) : "v"(lo), "v"(hi)); return r; }

constexpr int NPART = 64;

struct EpiScale {
    static constexpr bool PERM = true, AFTER_DRAIN = false;
    bf16_t* O; int ldc; const float* part; float inv_k; float eps; int qcols; float qs;
    __device__ __forceinline__ void operator()(const f32x4 (&acc)[2][2][4][2], const Unit& u, int wr, int wc, int fr, int fq) const {
        const int row0 = u.pm * BM + wr * 64 + fr; const int col0 = u.pn * BM + wc * 32 + 8 * fq;
        const float sc = (u.pn * BM < qcols) ? qs : 1.f;
#pragma unroll
        for (int ai = 0; ai < 2; ++ai)
#pragma unroll
            for (int m = 0; m < 4; ++m) {
                const int row = row0 + ai * HALF + m * 16;
                const f32x4* pp = (const f32x4*)(part + (size_t)row * NPART + fq * 16);
                const f32x4 a = pp[0], b = pp[1], c = pp[2], d = pp[3];
                float s = ((a[0] + a[1]) + (a[2] + a[3])) + ((b[0] + b[1]) + (b[2] + b[3])) + (((c[0] + c[1]) + (c[2] + c[3])) + ((d[0] + d[1]) + (d[2] + d[3])));
                s += __shfl_xor(s, 16); s += __shfl_xor(s, 32);
                const float r = rsqrtf(s * inv_k + eps) * sc;
                bf16_t* rowp = O + (size_t)row * ldc + col0;
#pragma unroll
                for (int bj = 0; bj < 2; ++bj) { const f32x4 v0 = acc[ai][bj][m][0] * r, v1 = acc[ai][bj][m][1] * r;
                    u32x4 w; w.x = cvt_pk_bf16(v0[0], v0[1]); w.y = cvt_pk_bf16(v0[2], v0[3]); w.z = cvt_pk_bf16(v1[0], v1[1]); w.w = cvt_pk_bf16(v1[2], v1[3]);
                    *(u32x4*)(rowp + bj * HALF) = w; }
            }
    }
};

template <bool WITH_XN> struct EpiResid {
    static constexpr bool PERM = false, AFTER_DRAIN = false;
    const float* base; float* out; bf16_t* xn; float* part; int ldc;
    __device__ __forceinline__ void operator()(const f32x4 (&acc)[2][2][4][2], const Unit& u, int wr, int wc, int fr, int fq) const {
        typedef unsigned u32x2v __attribute__((ext_vector_type(2)));
        const int row0 = u.pm * BM + wr * 64 + fr; const int col0 = u.pn * BM + wc * 32 + 4 * fq;
#pragma unroll
        for (int ai = 0; ai < 2; ++ai)
#pragma unroll
            for (int m = 0; m < 4; ++m) {
                const int row = row0 + ai * HALF + m * 16; const size_t off = (size_t)row * ldc + col0; float ss = 0.f;
#pragma unroll
                for (int bj = 0; bj < 2; ++bj)
#pragma unroll
                    for (int n = 0; n < 2; ++n) { const size_t o2 = off + bj * HALF + n * 16;
                        const f32x4 bs = *(const f32x4*)(base + o2); const f32x4 o = bs + acc[ai][bj][m][n];
                        *(f32x4*)(out + o2) = o;
                        if (WITH_XN) { u32x2v w; w.x = cvt_pk_bf16(o[0], o[1]); w.y = cvt_pk_bf16(o[2], o[3]); *(u32x2v*)(xn + o2) = w;
                            ss += (o[0] * o[0] + o[1] * o[1]) + (o[2] * o[2] + o[3] * o[3]); } }
                if (WITH_XN) { ss += __shfl_xor(ss, 16); ss += __shfl_xor(ss, 32); if (fq == 0) part[(size_t)row * NPART + u.pn * 4 + wc] = ss; }
            }
    }
};

template <class Epi, class Sched, bool ALIGN_EPI = false, bool SP2 = false>
__device__ __forceinline__ void gemm_phase(PG8_LAS unsigned char* lds, const Gemm g, const Sched& S, const Epi& E) {
    const int tid = threadIdx.x, wid = __builtin_amdgcn_readfirstlane(tid >> 6), lane = tid & 63, wr = wid >> 2, wc = wid & 3, fr = lane & 15, fq = lane >> 4;
    const int K = g.K, nt = K / BK;
    unsigned voffA[2], voffB[2];
#pragma unroll
    for (int i = 0; i < 2; ++i) { int R, C; stage_rc(tid * 16 + i * 8192, R, C); const int Rb = Epi::PERM ? ((R & ~31) + perm32(R & 31)) : R;
        voffA[i] = (unsigned)(R * K + C) * 2u; voffB[i] = (unsigned)(Rb * K + C) * 2u; }
    const size_t kstep = (size_t)(BK * 2);
    const size_t hstep = (size_t)HALF * K * 2;
    const size_t tstep = 2 * hstep;
    const unsigned ldsw = (unsigned)wid * 1024u;
    const int aoff = lds_byte(wr * 64 + fr, fq * 8), boff = lds_byte(wc * 32 + fr, fq * 8);
#define PG8_SA(b, h) (((b) * 2 + (h)) * HTB)
#define PG8_SB(b, h) ((4 + (b) * 2 + (h)) * HTB)
#define PG8_STAGE(bufoff, gbase, voff) do { _Pragma("unroll") for (int _i = 0; _i < 2; ++_i) \
        __builtin_amdgcn_global_load_lds((const unsigned*)((const char*)(gbase) + (voff)[_i]), (PG8_LAS unsigned*)(lds + (bufoff) + ldsw + _i * 8192), 16, 0, 0); } while (0)
#define PG8_LDA(dst, b, h) do { _Pragma("unroll") for (int m = 0; m < 4; ++m) _Pragma("unroll") for (int k = 0; k < 2; ++k) dst[m][k] = *(const PG8_LAS bf16x8*)(lds + PG8_SA(b, h) + aoff + m * 2048 + k * 1024); } while (0)
#define PG8_LDB(dst, b, h) do { _Pragma("unroll") for (int n = 0; n < 2; ++n) _Pragma("unroll") for (int k = 0; k < 2; ++k) dst[n][k] = *(const PG8_LAS bf16x8*)(lds + PG8_SB(b, h) + boff + n * 2048 + k * 1024); } while (0)
#define PG8_MMA(ai, bj, At, Bt) do { __builtin_amdgcn_s_setprio(1); _Pragma("unroll") for (int m = 0; m < 4; ++m) _Pragma("unroll") for (int n = 0; n < 2; ++n) _Pragma("unroll") for (int k = 0; k < 2; ++k) \
        acc[ai][bj][m][n] = __builtin_amdgcn_mfma_f32_16x16x32_bf16(Bt[n][k], At[m][k], acc[ai][bj][m][n], 0, 0, 0); __builtin_amdgcn_s_setprio(0); } while (0)
#define PG8_WAIT_V(n) asm volatile("s_waitcnt vmcnt(" #n ")" ::: "memory")
#define PG8_WAIT_L(n) asm volatile("s_waitcnt lgkmcnt(" #n ")" ::: "memory")
#define PG8_BAR __builtin_amdgcn_s_barrier()
#define PG8_SCHED __builtin_amdgcn_sched_barrier(0)
    Unit cur, nxt; int ui = 0;
    if (!S.next(0, cur)) return;
    f32x4 acc[2][2][4][2];
#pragma unroll
    for (int a = 0; a < 2; ++a)
#pragma unroll
        for (int b = 0; b < 2; ++b)
#pragma unroll
            for (int m = 0; m < 4; ++m)
#pragma unroll
                for (int n = 0; n < 2; ++n) acc[a][b][m][n] = (f32x4){0.f, 0.f, 0.f, 0.f};
    bf16x8 At[4][2], B0[2][2], B1[2][2];
    const char* cA = (const char*)g.A + (size_t)cur.pm * tstep; const char* cB = (const char*)g.Bt + (size_t)cur.pn * tstep;
    S.a_ready(cur);
    if constexpr (SP2) {
        PG8_STAGE(PG8_SB(0, 0), cB, voffB); PG8_STAGE(PG8_SB(0, 1), cB + hstep, voffB); PG8_STAGE(PG8_SA(0, 0), cA, voffA); PG8_STAGE(PG8_SA(0, 1), cA + hstep, voffA);
        if (wr == 1) PG8_BAR;
        PG8_WAIT_V(2); PG8_BAR;
        PG8_STAGE(PG8_SB(1, 0), cB + kstep, voffB); PG8_STAGE(PG8_SA(1, 0), cA + kstep, voffA); PG8_STAGE(PG8_SB(1, 1), cB + hstep + kstep, voffB);
        PG8_WAIT_V(6); PG8_BAR;
    } else {
        PG8_STAGE(PG8_SB(0, 0), cB, voffB); PG8_STAGE(PG8_SA(0, 0), cA, voffA); PG8_STAGE(PG8_SB(0, 1), cB + hstep, voffB); PG8_STAGE(PG8_SA(0, 1), cA + hstep, voffA);
        if (wr == 1) PG8_BAR;
        PG8_WAIT_V(4); PG8_BAR;
        PG8_STAGE(PG8_SB(1, 0), cB + kstep, voffB); PG8_STAGE(PG8_SA(1, 0), cA + kstep, voffA); PG8_STAGE(PG8_SB(1, 1), cB + hstep + kstep, voffB);
        PG8_WAIT_V(6); PG8_BAR;
    }
    for (;;) {
        const bool has_next = S.next(ui + 1, nxt);
        const char* nA = has_next ? (const char*)g.A + (size_t)nxt.pm * tstep : cA; const char* nB = has_next ? (const char*)g.Bt + (size_t)nxt.pn * tstep : cB;
        for (int t = 0; t < nt; t += 2) {
            const bool last = (t == nt - 2);
            const char* a1 = cA + (size_t)(t + 1) * kstep;
            const char* a2 = last ? nA : cA + (size_t)(t + 2) * kstep; const char* b2 = last ? nB : cB + (size_t)(t + 2) * kstep;
            const char* a3 = a2 + kstep; const char* b3 = b2 + kstep;
            if (last && has_next) S.a_ready(nxt);
            if constexpr (SP2) {
            PG8_LDB(B0, 0, 0); PG8_LDB(B1, 0, 1); PG8_SCHED; PG8_LDA(At, 0, 0); PG8_STAGE(PG8_SA(1, 1), a1 + hstep, voffA);
            PG8_WAIT_V(8); PG8_WAIT_L(0); PG8_BAR; PG8_MMA(0, 0, At, B0); PG8_MMA(0, 1, At, B1); PG8_BAR; PG8_SCHED;
            PG8_LDA(At, 0, 1); PG8_STAGE(PG8_SB(0, 0), b2, voffB); PG8_STAGE(PG8_SB(0, 1), b2 + hstep, voffB); PG8_STAGE(PG8_SA(0, 0), a2, voffA);
            PG8_WAIT_V(8); PG8_WAIT_L(0); PG8_BAR; PG8_MMA(1, 0, At, B0); PG8_MMA(1, 1, At, B1); PG8_BAR; PG8_SCHED;
            PG8_LDB(B0, 1, 0); PG8_LDB(B1, 1, 1); PG8_SCHED; PG8_LDA(At, 1, 0); PG8_STAGE(PG8_SA(0, 1), a2 + hstep, voffA);
            PG8_WAIT_V(8); PG8_WAIT_L(0); PG8_BAR; PG8_MMA(0, 0, At, B0); PG8_MMA(0, 1, At, B1); PG8_BAR; PG8_SCHED;
            PG8_LDA(At, 1, 1); PG8_STAGE(PG8_SB(1, 0), b3, voffB); PG8_STAGE(PG8_SB(1, 1), b3 + hstep, voffB); PG8_STAGE(PG8_SA(1, 0), a3, voffA);
            PG8_WAIT_V(8); PG8_WAIT_L(0); PG8_BAR; PG8_MMA(1, 0, At, B0); PG8_MMA(1, 1, At, B1); PG8_BAR; PG8_SCHED;
            } else {
            PG8_LDB(B0, 0, 0); PG8_SCHED; PG8_LDA(At, 0, 0); PG8_STAGE(PG8_SA(1, 1), a1 + hstep, voffA);
            PG8_WAIT_L(8); PG8_BAR; PG8_WAIT_L(0); PG8_MMA(0, 0, At, B0); PG8_BAR; PG8_SCHED;
            PG8_LDB(B1, 0, 1); PG8_STAGE(PG8_SB(0, 0), b2, voffB);
            PG8_BAR; PG8_WAIT_L(0); PG8_MMA(0, 1, At, B1); PG8_BAR;
            PG8_LDA(At, 0, 1); PG8_STAGE(PG8_SA(0, 0), a2, voffA);
            PG8_BAR; PG8_WAIT_L(0); PG8_MMA(1, 0, At, B0); PG8_BAR; PG8_SCHED;
            PG8_STAGE(PG8_SB(0, 1), b2 + hstep, voffB);
            PG8_WAIT_V(6); PG8_BAR; PG8_MMA(1, 1, At, B1); PG8_BAR;
            PG8_LDB(B0, 1, 0); PG8_SCHED; PG8_LDA(At, 1, 0); PG8_STAGE(PG8_SA(0, 1), a2 + hstep, voffA);
            PG8_WAIT_L(8); PG8_BAR; PG8_WAIT_L(0); PG8_MMA(0, 0, At, B0); PG8_BAR; PG8_SCHED;
            PG8_LDB(B1, 1, 1); PG8_STAGE(PG8_SB(1, 0), b3, voffB);
            PG8_BAR; PG8_WAIT_L(0); PG8_MMA(0, 1, At, B1); PG8_BAR;
            PG8_LDA(At, 1, 1); PG8_STAGE(PG8_SA(1, 0), a3, voffA);
            PG8_BAR; PG8_WAIT_L(0); PG8_MMA(1, 0, At, B0); PG8_BAR; PG8_SCHED;
            PG8_STAGE(PG8_SB(1, 1), b3 + hstep, voffB);
            PG8_WAIT_V(6); PG8_BAR; PG8_MMA(1, 1, At, B1); PG8_BAR;
            }
        }
        if constexpr (ALIGN_EPI) { if (wr == 0) PG8_BAR; }
        if constexpr (!Epi::AFTER_DRAIN) { E(acc, cur, wr, wc, fr, fq); S.done(cur); }
        if (!has_next) break;
#pragma unroll
        for (int a = 0; a < 2; ++a)
#pragma unroll
            for (int b = 0; b < 2; ++b)
#pragma unroll
                for (int m = 0; m < 4; ++m)
#pragma unroll
                    for (int n = 0; n < 2; ++n) acc[a][b][m][n] = (f32x4){0.f, 0.f, 0.f, 0.f};
        cur = nxt; cA = nA; cB = nB; ++ui;
        if constexpr (ALIGN_EPI) { if (wr == 1) PG8_BAR; }
    }
    PG8_WAIT_V(0);
    if constexpr (!ALIGN_EPI) { if (wr == 0) PG8_BAR; }
    PG8_BAR;
    if constexpr (Epi::AFTER_DRAIN) { E.fused(acc, cur, wr, wc, fr, fq, lds, wid, lane); S.done(cur); }
#undef PG8_SA
#undef PG8_SB
#undef PG8_STAGE
#undef PG8_LDA
#undef PG8_LDB
#undef PG8_MMA
#undef PG8_WAIT_V
#undef PG8_WAIT_L
#undef PG8_BAR
#undef PG8_SCHED
}
}
namespace att {
using bf16 = unsigned short;
typedef short bf16x8 __attribute__((ext_vector_type(8)));
typedef short s16x4 __attribute__((ext_vector_type(4)));
typedef float f32x16 __attribute__((ext_vector_type(16)));
typedef float f32x4 __attribute__((ext_vector_type(4)));
typedef unsigned u32x4 __attribute__((ext_vector_type(4)));
constexpr int D = 128, NW = 8, QBLK = 32, KVBLK = 64, QB = NW * QBLK;
constexpr int SHM_V = KVBLK * D * 2, SHM_K = KVBLK * D * 2;
constexpr int LDS_BYTES = 2 * SHM_V + 2 * SHM_K + NW * 64 * 4;
#define KSWZ(row, colB) ((row) * 256 + ((colB) ^ (((row) & 7) << 4)))
#define SBAR() __builtin_amdgcn_sched_barrier(0)
__device__ __forceinline__ int v_st(int k, int c) { const int kk = (k & ~0xC) | ((k & 4) << 1) | ((k & 8) >> 1); return ((kk >> 3) * 4 + (c >> 5)) * 512 + ((kk & 7) * 32 + (c & 31)) * 2; }
__device__ __forceinline__ int v_rd_base(int lane) { return ((lane & 3) << 3) | (((lane >> 2) & 3) << 6) | (((lane >> 4) & 1) << 5) | (((lane >> 5) & 1) << 8); }
constexpr int v_rd_off(int d0, int ks, int half) { return d0 * 512 + ks * 4096 + half * 2048; }
__device__ __forceinline__ int crow(int r, int hi) { return (r & 3) + 8 * (r >> 2) + 4 * hi; }
__device__ __forceinline__ unsigned cvtpk(float lo, float hi) { unsigned r; asm volatile("v_cvt_pk_bf16_f32 %0, %1, %2" : "=v"(r) : "v"(lo), "v"(hi)); return r; }
__device__ __forceinline__ bf16x8 load8(const bf16* p) { return *reinterpret_cast<const bf16x8*>(p); }

#define PK4(P, B_, OUT) do { unsigned a0 = cvtpk(P[B_+0], P[B_+1]), a1 = cvtpk(P[B_+2], P[B_+3]);                          \
        unsigned b0 = cvtpk(P[B_+4], P[B_+5]), b1 = cvtpk(P[B_+6], P[B_+7]);                                             \
        auto r0 = __builtin_amdgcn_permlane32_swap(a0, b0, false, false); auto r1 = __builtin_amdgcn_permlane32_swap(a1, b1, false, false); \
        u32x4 w = {r0[0], r1[0], r0[1], r1[1]}; OUT = *reinterpret_cast<bf16x8*>(&w); } while (0)

__device__ __forceinline__ void qkt_rt(f32x16& p0, f32x16& p1, const char* Kt, int r32, int hi, const bf16x8* qr) {
    p0 = f32x16{}; p1 = f32x16{};
    const char* kb[4];
#pragma unroll
    for (int dd = 0; dd < 4; ++dd) kb[dd] = Kt + KSWZ(r32, (dd * 16 + hi * 8) * 2);
#pragma unroll
    for (int d0 = 0; d0 < 8; ++d0) { const char* a = kb[d0 & 3] + (d0 >> 2) * 128;
        bf16x8 b0 = *reinterpret_cast<const bf16x8*>(a);
        bf16x8 b1 = *reinterpret_cast<const bf16x8*>(a + 32 * 256);
        p0 = __builtin_amdgcn_mfma_f32_32x32x16_bf16(b0, qr[d0], p0, 0, 0, 0);
        p1 = __builtin_amdgcn_mfma_f32_32x32x16_bf16(b1, qr[d0], p1, 0, 0, 0); }
}
__device__ __forceinline__ void pv_rt(f32x16* o, int vb, bf16x8 pa0, bf16x8 pa1, bf16x8 pa2, bf16x8 pa3) {
#define TRRD(dst, off) asm volatile("ds_read_b64_tr_b16 %0, %1 offset:%2" : "=&v"(dst) : "v"(vb), "i"(off) : "memory")
#define PV_D0(d0) do { s16x4 l0, l1, l2, l3, h0, h1, h2, h3; constexpr int b_ = v_rd_off(d0, 0, 0); \
        TRRD(l0, b_); TRRD(h0, b_ + 2048); TRRD(l1, b_ + 4096); TRRD(h1, b_ + 6144); TRRD(l2, b_ + 8192); TRRD(h2, b_ + 10240); TRRD(l3, b_ + 12288); TRRD(h3, b_ + 14336); \
        asm volatile("s_waitcnt lgkmcnt(0)" ::: "memory"); SBAR();   \
        o[d0] = __builtin_amdgcn_mfma_f32_32x32x16_bf16(pa0, (bf16x8){l0[0], l0[1], l0[2], l0[3], h0[0], h0[1], h0[2], h0[3]}, o[d0], 0, 0, 0);   \
        o[d0] = __builtin_amdgcn_mfma_f32_32x32x16_bf16(pa1, (bf16x8){l1[0], l1[1], l1[2], l1[3], h1[0], h1[1], h1[2], h1[3]}, o[d0], 0, 0, 0);   \
        o[d0] = __builtin_amdgcn_mfma_f32_32x32x16_bf16(pa2, (bf16x8){l2[0], l2[1], l2[2], l2[3], h2[0], h2[1], h2[2], h2[3]}, o[d0], 0, 0, 0);   \
        o[d0] = __builtin_amdgcn_mfma_f32_32x32x16_bf16(pa3, (bf16x8){l3[0], l3[1], l3[2], l3[3], h3[0], h3[1], h3[2], h3[3]}, o[d0], 0, 0, 0); } while (0)
    PV_D0(0); PV_D0(1); PV_D0(2); PV_D0(3);
#undef PV_D0
#undef TRRD
}

constexpr float SB_DONE = 1e-30f;
__device__ __forceinline__ void sb_half(f32x16& p, float& carry, int dq, bool needmask, bool lane_hi) {
    float kp[16];
#pragma unroll
    for (int r = 0; r < 16; ++r) {
        const float zz = fminf(p[r], 100.f);
        const float e = __builtin_amdgcn_exp2f(zz);
        float k = __builtin_amdgcn_rcpf(1.f + e);
        float be = e * k;
        if (needmask) { const int c = 8 * (r >> 2) + (r & 3); const bool valid = (dq - c) > 0; k = valid ? k : 1.f; be = valid ? be : 0.f; }
        kp[r] = k; p[r] = be;
    }
    float L[4], H[4];
#pragma unroll
    for (int j = 0; j < 4; ++j) { const float g = (kp[4 * j] * kp[4 * j + 1]) * (kp[4 * j + 2] * kp[4 * j + 3]);
        auto rr = __builtin_amdgcn_permlane32_swap(__float_as_uint(g), __float_as_uint(g), false, false);
        L[j] = __uint_as_float(rr[0]); H[j] = __uint_as_float(rr[1]); }
    float U[4]; U[3] = 1.f; U[2] = L[3] * H[3]; U[1] = U[2] * (L[2] * H[2]); U[0] = U[1] * (L[1] * H[1]);
    const float tot = U[0] * (L[0] * H[0]);
#pragma unroll
    for (int j = 0; j < 4; ++j) {
        const float a3 = carry * U[j] * (lane_hi ? 1.f : H[j]);
        const float a2 = a3 * kp[4 * j + 3], a1 = a2 * kp[4 * j + 2], a0 = a1 * kp[4 * j + 1];
        p[4 * j + 3] *= a3; p[4 * j + 2] *= a2; p[4 * j + 1] *= a1; p[4 * j] *= a0;
    }
    carry *= tot;
}

template <int PQ, int PK, int PV, int PO>
__device__ __forceinline__ void sb_block(const bf16* Q, const bf16* K, const bf16* V, bf16* O, int P0, char* lds, volatile __attribute__((address_space(3))) unsigned* flags) {
    const int tid = threadIdx.x, wid = __builtin_amdgcn_readfirstlane(tid >> 6), lane = tid & 63, r32 = lane & 31, hi = lane >> 5;
    char* K_lds = lds; char* V_lds = lds + 2 * SHM_K;
    const int sr = tid >> 4, sc = (tid & 15) * 8, vst0 = v_st(sr, sc), vst1 = v_st(32 + sr, sc), kws = KSWZ(sr, sc * 2);
    const int vb0 = (int)(uintptr_t)V_lds + v_rd_base(lane);
    bf16x8 qr[8];
#pragma unroll
    for (int d0 = 0; d0 < 8; ++d0) qr[d0] = load8(Q + (size_t)(wid * QBLK + r32) * PQ + d0 * 16 + hi * 8);
    f32x16 o[4] = {};
    float carry = 1.f;
    const int qlo = P0 + wid * QBLK, qpos = qlo + r32;
    int j = P0 / KVBLK + 3;
    bf16x8 st_k0, st_k1, st_v0, st_v1;
#define SB_LOAD(jt) do { const size_t k0_ = (size_t)(jt) * KVBLK; st_k0 = load8(K + (k0_ + sr) * PK + sc); st_k1 = load8(K + (k0_ + 32 + sr) * PK + sc); \
                         st_v0 = load8(V + (k0_ + sr) * PV + sc); st_v1 = load8(V + (k0_ + 32 + sr) * PV + sc); } while (0)
#define SB_WRITE(bf) do { *(bf16x8*)(K_lds + (bf) * SHM_K + kws) = st_k0; *(bf16x8*)(K_lds + (bf) * SHM_K + kws + 32 * 256) = st_k1; \
                          *(bf16x8*)(V_lds + (bf) * SHM_V + vst0) = st_v0; *(bf16x8*)(V_lds + (bf) * SHM_V + vst1) = st_v1; } while (0)
    SB_LOAD(j); asm volatile("s_waitcnt vmcnt(0)" ::: "memory"); SB_WRITE(0);
    __syncthreads();
    int buf = 0, it = 0; bool wdone = false;
    for (;;) {
        const int kb = j * KVBLK; const bool more = j > 0;
        if (more) SB_LOAD(j - 1);
        const bool act = !wdone && (kb < qlo + QBLK - 1);
        if (act) {
            f32x16 p0, p1;
            qkt_rt(p0, p1, K_lds + buf * SHM_K, r32, hi, qr);
            const bool needmask = kb + KVBLK - 1 >= qlo;
            sb_half(p1, carry, qpos - (kb + 32) - 4 * hi, needmask, hi != 0);
            sb_half(p0, carry, qpos - kb - 4 * hi, needmask, hi != 0);
            bf16x8 pa0, pa1, pa2, pa3;
            PK4(p0, 0, pa0); PK4(p0, 8, pa1); PK4(p1, 0, pa2); PK4(p1, 8, pa3);
            SBAR();
            pv_rt(o, vb0 + buf * SHM_V, pa0, pa1, pa2, pa3);
            wdone = __all(carry < SB_DONE);
        }
        if (more) { asm volatile("s_waitcnt vmcnt(0)" ::: "memory"); SB_WRITE(buf ^ 1); }
        if (lane == 0) flags[(it & 1) * 8 + wid] = wdone ? 1u : 0u;
        __syncthreads();
        unsigned alld = 1u;
#pragma unroll
        for (int w = 0; w < NW; ++w) alld &= flags[(it & 1) * 8 + w];
        if (!more || alld) break;
        --j; buf ^= 1; ++it;
    }
#undef SB_LOAD
#undef SB_WRITE
    bf16* Ow = O + (size_t)(wid * QBLK) * PO;
#pragma unroll
    for (int r = 0; r < 16; ++r) { const int orow = crow(r, hi);
#pragma unroll
        for (int d0 = 0; d0 < 4; ++d0) { const float v = o[d0][r]; const float vn = __shfl_xor(v, 1);
            if ((r32 & 1) == 0) *(unsigned*)(Ow + (size_t)orow * PO + d0 * 32 + r32) = cvtpk(v, vn); } }
    __syncthreads();
}

constexpr float THR2 = 8.f * 1.4426950408889634f;
struct DiffRef { const bf16* Q; const bf16* K; const bf16* V; bf16* O; int P0; int mode; };
struct DiffConst { float lam; float omli; float eps; const float* gain; float* scr; };
template <int PQ, int PK, int PV, int PO>
__device__ __forceinline__ void sm_block(const DiffRef& cur, const DiffConst& C, char* lds) {
    const int tid = threadIdx.x, wid = __builtin_amdgcn_readfirstlane(tid >> 6), lane = tid & 63, r32 = lane & 31, hi = lane >> 5;
    char* K_lds = lds; char* V_lds = lds + 2 * SHM_K; float* al_l = (float*)(lds + 2 * SHM_K + 2 * SHM_V) + wid * 32;
    const int sr = tid >> 4, sc = (tid & 15) * 8, vst0 = v_st(sr, sc), vst1 = v_st(32 + sr, sc), kws = KSWZ(sr, sc * 2);
    const int vb0 = (int)(uintptr_t)V_lds + v_rd_base(lane);
    const bf16* Q = cur.Q; const bf16* K = cur.K; const bf16* V = cur.V; const int P0 = cur.P0;
    bf16x8 qr[8];
#pragma unroll
    for (int d0 = 0; d0 < 8; ++d0) qr[d0] = load8(Q + (size_t)(wid * QBLK + r32) * PQ + d0 * 16 + hi * 8);
    f32x16 o[4] = {};
    float m_reg = -1e30f, l_reg = 0.f;
    const int qlo = P0 + wid * QBLK, qm = qlo + r32 - 4 * hi;
    const int NT = P0 / KVBLK + 4;
    bf16x8 st_k0, st_k1, st_v0, st_v1;
#define SM_LOAD(jt) do { const size_t k0_ = (size_t)(jt) * KVBLK; st_k0 = load8(K + (k0_ + sr) * PK + sc); st_k1 = load8(K + (k0_ + 32 + sr) * PK + sc); \
                         st_v0 = load8(V + (k0_ + sr) * PV + sc); st_v1 = load8(V + (k0_ + 32 + sr) * PV + sc); } while (0)
#define SM_WRITE(bf) do { *(bf16x8*)(K_lds + (bf) * SHM_K + kws) = st_k0; *(bf16x8*)(K_lds + (bf) * SHM_K + kws + 32 * 256) = st_k1; \
                          *(bf16x8*)(V_lds + (bf) * SHM_V + vst0) = st_v0; *(bf16x8*)(V_lds + (bf) * SHM_V + vst1) = st_v1; } while (0)
    SM_LOAD(0); asm volatile("s_waitcnt vmcnt(0)" ::: "memory"); SM_WRITE(0);
    __syncthreads();
    int buf = 0;
    for (int t = 0; t < NT; ++t) {
        const int kb = t * KVBLK; const bool more = t + 1 < NT;
        if (more) SM_LOAD(t + 1);
        if (kb <= qlo + QBLK - 1) {
            f32x16 p0, p1;
            qkt_rt(p0, p1, K_lds + buf * SHM_K, r32, hi, qr);
            if (kb + KVBLK - 1 > qlo) {
                const int dq = qm - kb; const float NEG = -__builtin_inff();
#pragma unroll
                for (int r = 0; r < 16; ++r) { const int c = (r & 3) + 8 * (r >> 2); if ((dq - c) < 0) p0[r] = NEG; if ((dq - c - 32) < 0) p1[r] = NEG; }
            }
            float pmax = p0[0];
#pragma unroll
            for (int r = 1; r < 16; ++r) pmax = fmaxf(pmax, p0[r]);
#pragma unroll
            for (int r = 0; r < 16; ++r) pmax = fmaxf(pmax, p1[r]);
            { auto rr = __builtin_amdgcn_permlane32_swap(__float_as_uint(pmax), __float_as_uint(pmax), false, false); pmax = fmaxf(__uint_as_float(rr[0]), __uint_as_float(rr[1])); }
            float alpha = 1.f;
            if (!__all((pmax - m_reg) <= THR2)) {
                const float mn = fmaxf(m_reg, pmax); alpha = __builtin_amdgcn_exp2f(m_reg - mn); m_reg = mn;
                if (hi == 0) al_l[r32] = alpha; asm volatile("s_waitcnt lgkmcnt(0)" ::: "memory");
#pragma unroll
                for (int d_ = 0; d_ < 4; ++d_)
#pragma unroll
                    for (int r = 0; r < 16; ++r) o[d_][r] *= al_l[crow(r, hi)];
            }
            float ps = 0.f;
#pragma unroll
            for (int r = 0; r < 16; ++r) { p0[r] = __builtin_amdgcn_exp2f(p0[r] - m_reg); ps += p0[r]; }
#pragma unroll
            for (int r = 0; r < 16; ++r) { p1[r] = __builtin_amdgcn_exp2f(p1[r] - m_reg); ps += p1[r]; }
            { auto rr = __builtin_amdgcn_permlane32_swap(__float_as_uint(ps), __float_as_uint(ps), false, false); ps = __uint_as_float(rr[0]) + __uint_as_float(rr[1]); }
            l_reg = l_reg * alpha + ps;
            bf16x8 pa0, pa1, pa2, pa3;
            PK4(p0, 0, pa0); PK4(p0, 8, pa1); PK4(p1, 0, pa2); PK4(p1, 8, pa3);
            SBAR();
            pv_rt(o, vb0 + buf * SHM_V, pa0, pa1, pa2, pa3);
        }
        if (more) { asm volatile("s_waitcnt vmcnt(0)" ::: "memory"); SM_WRITE(buf ^ 1); }
        __syncthreads();
        buf ^= 1;
    }
#undef SM_LOAD
#undef SM_WRITE
    if (hi == 0) al_l[r32] = l_reg; asm volatile("s_waitcnt lgkmcnt(0)" ::: "memory");
    float rli[16];
#pragma unroll
    for (int r = 0; r < 16; ++r) rli[r] = __builtin_amdgcn_rcpf(al_l[crow(r, hi)]);
#define OPQ(v) asm volatile("" : "+v"(v))
    char* sA = (char*)C.scr; char* sB = sA + 16384;
    const unsigned lo16 = (unsigned)lane * 16u;
    const int mode = cur.mode;
    if (mode == 0 || mode == 1) { char* s = mode ? sB : sA;
#pragma unroll
        for (int r = 0; r < 16; ++r) { unsigned vo = lo16; OPQ(vo);
            const f32x4 v = {o[0][r] * rli[r], o[1][r] * rli[r], o[2][r] * rli[r], o[3][r] * rli[r]};
            *(f32x4*)(s + (size_t)(vo + r * 1024)) = v; }
    } else if (mode == 2) {
#pragma unroll
        for (int r = 0; r < 16; ++r) { unsigned vo = lo16; OPQ(vo);
            f32x4* ap = (f32x4*)(sA + (size_t)(vo + r * 1024)); const f32x4 a = *ap;
            const f32x4 v = {a[0] - C.lam * (o[0][r] * rli[r]), a[1] - C.lam * (o[1][r] * rli[r]), a[2] - C.lam * (o[2][r] * rli[r]), a[3] - C.lam * (o[3][r] * rli[r])};
            *ap = v;
            if ((r & 3) == 3) asm volatile("" ::: "memory"); }
    } else {
        float g0[4], g1[4];
#pragma unroll
        for (int d0 = 0; d0 < 4; ++d0) { g0[d0] = C.gain[d0 * 32 + r32]; g1[d0] = C.gain[128 + d0 * 32 + r32]; }
        char* Ow = (char*)(cur.O + (size_t)(wid * QBLK) * PO);
        const unsigned lo_o = (unsigned)((4 * hi) * PO + r32) * 2u;
#pragma unroll
        for (int r = 0; r < 16; ++r) { unsigned vo = lo16; OPQ(vo);
            const f32x4 a = *(const f32x4*)(sA + (size_t)(vo + r * 1024)); const f32x4 b = *(const f32x4*)(sB + (size_t)(vo + r * 1024));
            float d1[4], ss = 0.f;
#pragma unroll
            for (int d0 = 0; d0 < 4; ++d0) { d1[d0] = b[d0] - C.lam * (o[d0][r] * rli[r]); ss += d1[d0] * d1[d0] + a[d0] * a[d0]; }
            ss += __shfl_xor(ss, 1); ss += __shfl_xor(ss, 2); ss += __shfl_xor(ss, 4); ss += __shfl_xor(ss, 8); ss += __shfl_xor(ss, 16);
            const float scl = rsqrtf(ss * (1.f / 256.f) + C.eps) * C.omli;
            unsigned wo = lo_o; OPQ(wo);
            char* rowp = Ow + (size_t)(wo + (unsigned)(((r & 3) + 8 * (r >> 2)) * PO * 2));
#pragma unroll
            for (int d0 = 0; d0 < 4; ++d0) {
                const float v0 = a[d0] * scl * g0[d0], v1 = d1[d0] * scl * g1[d0];
                const float v0n = __shfl_xor(v0, 1), v1n = __shfl_xor(v1, 1);
                if ((r32 & 1) == 0) { *(unsigned*)(rowp + d0 * 64) = cvtpk(v0, v0n); *(unsigned*)(rowp + 256 + d0 * 64) = cvtpk(v1, v1n); }
            }
            if ((r & 1) == 1) asm volatile("" ::: "memory");
        }
    }
#undef OPQ
    __syncthreads();
}
}
#ifndef PG8_SP2
#define PG8_SP2 true
#endif
#ifndef PG8_ALIGN
#define PG8_ALIGN true
#endif
#ifndef MK_SPLIT
#define MK_SPLIT 0
#endif
#ifndef MK_CHECK
#define MK_CHECK 0
#endif
constexpr int NWAVES = 8;
constexpr int BATCH = 2, SEQ = 4096, DM = 4096, MROWS = BATCH * SEQ, FF = 11008, FF2 = 2 * FF, NQKV = 3 * DM;
constexpr int SB_H = 32, DF_H = 16, HD = 128;
constexpr float RMS_EPS = 1e-6f;
constexpr float LOG2E = 1.4426950408889634f;
constexpr float QSCALE = 0.08838834764831845f * LOG2E;
constexpr int NPH = 14;
constexpr size_t MiB = 1u << 20;
constexpr size_t WS_CTL = 0, CTL_ZERO_BYTES = 1 * MiB;
constexpr size_t WS_WQKV0 = 2 * MiB;
constexpr size_t WS_WO0   = WS_WQKV0 + 96 * MiB;
constexpr size_t WS_WQKV1 = WS_WO0 + 32 * MiB;
constexpr size_t WS_WO1   = WS_WQKV1 + 96 * MiB;
constexpr size_t WS_WUP0  = WS_WO1 + 32 * MiB;
constexpr size_t WS_WUP1  = WS_WUP0 + 172 * MiB;
constexpr size_t WS_WDN0  = WS_WUP1 + 172 * MiB;
constexpr size_t WS_WDN1  = WS_WDN0 + 86 * MiB;
constexpr size_t WS_XN    = WS_WDN1 + 86 * MiB;
constexpr size_t WS_PART  = WS_XN + 64 * MiB;
constexpr size_t WS_QKV   = WS_PART + 2 * MiB;
constexpr size_t WS_QKN   = WS_QKV + 192 * MiB;
constexpr size_t WS_AO    = WS_QKN + 128 * MiB;
constexpr size_t WS_U     = WS_AO + 64 * MiB;
constexpr size_t WS_ACT   = WS_U + 344 * MiB;
constexpr size_t WS_SCR   = WS_ACT + 172 * MiB;
constexpr size_t WS_X1    = WS_SCR + 64 * MiB;
constexpr size_t WS_END   = WS_X1 + (MK_CHECK ? 3 * 128 * MiB : 0);
constexpr int CW_TMO = 0, CW_CODE = 1, CW_FAIL = 2, CW_BAR = 4096;

constexpr int RING_OFF = 0, RING_BYTES = 131072;
constexpr int LDSCTL_OFF = RING_BYTES, MISC_OFF = LDSCTL_OFF + 320;
constexpr int LDS_BYTES = 147456;
static_assert(MISC_OFF + 128 <= LDS_BYTES, "LDS map");

#define GAS __attribute__((address_space(1)))
#define LAS __attribute__((address_space(3)))
typedef unsigned short bf16;
typedef unsigned v4u __attribute__((ext_vector_type(4)));
typedef unsigned v2u __attribute__((ext_vector_type(2)));
typedef float f32x4 __attribute__((ext_vector_type(4)));
typedef short bf16x8 __attribute__((ext_vector_type(8)));
typedef GAS unsigned gu32;
#define RLX_AGENT __ATOMIC_RELAXED, __HIP_MEMORY_SCOPE_AGENT
#define LDS_WAIT() asm volatile("s_waitcnt lgkmcnt(0)" ::: "memory")
#define VM_WAIT() asm volatile("s_waitcnt vmcnt(0)" ::: "memory")
__device__ __forceinline__ unsigned f2bf(float f) { unsigned u = __builtin_bit_cast(unsigned, f); return (u + 0x7fffu + ((u >> 16) & 1u)) >> 16; }
__device__ __forceinline__ unsigned pk2(float lo, float hi) { return f2bf(lo) | (f2bf(hi) << 16); }
__device__ __forceinline__ float bf2f(unsigned short b) { return __builtin_bit_cast(float, (unsigned)b << 16); }

#define XB_TMO      128
#define XB_XCNT(j)  (256  + 64 * (j))
#define XB_XSUB(j)  (1280 + 64 * (j))
#define XB_XGEN(j)  (2304 + 64 * (j))
#define XB_TOP      3328
#define XB_TOPGEN   3392
#define XCD_BAR_WORDS 3456
#define XB_SPIN_CAP (1u << 18)
__device__ __forceinline__ unsigned xb_ld(unsigned* p)              { return __hip_atomic_load(p, __ATOMIC_RELAXED, __HIP_MEMORY_SCOPE_AGENT); }
__device__ __forceinline__ unsigned xb_add(unsigned* p, unsigned v) { return __hip_atomic_fetch_add(p, v, __ATOMIC_RELAXED, __HIP_MEMORY_SCOPE_AGENT); }
__device__ __forceinline__ unsigned xb_xcc_id() { return (unsigned)__builtin_amdgcn_s_getreg((3 << 11) | 20) & 0xFu; }
#define XB_SPIN(cond, bar) do { unsigned _sp = 0; while (cond) { __builtin_amdgcn_s_sleep(1); \
    if ((++_sp & 255u) == 0u) { if (xb_ld(&(bar)[XB_TMO])) break; if (_sp > XB_SPIN_CAP) { atomicAdd(&(bar)[XB_TMO], 1u); break; } } } } while (0)
struct XcdBarrier { unsigned* bar; unsigned x; volatile LAS unsigned* st; };
__device__ __forceinline__ XcdBarrier xcd_barrier_post(unsigned* bar, volatile LAS unsigned* st) {
    XcdBarrier b; b.bar = bar; b.x = xb_xcc_id(); b.st = st;
    if (threadIdx.x == 0) (void)xb_add(&bar[XB_XCNT(b.x)], 1u);
    return b;
}
__device__ __forceinline__ void xcd_barrier_complete(unsigned* bar, unsigned x, unsigned& nloc, unsigned& nx) {
    const unsigned G = gridDim.x * gridDim.y * gridDim.z;
    unsigned sum, cnt, mine, sp = 0u;
    for (;;) {
        sum = 0u; cnt = 0u; mine = 0u;
#pragma unroll
        for (unsigned j = 0; j < 16; ++j) { const unsigned c = xb_ld(&bar[XB_XCNT(j)]); sum += c; cnt += (c > 0u) ? 1u : 0u; mine = (j == x) ? c : mine; }
        if (sum == G) break;
        __builtin_amdgcn_s_sleep(1);
        if ((++sp & 255u) == 0u) { if (xb_ld(&bar[XB_TMO])) break; if (sp > XB_SPIN_CAP) { atomicAdd(&bar[XB_TMO], 1u); break; } }
    }
    nloc = mine > 0u ? mine : 1u; nx = cnt > 0u ? cnt : 1u;
}
__device__ __forceinline__ void xcd_barrier(const XcdBarrier& b) {
    asm volatile("s_waitcnt vmcnt(0)" ::: "memory");
    __syncthreads();
    if (threadIdx.x == 0) {
        unsigned* bar = b.bar;
        __builtin_amdgcn_s_waitcnt(0);
        unsigned nloc = b.st[0], nx = b.st[1];
        if (nloc == 0u) { xcd_barrier_complete(bar, b.x, nloc, nx); b.st[0] = nloc; b.st[1] = nx; }
        const unsigned old = xb_add(&bar[XB_XSUB(b.x)], 1u);
        const unsigned gen = old / nloc;
        if (old + 1u == (gen + 1u) * nloc) {
            __builtin_amdgcn_fence(__ATOMIC_RELEASE, "agent");
            asm volatile("s_waitcnt vmcnt(0)" ::: "memory");
            const unsigned og = xb_add(&bar[XB_TOP], 1u);
            const unsigned tg = og / nx;
            if (og + 1u == (tg + 1u) * nx) xb_add(&bar[XB_TOPGEN], 1u);
            else XB_SPIN(xb_ld(&bar[XB_TOPGEN]) == tg, bar);
            __builtin_amdgcn_fence(__ATOMIC_ACQUIRE, "agent");
            xb_add(&bar[XB_XGEN(b.x)], 1u);
            asm volatile("s_waitcnt vmcnt(0)" ::: "memory");
        } else {
            XB_SPIN(xb_ld(&bar[XB_XGEN(b.x)]) == gen, bar);
            __builtin_amdgcn_fence(__ATOMIC_ACQUIRE, "agent");
            asm volatile("s_waitcnt vmcnt(0)" ::: "memory");
        }
    }
    __syncthreads();
}

__device__ __forceinline__ float wave_sum(float v) {
#pragma unroll
    for (int o = 1; o < 64; o <<= 1) v += __shfl_xor(v, o);
    return v;
}

constexpr int TR_STRIDE = 33;
__device__ __forceinline__ void transpose_item(const float* W, const float* gain, int K, int N, bf16* WT, LAS unsigned* scr, int item, int lane) {
    const int nblk = N / 64, kb = item / nblk, nb = item % nblk, k0 = 64 * kb, n0 = 64 * nb;
    const int kp = lane >> 4, c = lane & 15;
    f32x4 va[8], vb[8];
#pragma unroll
    for (int i = 0; i < 8; ++i) { const GAS float* src = (const GAS float*)W + (size_t)(k0 + 8 * i + 2 * kp) * N + n0 + 4 * c; va[i] = *(const GAS f32x4*)src; vb[i] = *(const GAS f32x4*)(src + N); }
#pragma unroll
    for (int i = 0; i < 8; ++i) { float ga = 1.f, gb = 1.f; if (gain) { ga = gain[k0 + 8 * i + 2 * kp]; gb = gain[k0 + 8 * i + 2 * kp + 1]; }
        LAS unsigned* d = scr + (4 * c) * TR_STRIDE + 4 * i + kp;
        d[0 * TR_STRIDE] = pk2(va[i].x * ga, vb[i].x * gb); d[1 * TR_STRIDE] = pk2(va[i].y * ga, vb[i].y * gb);
        d[2 * TR_STRIDE] = pk2(va[i].z * ga, vb[i].z * gb); d[3 * TR_STRIDE] = pk2(va[i].w * ga, vb[i].w * gb); }
    LDS_WAIT(); asm volatile("" ::: "memory");
    const int c8 = lane & 7, nr = lane >> 3;
#pragma unroll
    for (int j = 0; j < 8; ++j) { const int n = nr + 8 * j; const LAS unsigned* s = scr + n * TR_STRIDE + 4 * c8;
        v4u o; o.x = s[0]; o.y = s[1]; o.z = s[2]; o.w = s[3];
        *(GAS v4u*)(WT + (size_t)(n0 + n) * K + k0 + 8 * c8) = o; }
    LDS_WAIT(); asm volatile("" ::: "memory");
}
__device__ __forceinline__ void xrow_to_bf16(const float* xrow, bf16* orow, float* prow, int lane) {
    const GAS f32x4* xr = (const GAS f32x4*)xrow + lane;
    float s = 0.f; GAS unsigned long long* o8 = (GAS unsigned long long*)orow + lane;
#pragma unroll
    for (int j = 0; j < 16; ++j) { const f32x4 v = xr[64 * j]; s += (v.x * v.x + v.y * v.y) + (v.z * v.z + v.w * v.w);
        o8[64 * j] = (unsigned long long)pk2(v.x, v.y) | ((unsigned long long)pk2(v.z, v.w) << 32); }
    s = wave_sum(s);
    prow[lane] = lane == 0 ? s : 0.f;
}

__device__ __forceinline__ void cvt8(const v4u w, float (&f)[8]) {
    f[0] = __builtin_bit_cast(float, w.x << 16); f[1] = __builtin_bit_cast(float, w.x & 0xffff0000u); f[2] = __builtin_bit_cast(float, w.y << 16); f[3] = __builtin_bit_cast(float, w.y & 0xffff0000u);
    f[4] = __builtin_bit_cast(float, w.z << 16); f[5] = __builtin_bit_cast(float, w.z & 0xffff0000u); f[6] = __builtin_bit_cast(float, w.w << 16); f[7] = __builtin_bit_cast(float, w.w & 0xffff0000u);
}
constexpr int CG_ROWS = 32, CG_NCG = FF / 8, CG_ITEMS = (MROWS / CG_ROWS) * CG_NCG;
__device__ __forceinline__ void convgate_item(const bf16* U, const float* cw, const float* cb, bf16* ACT, int item) {
    const int chunk = item / CG_NCG, cg = item % CG_NCG, m0 = chunk * CG_ROWS, t0 = m0 % SEQ, j0 = cg * 8;
    float wg[3][8], wv[3][8], bg[8], bv[8];
#pragma unroll
    for (int i = 0; i < 3; ++i)
#pragma unroll
        for (int h = 0; h < 2; ++h) { const f32x4 a = *(const f32x4*)(cw + (size_t)i * FF2 + j0 + 4 * h), b = *(const f32x4*)(cw + (size_t)i * FF2 + FF + j0 + 4 * h);
            wg[i][4 * h] = a.x; wg[i][4 * h + 1] = a.y; wg[i][4 * h + 2] = a.z; wg[i][4 * h + 3] = a.w; wv[i][4 * h] = b.x; wv[i][4 * h + 1] = b.y; wv[i][4 * h + 2] = b.z; wv[i][4 * h + 3] = b.w; }
#pragma unroll
    for (int h = 0; h < 2; ++h) { const f32x4 a = *(const f32x4*)(cb + j0 + 4 * h), b = *(const f32x4*)(cb + FF + j0 + 4 * h);
        bg[4 * h] = a.x; bg[4 * h + 1] = a.y; bg[4 * h + 2] = a.z; bg[4 * h + 3] = a.w; bv[4 * h] = b.x; bv[4 * h + 1] = b.y; bv[4 * h + 2] = b.z; bv[4 * h + 3] = b.w; }
    float g2[8], g1[8], v2[8], v1[8];
    const v4u z4 = {0u, 0u, 0u, 0u};
    { const v4u a = t0 >= 2 ? *(const GAS v4u*)(U + (size_t)(m0 - 2) * FF2 + j0) : z4, b = t0 >= 2 ? *(const GAS v4u*)(U + (size_t)(m0 - 2) * FF2 + FF + j0) : z4; cvt8(a, g2); cvt8(b, v2); }
    { const v4u a = t0 >= 1 ? *(const GAS v4u*)(U + (size_t)(m0 - 1) * FF2 + j0) : z4, b = t0 >= 1 ? *(const GAS v4u*)(U + (size_t)(m0 - 1) * FF2 + FF + j0) : z4; cvt8(a, g1); cvt8(b, v1); }
#pragma unroll 4
    for (int r = 0; r < CG_ROWS; ++r) {
        float g0[8], v0[8]; cvt8(*(const GAS v4u*)(U + (size_t)(m0 + r) * FF2 + j0), g0); cvt8(*(const GAS v4u*)(U + (size_t)(m0 + r) * FF2 + FF + j0), v0);
        float o[8];
#pragma unroll
        for (int e = 0; e < 8; ++e) { const float cgv = bg[e] + wg[0][e] * g2[e] + wg[1][e] * g1[e] + wg[2][e] * g0[e]; const float cvv = bv[e] + wv[0][e] * v2[e] + wv[1][e] * v1[e] + wv[2][e] * v0[e];
            const float sg = cgv * __builtin_amdgcn_rcpf(1.f + __builtin_amdgcn_exp2f(-cgv * LOG2E)); o[e] = sg * cvv; g2[e] = g1[e]; g1[e] = g0[e]; v2[e] = v1[e]; v1[e] = v0[e]; }
        v4u w; w.x = pk2(o[0], o[1]); w.y = pk2(o[2], o[3]); w.z = pk2(o[4], o[5]); w.w = pk2(o[6], o[7]);
        *(GAS v4u*)(ACT + (size_t)(m0 + r) * FF + j0) = w;
    }
}

__device__ __forceinline__ void sincos_rev(float ang, float& s, float& c) {
    const float I1 = 0.15915493667125702f, I2 = 6.420638326565253e-09f;
    const float r1 = ang * I1; const float e1 = __builtin_fmaf(ang, I1, -r1); const float r2 = __builtin_fmaf(ang, I2, e1);
    const float fr = (r1 - __builtin_rintf(r1)) + r2;
    s = __builtin_amdgcn_sinf(fr); c = __builtin_amdgcn_cosf(fr);
}
__device__ __forceinline__ void qknorm_row(const bf16* qkv_row, bf16* qkn_row, const float* gq, const float* gk, int t, int lane) {
    const int lp = lane & 31, half = lane >> 5;
    float cs[2], sn[2];
#pragma unroll
    for (int e = 0; e < 2; ++e) { const int i = 2 * lp + e; const float invf = __builtin_amdgcn_exp2f(-(float)i * (13.287712379549449f / 64.f));
        sincos_rev((float)t * invf, sn[e], cs[e]); }
    const float gq0 = gq[2 * lp], gq1 = gq[2 * lp + 1], gq2 = gq[64 + 2 * lp], gq3 = gq[65 + 2 * lp];
    const float gk0 = gk[2 * lp], gk1 = gk[2 * lp + 1], gk2 = gk[64 + 2 * lp], gk3 = gk[65 + 2 * lp];
    for (int it = 0; it < 32; ++it) {
        const int g = 2 * it + half; const bool isq = g < 32; const int col = g * 128 + 2 * lp;
        const unsigned a = *(const GAS unsigned*)(qkv_row + col), b = *(const GAS unsigned*)(qkv_row + col + 64);
        const float x0 = __builtin_bit_cast(float, a << 16), x1 = __builtin_bit_cast(float, a & 0xffff0000u), x2 = __builtin_bit_cast(float, b << 16), x3 = __builtin_bit_cast(float, b & 0xffff0000u);
        float ss = (x0 * x0 + x1 * x1) + (x2 * x2 + x3 * x3);
        ss += __shfl_xor(ss, 1); ss += __shfl_xor(ss, 2); ss += __shfl_xor(ss, 4); ss += __shfl_xor(ss, 8); ss += __shfl_xor(ss, 16);
        const float inv = rsqrtf(ss * (1.f / 128.f) + RMS_EPS);
        const float y0 = x0 * inv * (isq ? gq0 : gk0), y1 = x1 * inv * (isq ? gq1 : gk1), y2 = x2 * inv * (isq ? gq2 : gk2), y3 = x3 * inv * (isq ? gq3 : gk3);
        const float sc = isq ? QSCALE : 1.f;
        const float o0 = (y0 * cs[0] - y2 * sn[0]) * sc, o1 = (y1 * cs[1] - y3 * sn[1]) * sc, o2 = (y2 * cs[0] + y0 * sn[0]) * sc, o3 = (y3 * cs[1] + y1 * sn[1]) * sc;
        *(GAS unsigned*)(qkn_row + col) = pk2(o0, o1); *(GAS unsigned*)(qkn_row + col + 64) = pk2(o2, o3);
    }
}
struct Args { const float* in[18]; float* out; unsigned char* ws; int ph_lo, ph_hi; };
static_assert(sizeof(Args) == 18 * 8 + 8 + 8 + 8, "Args has no padding");

struct MatDesc { int in_idx; size_t in_off; int gain_idx; size_t gain_off; int K, N; size_t ws_off; };
__device__ __forceinline__ MatDesc mat_desc(int i) {
    switch (i) {
    case 0: return MatDesc{2, 0, 1, 0, DM, NQKV, WS_WQKV0};
    case 1: return MatDesc{3, 0, -1, 0, DM, DM, WS_WO0};
    case 2: return MatDesc{14, 0, 13, 0, DM, FF2, WS_WUP0};
    case 3: return MatDesc{17, 0, -1, 0, FF, DM, WS_WDN0};
    case 4: return MatDesc{4, 0, 1, (size_t)DM, DM, NQKV, WS_WQKV1};
    case 5: return MatDesc{5, 0, -1, 0, DM, DM, WS_WO1};
    case 6: return MatDesc{14, (size_t)DM * FF2, 13, (size_t)DM, DM, FF2, WS_WUP1};
    default: return MatDesc{17, (size_t)FF * DM, -1, 0, FF, DM, WS_WDN1};
    }
}

__global__ void __launch_bounds__(NWAVES * 64, 2) mk_fwd(Args args) {
    extern __shared__ __attribute__((aligned(16))) unsigned char lds[];
    LAS unsigned char* ldsl = (LAS unsigned char*)lds;
    volatile LAS unsigned* MISC = (volatile LAS unsigned*)(ldsl + MISC_OFF);
    const int tid = threadIdx.x, lane = tid & 63, wave = __builtin_amdgcn_readfirstlane(tid >> 6);
    const int G = gridDim.x, bx = blockIdx.x;
    const int gw = bx * NWAVES + wave, NGW = G * NWAVES;
    unsigned char* ws = args.ws;
    gu32* ctl = (gu32*)(ws + WS_CTL);
    for (int u = tid; u < (LDS_BYTES - LDSCTL_OFF) / 4; u += NWAVES * 64) ((LAS unsigned*)(ldsl + LDSCTL_OFF))[u] = 0u;
    __syncthreads();
    XcdBarrier bar; bar.bar = (unsigned*)(ctl + CW_BAR); bar.x = 0; bar.st = nullptr;
    const int lo = args.ph_lo, hi = args.ph_hi;
    if (hi - lo > 1) bar = xcd_barrier_post((unsigned*)(ctl + CW_BAR), MISC + 8);
#ifndef PH_MASK
#define PH_MASK 0x3fff
#endif
#define IN(k) (((PH_MASK >> (k)) & 1) && lo <= (k) && (k) < hi)
#define SEAM(k) do { if (IN(k) && IN((k) + 1)) xcd_barrier(bar); } while (0)
#ifndef REPEAT_PHASE
#define REPEAT_PHASE -1
#endif
#ifndef REPEAT_N
#define REPEAT_N 1
#endif
#define NREP(k) (REPEAT_PHASE == (k) ? 1 + REPEAT_N : 1)
    float* DUMMY = (float*)(ws + WS_END);

    bf16* XN = (bf16*)(ws + WS_XN); float* PART = (float*)(ws + WS_PART);
    bf16* QKV = (bf16*)(ws + WS_QKV); bf16* QKN = (bf16*)(ws + WS_QKN); bf16* AO = (bf16*)(ws + WS_AO);
    bf16* U = (bf16*)(ws + WS_U); bf16* ACT = (bf16*)(ws + WS_ACT);
    const float* x_in = args.in[0];
#if MK_CHECK
    float* X1 = (float*)(ws + WS_X1); float* X2 = X1 + (size_t)MROWS * DM; float* X3 = X2 + (size_t)MROWS * DM;
#else
    float* X1 = args.out; float* X2 = args.out; float* X3 = args.out;
#endif

    if (IN(0)) _Pragma("unroll") for (int rep = 0; rep < NREP(0); ++rep) { if (rep) xcd_barrier(bar);
        LAS unsigned* scr = (LAS unsigned*)(ldsl + RING_OFF + wave * 16384);
#pragma unroll 1
        for (int mi = 0; mi < 8; ++mi) { const MatDesc md = mat_desc(mi);
            const float* W = args.in[md.in_idx] + md.in_off; const float* gain = md.gain_idx >= 0 ? args.in[md.gain_idx] + md.gain_off : nullptr;
            bf16* WT = (bf16*)(ws + md.ws_off); const int nitems = (md.K / 64) * (md.N / 64);
            for (int it = gw; it < nitems; it += NGW) transpose_item(W, gain, md.K, md.N, WT, scr, it, lane); }
        for (int m = gw; m < MROWS; m += NGW) xrow_to_bf16(x_in + (size_t)m * DM, XN + (size_t)m * DM, PART + (size_t)m * pg8::NPART, lane);
    }
    SEAM(0);
    if (IN(1)) _Pragma("unroll") for (int rep = 0; rep < NREP(1); ++rep) { if (rep) xcd_barrier(bar);
        pg8::Gemm g{XN, (const bf16*)(ws + WS_WQKV0), MROWS, NQKV, DM}; pg8::StaticOrder S; S.init(MROWS, NQKV, G, bx);
        pg8::EpiScale E{QKV, NQKV, PART, 1.f / DM, RMS_EPS, DM, QSCALE};
        pg8::gemm_phase<pg8::EpiScale, pg8::StaticOrder, PG8_ALIGN, PG8_SP2>(ldsl + RING_OFF, g, S, E);
    }
    SEAM(1);
    if (IN(2)) _Pragma("unroll") for (int rep = 0; rep < NREP(2); ++rep) { if (rep) xcd_barrier(bar);
        constexpr int NBLK = BATCH * SB_H * (SEQ / 256);
        for (int L = bx; L < NBLK; L += G) { const int qb = L % 16, bh = L / 16, b = bh / SB_H, h = bh % SB_H;
            const bf16* kvbase = QKV + (size_t)(b * SEQ) * NQKV + h * HD;
            att::sb_block<NQKV, NQKV, NQKV, DM>(kvbase + (size_t)(qb * 256) * NQKV, kvbase + DM, kvbase + 2 * DM, AO + (size_t)(b * SEQ + qb * 256) * DM + h * HD, qb * 256, (char*)lds + RING_OFF, (volatile LAS unsigned*)(ldsl + RING_OFF + 65536)); }
    }
    SEAM(2);
    if (IN(3)) _Pragma("unroll") for (int rep = 0; rep < NREP(3); ++rep) { if (rep) xcd_barrier(bar);
        pg8::Gemm g{AO, (const bf16*)(ws + WS_WO0), MROWS, DM, DM}; pg8::StaticOrder S; S.init(MROWS, DM, G, bx);
        pg8::EpiResid<true> E{x_in, X1, XN, PART, DM};
        pg8::gemm_phase<pg8::EpiResid<true>, pg8::StaticOrder, PG8_ALIGN, PG8_SP2>(ldsl + RING_OFF, g, S, E);
    }
    SEAM(3);
#define UP_PHASE(WOFF) do { pg8::Gemm g{XN, (const bf16*)(ws + (WOFF)), MROWS, FF2, DM}; pg8::StaticOrder S; S.init(MROWS, FF2, G, bx); \
        pg8::EpiScale E{U, FF2, PART, 1.f / DM, RMS_EPS, 0, 1.f}; \
        pg8::gemm_phase<pg8::EpiScale, pg8::StaticOrder, PG8_ALIGN, PG8_SP2>(ldsl + RING_OFF, g, S, E); } while (0)
#define CG_PHASE(LAYER) do { const float* cw = args.in[15] + (size_t)(LAYER) * 3 * FF2; const float* cb = args.in[16] + (size_t)(LAYER) * FF2; \
        for (int it = bx * (NWAVES * 64) + tid; it < CG_ITEMS; it += G * NWAVES * 64) convgate_item(U, cw, cb, ACT, it); } while (0)
#define DOWN_PHASE(WOFF, BASE, OUT, WITHXN) do { pg8::Gemm g{ACT, (const bf16*)(ws + (WOFF)), MROWS, DM, FF}; pg8::StaticOrder S; S.init(MROWS, DM, G, bx); \
        pg8::EpiResid<WITHXN> E{BASE, OUT, XN, PART, DM}; \
        pg8::gemm_phase<pg8::EpiResid<WITHXN>, pg8::StaticOrder, PG8_ALIGN, PG8_SP2>(ldsl + RING_OFF, g, S, E); } while (0)
    if (IN(4)) _Pragma("unroll") for (int rep = 0; rep < NREP(4); ++rep) { if (rep) xcd_barrier(bar); UP_PHASE(WS_WUP0); }
    SEAM(4);
    if (IN(5)) _Pragma("unroll") for (int rep = 0; rep < NREP(5); ++rep) { if (rep) xcd_barrier(bar); CG_PHASE(0); }
    SEAM(5);
    if (IN(6)) { DOWN_PHASE(WS_WDN0, X1, X2, true); for (int rep = 1; rep < NREP(6); ++rep) { xcd_barrier(bar); DOWN_PHASE(WS_WDN0, X2, DUMMY, false); } }
    SEAM(6);
    if (IN(7)) _Pragma("unroll") for (int rep = 0; rep < NREP(7); ++rep) { if (rep) xcd_barrier(bar);
        pg8::Gemm g{XN, (const bf16*)(ws + WS_WQKV1), MROWS, NQKV, DM}; pg8::StaticOrder S; S.init(MROWS, NQKV, G, bx);
        pg8::EpiScale E{QKV, NQKV, PART, 1.f / DM, RMS_EPS, 0, 1.f};
        pg8::gemm_phase<pg8::EpiScale, pg8::StaticOrder, PG8_ALIGN, PG8_SP2>(ldsl + RING_OFF, g, S, E);
    }
    SEAM(7);
    if (IN(8)) _Pragma("unroll") for (int rep = 0; rep < NREP(8); ++rep) { if (rep) xcd_barrier(bar); for (int m = gw; m < MROWS; m += NGW) qknorm_row(QKV + (size_t)m * NQKV, QKN + (size_t)m * 8192, args.in[6], args.in[7], m % SEQ, lane); }
    SEAM(8);
    if (IN(9)) _Pragma("unroll") for (int rep = 0; rep < NREP(9); ++rep) { if (rep) xcd_barrier(bar);
        float lam, omli;
        { const float a1 = wave_sum(args.in[8][lane] * args.in[9][lane] + args.in[8][lane + 64] * args.in[9][lane + 64]);
          const float a2 = wave_sum(args.in[10][lane] * args.in[11][lane] + args.in[10][lane + 64] * args.in[11][lane + 64]);
          const float li = 0.8f - 0.6f * 0.7408182206817179f;
          lam = __expf(a1) - __expf(a2) + li; omli = 1.f - li; }
        att::DiffConst C{lam, omli, RMS_EPS, args.in[12], (float*)(ws + WS_SCR) + ((size_t)bx * NWAVES + wave) * 8192};
        constexpr int NITEM = BATCH * DF_H * 8;
        for (int w = bx; w < NITEM; w += G) {
            const int bh = w / 8, xq = w % 8, b = bh / DF_H, h = bh % DF_H;
            const bf16* qn = QKN + (size_t)(b * SEQ) * 8192 + h * 256; const bf16* vb = QKV + (size_t)(b * SEQ) * NQKV + 2 * DM + h * 256;
#define DREF(s) att::DiffRef{ qn + (size_t)((((s) >> 2) ? 15 - xq : xq) * 256) * 8192 + (((s) >> 1) & 1) * 128, qn + 4096 + (((s) >> 1) & 1) * 128, vb + ((s) & 1) * 128, \
                              AO + (size_t)(b * SEQ + (((s) >> 2) ? 15 - xq : xq) * 256) * DM + h * 256, (((s) >> 2) ? 15 - xq : xq) * 256, (s) & 3 }
#pragma unroll 1
            for (int s = 0; s < 8; ++s) { const att::DiffRef cur = DREF(s); att::sm_block<8192, 8192, NQKV, DM>(cur, C, (char*)lds + RING_OFF); }
#undef DREF
        }
    }
    SEAM(9);
    if (IN(10)) {
        pg8::Gemm g{AO, (const bf16*)(ws + WS_WO1), MROWS, DM, DM}; pg8::StaticOrder S; S.init(MROWS, DM, G, bx);
        pg8::EpiResid<true> E{X2, X3, XN, PART, DM};
        pg8::gemm_phase<pg8::EpiResid<true>, pg8::StaticOrder, PG8_ALIGN, PG8_SP2>(ldsl + RING_OFF, g, S, E);
    }
    SEAM(10);
    if (IN(11)) UP_PHASE(WS_WUP1);
    SEAM(11);
    if (IN(12)) CG_PHASE(1);
    SEAM(12);
    if (IN(13)) DOWN_PHASE(WS_WDN1, X3, args.out, false);
#undef IN
#undef SEAM
}
#if MK_CHECK
#include "check.inc"
#endif
extern "C" void kernel_launch(void* const* d_in, const int* in_sizes, int n_in, void* d_out, int out_size, void* d_ws, size_t ws_size, hipStream_t stream) {
    static int grid = 0;
    if (grid == 0) {
        if (n_in != 18 || in_sizes[0] != MROWS * DM || out_size != MROWS * DM || ws_size < WS_END) {
            fprintf(stderr, "kernel_launch: built for 18 inputs, x/out of %d floats, >= %zu bytes of workspace; got n_in %d, in0 %d, out %d, ws %zu; nothing launched\n", MROWS * DM, (size_t)WS_END, n_in, n_in > 0 ? in_sizes[0] : -1, out_size, ws_size); grid = -1; return; }
        int dev = 0, cus = 0, per_cu = 0;
        if (hipGetDevice(&dev) != hipSuccess || hipDeviceGetAttribute(&cus, hipDeviceAttributeMultiprocessorCount, dev) != hipSuccess) { fprintf(stderr, "kernel_launch: device query failed\n"); grid = -1; return; }
        if (hipFuncSetAttribute((const void*)mk_fwd, hipFuncAttributeMaxDynamicSharedMemorySize, LDS_BYTES) != hipSuccess) { fprintf(stderr, "kernel_launch: hipFuncSetAttribute failed\n"); grid = -1; return; }
        if (hipOccupancyMaxActiveBlocksPerMultiprocessor(&per_cu, (const void*)mk_fwd, NWAVES * 64, LDS_BYTES) != hipSuccess || per_cu < 1)
            fprintf(stderr, "kernel_launch: note: occupancy query reports %d workgroups per CU\n", per_cu);
        (void)hipGetLastError();
        grid = cus;
    }
    if (grid < 0) return;
    if (hipMemsetAsync((char*)d_ws + WS_CTL, 0, CTL_ZERO_BYTES, stream) != hipSuccess) { fprintf(stderr, "kernel_launch: memset failed\n"); return; }
    Args a{};
    for (int i = 0; i < 18; ++i) a.in[i] = (const float*)d_in[i];
    a.out = (float*)d_out; a.ws = (unsigned char*)d_ws;
#if MK_CHECK
    for (int p = 0; p < NPH; ++p) { a.ph_lo = p; a.ph_hi = p + 1;
        hipLaunchKernelGGL(mk_fwd, dim3(grid), dim3(NWAVES * 64), LDS_BYTES, stream, a);
        hipLaunchKernelGGL(mk_check, dim3(256), dim3(256), 0, stream, a, p); }
    hipLaunchKernelGGL(mk_report, dim3(1), dim3(64), 0, stream, a);
#elif MK_SPLIT
    for (int p = 0; p < NPH; ++p) { a.ph_lo = p; a.ph_hi = p + 1; hipLaunchKernelGGL(mk_fwd, dim3(grid), dim3(NWAVES * 64), LDS_BYTES, stream, a); }
#else
    a.ph_lo = 0; a.ph_hi = NPH;
    hipLaunchKernelGGL(mk_fwd, dim3(grid), dim3(NWAVES * 64), LDS_BYTES, stream, a);
#endif
    const hipError_t le = hipPeekAtLastError();
    if (le != hipSuccess) fprintf(stderr, "kernel_launch: launch failed: %s\n", hipGetErrorName(le));
}
```

```cpp
#include <hip/hip_runtime.h>
#include <cstdio>
#include <cstdint>
namespace pg8 {
#define PG8_LAS __attribute__((address_space(3)))
typedef unsigned short bf16_t;
typedef short bf16x8 __attribute__((ext_vector_type(8)));
typedef float f32x4 __attribute__((ext_vector_type(4)));
typedef unsigned u32x4 __attribute__((ext_vector_type(4)));
constexpr int BM = 256, BK = 64, HALF = 128, HTB = HALF * BK * 2  , STAGE_BYTES = 8 * HTB, NXCD = 8, WGM = 8;

__host__ __device__ __forceinline__ int lds_byte(int r, int c) { const int st = (r >> 4) * 2 + (c >> 5), rr = r & 15, cc = c & 31, ob = rr * 64 + cc * 2; return st * 1024 + (ob ^ (((ob >> 9) & 1) << 5)); }
__host__ __device__ __forceinline__ void stage_rc(int b, int& R, int& C) { const int st = b / 1024, sb = b % 1024, swz = sb ^ (((sb >> 9) & 1) << 5); R = (st >> 1) * 16 + swz / 64; C = (st & 1) * 32 + (swz % 64) / 2; }
__host__ __device__ __forceinline__ int perm32(int rho) { const int n = rho >> 4, i = rho & 15; return 8 * (i >> 2) + 4 * n + (i & 3); }

struct Unit { int pm, pn; };
struct Gemm { const bf16_t* A; const bf16_t* Bt; int M, N, K; };

struct StaticOrder {
    int nM, nN, nwg, G, c, wgm;
    __host__ __device__ void init(int M, int N, int G_, int c_, int wgm_ = WGM) { nM = M / BM; nN = N / BM; nwg = nM * nN; G = G_; c = c_; wgm = wgm_; }
    __host__ __device__ bool next(int i, Unit& u) const {
        const long L = (long)i * G + c; if (L >= nwg) return false;
        int wgid = (int)L; { const int q = nwg / NXCD, r = nwg % NXCD, xcd = wgid % NXCD, off = wgid / NXCD; wgid = (xcd < r ? xcd * (q + 1) : r * (q + 1) + (xcd - r) * q) + off; }
        const int nig = wgm * nN, gid = wgid / nig, fm = gid * wgm, gsz = (nM - fm) < wgm ? (nM - fm) : wgm;
        u.pm = fm + ((wgid % nig) % gsz); u.pn = (wgid % nig) / gsz; return true;
    }
    __device__ __forceinline__ void a_ready(const Unit&) const {}
    __device__ __forceinline__ void done(const Unit&) const {}
};
struct RangeOrder : StaticOrder {
    int i0, i1;
    __host__ __device__ bool next(int i, Unit& u) const { return (i0 + i < i1) && StaticOrder::next(i0 + i, u); }
};


__device__ __forceinline__ unsigned cvt_pk_bf16(float lo, float hi) { unsigned r; asm volatile("v_cvt_pk_bf16_f32 %0, %1, %2" : "=v"(r) : "v"(lo), "v"(hi)); return r; }

constexpr int NPART = 64;

struct EpiScale {
    static constexpr bool PERM = true, AFTER_DRAIN = false;
    bf16_t* O; int ldc; const float* part; float inv_k; float eps; int qcols; float qs;
    __device__ __forceinline__ void operator()(const f32x4 (&acc)[2][2][4][2], const Unit& u, int wr, int wc, int fr, int fq) const {
        const int row0 = u.pm * BM + wr * 64 + fr; const int col0 = u.pn * BM + wc * 32 + 8 * fq;
        const float sc = (u.pn * BM < qcols) ? qs : 1.f;
#pragma unroll
        for (int ai = 0; ai < 2; ++ai)
#pragma unroll
            for (int m = 0; m < 4; ++m) {
                const int row = row0 + ai * HALF + m * 16;
                const f32x4* pp = (const f32x4*)(part + (size_t)row * NPART + fq * 16);
                const f32x4 a = pp[0], b = pp[1], c = pp[2], d = pp[3];
                float s = ((a[0] + a[1]) + (a[2] + a[3])) + ((b[0] + b[1]) + (b[2] + b[3])) + (((c[0] + c[1]) + (c[2] + c[3])) + ((d[0] + d[1]) + (d[2] + d[3])));
                s += __shfl_xor(s, 16); s += __shfl_xor(s, 32);
                const float r = rsqrtf(s * inv_k + eps) * sc;
                bf16_t* rowp = O + (size_t)row * ldc + col0;
#pragma unroll
                for (int bj = 0; bj < 2; ++bj) { const f32x4 v0 = acc[ai][bj][m][0] * r, v1 = acc[ai][bj][m][1] * r;
                    u32x4 w; w.x = cvt_pk_bf16(v0[0], v0[1]); w.y = cvt_pk_bf16(v0[2], v0[3]); w.z = cvt_pk_bf16(v1[0], v1[1]); w.w = cvt_pk_bf16(v1[2], v1[3]);
                    *(u32x4*)(rowp + bj * HALF) = w; }
            }
    }
};

template <bool BASE_F32, bool OUT_F32> struct EpiResid {
    static constexpr bool PERM = false, AFTER_DRAIN = false;
    const float* basef; float* outf; bf16_t* xn; float* part; int ldc;
    __device__ __forceinline__ void operator()(const f32x4 (&acc)[2][2][4][2], const Unit& u, int wr, int wc, int fr, int fq) const {
        typedef unsigned u32x2v __attribute__((ext_vector_type(2)));
        const int row0 = u.pm * BM + wr * 64 + fr; const int col0 = u.pn * BM + wc * 32 + 4 * fq;
#pragma unroll
        for (int ai = 0; ai < 2; ++ai)
#pragma unroll
            for (int m = 0; m < 4; ++m) {
                const int row = row0 + ai * HALF + m * 16; const size_t off = (size_t)row * ldc + col0; float ss = 0.f;
#pragma unroll
                for (int bj = 0; bj < 2; ++bj)
#pragma unroll
                    for (int n = 0; n < 2; ++n) { const size_t o2 = off + bj * HALF + n * 16;
                        f32x4 bs;
                        if (BASE_F32) bs = *(const f32x4*)(basef + o2);
                        else { const u32x2v b = *(const u32x2v*)(xn + o2); bs[0] = __builtin_bit_cast(float, b.x << 16); bs[1] = __builtin_bit_cast(float, b.x & 0xffff0000u); bs[2] = __builtin_bit_cast(float, b.y << 16); bs[3] = __builtin_bit_cast(float, b.y & 0xffff0000u); }
                        const f32x4 o = bs + acc[ai][bj][m][n];
                        if (OUT_F32) *(f32x4*)(outf + o2) = o;
                        else { u32x2v w; w.x = cvt_pk_bf16(o[0], o[1]); w.y = cvt_pk_bf16(o[2], o[3]); *(u32x2v*)(xn + o2) = w;
                            ss += (o[0] * o[0] + o[1] * o[1]) + (o[2] * o[2] + o[3] * o[3]); } }
                if (!OUT_F32) { ss += __shfl_xor(ss, 16); ss += __shfl_xor(ss, 32); if (fq == 0) part[(size_t)row * NPART + u.pn * 4 + wc] = ss; }
            }
    }
};

__device__ __forceinline__ float dpp_ror1(float v) { return __builtin_bit_cast(float, __builtin_amdgcn_update_dpp(0, __builtin_bit_cast(int, v), 0x121, 0xf, 0xf, false)); }
__device__ __forceinline__ float dpp_ror2(float v) { return __builtin_bit_cast(float, __builtin_amdgcn_update_dpp(0, __builtin_bit_cast(int, v), 0x122, 0xf, 0xf, false)); }
__device__ __forceinline__ float dpp_shr1(float old, float v) { return __builtin_bit_cast(float, __builtin_amdgcn_update_dpp(__builtin_bit_cast(int, old), __builtin_bit_cast(int, v), 0x111, 0xf, 0xf, false)); }
__device__ __forceinline__ float dpp_shr2(float old, float v) { return __builtin_bit_cast(float, __builtin_amdgcn_update_dpp(__builtin_bit_cast(int, old), __builtin_bit_cast(int, v), 0x112, 0xf, 0xf, false)); }
__device__ __forceinline__ void conv_taps(float& acc, float cur, float prev, float w1, float w0) {
    asm("s_nop 1\n\t"
        "v_fmac_f32_dpp %0, %1, %3 row_shr:1 row_mask:0xf bank_mask:0xf\n\t"
        "v_fmac_f32_dpp %0, %1, %4 row_shr:2 row_mask:0xf bank_mask:0xf\n\t"
        "v_fmac_f32_dpp %0, %2, %3 row_shl:15 row_mask:0xf bank_mask:0xf\n\t"
        "v_fmac_f32_dpp %0, %2, %4 row_shl:14 row_mask:0xf bank_mask:0xf"
        : "+v"(acc) : "v"(cur), "v"(prev), "v"(w1), "v"(w0));
}
template <int CTRL> __device__ __forceinline__ float dppz(float v) { return __builtin_bit_cast(float, __builtin_amdgcn_update_dpp(0, __builtin_bit_cast(int, v), CTRL, 0xf, 0xf, true)); }
struct EpiConvGate {
    static constexpr bool PERM = true, AFTER_DRAIN = false;
    bf16_t* ACT; int ff; const float* part; float inv_k; float eps; const float* cw; const float* cb; float* halo;
    __device__ __forceinline__ void operator()(const f32x4 (&acc)[2][2][4][2], const Unit& u, int wr, int wc, int fr, int fq) const {
        typedef unsigned u32x2v __attribute__((ext_vector_type(2)));
        const int ff2 = 2 * ff;
        const int row0 = u.pm * BM + wr * 64 + fr; const int ch0 = u.pn * HALF + wc * 32 + 8 * fq;
        float rs[2][4];
#pragma unroll
        for (int ai = 0; ai < 2; ++ai)
#pragma unroll
            for (int m = 0; m < 4; ++m) { const int row = row0 + ai * HALF + m * 16;
                const f32x4* pp = (const f32x4*)(part + (size_t)row * NPART + fq * 16);
                const f32x4 a = pp[0], b = pp[1], c = pp[2], d = pp[3];
                float s = ((a[0] + a[1]) + (a[2] + a[3])) + ((b[0] + b[1]) + (b[2] + b[3])) + (((c[0] + c[1]) + (c[2] + c[3])) + ((d[0] + d[1]) + (d[2] + d[3])));
                s += __shfl_xor(s, 16); s += __shfl_xor(s, 32);
                rs[ai][m] = rsqrtf(s * inv_k + eps); }
        u32x2v lo[2][4];
#pragma unroll
        for (int n = 0; n < 2; ++n) {
            const int ch = ch0 + 4 * n;
            const f32x4 wg0 = *(const f32x4*)(cw + ch), wg1 = *(const f32x4*)(cw + ff2 + ch), wg2 = *(const f32x4*)(cw + 2 * ff2 + ch), bg = *(const f32x4*)(cb + ch);
            const f32x4 wv0 = *(const f32x4*)(cw + ff + ch), wv1 = *(const f32x4*)(cw + ff2 + ff + ch), wv2 = *(const f32x4*)(cw + 2 * ff2 + ff + ch), bv = *(const f32x4*)(cb + ff + ch);
#pragma unroll
            for (int ai = 0; ai < 2; ++ai) {
                f32x4 gq = {0.f, 0.f, 0.f, 0.f}, vq = gq;
                const int grp = (u.pm * BM + ai * HALF + wr * 64) >> 6;
#pragma unroll
                for (int m = 0; m < 4; ++m) {
                    const f32x4 g = acc[ai][0][m][n] * rs[ai][m], v = acc[ai][1][m][n] * rs[ai][m];
                    f32x4 cg, cv;
#pragma unroll
                    for (int e = 0; e < 4; ++e) {
                        float a = __builtin_fmaf(wg2[e], g[e], bg[e]), b = __builtin_fmaf(wv2[e], v[e], bv[e]);
                        conv_taps(a, g[e], gq[e], wg1[e], wg0[e]); conv_taps(b, v[e], vq[e], wv1[e], wv0[e]);
                        cg[e] = a; cv[e] = b; }
                    gq = g; vq = v;
                    f32x4 o;
#pragma unroll
                    for (int e = 0; e < 4; ++e) o[e] = cg[e] * __builtin_amdgcn_rcpf(1.f + __builtin_amdgcn_exp2f(-1.4426950408889634f * cg[e])) * cv[e];
                    u32x2v w; w.x = cvt_pk_bf16(o[0], o[1]); w.y = cvt_pk_bf16(o[2], o[3]);
                    const int row = row0 + ai * HALF + m * 16;
                    if (n == 0) lo[ai][m] = w;
                    else if (!(m == 0 && fr < 2)) { u32x4 w4; w4.x = lo[ai][m].x; w4.y = lo[ai][m].y; w4.z = w.x; w4.w = w.y; *(u32x4*)(ACT + (size_t)row * ff + ch0) = w4; }
                    if ((m == 0 && fr < 2) || (m == 3 && fr >= 14)) { float* hp = halo + ((size_t)grp * 4 + (m == 0 ? fr : fr - 12)) * ff2 + ch; *(f32x4*)hp = g; *(f32x4*)(hp + ff) = v; }
                }
            }
        }
    }
};
template <class Epi, class Sched, bool ALIGN_EPI = false, bool SP2 = false>
__device__ __forceinline__ void gemm_phase(PG8_LAS unsigned char* lds, const Gemm g, const Sched& S, const Epi& E) {
    const int tid = threadIdx.x, wid = __builtin_amdgcn_readfirstlane(tid >> 6), lane = tid & 63, wr = wid >> 2, wc = wid & 3, fr = lane & 15, fq = lane >> 4;
    const int K = g.K, nt = K / BK;
    unsigned voffA[2], voffB[2];
#pragma unroll
    for (int i = 0; i < 2; ++i) { int R, C; stage_rc(tid * 16 + i * 8192, R, C); const int Rb = Epi::PERM ? ((R & ~31) + perm32(R & 31)) : R;
        voffA[i] = (unsigned)(R * K + C) * 2u; voffB[i] = (unsigned)(Rb * K + C) * 2u; }
    const size_t kstep = (size_t)(BK * 2);
    const size_t hstep = (size_t)HALF * K * 2;
    const size_t tstep = 2 * hstep;
    const unsigned ldsw = (unsigned)wid * 1024u;
    const int aoff = lds_byte(wr * 64 + fr, fq * 8), boff = lds_byte(wc * 32 + fr, fq * 8);
#define PG8_SA(b, h) (((b) * 2 + (h)) * HTB)
#define PG8_SB(b, h) ((4 + (b) * 2 + (h)) * HTB)
#define PG8_STAGE(bufoff, gbase, voff) do { _Pragma("unroll") for (int _i = 0; _i < 2; ++_i) \
        __builtin_amdgcn_global_load_lds((const unsigned*)((const char*)(gbase) + (voff)[_i]), (PG8_LAS unsigned*)(lds + (bufoff) + ldsw + _i * 8192), 16, 0, 0); } while (0)
#define PG8_LDA(dst, b, h) do { _Pragma("unroll") for (int m = 0; m < 4; ++m) _Pragma("unroll") for (int k = 0; k < 2; ++k) dst[m][k] = *(const PG8_LAS bf16x8*)(lds + PG8_SA(b, h) + aoff + m * 2048 + k * 1024); } while (0)
#define PG8_LDB(dst, b, h) do { _Pragma("unroll") for (int n = 0; n < 2; ++n) _Pragma("unroll") for (int k = 0; k < 2; ++k) dst[n][k] = *(const PG8_LAS bf16x8*)(lds + PG8_SB(b, h) + boff + n * 2048 + k * 1024); } while (0)
#define PG8_MMA(ai, bj, At, Bt) do { __builtin_amdgcn_s_setprio(1); _Pragma("unroll") for (int m = 0; m < 4; ++m) _Pragma("unroll") for (int n = 0; n < 2; ++n) _Pragma("unroll") for (int k = 0; k < 2; ++k) \
        acc[ai][bj][m][n] = __builtin_amdgcn_mfma_f32_16x16x32_bf16(Bt[n][k], At[m][k], acc[ai][bj][m][n], 0, 0, 0); __builtin_amdgcn_s_setprio(0); } while (0)
#define PG8_WAIT_V(n) asm volatile("s_waitcnt vmcnt(" #n ")" ::: "memory")
#define PG8_WAIT_L(n) asm volatile("s_waitcnt lgkmcnt(" #n ")" ::: "memory")
#define PG8_BAR __builtin_amdgcn_s_barrier()
#define PG8_SCHED __builtin_amdgcn_sched_barrier(0)
    Unit cur, nxt; int ui = 0;
    if (!S.next(0, cur)) return;
    f32x4 acc[2][2][4][2];
#pragma unroll
    for (int a = 0; a < 2; ++a)
#pragma unroll
        for (int b = 0; b < 2; ++b)
#pragma unroll
            for (int m = 0; m < 4; ++m)
#pragma unroll
                for (int n = 0; n < 2; ++n) acc[a][b][m][n] = (f32x4){0.f, 0.f, 0.f, 0.f};
    bf16x8 At[4][2], B0[2][2], B1[2][2];
    const char* cA = (const char*)g.A + (size_t)cur.pm * tstep; const char* cB = (const char*)g.Bt + (size_t)cur.pn * tstep;
    S.a_ready(cur);
    if constexpr (SP2) {
        PG8_STAGE(PG8_SB(0, 0), cB, voffB); PG8_STAGE(PG8_SB(0, 1), cB + hstep, voffB); PG8_STAGE(PG8_SA(0, 0), cA, voffA); PG8_STAGE(PG8_SA(0, 1), cA + hstep, voffA);
        if (wr == 1) PG8_BAR;
        PG8_WAIT_V(2); PG8_BAR;
        PG8_STAGE(PG8_SB(1, 0), cB + kstep, voffB); PG8_STAGE(PG8_SA(1, 0), cA + kstep, voffA); PG8_STAGE(PG8_SB(1, 1), cB + hstep + kstep, voffB);
        PG8_WAIT_V(6); PG8_BAR;
    } else {
        PG8_STAGE(PG8_SB(0, 0), cB, voffB); PG8_STAGE(PG8_SA(0, 0), cA, voffA); PG8_STAGE(PG8_SB(0, 1), cB + hstep, voffB); PG8_STAGE(PG8_SA(0, 1), cA + hstep, voffA);
        if (wr == 1) PG8_BAR;
        PG8_WAIT_V(4); PG8_BAR;
        PG8_STAGE(PG8_SB(1, 0), cB + kstep, voffB); PG8_STAGE(PG8_SA(1, 0), cA + kstep, voffA); PG8_STAGE(PG8_SB(1, 1), cB + hstep + kstep, voffB);
        PG8_WAIT_V(6); PG8_BAR;
    }
    for (;;) {
        const bool has_next = S.next(ui + 1, nxt);
        const char* nA = has_next ? (const char*)g.A + (size_t)nxt.pm * tstep : cA; const char* nB = has_next ? (const char*)g.Bt + (size_t)nxt.pn * tstep : cB;
        for (int t = 0; t < nt; t += 2) {
            const bool last = (t == nt - 2);
            const char* a1 = cA + (size_t)(t + 1) * kstep;
            const char* a2 = last ? nA : cA + (size_t)(t + 2) * kstep; const char* b2 = last ? nB : cB + (size_t)(t + 2) * kstep;
            const char* a3 = a2 + kstep; const char* b3 = b2 + kstep;
            if (last && has_next) S.a_ready(nxt);
            if constexpr (SP2) {
            PG8_LDB(B0, 0, 0); PG8_LDB(B1, 0, 1); PG8_SCHED; PG8_LDA(At, 0, 0); PG8_STAGE(PG8_SA(1, 1), a1 + hstep, voffA);
            PG8_WAIT_V(8); PG8_WAIT_L(0); PG8_BAR; PG8_MMA(0, 0, At, B0); PG8_MMA(0, 1, At, B1); PG8_BAR; PG8_SCHED;
            PG8_LDA(At, 0, 1); PG8_STAGE(PG8_SB(0, 0), b2, voffB); PG8_STAGE(PG8_SB(0, 1), b2 + hstep, voffB); PG8_STAGE(PG8_SA(0, 0), a2, voffA);
            PG8_WAIT_V(8); PG8_WAIT_L(0); PG8_BAR; PG8_MMA(1, 0, At, B0); PG8_MMA(1, 1, At, B1); PG8_BAR; PG8_SCHED;
            PG8_LDB(B0, 1, 0); PG8_LDB(B1, 1, 1); PG8_SCHED; PG8_LDA(At, 1, 0); PG8_STAGE(PG8_SA(0, 1), a2 + hstep, voffA);
            PG8_WAIT_V(8); PG8_WAIT_L(0); PG8_BAR; PG8_MMA(0, 0, At, B0); PG8_MMA(0, 1, At, B1); PG8_BAR; PG8_SCHED;
            PG8_LDA(At, 1, 1); PG8_STAGE(PG8_SB(1, 0), b3, voffB); PG8_STAGE(PG8_SB(1, 1), b3 + hstep, voffB); PG8_STAGE(PG8_SA(1, 0), a3, voffA);
            PG8_WAIT_V(8); PG8_WAIT_L(0); PG8_BAR; PG8_MMA(1, 0, At, B0); PG8_MMA(1, 1, At, B1); PG8_BAR; PG8_SCHED;
            } else {
            PG8_LDB(B0, 0, 0); PG8_SCHED; PG8_LDA(At, 0, 0); PG8_STAGE(PG8_SA(1, 1), a1 + hstep, voffA);
            PG8_WAIT_L(8); PG8_BAR; PG8_WAIT_L(0); PG8_MMA(0, 0, At, B0); PG8_BAR; PG8_SCHED;
            PG8_LDB(B1, 0, 1); PG8_STAGE(PG8_SB(0, 0), b2, voffB);
            PG8_BAR; PG8_WAIT_L(0); PG8_MMA(0, 1, At, B1); PG8_BAR;
            PG8_LDA(At, 0, 1); PG8_STAGE(PG8_SA(0, 0), a2, voffA);
            PG8_BAR; PG8_WAIT_L(0); PG8_MMA(1, 0, At, B0); PG8_BAR; PG8_SCHED;
            PG8_STAGE(PG8_SB(0, 1), b2 + hstep, voffB);
            PG8_WAIT_V(6); PG8_BAR; PG8_MMA(1, 1, At, B1); PG8_BAR;
            PG8_LDB(B0, 1, 0); PG8_SCHED; PG8_LDA(At, 1, 0); PG8_STAGE(PG8_SA(0, 1), a2 + hstep, voffA);
            PG8_WAIT_L(8); PG8_BAR; PG8_WAIT_L(0); PG8_MMA(0, 0, At, B0); PG8_BAR; PG8_SCHED;
            PG8_LDB(B1, 1, 1); PG8_STAGE(PG8_SB(1, 0), b3, voffB);
            PG8_BAR; PG8_WAIT_L(0); PG8_MMA(0, 1, At, B1); PG8_BAR;
            PG8_LDA(At, 1, 1); PG8_STAGE(PG8_SA(1, 0), a3, voffA);
            PG8_BAR; PG8_WAIT_L(0); PG8_MMA(1, 0, At, B0); PG8_BAR; PG8_SCHED;
            PG8_STAGE(PG8_SB(1, 1), b3 + hstep, voffB);
            PG8_WAIT_V(6); PG8_BAR; PG8_MMA(1, 1, At, B1); PG8_BAR;
            }
        }
        if constexpr (ALIGN_EPI) { if (wr == 0) PG8_BAR; }
        if constexpr (!Epi::AFTER_DRAIN) { E(acc, cur, wr, wc, fr, fq); S.done(cur); }
        if (!has_next) break;
#pragma unroll
        for (int a = 0; a < 2; ++a)
#pragma unroll
            for (int b = 0; b < 2; ++b)
#pragma unroll
                for (int m = 0; m < 4; ++m)
#pragma unroll
                    for (int n = 0; n < 2; ++n) acc[a][b][m][n] = (f32x4){0.f, 0.f, 0.f, 0.f};
        cur = nxt; cA = nA; cB = nB; ++ui;
        if constexpr (ALIGN_EPI) { if (wr == 1) PG8_BAR; }
    }
    PG8_WAIT_V(0);
    if constexpr (!ALIGN_EPI) { if (wr == 0) PG8_BAR; }
    PG8_BAR;
    if constexpr (Epi::AFTER_DRAIN) { E.fused(acc, cur, wr, wc, fr, fq, lds, wid, lane); S.done(cur); }
#undef PG8_SA
#undef PG8_SB
#undef PG8_STAGE
#undef PG8_LDA
#undef PG8_LDB
#undef PG8_MMA
#undef PG8_WAIT_V
#undef PG8_WAIT_L
#undef PG8_BAR
#undef PG8_SCHED
}
}
namespace att {
using bf16 = unsigned short;
typedef short bf16x8 __attribute__((ext_vector_type(8)));
typedef short s16x4 __attribute__((ext_vector_type(4)));
typedef float f32x16 __attribute__((ext_vector_type(16)));
typedef float f32x4 __attribute__((ext_vector_type(4)));
typedef unsigned u32x4 __attribute__((ext_vector_type(4)));
constexpr int D = 128, NW = 8, QBLK = 32, KVBLK = 64, QB = NW * QBLK;
constexpr int SHM_V = KVBLK * D * 2, SHM_K = KVBLK * D * 2;
constexpr int LDS_BYTES = 2 * SHM_V + 2 * SHM_K + NW * 64 * 4;
#define KSWZ(row, colB) ((row) * 256 + ((colB) ^ (((row) & 7) << 4)))
#define SBAR() __builtin_amdgcn_sched_barrier(0)
__device__ __forceinline__ int v_st(int k, int c) { const int kk = (k & ~0xC) | ((k & 4) << 1) | ((k & 8) >> 1); return ((kk >> 3) * 4 + (c >> 5)) * 512 + ((kk & 7) * 32 + (c & 31)) * 2; }
__device__ __forceinline__ int v_rd_base(int lane) { return ((lane & 3) << 3) | (((lane >> 2) & 3) << 6) | (((lane >> 4) & 1) << 5) | (((lane >> 5) & 1) << 8); }
constexpr int v_rd_off(int d0, int ks, int half) { return d0 * 512 + ks * 4096 + half * 2048; }
__device__ __forceinline__ int crow(int r, int hi) { return (r & 3) + 8 * (r >> 2) + 4 * hi; }
__device__ __forceinline__ unsigned cvtpk(float lo, float hi) { unsigned r; asm volatile("v_cvt_pk_bf16_f32 %0, %1, %2" : "=v"(r) : "v"(lo), "v"(hi)); return r; }
__device__ __forceinline__ bf16x8 load8(const bf16* p) { return *reinterpret_cast<const bf16x8*>(p); }

#define PK4(P, B_, OUT) do { unsigned a0 = cvtpk(P[B_+0], P[B_+1]), a1 = cvtpk(P[B_+2], P[B_+3]);                          \
        unsigned b0 = cvtpk(P[B_+4], P[B_+5]), b1 = cvtpk(P[B_+6], P[B_+7]);                                             \
        auto r0 = __builtin_amdgcn_permlane32_swap(a0, b0, false, false); auto r1 = __builtin_amdgcn_permlane32_swap(a1, b1, false, false); \
        u32x4 w = {r0[0], r1[0], r0[1], r1[1]}; OUT = *reinterpret_cast<bf16x8*>(&w); } while (0)

__device__ __forceinline__ void qkt_rt(f32x16& p0, f32x16& p1, const char* Kt, int r32, int hi, const bf16x8* qr) {
    p0 = f32x16{}; p1 = f32x16{};
    const char* kb[4];
#pragma unroll
    for (int dd = 0; dd < 4; ++dd) kb[dd] = Kt + KSWZ(r32, (dd * 16 + hi * 8) * 2);
#pragma unroll
    for (int d0 = 0; d0 < 8; ++d0) { const char* a = kb[d0 & 3] + (d0 >> 2) * 128;
        bf16x8 b0 = *reinterpret_cast<const bf16x8*>(a);
        bf16x8 b1 = *reinterpret_cast<const bf16x8*>(a + 32 * 256);
        p0 = __builtin_amdgcn_mfma_f32_32x32x16_bf16(b0, qr[d0], p0, 0, 0, 0);
        p1 = __builtin_amdgcn_mfma_f32_32x32x16_bf16(b1, qr[d0], p1, 0, 0, 0); }
}
__device__ __forceinline__ void pv_rt(f32x16* o, int vb, bf16x8 pa0, bf16x8 pa1, bf16x8 pa2, bf16x8 pa3) {
#define TRRD(dst, off) asm volatile("ds_read_b64_tr_b16 %0, %1 offset:%2" : "=&v"(dst) : "v"(vb), "i"(off) : "memory")
#define PV_D0(d0) do { s16x4 l0, l1, l2, l3, h0, h1, h2, h3; constexpr int b_ = v_rd_off(d0, 0, 0); \
        TRRD(l0, b_); TRRD(h0, b_ + 2048); TRRD(l1, b_ + 4096); TRRD(h1, b_ + 6144); TRRD(l2, b_ + 8192); TRRD(h2, b_ + 10240); TRRD(l3, b_ + 12288); TRRD(h3, b_ + 14336); \
        asm volatile("s_waitcnt lgkmcnt(0)" ::: "memory"); SBAR();   \
        o[d0] = __builtin_amdgcn_mfma_f32_32x32x16_bf16(pa0, (bf16x8){l0[0], l0[1], l0[2], l0[3], h0[0], h0[1], h0[2], h0[3]}, o[d0], 0, 0, 0);   \
        o[d0] = __builtin_amdgcn_mfma_f32_32x32x16_bf16(pa1, (bf16x8){l1[0], l1[1], l1[2], l1[3], h1[0], h1[1], h1[2], h1[3]}, o[d0], 0, 0, 0);   \
        o[d0] = __builtin_amdgcn_mfma_f32_32x32x16_bf16(pa2, (bf16x8){l2[0], l2[1], l2[2], l2[3], h2[0], h2[1], h2[2], h2[3]}, o[d0], 0, 0, 0);   \
        o[d0] = __builtin_amdgcn_mfma_f32_32x32x16_bf16(pa3, (bf16x8){l3[0], l3[1], l3[2], l3[3], h3[0], h3[1], h3[2], h3[3]}, o[d0], 0, 0, 0); } while (0)
    PV_D0(0); PV_D0(1); PV_D0(2); PV_D0(3);
#undef PV_D0
#undef TRRD
}

constexpr float SB_DONE = 1e-30f;
__device__ __forceinline__ void sb_half(f32x16& p, float& carry, int dq, bool needmask, bool lane_hi) {
    float kp[16];
#pragma unroll
    for (int r = 0; r < 16; ++r) {
        const float zz = fminf(p[r], 100.f);
        const float e = __builtin_amdgcn_exp2f(zz);
        float k = __builtin_amdgcn_rcpf(1.f + e);
        float be = e * k;
        if (needmask) { const int c = 8 * (r >> 2) + (r & 3); const bool valid = (dq - c) > 0; k = valid ? k : 1.f; be = valid ? be : 0.f; }
        kp[r] = k; p[r] = be;
    }
    float L[4], H[4];
#pragma unroll
    for (int j = 0; j < 4; ++j) { const float g = (kp[4 * j] * kp[4 * j + 1]) * (kp[4 * j + 2] * kp[4 * j + 3]);
        auto rr = __builtin_amdgcn_permlane32_swap(__float_as_uint(g), __float_as_uint(g), false, false);
        L[j] = __uint_as_float(rr[0]); H[j] = __uint_as_float(rr[1]); }
    float U[4]; U[3] = 1.f; U[2] = L[3] * H[3]; U[1] = U[2] * (L[2] * H[2]); U[0] = U[1] * (L[1] * H[1]);
    const float tot = U[0] * (L[0] * H[0]);
#pragma unroll
    for (int j = 0; j < 4; ++j) {
        const float a3 = carry * U[j] * (lane_hi ? 1.f : H[j]);
        const float a2 = a3 * kp[4 * j + 3], a1 = a2 * kp[4 * j + 2], a0 = a1 * kp[4 * j + 1];
        p[4 * j + 3] *= a3; p[4 * j + 2] *= a2; p[4 * j + 1] *= a1; p[4 * j] *= a0;
    }
    carry *= tot;
}

template <int PQ, int PK, int PV, int PO>
__device__ __forceinline__ void sb_block(const bf16* Q, const bf16* K, const bf16* V, bf16* O, int P0, char* lds, volatile __attribute__((address_space(3))) unsigned* flags) {
    const int tid = threadIdx.x, wid = __builtin_amdgcn_readfirstlane(tid >> 6), lane = tid & 63, r32 = lane & 31, hi = lane >> 5;
    char* K_lds = lds; char* V_lds = lds + 2 * SHM_K;
    const int sr = tid >> 4, sc = (tid & 15) * 8, vst0 = v_st(sr, sc), vst1 = v_st(32 + sr, sc), kws = KSWZ(sr, sc * 2);
    const int vb0 = (int)(uintptr_t)V_lds + v_rd_base(lane);
    bf16x8 qr[8];
#pragma unroll
    for (int d0 = 0; d0 < 8; ++d0) qr[d0] = load8(Q + (size_t)(wid * QBLK + r32) * PQ + d0 * 16 + hi * 8);
    f32x16 o[4] = {};
    float carry = 1.f;
    const int qlo = P0 + wid * QBLK, qpos = qlo + r32;
    int j = P0 / KVBLK + 3;
    bf16x8 st_k0, st_k1, st_v0, st_v1;
#define SB_LOAD(jt) do { const size_t k0_ = (size_t)(jt) * KVBLK; st_k0 = load8(K + (k0_ + sr) * PK + sc); st_k1 = load8(K + (k0_ + 32 + sr) * PK + sc); \
                         st_v0 = load8(V + (k0_ + sr) * PV + sc); st_v1 = load8(V + (k0_ + 32 + sr) * PV + sc); } while (0)
#define SB_WRITE(bf) do { *(bf16x8*)(K_lds + (bf) * SHM_K + kws) = st_k0; *(bf16x8*)(K_lds + (bf) * SHM_K + kws + 32 * 256) = st_k1; \
                          *(bf16x8*)(V_lds + (bf) * SHM_V + vst0) = st_v0; *(bf16x8*)(V_lds + (bf) * SHM_V + vst1) = st_v1; } while (0)
    SB_LOAD(j); asm volatile("s_waitcnt vmcnt(0)" ::: "memory"); SB_WRITE(0);
    __syncthreads();
    int buf = 0, it = 0; bool wdone = false;
    for (;;) {
        const int kb = j * KVBLK; const bool more = j > 0;
        if (more) SB_LOAD(j - 1);
        const bool act = !wdone && (kb < qlo + QBLK - 1);
        if (act) {
            f32x16 p0, p1;
            qkt_rt(p0, p1, K_lds + buf * SHM_K, r32, hi, qr);
            const bool needmask = kb + KVBLK - 1 >= qlo;
            sb_half(p1, carry, qpos - (kb + 32) - 4 * hi, needmask, hi != 0);
            sb_half(p0, carry, qpos - kb - 4 * hi, needmask, hi != 0);
            bf16x8 pa0, pa1, pa2, pa3;
            PK4(p0, 0, pa0); PK4(p0, 8, pa1); PK4(p1, 0, pa2); PK4(p1, 8, pa3);
            SBAR();
            pv_rt(o, vb0 + buf * SHM_V, pa0, pa1, pa2, pa3);
            wdone = __all(carry < SB_DONE);
        }
        if (more) { asm volatile("s_waitcnt vmcnt(0)" ::: "memory"); SB_WRITE(buf ^ 1); }
        if (lane == 0) flags[(it & 1) * 8 + wid] = wdone ? 1u : 0u;
        __syncthreads();
        unsigned alld = 1u;
#pragma unroll
        for (int w = 0; w < NW; ++w) alld &= flags[(it & 1) * 8 + w];
        if (!more || alld) break;
        --j; buf ^= 1; ++it;
    }
#undef SB_LOAD
#undef SB_WRITE
    bf16* Ow = O + (size_t)(wid * QBLK) * PO;
#pragma unroll
    for (int r = 0; r < 16; ++r) { const int orow = crow(r, hi);
#pragma unroll
        for (int d0 = 0; d0 < 4; ++d0) { const float v = o[d0][r]; const float vn = __shfl_xor(v, 1);
            if ((r32 & 1) == 0) *(unsigned*)(Ow + (size_t)orow * PO + d0 * 32 + r32) = cvtpk(v, vn); } }
    __syncthreads();
}

constexpr float THR2 = 8.f * 1.4426950408889634f;
struct DiffRef { const bf16* Q; const bf16* K; const bf16* V; bf16* O; int P0; int mode; };
struct DiffConst { float lam; float omli; float eps; const float* gain; float* scr; };
template <int PQ, int PK, int PV, int PO>
__device__ __forceinline__ void sm_block(const DiffRef& cur, const DiffConst& C, char* lds) {
    const int tid = threadIdx.x, wid = __builtin_amdgcn_readfirstlane(tid >> 6), lane = tid & 63, r32 = lane & 31, hi = lane >> 5;
    char* K_lds = lds; char* V_lds = lds + 2 * SHM_K; float* al_l = (float*)(lds + 2 * SHM_K + 2 * SHM_V) + wid * 32;
    const int sr = tid >> 4, sc = (tid & 15) * 8, vst0 = v_st(sr, sc), vst1 = v_st(32 + sr, sc), kws = KSWZ(sr, sc * 2);
    const int vb0 = (int)(uintptr_t)V_lds + v_rd_base(lane);
    const bf16* Q = cur.Q; const bf16* K = cur.K; const bf16* V = cur.V; const int P0 = cur.P0;
    bf16x8 qr[8];
#pragma unroll
    for (int d0 = 0; d0 < 8; ++d0) qr[d0] = load8(Q + (size_t)(wid * QBLK + r32) * PQ + d0 * 16 + hi * 8);
    f32x16 o[4] = {};
    float m_reg = -1e30f, l_reg = 0.f;
    const int qlo = P0 + wid * QBLK, qm = qlo + r32 - 4 * hi;
    const int NT = P0 / KVBLK + 4;
    bf16x8 st_k0, st_k1, st_v0, st_v1;
#define SM_LOAD(jt) do { const size_t k0_ = (size_t)(jt) * KVBLK; st_k0 = load8(K + (k0_ + sr) * PK + sc); st_k1 = load8(K + (k0_ + 32 + sr) * PK + sc); \
                         st_v0 = load8(V + (k0_ + sr) * PV + sc); st_v1 = load8(V + (k0_ + 32 + sr) * PV + sc); } while (0)
#define SM_WRITE(bf) do { *(bf16x8*)(K_lds + (bf) * SHM_K + kws) = st_k0; *(bf16x8*)(K_lds + (bf) * SHM_K + kws + 32 * 256) = st_k1; \
                          *(bf16x8*)(V_lds + (bf) * SHM_V + vst0) = st_v0; *(bf16x8*)(V_lds + (bf) * SHM_V + vst1) = st_v1; } while (0)
    SM_LOAD(0); asm volatile("s_waitcnt vmcnt(0)" ::: "memory"); SM_WRITE(0);
    __syncthreads();
    int buf = 0;
    for (int t = 0; t < NT; ++t) {
        const int kb = t * KVBLK; const bool more = t + 1 < NT;
        if (more) SM_LOAD(t + 1);
        if (kb <= qlo + QBLK - 1) {
            f32x16 p0, p1;
            qkt_rt(p0, p1, K_lds + buf * SHM_K, r32, hi, qr);
            if (kb + KVBLK - 1 > qlo) {
                const int dq = qm - kb; const float NEG = -__builtin_inff();
#pragma unroll
                for (int r = 0; r < 16; ++r) { const int c = (r & 3) + 8 * (r >> 2); if ((dq - c) < 0) p0[r] = NEG; if ((dq - c - 32) < 0) p1[r] = NEG; }
            }
            float pmax = p0[0];
#pragma unroll
            for (int r = 1; r < 16; ++r) pmax = fmaxf(pmax, p0[r]);
#pragma unroll
            for (int r = 0; r < 16; ++r) pmax = fmaxf(pmax, p1[r]);
            { auto rr = __builtin_amdgcn_permlane32_swap(__float_as_uint(pmax), __float_as_uint(pmax), false, false); pmax = fmaxf(__uint_as_float(rr[0]), __uint_as_float(rr[1])); }
            float alpha = 1.f;
            if (!__all((pmax - m_reg) <= THR2)) {
                const float mn = fmaxf(m_reg, pmax); alpha = __builtin_amdgcn_exp2f(m_reg - mn); m_reg = mn;
                if (hi == 0) al_l[r32] = alpha; asm volatile("s_waitcnt lgkmcnt(0)" ::: "memory");
#pragma unroll
                for (int d_ = 0; d_ < 4; ++d_)
#pragma unroll
                    for (int r = 0; r < 16; ++r) o[d_][r] *= al_l[crow(r, hi)];
            }
            float ps = 0.f;
#pragma unroll
            for (int r = 0; r < 16; ++r) { p0[r] = __builtin_amdgcn_exp2f(p0[r] - m_reg); ps += p0[r]; }
#pragma unroll
            for (int r = 0; r < 16; ++r) { p1[r] = __builtin_amdgcn_exp2f(p1[r] - m_reg); ps += p1[r]; }
            { auto rr = __builtin_amdgcn_permlane32_swap(__float_as_uint(ps), __float_as_uint(ps), false, false); ps = __uint_as_float(rr[0]) + __uint_as_float(rr[1]); }
            l_reg = l_reg * alpha + ps;
            bf16x8 pa0, pa1, pa2, pa3;
            PK4(p0, 0, pa0); PK4(p0, 8, pa1); PK4(p1, 0, pa2); PK4(p1, 8, pa3);
            SBAR();
            pv_rt(o, vb0 + buf * SHM_V, pa0, pa1, pa2, pa3);
        }
        if (more) { asm volatile("s_waitcnt vmcnt(0)" ::: "memory"); SM_WRITE(buf ^ 1); }
        __syncthreads();
        buf ^= 1;
    }
#undef SM_LOAD
#undef SM_WRITE
    if (hi == 0) al_l[r32] = l_reg; asm volatile("s_waitcnt lgkmcnt(0)" ::: "memory");
    float rli[16];
#pragma unroll
    for (int r = 0; r < 16; ++r) rli[r] = __builtin_amdgcn_rcpf(al_l[crow(r, hi)]);
#define OPQ(v) asm volatile("" : "+v"(v))
    char* sA = (char*)C.scr; char* sB = sA + 16384;
    const unsigned lo16 = (unsigned)lane * 16u;
    const int mode = cur.mode;
    if (mode == 0 || mode == 1) { char* s = mode ? sB : sA;
#pragma unroll
        for (int r = 0; r < 16; ++r) { unsigned vo = lo16; OPQ(vo);
            const f32x4 v = {o[0][r] * rli[r], o[1][r] * rli[r], o[2][r] * rli[r], o[3][r] * rli[r]};
            *(f32x4*)(s + (size_t)(vo + r * 1024)) = v; }
    } else if (mode == 2) {
#pragma unroll
        for (int r = 0; r < 16; ++r) { unsigned vo = lo16; OPQ(vo);
            f32x4* ap = (f32x4*)(sA + (size_t)(vo + r * 1024)); const f32x4 a = *ap;
            const f32x4 v = {a[0] - C.lam * (o[0][r] * rli[r]), a[1] - C.lam * (o[1][r] * rli[r]), a[2] - C.lam * (o[2][r] * rli[r]), a[3] - C.lam * (o[3][r] * rli[r])};
            *ap = v;
            if ((r & 3) == 3) asm volatile("" ::: "memory"); }
    } else {
        float g0[4], g1[4];
#pragma unroll
        for (int d0 = 0; d0 < 4; ++d0) { g0[d0] = C.gain[d0 * 32 + r32]; g1[d0] = C.gain[128 + d0 * 32 + r32]; }
        char* Ow = (char*)(cur.O + (size_t)(wid * QBLK) * PO);
        const unsigned lo_o = (unsigned)((4 * hi) * PO + r32) * 2u;
#pragma unroll
        for (int r = 0; r < 16; ++r) { unsigned vo = lo16; OPQ(vo);
            const f32x4 a = *(const f32x4*)(sA + (size_t)(vo + r * 1024)); const f32x4 b = *(const f32x4*)(sB + (size_t)(vo + r * 1024));
            float d1[4], ss = 0.f;
#pragma unroll
            for (int d0 = 0; d0 < 4; ++d0) { d1[d0] = b[d0] - C.lam * (o[d0][r] * rli[r]); ss += d1[d0] * d1[d0] + a[d0] * a[d0]; }
            ss += __shfl_xor(ss, 1); ss += __shfl_xor(ss, 2); ss += __shfl_xor(ss, 4); ss += __shfl_xor(ss, 8); ss += __shfl_xor(ss, 16);
            const float scl = rsqrtf(ss * (1.f / 256.f) + C.eps) * C.omli;
            unsigned wo = lo_o; OPQ(wo);
            char* rowp = Ow + (size_t)(wo + (unsigned)(((r & 3) + 8 * (r >> 2)) * PO * 2));
#pragma unroll
            for (int d0 = 0; d0 < 4; ++d0) {
                const float v0 = a[d0] * scl * g0[d0], v1 = d1[d0] * scl * g1[d0];
                const float v0n = __shfl_xor(v0, 1), v1n = __shfl_xor(v1, 1);
                if ((r32 & 1) == 0) { *(unsigned*)(rowp + d0 * 64) = cvtpk(v0, v0n); *(unsigned*)(rowp + 256 + d0 * 64) = cvtpk(v1, v1n); }
            }
            if ((r & 1) == 1) asm volatile("" ::: "memory");
        }
    }
#undef OPQ
    __syncthreads();
}

constexpr int K2 = 32;
constexpr int ST2_K0 = 0, ST2_K1 = 8192, ST2_V = 16384, ST2_BYTES = 32768;
__device__ __forceinline__ int v_st2(int k, int c) { const int kk = (k & ~0xC) | ((k & 4) << 1) | ((k & 8) >> 1); return ((kk >> 3) * 8 + (c >> 5)) * 512 + ((kk & 7) * 32 + (c & 31)) * 2; }
struct Diff2Const { float lam; float omli; float eps; float mb; const float* gain; };
template <int PQ, int PK, int PV, int PO>
__device__ __forceinline__ void diff2_block(const bf16* Qb  , const bf16* Kb  , const bf16* Vb  ,
                                            bf16* Ob, int P0, const Diff2Const& C, char* lds) {
    const int tid = threadIdx.x, wid = __builtin_amdgcn_readfirstlane(tid >> 6), lane = tid & 63, r32 = lane & 31, hi = lane >> 5;
    const int rg = wid & 3, cc = wid >> 2;
    const int krow = tid >> 4, kcol = (tid & 15) * 8, kws = KSWZ(krow, kcol * 2);
    const int vrow0 = tid >> 5, vcol = (tid & 31) * 8, vst0 = v_st2(vrow0, vcol), vst1 = v_st2(16 + vrow0, vcol);
    const int vb0 = (int)(uintptr_t)lds + ST2_V + v_rd_base(lane);
    const char* Kmine = lds + (cc ? ST2_K1 : ST2_K0);
    bf16x8 qr[8];
    { unsigned qo = (unsigned)((rg * QBLK + r32) * PQ + cc * 128 + hi * 8) * 2u; asm volatile("" : "+v"(qo));
#pragma unroll
      for (int d0 = 0; d0 < 8; ++d0) qr[d0] = *(const bf16x8*)((const char*)Qb + (size_t)qo + d0 * 32); }
    f32x16 o[8];
#pragma unroll
    for (int d0 = 0; d0 < 8; ++d0) o[d0] = f32x16{};
    float l_reg = 0.f;
    const int qlo = P0 + rg * QBLK, qm = qlo + r32 - 4 * hi;
    const int NT = P0 / K2 + 4;
    bf16x8 st_k0, st_k1, st_v0, st_v1;
    const unsigned koff = (unsigned)(krow * PK + kcol) * 2u, voffa = (unsigned)(vrow0 * PV + vcol) * 2u, voffb = (unsigned)((16 + vrow0) * PV + vcol) * 2u;
#define D2_LOAD(jt) do { const char* kt_ = (const char*)Kb + (size_t)(jt) * (K2 * PK * 2); const char* vt_ = (const char*)Vb + (size_t)(jt) * (K2 * PV * 2); \
                         unsigned ko_ = koff, va_ = voffa, vb_ = voffb; asm volatile("" : "+v"(ko_), "+v"(va_), "+v"(vb_)); \
                         st_k0 = *(const bf16x8*)(kt_ + (size_t)ko_); st_k1 = *(const bf16x8*)(kt_ + (size_t)ko_ + 256); \
                         st_v0 = *(const bf16x8*)(vt_ + (size_t)va_); st_v1 = *(const bf16x8*)(vt_ + (size_t)vb_); } while (0)
#define D2_WRITE(bf) do { char* st_ = lds + (bf) * ST2_BYTES; *(bf16x8*)(st_ + ST2_K0 + kws) = st_k0; *(bf16x8*)(st_ + ST2_K1 + kws) = st_k1; \
                          *(bf16x8*)(st_ + ST2_V + vst0) = st_v0; *(bf16x8*)(st_ + ST2_V + vst1) = st_v1; } while (0)
    D2_LOAD(0); asm volatile("s_waitcnt vmcnt(0)" ::: "memory"); D2_WRITE(0);
    __syncthreads();
    int buf = 0;
    for (int t = 0; t < NT; ++t) {
        const int kb = t * K2; const bool more = t + 1 < NT;
        if (more) D2_LOAD(t + 1);
        if (kb <= qlo + QBLK - 1) {
            f32x16 p0 = f32x16{};
            { const char* Kt = Kmine + buf * ST2_BYTES; const char* kbp[4];
#pragma unroll
              for (int dd = 0; dd < 4; ++dd) kbp[dd] = Kt + KSWZ(r32, (dd * 16 + hi * 8) * 2);
#pragma unroll
              for (int d0 = 0; d0 < 8; ++d0) { const bf16x8 b0 = *reinterpret_cast<const bf16x8*>(kbp[d0 & 3] + (d0 >> 2) * 128); p0 = __builtin_amdgcn_mfma_f32_32x32x16_bf16(b0, qr[d0], p0, 0, 0, 0); } }
            const float mb = C.mb;
            if (kb + K2 - 1 > qlo) {
                const int dq = qm - kb;
#pragma unroll
                for (int r = 0; r < 16; ++r) { const int c = (r & 3) + 8 * (r >> 2); const float e = __builtin_amdgcn_exp2f(p0[r] - mb); p0[r] = (dq - c) >= 0 ? e : 0.f; }
            } else {
#pragma unroll
                for (int r = 0; r < 16; ++r) p0[r] = __builtin_amdgcn_exp2f(p0[r] - mb);
            }
            float ps = 0.f;
#pragma unroll
            for (int r = 0; r < 16; ++r) ps += p0[r];
            l_reg += ps;
            bf16x8 pa0, pa1;
            PK4(p0, 0, pa0); PK4(p0, 8, pa1);
            SBAR();
            const int vb = vb0 + buf * ST2_BYTES;
#define TRRD(dst, off) asm volatile("ds_read_b64_tr_b16 %0, %1 offset:%2" : "=&v"(dst) : "v"(vb), "i"(off) : "memory")
#define PV2_RD(d0, L0, H0, L1, H1) do { constexpr int b_ = (d0) * 512; TRRD(L0, b_); TRRD(H0, b_ + 4096); TRRD(L1, b_ + 8192); TRRD(H1, b_ + 12288); } while (0)
#define PV2_MM(d0, L0, H0, L1, H1) do { \
        o[d0] = __builtin_amdgcn_mfma_f32_32x32x16_bf16(pa0, (bf16x8){L0[0], L0[1], L0[2], L0[3], H0[0], H0[1], H0[2], H0[3]}, o[d0], 0, 0, 0); \
        o[d0] = __builtin_amdgcn_mfma_f32_32x32x16_bf16(pa1, (bf16x8){L1[0], L1[1], L1[2], L1[3], H1[0], H1[1], H1[2], H1[3]}, o[d0], 0, 0, 0); } while (0)
#define LGK(n) do { asm volatile("s_waitcnt lgkmcnt(" #n ")" ::: "memory"); SBAR(); } while (0)
            { s16x4 la0, ha0, la1, ha1, lb0, hb0, lb1, hb1;
              PV2_RD(0, la0, ha0, la1, ha1);
              PV2_RD(1, lb0, hb0, lb1, hb1); LGK(4); PV2_MM(0, la0, ha0, la1, ha1);
              PV2_RD(2, la0, ha0, la1, ha1); LGK(4); PV2_MM(1, lb0, hb0, lb1, hb1);
              PV2_RD(3, lb0, hb0, lb1, hb1); LGK(4); PV2_MM(2, la0, ha0, la1, ha1);
              PV2_RD(4, la0, ha0, la1, ha1); LGK(4); PV2_MM(3, lb0, hb0, lb1, hb1);
              PV2_RD(5, lb0, hb0, lb1, hb1); LGK(4); PV2_MM(4, la0, ha0, la1, ha1);
              PV2_RD(6, la0, ha0, la1, ha1); LGK(4); PV2_MM(5, lb0, hb0, lb1, hb1);
              PV2_RD(7, lb0, hb0, lb1, hb1); LGK(4); PV2_MM(6, la0, ha0, la1, ha1);
              LGK(0); PV2_MM(7, lb0, hb0, lb1, hb1); }
#undef PV2_RD
#undef PV2_MM
#undef LGK
#undef TRRD
        }
        if (more) { asm volatile("s_waitcnt vmcnt(0)" ::: "memory"); D2_WRITE(buf ^ 1); }
        __syncthreads();
        buf ^= 1;
    }
#undef D2_LOAD
#undef D2_WRITE
    { auto rr = __builtin_amdgcn_permlane32_swap(__float_as_uint(l_reg), __float_as_uint(l_reg), false, false); l_reg = __uint_as_float(rr[0]) + __uint_as_float(rr[1]); }
    float* lw = (float*)(lds + 132096) + wid * 32;
    if (hi == 0) lw[r32] = l_reg; asm volatile("s_waitcnt lgkmcnt(0)" ::: "memory");
    float rli[16];
#pragma unroll
    for (int r = 0; r < 16; ++r) rli[r] = __builtin_amdgcn_rcpf(lw[crow(r, hi)]);
    float* X = (float*)lds + rg * 8192;
#define OPQ(v) asm volatile("" : "+v"(v))
    if (cc == 1) {
#pragma unroll
        for (int r = 0; r < 16; ++r) { const float f = C.lam * rli[r]; unsigned vo = (unsigned)lane; OPQ(vo);
#pragma unroll
            for (int d0 = 0; d0 < 8; ++d0) X[(r * 8 + d0) * 64 + vo] = o[d0][r] * f; }
    }
    __syncthreads();
    if (cc == 0) {
        float g[8];
        { unsigned go = (unsigned)r32 * 4u; OPQ(go);
#pragma unroll
          for (int d0 = 0; d0 < 8; ++d0) g[d0] = *(const float*)((const char*)C.gain + (size_t)go + d0 * 128); }
        char* Ow = (char*)(Ob + (size_t)(rg * QBLK) * PO);
        const unsigned lo_o = (unsigned)((4 * hi) * PO + r32) * 2u;
#pragma unroll
        for (int r = 0; r < 16; ++r) { unsigned vo = (unsigned)lane; OPQ(vo);
            float d[8], ss = 0.f;
#pragma unroll
            for (int d0 = 0; d0 < 8; ++d0) { d[d0] = o[d0][r] * rli[r] - X[(r * 8 + d0) * 64 + vo]; ss += d[d0] * d[d0]; }
            ss += __shfl_xor(ss, 1); ss += __shfl_xor(ss, 2); ss += __shfl_xor(ss, 4); ss += __shfl_xor(ss, 8); ss += __shfl_xor(ss, 16);
            const float scl = rsqrtf(ss * (1.f / 256.f) + C.eps) * C.omli;
            unsigned wo = lo_o; OPQ(wo);
            char* rowp = Ow + (size_t)(wo + (unsigned)(((r & 3) + 8 * (r >> 2)) * PO * 2));
#pragma unroll
            for (int d0 = 0; d0 < 8; ++d0) { const float v = d[d0] * scl * g[d0]; const float vn = __shfl_xor(v, 1);
                if ((r32 & 1) == 0) *(unsigned*)(rowp + d0 * 64) = cvtpk(v, vn); }
        }
    }
#undef OPQ
    __syncthreads();
}
}
#ifndef PG8_SP2
#define PG8_SP2 true
#endif
#ifndef PG8_ALIGN
#define PG8_ALIGN true
#endif
#ifndef MK_SPLIT
#define MK_SPLIT 0
#endif
#ifndef MK_CHECK
#define MK_CHECK 0
#endif
constexpr int NWAVES = 8;
constexpr int BATCH = 2, SEQ = 4096, DM = 4096, MROWS = BATCH * SEQ, FF = 11008, FF2 = 2 * FF, NQKV = 3 * DM;
constexpr int SB_H = 32, DF_H = 16, HD = 128;
constexpr float RMS_EPS = 1e-6f;
constexpr float LOG2E = 1.4426950408889634f;
constexpr float QSCALE = 0.08838834764831845f * LOG2E;
constexpr int NPH = 14;
constexpr size_t MiB = 1u << 20;
constexpr size_t WS_CTL = 0, CTL_ZERO_BYTES = 1 * MiB;
constexpr size_t WS_WQKV0 = 2 * MiB;
constexpr size_t WS_WO0   = WS_WQKV0 + 96 * MiB;
constexpr size_t WS_WQKV1 = WS_WO0 + 32 * MiB;
constexpr size_t WS_WO1   = WS_WQKV1 + 96 * MiB;
constexpr size_t WS_WUP0  = WS_WO1 + 32 * MiB;
constexpr size_t WS_WUP1  = WS_WUP0 + 172 * MiB;
constexpr size_t WS_WDN0  = WS_WUP1 + 172 * MiB;
constexpr size_t WS_WDN1  = WS_WDN0 + 86 * MiB;
constexpr size_t WS_XN    = WS_WDN1 + 86 * MiB;
constexpr size_t WS_PART  = WS_XN + 64 * MiB;
constexpr size_t WS_QKV   = WS_PART + 2 * MiB;
constexpr size_t WS_QKN   = WS_QKV + 192 * MiB;
constexpr size_t WS_AO    = WS_QKN + 128 * MiB;
constexpr size_t WS_U     = WS_AO + 64 * MiB;
constexpr size_t WS_ACT   = WS_U + 344 * MiB;
constexpr size_t WS_SCR   = WS_ACT + 172 * MiB;
constexpr size_t WS_HALO  = WS_SCR + 64 * MiB;
constexpr size_t WS_X1    = WS_HALO + 44 * MiB;
constexpr size_t WS_END   = WS_X1 + (MK_CHECK ? 3 * 128 * MiB : 0);
constexpr int CW_TMO = 0, CW_CODE = 1, CW_FAIL = 2, CW_BAR = 4096;

constexpr int RING_OFF = 0, RING_BYTES = 131072;
constexpr int LDSCTL_OFF = RING_BYTES, MISC_OFF = LDSCTL_OFF + 320;
constexpr int LDS_BYTES = 147456;
static_assert(MISC_OFF + 128 <= LDS_BYTES, "LDS map");

#define GAS __attribute__((address_space(1)))
#define LAS __attribute__((address_space(3)))
typedef unsigned short bf16;
typedef unsigned v4u __attribute__((ext_vector_type(4)));
typedef unsigned v2u __attribute__((ext_vector_type(2)));
typedef float f32x4 __attribute__((ext_vector_type(4)));
typedef short bf16x8 __attribute__((ext_vector_type(8)));
typedef GAS unsigned gu32;
#define RLX_AGENT __ATOMIC_RELAXED, __HIP_MEMORY_SCOPE_AGENT
#define LDS_WAIT() asm volatile("s_waitcnt lgkmcnt(0)" ::: "memory")
#define VM_WAIT() asm volatile("s_waitcnt vmcnt(0)" ::: "memory")
__device__ __forceinline__ unsigned f2bf(float f) { unsigned u = __builtin_bit_cast(unsigned, f); return (u + 0x7fffu + ((u >> 16) & 1u)) >> 16; }
__device__ __forceinline__ unsigned pk2(float lo, float hi) { return f2bf(lo) | (f2bf(hi) << 16); }
__device__ __forceinline__ float bf2f(unsigned short b) { return __builtin_bit_cast(float, (unsigned)b << 16); }

#define XB_TMO      128
#define XB_XCNT(j)  (256  + 64 * (j))
#define XB_XSUB(j)  (1280 + 64 * (j))
#define XB_XGEN(j)  (2304 + 64 * (j))
#define XB_TOP      3328
#define XB_TOPGEN   3392
#define XCD_BAR_WORDS 3456
#define XB_SPIN_CAP (1u << 18)
__device__ __forceinline__ unsigned xb_ld(unsigned* p)              { return __hip_atomic_load(p, __ATOMIC_RELAXED, __HIP_MEMORY_SCOPE_AGENT); }
__device__ __forceinline__ unsigned xb_add(unsigned* p, unsigned v) { return __hip_atomic_fetch_add(p, v, __ATOMIC_RELAXED, __HIP_MEMORY_SCOPE_AGENT); }
__device__ __forceinline__ unsigned xb_xcc_id() { return (unsigned)__builtin_amdgcn_s_getreg((3 << 11) | 20) & 0xFu; }
#define XB_SPIN(cond, bar) do { unsigned _sp = 0; while (cond) { __builtin_amdgcn_s_sleep(1); \
    if ((++_sp & 255u) == 0u) { if (xb_ld(&(bar)[XB_TMO])) break; if (_sp > XB_SPIN_CAP) { atomicAdd(&(bar)[XB_TMO], 1u); break; } } } } while (0)
struct XcdBarrier { unsigned* bar; unsigned x; volatile LAS unsigned* st; };
__device__ __forceinline__ XcdBarrier xcd_barrier_post(unsigned* bar, volatile LAS unsigned* st) {
    XcdBarrier b; b.bar = bar; b.x = xb_xcc_id(); b.st = st;
    if (threadIdx.x == 0) (void)xb_add(&bar[XB_XCNT(b.x)], 1u);
    return b;
}
__device__ __forceinline__ void xcd_barrier_complete(unsigned* bar, unsigned x, unsigned& nloc, unsigned& nx) {
    const unsigned G = gridDim.x * gridDim.y * gridDim.z;
    unsigned sum, cnt, mine, sp = 0u;
    for (;;) {
        sum = 0u; cnt = 0u; mine = 0u;
#pragma unroll
        for (unsigned j = 0; j < 16; ++j) { const unsigned c = xb_ld(&bar[XB_XCNT(j)]); sum += c; cnt += (c > 0u) ? 1u : 0u; mine = (j == x) ? c : mine; }
        if (sum == G) break;
        __builtin_amdgcn_s_sleep(1);
        if ((++sp & 255u) == 0u) { if (xb_ld(&bar[XB_TMO])) break; if (sp > XB_SPIN_CAP) { atomicAdd(&bar[XB_TMO], 1u); break; } }
    }
    nloc = mine > 0u ? mine : 1u; nx = cnt > 0u ? cnt : 1u;
}
__device__ __forceinline__ void xcd_barrier(const XcdBarrier& b) {
    asm volatile("s_waitcnt vmcnt(0)" ::: "memory");
    __syncthreads();
    if (threadIdx.x == 0) {
        unsigned* bar = b.bar;
        __builtin_amdgcn_s_waitcnt(0);
        unsigned nloc = b.st[0], nx = b.st[1];
        if (nloc == 0u) { xcd_barrier_complete(bar, b.x, nloc, nx); b.st[0] = nloc; b.st[1] = nx; }
        const unsigned old = xb_add(&bar[XB_XSUB(b.x)], 1u);
        const unsigned gen = old / nloc;
        if (old + 1u == (gen + 1u) * nloc) {
            __builtin_amdgcn_fence(__ATOMIC_RELEASE, "agent");
            asm volatile("s_waitcnt vmcnt(0)" ::: "memory");
            const unsigned og = xb_add(&bar[XB_TOP], 1u);
            const unsigned tg = og / nx;
            if (og + 1u == (tg + 1u) * nx) xb_add(&bar[XB_TOPGEN], 1u);
            else XB_SPIN(xb_ld(&bar[XB_TOPGEN]) == tg, bar);
            __builtin_amdgcn_fence(__ATOMIC_ACQUIRE, "agent");
            xb_add(&bar[XB_XGEN(b.x)], 1u);
            asm volatile("s_waitcnt vmcnt(0)" ::: "memory");
        } else {
            XB_SPIN(xb_ld(&bar[XB_XGEN(b.x)]) == gen, bar);
            __builtin_amdgcn_fence(__ATOMIC_ACQUIRE, "agent");
            asm volatile("s_waitcnt vmcnt(0)" ::: "memory");
        }
    }
    __syncthreads();
}

__device__ __forceinline__ float wave_sum(float v) {
#pragma unroll
    for (int o = 1; o < 64; o <<= 1) v += __shfl_xor(v, o);
    return v;
}

constexpr int TR_STRIDE = 33;
__device__ __forceinline__ void transpose_item(const float* W, const float* gain, int K, int N, bf16* WT, LAS unsigned* scr, int item, int lane, bool gateperm) {
    const int nblk = N / 64, kb = item / nblk, nb = item % nblk, k0 = 64 * kb, n0 = 64 * nb;
    const int h_ = N / 2, nd0 = gateperm ? ((n0 % h_) / 128) * 256 + (n0 / h_) * 128 + (n0 % 128) : n0;
    const int kp = lane >> 4, c = lane & 15;
    f32x4 va[8], vb[8];
#pragma unroll
    for (int i = 0; i < 8; ++i) { const GAS float* src = (const GAS float*)W + (size_t)(k0 + 8 * i + 2 * kp) * N + n0 + 4 * c; va[i] = __builtin_nontemporal_load((const GAS f32x4*)src); vb[i] = __builtin_nontemporal_load((const GAS f32x4*)(src + N)); }
#pragma unroll
    for (int i = 0; i < 8; ++i) { float ga = 1.f, gb = 1.f; if (gain) { ga = gain[k0 + 8 * i + 2 * kp]; gb = gain[k0 + 8 * i + 2 * kp + 1]; }
        LAS unsigned* d = scr + (4 * c) * TR_STRIDE + 4 * i + kp;
        d[0 * TR_STRIDE] = pk2(va[i].x * ga, vb[i].x * gb); d[1 * TR_STRIDE] = pk2(va[i].y * ga, vb[i].y * gb);
        d[2 * TR_STRIDE] = pk2(va[i].z * ga, vb[i].z * gb); d[3 * TR_STRIDE] = pk2(va[i].w * ga, vb[i].w * gb); }
    LDS_WAIT(); asm volatile("" ::: "memory");
    const int c8 = lane & 7, nr = lane >> 3;
#pragma unroll
    for (int j = 0; j < 8; ++j) { const int n = nr + 8 * j; const LAS unsigned* s = scr + n * TR_STRIDE + 4 * c8;
        v4u o; o.x = s[0]; o.y = s[1]; o.z = s[2]; o.w = s[3];
        *(GAS v4u*)(WT + (size_t)(nd0 + n) * K + k0 + 8 * c8) = o; }
    LDS_WAIT(); asm volatile("" ::: "memory");
}
__device__ __forceinline__ void xrow_to_bf16(const float* xrow, bf16* orow, float* prow, int lane) {
    const GAS f32x4* xr = (const GAS f32x4*)xrow + lane;
    float s = 0.f; GAS unsigned long long* o8 = (GAS unsigned long long*)orow + lane;
#pragma unroll
    for (int j = 0; j < 16; ++j) { const f32x4 v = xr[64 * j]; s += (v.x * v.x + v.y * v.y) + (v.z * v.z + v.w * v.w);
        o8[64 * j] = (unsigned long long)pk2(v.x, v.y) | ((unsigned long long)pk2(v.z, v.w) << 32); }
    s = wave_sum(s);
    prow[lane] = lane == 0 ? s : 0.f;
}

__device__ __forceinline__ void cvt8(const v4u w, float (&f)[8]) {
    f[0] = __builtin_bit_cast(float, w.x << 16); f[1] = __builtin_bit_cast(float, w.x & 0xffff0000u); f[2] = __builtin_bit_cast(float, w.y << 16); f[3] = __builtin_bit_cast(float, w.y & 0xffff0000u);
    f[4] = __builtin_bit_cast(float, w.z << 16); f[5] = __builtin_bit_cast(float, w.z & 0xffff0000u); f[6] = __builtin_bit_cast(float, w.w << 16); f[7] = __builtin_bit_cast(float, w.w & 0xffff0000u);
}
constexpr int CG_ROWS = 32, CG_NCG = FF / 8, CG_ITEMS = (MROWS / CG_ROWS) * CG_NCG;
__device__ __forceinline__ void convgate_item(const bf16* U, const float* cw, const float* cb, bf16* ACT, int item) {
    const int chunk = item / CG_NCG, cg = item % CG_NCG, m0 = chunk * CG_ROWS, t0 = m0 % SEQ, j0 = cg * 8;
    float wg[3][8], wv[3][8], bg[8], bv[8];
#pragma unroll
    for (int i = 0; i < 3; ++i)
#pragma unroll
        for (int h = 0; h < 2; ++h) { const f32x4 a = *(const f32x4*)(cw + (size_t)i * FF2 + j0 + 4 * h), b = *(const f32x4*)(cw + (size_t)i * FF2 + FF + j0 + 4 * h);
            wg[i][4 * h] = a.x; wg[i][4 * h + 1] = a.y; wg[i][4 * h + 2] = a.z; wg[i][4 * h + 3] = a.w; wv[i][4 * h] = b.x; wv[i][4 * h + 1] = b.y; wv[i][4 * h + 2] = b.z; wv[i][4 * h + 3] = b.w; }
#pragma unroll
    for (int h = 0; h < 2; ++h) { const f32x4 a = *(const f32x4*)(cb + j0 + 4 * h), b = *(const f32x4*)(cb + FF + j0 + 4 * h);
        bg[4 * h] = a.x; bg[4 * h + 1] = a.y; bg[4 * h + 2] = a.z; bg[4 * h + 3] = a.w; bv[4 * h] = b.x; bv[4 * h + 1] = b.y; bv[4 * h + 2] = b.z; bv[4 * h + 3] = b.w; }
    float g2[8], g1[8], v2[8], v1[8];
    const v4u z4 = {0u, 0u, 0u, 0u};
    { const v4u a = t0 >= 2 ? *(const GAS v4u*)(U + (size_t)(m0 - 2) * FF2 + j0) : z4, b = t0 >= 2 ? *(const GAS v4u*)(U + (size_t)(m0 - 2) * FF2 + FF + j0) : z4; cvt8(a, g2); cvt8(b, v2); }
    { const v4u a = t0 >= 1 ? *(const GAS v4u*)(U + (size_t)(m0 - 1) * FF2 + j0) : z4, b = t0 >= 1 ? *(const GAS v4u*)(U + (size_t)(m0 - 1) * FF2 + FF + j0) : z4; cvt8(a, g1); cvt8(b, v1); }
#pragma unroll 4
    for (int r = 0; r < CG_ROWS; ++r) {
        float g0[8], v0[8]; cvt8(*(const GAS v4u*)(U + (size_t)(m0 + r) * FF2 + j0), g0); cvt8(*(const GAS v4u*)(U + (size_t)(m0 + r) * FF2 + FF + j0), v0);
        float o[8];
#pragma unroll
        for (int e = 0; e < 8; ++e) { const float cgv = bg[e] + wg[0][e] * g2[e] + wg[1][e] * g1[e] + wg[2][e] * g0[e]; const float cvv = bv[e] + wv[0][e] * v2[e] + wv[1][e] * v1[e] + wv[2][e] * v0[e];
            const float sg = cgv * __builtin_amdgcn_rcpf(1.f + __builtin_amdgcn_exp2f(-cgv * LOG2E)); o[e] = sg * cvv; g2[e] = g1[e]; g1[e] = g0[e]; v2[e] = v1[e]; v1[e] = v0[e]; }
        v4u w; w.x = pk2(o[0], o[1]); w.y = pk2(o[2], o[3]); w.z = pk2(o[4], o[5]); w.w = pk2(o[6], o[7]);
        *(GAS v4u*)(ACT + (size_t)(m0 + r) * FF + j0) = w;
    }
}

constexpr int FX_ITEMS = (MROWS / 64) * CG_NCG;
__device__ __forceinline__ void ld8(const float* p, float (&f)[8]) { const f32x4 a = *(const GAS f32x4*)p, b = *(const GAS f32x4*)(p + 4); f[0] = a.x; f[1] = a.y; f[2] = a.z; f[3] = a.w; f[4] = b.x; f[5] = b.y; f[6] = b.z; f[7] = b.w; }
__device__ __forceinline__ void fixup_item(const float* halo, const float* cw, const float* cb, bf16* ACT, int item) {
    const int grp = item / CG_NCG, cg = item % CG_NCG, j0 = cg * 8; const bool first = (grp % (SEQ / 64)) == 0;
    float wg[3][8], wv[3][8], bg[8], bv[8];
#pragma unroll
    for (int i = 0; i < 3; ++i) { ld8(cw + (size_t)i * FF2 + j0, wg[i]); ld8(cw + (size_t)i * FF2 + FF + j0, wv[i]); }
    ld8(cb + j0, bg); ld8(cb + FF + j0, bv);
    float h0g[8], h0v[8], h1g[8], h1v[8], t0g[8], t0v[8], t1g[8], t1v[8];
    const float* hb = halo + (size_t)grp * 4 * FF2 + j0;
    ld8(hb, h0g); ld8(hb + FF, h0v); ld8(hb + FF2, h1g); ld8(hb + FF2 + FF, h1v);
    if (!first) { const float* pb = hb - 4 * (size_t)FF2; ld8(pb + 2 * (size_t)FF2, t0g); ld8(pb + 2 * (size_t)FF2 + FF, t0v); ld8(pb + 3 * (size_t)FF2, t1g); ld8(pb + 3 * (size_t)FF2 + FF, t1v); }
    else {
#pragma unroll
        for (int e = 0; e < 8; ++e) { t0g[e] = 0.f; t0v[e] = 0.f; t1g[e] = 0.f; t1v[e] = 0.f; } }
    float o0[8], o1[8];
#pragma unroll
    for (int e = 0; e < 8; ++e) {
        const float cg0 = bg[e] + wg[0][e] * t0g[e] + wg[1][e] * t1g[e] + wg[2][e] * h0g[e], cv0 = bv[e] + wv[0][e] * t0v[e] + wv[1][e] * t1v[e] + wv[2][e] * h0v[e];
        const float cg1 = bg[e] + wg[0][e] * t1g[e] + wg[1][e] * h0g[e] + wg[2][e] * h1g[e], cv1 = bv[e] + wv[0][e] * t1v[e] + wv[1][e] * h0v[e] + wv[2][e] * h1v[e];
        o0[e] = cg0 * __builtin_amdgcn_rcpf(1.f + __builtin_amdgcn_exp2f(-cg0 * LOG2E)) * cv0; o1[e] = cg1 * __builtin_amdgcn_rcpf(1.f + __builtin_amdgcn_exp2f(-cg1 * LOG2E)) * cv1; }
    v4u w0, w1; w0.x = pk2(o0[0], o0[1]); w0.y = pk2(o0[2], o0[3]); w0.z = pk2(o0[4], o0[5]); w0.w = pk2(o0[6], o0[7]);
    w1.x = pk2(o1[0], o1[1]); w1.y = pk2(o1[2], o1[3]); w1.z = pk2(o1[4], o1[5]); w1.w = pk2(o1[6], o1[7]);
    *(GAS v4u*)(ACT + (size_t)(grp * 64) * FF + j0) = w0; *(GAS v4u*)(ACT + (size_t)(grp * 64 + 1) * FF + j0) = w1;
}

__device__ __forceinline__ void sincos_rev(float ang, float& s, float& c) {
    const float I1 = 0.15915493667125702f, I2 = 6.420638326565253e-09f;
    const float r1 = ang * I1; const float e1 = __builtin_fmaf(ang, I1, -r1); const float r2 = __builtin_fmaf(ang, I2, e1);
    const float fr = (r1 - __builtin_rintf(r1)) + r2;
    s = __builtin_amdgcn_sinf(fr); c = __builtin_amdgcn_cosf(fr);
}
__device__ __forceinline__ void qknorm_row(const bf16* qkv_row, bf16* qkn_row, const float* gq, const float* gk, int t, int lane) {
    const int c = lane & 7, gs = lane >> 3;
    float cs[8], sn[8];
#pragma unroll
    for (int e = 0; e < 8; ++e) { const int i = 8 * c + e; const float invf = __builtin_amdgcn_exp2f(-(float)i * (13.287712379549449f / 64.f));
        sincos_rev((float)t * invf, sn[e], cs[e]); }
    float gA[8], gB[8];
#pragma unroll 1
    for (int qk = 0; qk < 2; ++qk) {
        const float* gn = qk ? gk : gq; const float sc = qk ? 1.f : QSCALE;
#pragma unroll
        for (int e = 0; e < 8; ++e) { gA[e] = gn[8 * c + e]; gB[e] = gn[64 + 8 * c + e]; }
        v4u ra[4], rb[4];
#pragma unroll
        for (int it = 0; it < 4; ++it) { const int col = qk * 4096 + (it * 8 + gs) * 128 + 8 * c; ra[it] = *(const GAS v4u*)(qkv_row + col); rb[it] = *(const GAS v4u*)(qkv_row + col + 64); }
#pragma unroll
        for (int it = 0; it < 4; ++it) {
            const int col = qk * 4096 + (it * 8 + gs) * 128 + 8 * c;
            float xa[8], xb[8]; cvt8(ra[it], xa); cvt8(rb[it], xb);
            float ss = 0.f;
#pragma unroll
            for (int e = 0; e < 8; ++e) ss += xa[e] * xa[e] + xb[e] * xb[e];
            ss += __shfl_xor(ss, 1); ss += __shfl_xor(ss, 2); ss += __shfl_xor(ss, 4);
            const float inv = rsqrtf(ss * (1.f / 128.f) + RMS_EPS);
            float oa[8], ob[8];
#pragma unroll
            for (int e = 0; e < 8; ++e) { const float ya = xa[e] * inv * gA[e], yb = xb[e] * inv * gB[e]; oa[e] = (ya * cs[e] - yb * sn[e]) * sc; ob[e] = (yb * cs[e] + ya * sn[e]) * sc; }
            v4u wa, wb; wa.x = pk2(oa[0], oa[1]); wa.y = pk2(oa[2], oa[3]); wa.z = pk2(oa[4], oa[5]); wa.w = pk2(oa[6], oa[7]);
            wb.x = pk2(ob[0], ob[1]); wb.y = pk2(ob[2], ob[3]); wb.z = pk2(ob[4], ob[5]); wb.w = pk2(ob[6], ob[7]);
            *(GAS v4u*)(qkn_row + col) = wa; *(GAS v4u*)(qkn_row + col + 64) = wb;
        }
    }
}
struct Args { const float* in[18]; float* out; unsigned char* ws; int ph_lo, ph_hi; };
static_assert(sizeof(Args) == 18 * 8 + 8 + 8 + 8, "Args has no padding");

struct MatDesc { int in_idx; size_t in_off; int gain_idx; size_t gain_off; int K, N; size_t ws_off; int gateperm; };
__device__ __forceinline__ MatDesc mat_desc(int i) {
    switch (i) {
    case 0: return MatDesc{2, 0, 1, 0, DM, NQKV, WS_WQKV0, 0};
    case 1: return MatDesc{3, 0, -1, 0, DM, DM, WS_WO0, 0};
    case 2: return MatDesc{14, 0, 13, 0, DM, FF2, WS_WUP0, 1};
    case 3: return MatDesc{17, 0, -1, 0, FF, DM, WS_WDN0, 0};
    case 4: return MatDesc{4, 0, 1, (size_t)DM, DM, NQKV, WS_WQKV1, 0};
    case 5: return MatDesc{5, 0, -1, 0, DM, DM, WS_WO1, 0};
    case 6: return MatDesc{14, (size_t)DM * FF2, 13, (size_t)DM, DM, FF2, WS_WUP1, 1};
    default: return MatDesc{17, (size_t)FF * DM, -1, 0, FF, DM, WS_WDN1, 0};
    }
}

__global__ void __launch_bounds__(NWAVES * 64, 2) mk_fwd(Args args) {
    extern __shared__ __attribute__((aligned(16))) unsigned char lds[];
    LAS unsigned char* ldsl = (LAS unsigned char*)lds;
    volatile LAS unsigned* MISC = (volatile LAS unsigned*)(ldsl + MISC_OFF);
    const int tid = threadIdx.x, lane = tid & 63, wave = __builtin_amdgcn_readfirstlane(tid >> 6);
    const int G = gridDim.x, bx = blockIdx.x;
    const int gw = bx * NWAVES + wave, NGW = G * NWAVES;
    unsigned char* ws = args.ws;
    gu32* ctl = (gu32*)(ws + WS_CTL);
    for (int u = tid; u < (LDS_BYTES - LDSCTL_OFF) / 4; u += NWAVES * 64) ((LAS unsigned*)(ldsl + LDSCTL_OFF))[u] = 0u;
    __syncthreads();
    XcdBarrier bar; bar.bar = (unsigned*)(ctl + CW_BAR); bar.x = 0; bar.st = nullptr;
    const int lo = args.ph_lo, hi = args.ph_hi;
    if (hi - lo > 1) bar = xcd_barrier_post((unsigned*)(ctl + CW_BAR), MISC + 8);
#ifndef PH_MASK
#define PH_MASK 0x3fff
#endif
#define IN(k) (((PH_MASK >> (k)) & 1) && lo <= (k) && (k) < hi)
#define SEAM(k) do { if (IN(k) && IN((k) + 1)) xcd_barrier(bar); STAMP((k) + 1); } while (0)
#ifndef REPEAT_PHASE
#define REPEAT_PHASE -1
#endif
#ifndef REPEAT_N
#define REPEAT_N 1
#endif
#ifndef LEAK_A
#define LEAK_A -1
#endif
#ifndef LEAK_B
#define LEAK_B 14
#endif
#ifndef LEAK_OFF
#define LEAK_OFF 0
#endif
    unsigned long long tA = 0, tB = 0;
#define STAMP(k) do { if (LEAK_A >= 0 && bx == 0 && tid == 0) { if ((k) == LEAK_A) tA = __builtin_amdgcn_s_memrealtime(); if ((k) == LEAK_B) tB = __builtin_amdgcn_s_memrealtime(); } } while (0)
#define NREP(k) (REPEAT_PHASE == (k) ? 1 + REPEAT_N : 1)
    float* DUMMY = (float*)(ws + WS_END);

    bf16* XN = (bf16*)(ws + WS_XN); float* PART = (float*)(ws + WS_PART);
    bf16* QKV = (bf16*)(ws + WS_QKV); bf16* QKN = (bf16*)(ws + WS_QKN); bf16* AO = (bf16*)(ws + WS_AO);
    bf16* ACT = (bf16*)(ws + WS_ACT); float* HALO = (float*)(ws + WS_HALO);
    const float* x_in = args.in[0];

#ifndef JIT_CONV
#define JIT_CONV 1
#endif
#define CONVERT_MAT(MI) do { const MatDesc md = mat_desc(MI); LAS unsigned* scr_ = (LAS unsigned*)(ldsl + RING_OFF + wave * 16384); \
        const float* W_ = args.in[md.in_idx] + md.in_off; const float* gain_ = md.gain_idx >= 0 ? args.in[md.gain_idx] + md.gain_off : nullptr; \
        bf16* WT_ = (bf16*)(ws + md.ws_off); const int nitems_ = (md.K / 64) * (md.N / 64); \
        for (int it_ = gw; it_ < nitems_; it_ += NGW) transpose_item(W_, gain_, md.K, md.N, WT_, scr_, it_, lane, md.gateperm != 0); } while (0)
#define CONVERT_MAT_RANGE(MI, I0, I1, WG0) do { const MatDesc md = mat_desc(MI); LAS unsigned* scr_ = (LAS unsigned*)(ldsl + RING_OFF + wave * 16384); \
        const float* W_ = args.in[md.in_idx] + md.in_off; const float* gain_ = md.gain_idx >= 0 ? args.in[md.gain_idx] + md.gain_off : nullptr; \
        bf16* WT_ = (bf16*)(ws + md.ws_off); const int i1_ = (I1); \
        for (int it_ = (I0) + (bx - (WG0)) * NWAVES + wave; it_ < i1_; it_ += (G - (WG0)) * NWAVES) transpose_item(W_, gain_, md.K, md.N, WT_, scr_, it_, lane, md.gateperm != 0); } while (0)
#ifndef TAILFILL
#define TAILFILL 1
#endif
constexpr int DN_ITEMS = (FF / 64) * (DM / 64), DN_SPLIT = TAILFILL ? (DN_ITEMS * 13) / 25 : 0;
#ifndef SPLIT_CONV
#define SPLIT_CONV 1
#endif
#ifdef PROBE_XCC
    if (tid == 0) __hip_atomic_store(ctl + 2048 + bx, 1u + xb_xcc_id(), RLX_AGENT);
#endif
    STAMP(0);
    if (IN(0)) _Pragma("unroll") for (int rep = 0; rep < NREP(0); ++rep) { if (rep) xcd_barrier(bar);
        LAS unsigned* scr = (LAS unsigned*)(ldsl + RING_OFF + wave * 16384);
#pragma unroll 1
#if JIT_CONV
        for (int m = gw; m < MROWS; m += NGW) xrow_to_bf16(x_in + (size_t)m * DM, XN + (size_t)m * DM, PART + (size_t)m * pg8::NPART, lane);
        CONVERT_MAT(0);
    }
#else
        for (int mo = 0; mo < (SPLIT_CONV ? 4 : 8); ++mo) { const int mi = SPLIT_CONV ? ((mo + 1) & 3) : ((mo + 1) & 7); const MatDesc md = mat_desc(mi);
            if (mi == 0) { for (int m = gw; m < MROWS; m += NGW) xrow_to_bf16(x_in + (size_t)m * DM, XN + (size_t)m * DM, PART + (size_t)m * pg8::NPART, lane); }
            const float* W = args.in[md.in_idx] + md.in_off; const float* gain = md.gain_idx >= 0 ? args.in[md.gain_idx] + md.gain_off : nullptr;
            bf16* WT = (bf16*)(ws + md.ws_off); const int nitems = (md.K / 64) * (md.N / 64);
            for (int it = gw; it < nitems; it += NGW) transpose_item(W, gain, md.K, md.N, WT, scr, it, lane, md.gateperm != 0); }
    }
#endif
    SEAM(0);
    if (IN(1)) _Pragma("unroll") for (int rep = 0; rep < NREP(1); ++rep) { if (rep) xcd_barrier(bar);
        pg8::Gemm g{XN, (const bf16*)(ws + WS_WQKV0), MROWS, NQKV, DM}; pg8::StaticOrder S; S.init(MROWS, NQKV, G, bx);
        pg8::EpiScale E{QKV, NQKV, PART, 1.f / DM, RMS_EPS, DM, QSCALE};
        pg8::gemm_phase<pg8::EpiScale, pg8::StaticOrder, PG8_ALIGN, PG8_SP2>(ldsl + RING_OFF, g, S, E);
    }
    SEAM(1);
    if (IN(2)) _Pragma("unroll") for (int rep = 0; rep < NREP(2); ++rep) { if (rep) xcd_barrier(bar);
        constexpr int NBLK = BATCH * SB_H * (SEQ / 256);
        for (int L = bx; L < NBLK; L += G) { const int qb = L % 16, bh = L / 16, b = bh / SB_H, h = bh % SB_H;
            const bf16* kvbase = QKV + (size_t)(b * SEQ) * NQKV + h * HD;
            att::sb_block<NQKV, NQKV, NQKV, DM>(kvbase + (size_t)(qb * 256) * NQKV, kvbase + DM, kvbase + 2 * DM, AO + (size_t)(b * SEQ + qb * 256) * DM + h * HD, qb * 256, (char*)lds + RING_OFF, (volatile LAS unsigned*)(ldsl + RING_OFF + 65536)); }
        if (JIT_CONV) CONVERT_MAT(1);
    }
    SEAM(2);
    if (IN(3)) _Pragma("unroll") for (int rep = 0; rep < NREP(3); ++rep) { if (rep) xcd_barrier(bar);
        pg8::Gemm g{AO, (const bf16*)(ws + WS_WO0), MROWS, DM, DM}; pg8::StaticOrder S; S.init(MROWS, DM, G, bx);
        pg8::EpiResid<false, false> E{nullptr, nullptr, XN, PART, DM};
        pg8::gemm_phase<pg8::EpiResid<false, false>, pg8::StaticOrder, PG8_ALIGN, PG8_SP2>(ldsl + RING_OFF, g, S, E);
        if (JIT_CONV) CONVERT_MAT(2);
    }
    SEAM(3);
#define UP_PHASE(WOFF, LAYER) do { pg8::Gemm g{XN, (const bf16*)(ws + (WOFF)), MROWS, FF2, DM}; pg8::StaticOrder S; S.init(MROWS, FF2, G, bx); \
        pg8::EpiConvGate E{ACT, FF, PART, 1.f / DM, RMS_EPS, args.in[15] + (size_t)(LAYER) * 3 * FF2, args.in[16] + (size_t)(LAYER) * FF2, HALO}; \
        pg8::gemm_phase<pg8::EpiConvGate, pg8::StaticOrder, PG8_ALIGN, PG8_SP2>(ldsl + RING_OFF, g, S, E); } while (0)
#define CG_PHASE(LAYER) do { const float* cw = args.in[15] + (size_t)(LAYER) * 3 * FF2; const float* cb = args.in[16] + (size_t)(LAYER) * FF2; \
        for (int it = bx * (NWAVES * 64) + tid; it < FX_ITEMS; it += G * NWAVES * 64) fixup_item(HALO, cw, cb, ACT, it); } while (0)
#ifndef DOWN_WGM
#define DOWN_WGM 8
#endif
#define DOWN_PHASE(WOFF, OUT, LAST) do { pg8::Gemm g{ACT, (const bf16*)(ws + (WOFF)), MROWS, DM, FF}; pg8::StaticOrder S; S.init(MROWS, DM, G, bx, DOWN_WGM); \
        pg8::EpiResid<false, LAST> E{nullptr, OUT, XN, PART, DM}; \
        pg8::gemm_phase<pg8::EpiResid<false, LAST>, pg8::StaticOrder, PG8_ALIGN, PG8_SP2>(ldsl + RING_OFF, g, S, E); } while (0)
    const int up_units = (MROWS / 256) * (FF2 / 256), up_full = up_units % G;
    if (IN(4)) _Pragma("unroll") for (int rep = 0; rep < NREP(4); ++rep) { if (rep) xcd_barrier(bar); UP_PHASE(WS_WUP0, 0); if (JIT_CONV && TAILFILL && up_full && bx >= up_full) CONVERT_MAT_RANGE(3, 0, DN_SPLIT, up_full); }
    SEAM(4);
    if (IN(5)) _Pragma("unroll") for (int rep = 0; rep < NREP(5); ++rep) { if (rep) xcd_barrier(bar); CG_PHASE(0); if (JIT_CONV) { if (TAILFILL && up_full) CONVERT_MAT_RANGE(3, DN_SPLIT, DN_ITEMS, 0); else CONVERT_MAT(3); } }
    SEAM(5);
    if (IN(6)) { DOWN_PHASE(WS_WDN0, nullptr, false); for (int rep = 1; rep < NREP(6); ++rep) { xcd_barrier(bar); DOWN_PHASE(WS_WDN0, DUMMY, true); } if (JIT_CONV) CONVERT_MAT(4); }
    SEAM(6);
#ifdef PROBE_LATE_QKV
    { pg8::Gemm g{XN, (const bf16*)(ws + WS_WQKV0), MROWS, NQKV, DM}; pg8::StaticOrder S; S.init(MROWS, NQKV, G, bx);
      pg8::EpiScale E{QKV, NQKV, PART, 1.f / DM, RMS_EPS, DM, QSCALE};
      pg8::gemm_phase<pg8::EpiScale, pg8::StaticOrder, PG8_ALIGN, PG8_SP2>(ldsl + RING_OFF, g, S, E); xcd_barrier(bar); }
#if PROBE_LATE_QKV == 2
    { pg8::Gemm g{XN, (const bf16*)(ws + WS_WQKV0), MROWS, NQKV, DM}; pg8::StaticOrder S; S.init(MROWS, NQKV, G, bx);
      pg8::EpiScale E{QKV, NQKV, PART, 1.f / DM, RMS_EPS, DM, QSCALE};
      pg8::gemm_phase<pg8::EpiScale, pg8::StaticOrder, PG8_ALIGN, PG8_SP2>(ldsl + RING_OFF, g, S, E); xcd_barrier(bar); }
#endif
#endif
    if (IN(7)) _Pragma("unroll") for (int rep = 0; rep < NREP(7); ++rep) { if (rep) xcd_barrier(bar);
        pg8::Gemm g{XN, (const bf16*)(ws + WS_WQKV1), MROWS, NQKV, DM}; pg8::StaticOrder S; S.init(MROWS, NQKV, G, bx);
        pg8::EpiScale E{QKV, NQKV, PART, 1.f / DM, RMS_EPS, 0, 1.f};
        pg8::gemm_phase<pg8::EpiScale, pg8::StaticOrder, PG8_ALIGN, PG8_SP2>(ldsl + RING_OFF, g, S, E);
    }
    SEAM(7);
    if (IN(8)) _Pragma("unroll") for (int rep = 0; rep < NREP(8); ++rep) { if (rep) xcd_barrier(bar); for (int m = gw; m < MROWS; m += NGW) qknorm_row(QKV + (size_t)m * NQKV, QKN + (size_t)m * 8192, args.in[6], args.in[7], m % SEQ, lane); }
    SEAM(8);
    if (IN(9)) _Pragma("unroll") for (int rep = 0; rep < NREP(9); ++rep) { if (rep) xcd_barrier(bar);
        float lam, omli;
        { const float a1 = wave_sum(args.in[8][lane] * args.in[9][lane] + args.in[8][lane + 64] * args.in[9][lane + 64]);
          const float a2 = wave_sum(args.in[10][lane] * args.in[11][lane] + args.in[10][lane + 64] * args.in[11][lane + 64]);
          const float li = 0.8f - 0.6f * 0.7408182206817179f;
          lam = __expf(a1) - __expf(a2) + li; omli = 1.f - li; }
        float mq = fmaxf(fabsf(args.in[6][lane]), fabsf(args.in[6][lane + 64])), mk = fmaxf(fabsf(args.in[7][lane]), fabsf(args.in[7][lane + 64]));
#pragma unroll
        for (int o_ = 1; o_ < 64; o_ <<= 1) { mq = fmaxf(mq, __shfl_xor(mq, o_)); mk = fmaxf(mk, __shfl_xor(mk, o_)); }
        att::Diff2Const C{lam, omli, RMS_EPS, QSCALE * 128.f * mq * mk * 1.02f, args.in[12]};
        constexpr int NITEM = BATCH * DF_H * 16;
        for (int w = bx; w < NITEM; w += G) {
            const int bh = w >> 4, xq = w & 15, b = bh / DF_H, h = bh % DF_H;
            const bf16* qn = QKN + (size_t)(b * SEQ) * 8192 + h * 256; const bf16* vb = QKV + (size_t)(b * SEQ) * NQKV + 2 * DM + h * 256;
#pragma unroll 1
            for (int ps = 0; ps < 2; ++ps) { const int qb = ps ? 31 - xq : xq;
                att::diff2_block<8192, 8192, NQKV, DM>(qn + (size_t)(qb * 128) * 8192, qn + 4096, vb, AO + (size_t)(b * SEQ + qb * 128) * DM + h * 256, qb * 128, C, (char*)lds + RING_OFF); }
        }
        if (JIT_CONV) CONVERT_MAT(5);
    }
    SEAM(9);
    if (IN(10)) {
        pg8::Gemm g{AO, (const bf16*)(ws + WS_WO1), MROWS, DM, DM}; pg8::StaticOrder S; S.init(MROWS, DM, G, bx);
        pg8::EpiResid<false, false> E{nullptr, nullptr, XN, PART, DM};
        pg8::gemm_phase<pg8::EpiResid<false, false>, pg8::StaticOrder, PG8_ALIGN, PG8_SP2>(ldsl + RING_OFF, g, S, E);
        if (JIT_CONV) CONVERT_MAT(6);
    }
    SEAM(10);
    if (IN(11)) { UP_PHASE(WS_WUP1, 1); if (JIT_CONV && TAILFILL && up_full && bx >= up_full) CONVERT_MAT_RANGE(7, 0, DN_SPLIT, up_full); }
    SEAM(11);
    if (IN(12)) { CG_PHASE(1); if (JIT_CONV) { if (TAILFILL && up_full) CONVERT_MAT_RANGE(7, DN_SPLIT, DN_ITEMS, 0); else CONVERT_MAT(7); } }
    SEAM(12);
    if (IN(13)) DOWN_PHASE(WS_WDN1, args.out, true);
#ifdef PROBE_XCC
    { xcd_barrier(bar);
      if (bx == 0 && tid == 0) { unsigned bad = 0; for (int i = 0; i < G; ++i) { const unsigned xi = __hip_atomic_load(ctl + 2048 + i, RLX_AGENT), xr = __hip_atomic_load(ctl + 2048 + (i & 7), RLX_AGENT); if (xi != xr || xi == 0u) ++bad; }
          for (int r = 0; r < 8; ++r) for (int q = r + 1; q < 8; ++q) if (__hip_atomic_load(ctl + 2048 + r, RLX_AGENT) == __hip_atomic_load(ctl + 2048 + q, RLX_AGENT)) bad += 1000;
          if (bad) args.out[0] = 1000.f * (float)bad; } }
#endif
    if (LEAK_A >= 0) { xcd_barrier(bar); STAMP(14); if (bx == 0 && tid == 0) args.out[0] = 1000.f * ((float)(long long)(tB - tA) * 0.01f - (float)(LEAK_OFF)); }
#undef IN
#undef SEAM
}
#if MK_CHECK
#include "check.inc"
#endif
extern "C" void kernel_launch(void* const* d_in, const int* in_sizes, int n_in, void* d_out, int out_size, void* d_ws, size_t ws_size, hipStream_t stream) {
    static int grid = 0;
    if (grid == 0) {
        if (n_in != 18 || in_sizes[0] != MROWS * DM || out_size != MROWS * DM || ws_size < WS_END) {
            fprintf(stderr, "kernel_launch: built for 18 inputs, x/out of %d floats, >= %zu bytes of workspace; got n_in %d, in0 %d, out %d, ws %zu; nothing launched\n", MROWS * DM, (size_t)WS_END, n_in, n_in > 0 ? in_sizes[0] : -1, out_size, ws_size); grid = -1; return; }
        int dev = 0, cus = 0, per_cu = 0;
        if (hipGetDevice(&dev) != hipSuccess || hipDeviceGetAttribute(&cus, hipDeviceAttributeMultiprocessorCount, dev) != hipSuccess) { fprintf(stderr, "kernel_launch: device query failed\n"); grid = -1; return; }
        if (hipFuncSetAttribute((const void*)mk_fwd, hipFuncAttributeMaxDynamicSharedMemorySize, LDS_BYTES) != hipSuccess) { fprintf(stderr, "kernel_launch: hipFuncSetAttribute failed\n"); grid = -1; return; }
        if (hipOccupancyMaxActiveBlocksPerMultiprocessor(&per_cu, (const void*)mk_fwd, NWAVES * 64, LDS_BYTES) != hipSuccess || per_cu < 1)
            fprintf(stderr, "kernel_launch: note: occupancy query reports %d workgroups per CU\n", per_cu);
        (void)hipGetLastError();
        grid = cus;
    }
    if (grid < 0) return;
    if (hipMemsetAsync((char*)d_ws + WS_CTL, 0, CTL_ZERO_BYTES, stream) != hipSuccess) { fprintf(stderr, "kernel_launch: memset failed\n"); return; }
    Args a{};
    for (int i = 0; i < 18; ++i) a.in[i] = (const float*)d_in[i];
    a.out = (float*)d_out; a.ws = (unsigned char*)d_ws;
#if MK_CHECK
    for (int p = 0; p < NPH; ++p) { a.ph_lo = p; a.ph_hi = p + 1;
        hipLaunchKernelGGL(mk_fwd, dim3(grid), dim3(NWAVES * 64), LDS_BYTES, stream, a);
        hipLaunchKernelGGL(mk_check, dim3(256), dim3(256), 0, stream, a, p); }
    hipLaunchKernelGGL(mk_report, dim3(1), dim3(64), 0, stream, a);
#elif MK_SPLIT
    for (int p = 0; p < NPH; ++p) { a.ph_lo = p; a.ph_hi = p + 1; hipLaunchKernelGGL(mk_fwd, dim3(grid), dim3(NWAVES * 64), LDS_BYTES, stream, a); }
#else
    a.ph_lo = 0; a.ph_hi = NPH;
    hipLaunchKernelGGL(mk_fwd, dim3(grid), dim3(NWAVES * 64), LDS_BYTES, stream, a);
#ifdef PROBE_TWICE
    (void)hipMemsetAsync((char*)d_ws + WS_CTL, 0, CTL_ZERO_BYTES, stream);
    hipLaunchKernelGGL(mk_fwd, dim3(grid), dim3(NWAVES * 64), LDS_BYTES, stream, a);
#endif
#endif
    const hipError_t le = hipPeekAtLastError();
    if (le != hipSuccess) fprintf(stderr, "kernel_launch: launch failed: %s\n", hipGetErrorName(le));
}
```

```cpp
#include <hip/hip_runtime.h>
#include <cstdio>
#include <cstdint>
namespace pg8 {
#define PG8_LAS __attribute__((address_space(3)))
typedef unsigned short bf16_t;
typedef short bf16x8 __attribute__((ext_vector_type(8)));
typedef float f32x4 __attribute__((ext_vector_type(4)));
typedef unsigned u32x4 __attribute__((ext_vector_type(4)));
constexpr int BM = 256, BK = 64, HALF = 128, HTB = HALF * BK * 2  , STAGE_BYTES = 8 * HTB, NXCD = 8, WGM = 8;

__host__ __device__ __forceinline__ int lds_byte(int r, int c) { const int st = (r >> 4) * 2 + (c >> 5), rr = r & 15, cc = c & 31, ob = rr * 64 + cc * 2; return st * 1024 + (ob ^ (((ob >> 9) & 1) << 5)); }
__host__ __device__ __forceinline__ void stage_rc(int b, int& R, int& C) { const int st = b / 1024, sb = b % 1024, swz = sb ^ (((sb >> 9) & 1) << 5); R = (st >> 1) * 16 + swz / 64; C = (st & 1) * 32 + (swz % 64) / 2; }
__host__ __device__ __forceinline__ int perm32(int rho) { const int n = rho >> 4, i = rho & 15; return 8 * (i >> 2) + 4 * n + (i & 3); }

struct Unit { int pm, pn; };
struct Gemm { const bf16_t* A; const bf16_t* Bt; int M, N, K; };

struct StaticOrder {
    int nM, nN, nwg, G, c, wgm;
    __host__ __device__ void init(int M, int N, int G_, int c_, int wgm_ = WGM) { nM = M / BM; nN = N / BM; nwg = nM * nN; G = G_; c = c_; wgm = wgm_; }
    __host__ __device__ bool next(int i, Unit& u) const {
        const long L = (long)i * G + c; if (L >= nwg) return false;
        int wgid = (int)L; { const int q = nwg / NXCD, r = nwg % NXCD, xcd = wgid % NXCD, off = wgid / NXCD; wgid = (xcd < r ? xcd * (q + 1) : r * (q + 1) + (xcd - r) * q) + off; }
        const int nig = wgm * nN, gid = wgid / nig, fm = gid * wgm, gsz = (nM - fm) < wgm ? (nM - fm) : wgm;
        u.pm = fm + ((wgid % nig) % gsz); u.pn = (wgid % nig) / gsz; return true;
    }
    __device__ __forceinline__ void a_ready(const Unit&) const {}
    __device__ __forceinline__ void done(const Unit&) const {}
};
struct RangeOrder : StaticOrder {
    int i0, i1;
    __host__ __device__ bool next(int i, Unit& u) const { return (i0 + i < i1) && StaticOrder::next(i0 + i, u); }
};


__device__ __forceinline__ unsigned cvt_pk_bf16(float lo, float hi) { unsigned r; asm volatile("v_cvt_pk_bf16_f32 %0, %1, %2" : "=v"(r) : "v"(lo), "v"(hi)); return r; }

constexpr int NPART = 64;

struct EpiScale {
    static constexpr bool PERM = true, AFTER_DRAIN = false;
    bf16_t* O; int ldc; const float* part; float inv_k; float eps; int qcols; float qs;
    __device__ __forceinline__ void operator()(const f32x4 (&acc)[2][2][4][2], const Unit& u, int wr, int wc, int fr, int fq) const {
        const int row0 = u.pm * BM + wr * 64 + fr; const int col0 = u.pn * BM + wc * 32 + 8 * fq;
        const float sc = (u.pn * BM < qcols) ? qs : 1.f;
#pragma unroll
        for (int ai = 0; ai < 2; ++ai)
#pragma unroll
            for (int m = 0; m < 4; ++m) {
                const int row = row0 + ai * HALF + m * 16;
                const f32x4* pp = (const f32x4*)(part + (size_t)row * NPART + fq * 16);
                const f32x4 a = pp[0], b = pp[1], c = pp[2], d = pp[3];
                float s = ((a[0] + a[1]) + (a[2] + a[3])) + ((b[0] + b[1]) + (b[2] + b[3])) + (((c[0] + c[1]) + (c[2] + c[3])) + ((d[0] + d[1]) + (d[2] + d[3])));
                s += __shfl_xor(s, 16); s += __shfl_xor(s, 32);
                const float r = rsqrtf(s * inv_k + eps) * sc;
                bf16_t* rowp = O + (size_t)row * ldc + col0;
#pragma unroll
                for (int bj = 0; bj < 2; ++bj) { const f32x4 v0 = acc[ai][bj][m][0] * r, v1 = acc[ai][bj][m][1] * r;
                    u32x4 w; w.x = cvt_pk_bf16(v0[0], v0[1]); w.y = cvt_pk_bf16(v0[2], v0[3]); w.z = cvt_pk_bf16(v1[0], v1[1]); w.w = cvt_pk_bf16(v1[2], v1[3]);
                    *(u32x4*)(rowp + bj * HALF) = w; }
            }
    }
};

template <bool BASE_F32, bool OUT_F32> struct EpiResid {
    static constexpr bool PERM = false, AFTER_DRAIN = false;
    const float* basef; float* outf; bf16_t* xn; float* part; int ldc;
    __device__ __forceinline__ void operator()(const f32x4 (&acc)[2][2][4][2], const Unit& u, int wr, int wc, int fr, int fq) const {
        typedef unsigned u32x2v __attribute__((ext_vector_type(2)));
        const int row0 = u.pm * BM + wr * 64 + fr; const int col0 = u.pn * BM + wc * 32 + 4 * fq;
#pragma unroll
        for (int ai = 0; ai < 2; ++ai)
#pragma unroll
            for (int m = 0; m < 4; ++m) {
                const int row = row0 + ai * HALF + m * 16; const size_t off = (size_t)row * ldc + col0; float ss = 0.f;
#pragma unroll
                for (int bj = 0; bj < 2; ++bj)
#pragma unroll
                    for (int n = 0; n < 2; ++n) { const size_t o2 = off + bj * HALF + n * 16;
                        f32x4 bs;
                        if (BASE_F32) bs = *(const f32x4*)(basef + o2);
                        else { const u32x2v b = *(const u32x2v*)(xn + o2); bs[0] = __builtin_bit_cast(float, b.x << 16); bs[1] = __builtin_bit_cast(float, b.x & 0xffff0000u); bs[2] = __builtin_bit_cast(float, b.y << 16); bs[3] = __builtin_bit_cast(float, b.y & 0xffff0000u); }
                        const f32x4 o = bs + acc[ai][bj][m][n];
                        if (OUT_F32) *(f32x4*)(outf + o2) = o;
                        else { u32x2v w; w.x = cvt_pk_bf16(o[0], o[1]); w.y = cvt_pk_bf16(o[2], o[3]); *(u32x2v*)(xn + o2) = w;
                            ss += (o[0] * o[0] + o[1] * o[1]) + (o[2] * o[2] + o[3] * o[3]); } }
                if (!OUT_F32) { ss += __shfl_xor(ss, 16); ss += __shfl_xor(ss, 32); if (fq == 0) part[(size_t)row * NPART + u.pn * 4 + wc] = ss; }
            }
    }
};

__device__ __forceinline__ float dpp_ror1(float v) { return __builtin_bit_cast(float, __builtin_amdgcn_update_dpp(0, __builtin_bit_cast(int, v), 0x121, 0xf, 0xf, false)); }
__device__ __forceinline__ float dpp_ror2(float v) { return __builtin_bit_cast(float, __builtin_amdgcn_update_dpp(0, __builtin_bit_cast(int, v), 0x122, 0xf, 0xf, false)); }
__device__ __forceinline__ float dpp_shr1(float old, float v) { return __builtin_bit_cast(float, __builtin_amdgcn_update_dpp(__builtin_bit_cast(int, old), __builtin_bit_cast(int, v), 0x111, 0xf, 0xf, false)); }
__device__ __forceinline__ float dpp_shr2(float old, float v) { return __builtin_bit_cast(float, __builtin_amdgcn_update_dpp(__builtin_bit_cast(int, old), __builtin_bit_cast(int, v), 0x112, 0xf, 0xf, false)); }
__device__ __forceinline__ void conv_taps(float& acc, float cur, float prev, float w1, float w0) {
    asm("s_nop 1\n\t"
        "v_fmac_f32_dpp %0, %1, %3 row_shr:1 row_mask:0xf bank_mask:0xf\n\t"
        "v_fmac_f32_dpp %0, %1, %4 row_shr:2 row_mask:0xf bank_mask:0xf\n\t"
        "v_fmac_f32_dpp %0, %2, %3 row_shl:15 row_mask:0xf bank_mask:0xf\n\t"
        "v_fmac_f32_dpp %0, %2, %4 row_shl:14 row_mask:0xf bank_mask:0xf"
        : "+v"(acc) : "v"(cur), "v"(prev), "v"(w1), "v"(w0));
}
template <int CTRL> __device__ __forceinline__ float dppz(float v) { return __builtin_bit_cast(float, __builtin_amdgcn_update_dpp(0, __builtin_bit_cast(int, v), CTRL, 0xf, 0xf, true)); }
struct EpiConvGate {
    static constexpr bool PERM = true, AFTER_DRAIN = false;
    bf16_t* ACT; int ff; const float* part; float inv_k; float eps; const float* cw; const float* cb; float* halo;
    __device__ __forceinline__ void operator()(const f32x4 (&acc)[2][2][4][2], const Unit& u, int wr, int wc, int fr, int fq) const {
        typedef unsigned u32x2v __attribute__((ext_vector_type(2)));
        const int ff2 = 2 * ff;
        const int row0 = u.pm * BM + wr * 64 + fr; const int ch0 = u.pn * HALF + wc * 32 + 8 * fq;
        float rs[2][4];
#pragma unroll
        for (int ai = 0; ai < 2; ++ai)
#pragma unroll
            for (int m = 0; m < 4; ++m) { const int row = row0 + ai * HALF + m * 16;
                const f32x4* pp = (const f32x4*)(part + (size_t)row * NPART + fq * 16);
                const f32x4 a = pp[0], b = pp[1], c = pp[2], d = pp[3];
                float s = ((a[0] + a[1]) + (a[2] + a[3])) + ((b[0] + b[1]) + (b[2] + b[3])) + (((c[0] + c[1]) + (c[2] + c[3])) + ((d[0] + d[1]) + (d[2] + d[3])));
                s += __shfl_xor(s, 16); s += __shfl_xor(s, 32);
                rs[ai][m] = rsqrtf(s * inv_k + eps); }
        u32x2v lo[2][4];
#pragma unroll
        for (int n = 0; n < 2; ++n) {
            const int ch = ch0 + 4 * n;
            const f32x4 wg0 = *(const f32x4*)(cw + ch), wg1 = *(const f32x4*)(cw + ff2 + ch), wg2 = *(const f32x4*)(cw + 2 * ff2 + ch), bg = *(const f32x4*)(cb + ch);
            const f32x4 wv0 = *(const f32x4*)(cw + ff + ch), wv1 = *(const f32x4*)(cw + ff2 + ff + ch), wv2 = *(const f32x4*)(cw + 2 * ff2 + ff + ch), bv = *(const f32x4*)(cb + ff + ch);
#pragma unroll
            for (int ai = 0; ai < 2; ++ai) {
                f32x4 gq = {0.f, 0.f, 0.f, 0.f}, vq = gq;
                const int grp = (u.pm * BM + ai * HALF + wr * 64) >> 6;
#pragma unroll
                for (int m = 0; m < 4; ++m) {
                    const f32x4 g = acc[ai][0][m][n] * rs[ai][m], v = acc[ai][1][m][n] * rs[ai][m];
                    f32x4 cg, cv;
#pragma unroll
                    for (int e = 0; e < 4; ++e) {
                        float a = __builtin_fmaf(wg2[e], g[e], bg[e]), b = __builtin_fmaf(wv2[e], v[e], bv[e]);
                        conv_taps(a, g[e], gq[e], wg1[e], wg0[e]); conv_taps(b, v[e], vq[e], wv1[e], wv0[e]);
                        cg[e] = a; cv[e] = b; }
                    gq = g; vq = v;
                    f32x4 o;
#pragma unroll
                    for (int e = 0; e < 4; ++e) o[e] = cg[e] * __builtin_amdgcn_rcpf(1.f + __builtin_amdgcn_exp2f(-1.4426950408889634f * cg[e])) * cv[e];
                    u32x2v w; w.x = cvt_pk_bf16(o[0], o[1]); w.y = cvt_pk_bf16(o[2], o[3]);
                    const int row = row0 + ai * HALF + m * 16;
                    if (n == 0) lo[ai][m] = w;
                    else if (!(m == 0 && fr < 2)) { u32x4 w4; w4.x = lo[ai][m].x; w4.y = lo[ai][m].y; w4.z = w.x; w4.w = w.y; *(u32x4*)(ACT + (size_t)row * ff + ch0) = w4; }
                    if ((m == 0 && fr < 2) || (m == 3 && fr >= 14)) { float* hp = halo + ((size_t)grp * 4 + (m == 0 ? fr : fr - 12)) * ff2 + ch; *(f32x4*)hp = g; *(f32x4*)(hp + ff) = v; }
                }
            }
        }
    }
};
template <class Epi, class Sched, bool ALIGN_EPI = false, bool SP2 = false>
__device__ __forceinline__ void gemm_phase(PG8_LAS unsigned char* lds, const Gemm g, const Sched& S, const Epi& E) {
    const int tid = threadIdx.x, wid = __builtin_amdgcn_readfirstlane(tid >> 6), lane = tid & 63, wr = wid >> 2, wc = wid & 3, fr = lane & 15, fq = lane >> 4;
    const int K = g.K, nt = K / BK;
    unsigned voffA[2], voffB[2];
#pragma unroll
    for (int i = 0; i < 2; ++i) { int R, C; stage_rc(tid * 16 + i * 8192, R, C); const int Rb = Epi::PERM ? ((R & ~31) + perm32(R & 31)) : R;
        voffA[i] = (unsigned)(R * K + C) * 2u; voffB[i] = (unsigned)(Rb * K + C) * 2u; }
    const size_t kstep = (size_t)(BK * 2);
    const size_t hstep = (size_t)HALF * K * 2;
    const size_t tstep = 2 * hstep;
    const unsigned ldsw = (unsigned)wid * 1024u;
    const int aoff = lds_byte(wr * 64 + fr, fq * 8), boff = lds_byte(wc * 32 + fr, fq * 8);
#define PG8_SA(b, h) (((b) * 2 + (h)) * HTB)
#define PG8_SB(b, h) ((4 + (b) * 2 + (h)) * HTB)
#define PG8_STAGE(bufoff, gbase, voff) do { _Pragma("unroll") for (int _i = 0; _i < 2; ++_i) \
        __builtin_amdgcn_global_load_lds((const unsigned*)((const char*)(gbase) + (voff)[_i]), (PG8_LAS unsigned*)(lds + (bufoff) + ldsw + _i * 8192), 16, 0, 0); } while (0)
#define PG8_LDA(dst, b, h) do { _Pragma("unroll") for (int m = 0; m < 4; ++m) _Pragma("unroll") for (int k = 0; k < 2; ++k) dst[m][k] = *(const PG8_LAS bf16x8*)(lds + PG8_SA(b, h) + aoff + m * 2048 + k * 1024); } while (0)
#define PG8_LDB(dst, b, h) do { _Pragma("unroll") for (int n = 0; n < 2; ++n) _Pragma("unroll") for (int k = 0; k < 2; ++k) dst[n][k] = *(const PG8_LAS bf16x8*)(lds + PG8_SB(b, h) + boff + n * 2048 + k * 1024); } while (0)
#define PG8_MMA(ai, bj, At, Bt) do { __builtin_amdgcn_s_setprio(1); _Pragma("unroll") for (int m = 0; m < 4; ++m) _Pragma("unroll") for (int n = 0; n < 2; ++n) _Pragma("unroll") for (int k = 0; k < 2; ++k) \
        acc[ai][bj][m][n] = __builtin_amdgcn_mfma_f32_16x16x32_bf16(Bt[n][k], At[m][k], acc[ai][bj][m][n], 0, 0, 0); __builtin_amdgcn_s_setprio(0); } while (0)
#define PG8_WAIT_V(n) asm volatile("s_waitcnt vmcnt(" #n ")" ::: "memory")
#define PG8_WAIT_L(n) asm volatile("s_waitcnt lgkmcnt(" #n ")" ::: "memory")
#define PG8_BAR __builtin_amdgcn_s_barrier()
#define PG8_SCHED __builtin_amdgcn_sched_barrier(0)
    Unit cur, nxt; int ui = 0;
    if (!S.next(0, cur)) return;
    f32x4 acc[2][2][4][2];
#pragma unroll
    for (int a = 0; a < 2; ++a)
#pragma unroll
        for (int b = 0; b < 2; ++b)
#pragma unroll
            for (int m = 0; m < 4; ++m)
#pragma unroll
                for (int n = 0; n < 2; ++n) acc[a][b][m][n] = (f32x4){0.f, 0.f, 0.f, 0.f};
    bf16x8 At[4][2], B0[2][2], B1[2][2];
    const char* cA = (const char*)g.A + (size_t)cur.pm * tstep; const char* cB = (const char*)g.Bt + (size_t)cur.pn * tstep;
    S.a_ready(cur);
    if constexpr (SP2) {
        PG8_STAGE(PG8_SB(0, 0), cB, voffB); PG8_STAGE(PG8_SB(0, 1), cB + hstep, voffB); PG8_STAGE(PG8_SA(0, 0), cA, voffA); PG8_STAGE(PG8_SA(0, 1), cA + hstep, voffA);
        if (wr == 1) PG8_BAR;
        PG8_WAIT_V(2); PG8_BAR;
        PG8_STAGE(PG8_SB(1, 0), cB + kstep, voffB); PG8_STAGE(PG8_SA(1, 0), cA + kstep, voffA); PG8_STAGE(PG8_SB(1, 1), cB + hstep + kstep, voffB);
        PG8_WAIT_V(6); PG8_BAR;
    } else {
        PG8_STAGE(PG8_SB(0, 0), cB, voffB); PG8_STAGE(PG8_SA(0, 0), cA, voffA); PG8_STAGE(PG8_SB(0, 1), cB + hstep, voffB); PG8_STAGE(PG8_SA(0, 1), cA + hstep, voffA);
        if (wr == 1) PG8_BAR;
        PG8_WAIT_V(4); PG8_BAR;
        PG8_STAGE(PG8_SB(1, 0), cB + kstep, voffB); PG8_STAGE(PG8_SA(1, 0), cA + kstep, voffA); PG8_STAGE(PG8_SB(1, 1), cB + hstep + kstep, voffB);
        PG8_WAIT_V(6); PG8_BAR;
    }
    for (;;) {
        const bool has_next = S.next(ui + 1, nxt);
        const char* nA = has_next ? (const char*)g.A + (size_t)nxt.pm * tstep : cA; const char* nB = has_next ? (const char*)g.Bt + (size_t)nxt.pn * tstep : cB;
        for (int t = 0; t < nt; t += 2) {
            const bool last = (t == nt - 2);
            const char* a1 = cA + (size_t)(t + 1) * kstep;
            const char* a2 = last ? nA : cA + (size_t)(t + 2) * kstep; const char* b2 = last ? nB : cB + (size_t)(t + 2) * kstep;
            const char* a3 = a2 + kstep; const char* b3 = b2 + kstep;
            if (last && has_next) S.a_ready(nxt);
            if constexpr (SP2) {
            PG8_LDB(B0, 0, 0); PG8_LDB(B1, 0, 1); PG8_SCHED; PG8_LDA(At, 0, 0); PG8_STAGE(PG8_SA(1, 1), a1 + hstep, voffA);
            PG8_WAIT_V(8); PG8_WAIT_L(0); PG8_BAR; PG8_MMA(0, 0, At, B0); PG8_MMA(0, 1, At, B1); PG8_BAR; PG8_SCHED;
            PG8_LDA(At, 0, 1); PG8_STAGE(PG8_SB(0, 0), b2, voffB); PG8_STAGE(PG8_SB(0, 1), b2 + hstep, voffB); PG8_STAGE(PG8_SA(0, 0), a2, voffA);
            PG8_WAIT_V(8); PG8_WAIT_L(0); PG8_BAR; PG8_MMA(1, 0, At, B0); PG8_MMA(1, 1, At, B1); PG8_BAR; PG8_SCHED;
            PG8_LDB(B0, 1, 0); PG8_LDB(B1, 1, 1); PG8_SCHED; PG8_LDA(At, 1, 0); PG8_STAGE(PG8_SA(0, 1), a2 + hstep, voffA);
            PG8_WAIT_V(8); PG8_WAIT_L(0); PG8_BAR; PG8_MMA(0, 0, At, B0); PG8_MMA(0, 1, At, B1); PG8_BAR; PG8_SCHED;
            PG8_LDA(At, 1, 1); PG8_STAGE(PG8_SB(1, 0), b3, voffB); PG8_STAGE(PG8_SB(1, 1), b3 + hstep, voffB); PG8_STAGE(PG8_SA(1, 0), a3, voffA);
            PG8_WAIT_V(8); PG8_WAIT_L(0); PG8_BAR; PG8_MMA(1, 0, At, B0); PG8_MMA(1, 1, At, B1); PG8_BAR; PG8_SCHED;
            } else {
            PG8_LDB(B0, 0, 0); PG8_SCHED; PG8_LDA(At, 0, 0); PG8_STAGE(PG8_SA(1, 1), a1 + hstep, voffA);
            PG8_WAIT_L(8); PG8_BAR; PG8_WAIT_L(0); PG8_MMA(0, 0, At, B0); PG8_BAR; PG8_SCHED;
            PG8_LDB(B1, 0, 1); PG8_STAGE(PG8_SB(0, 0), b2, voffB);
            PG8_BAR; PG8_WAIT_L(0); PG8_MMA(0, 1, At, B1); PG8_BAR;
            PG8_LDA(At, 0, 1); PG8_STAGE(PG8_SA(0, 0), a2, voffA);
            PG8_BAR; PG8_WAIT_L(0); PG8_MMA(1, 0, At, B0); PG8_BAR; PG8_SCHED;
            PG8_STAGE(PG8_SB(0, 1), b2 + hstep, voffB);
            PG8_WAIT_V(6); PG8_BAR; PG8_MMA(1, 1, At, B1); PG8_BAR;
            PG8_LDB(B0, 1, 0); PG8_SCHED; PG8_LDA(At, 1, 0); PG8_STAGE(PG8_SA(0, 1), a2 + hstep, voffA);
            PG8_WAIT_L(8); PG8_BAR; PG8_WAIT_L(0); PG8_MMA(0, 0, At, B0); PG8_BAR; PG8_SCHED;
            PG8_LDB(B1, 1, 1); PG8_STAGE(PG8_SB(1, 0), b3, voffB);
            PG8_BAR; PG8_WAIT_L(0); PG8_MMA(0, 1, At, B1); PG8_BAR;
            PG8_LDA(At, 1, 1); PG8_STAGE(PG8_SA(1, 0), a3, voffA);
            PG8_BAR; PG8_WAIT_L(0); PG8_MMA(1, 0, At, B0); PG8_BAR; PG8_SCHED;
            PG8_STAGE(PG8_SB(1, 1), b3 + hstep, voffB);
            PG8_WAIT_V(6); PG8_BAR; PG8_MMA(1, 1, At, B1); PG8_BAR;
            }
        }
        if constexpr (ALIGN_EPI) { if (wr == 0) PG8_BAR; }
        if constexpr (!Epi::AFTER_DRAIN) { E(acc, cur, wr, wc, fr, fq); S.done(cur); }
        if (!has_next) break;
#pragma unroll
        for (int a = 0; a < 2; ++a)
#pragma unroll
            for (int b = 0; b < 2; ++b)
#pragma unroll
                for (int m = 0; m < 4; ++m)
#pragma unroll
                    for (int n = 0; n < 2; ++n) acc[a][b][m][n] = (f32x4){0.f, 0.f, 0.f, 0.f};
        cur = nxt; cA = nA; cB = nB; ++ui;
        if constexpr (ALIGN_EPI) { if (wr == 1) PG8_BAR; }
    }
    PG8_WAIT_V(0);
    if constexpr (!ALIGN_EPI) { if (wr == 0) PG8_BAR; }
    PG8_BAR;
    if constexpr (Epi::AFTER_DRAIN) { E.fused(acc, cur, wr, wc, fr, fq, lds, wid, lane); S.done(cur); }
#undef PG8_SA
#undef PG8_SB
#undef PG8_STAGE
#undef PG8_LDA
#undef PG8_LDB
#undef PG8_MMA
#undef PG8_WAIT_V
#undef PG8_WAIT_L
#undef PG8_BAR
#undef PG8_SCHED
}
}
namespace att {
using bf16 = unsigned short;
typedef short bf16x8 __attribute__((ext_vector_type(8)));
typedef short s16x4 __attribute__((ext_vector_type(4)));
typedef float f32x16 __attribute__((ext_vector_type(16)));
typedef float f32x4 __attribute__((ext_vector_type(4)));
typedef unsigned u32x4 __attribute__((ext_vector_type(4)));
constexpr int D = 128, NW = 8, QBLK = 32, KVBLK = 64, QB = NW * QBLK;
constexpr int SHM_V = KVBLK * D * 2, SHM_K = KVBLK * D * 2;
constexpr int LDS_BYTES = 2 * SHM_V + 2 * SHM_K + NW * 64 * 4;
#define KSWZ(row, colB) ((row) * 256 + ((colB) ^ (((row) & 7) << 4)))
#define SBAR() __builtin_amdgcn_sched_barrier(0)
__device__ __forceinline__ int v_st(int k, int c) { const int kk = (k & ~0xC) | ((k & 4) << 1) | ((k & 8) >> 1); return ((kk >> 3) * 4 + (c >> 5)) * 512 + ((kk & 7) * 32 + (c & 31)) * 2; }
__device__ __forceinline__ int v_rd_base(int lane) { return ((lane & 3) << 3) | (((lane >> 2) & 3) << 6) | (((lane >> 4) & 1) << 5) | (((lane >> 5) & 1) << 8); }
constexpr int v_rd_off(int d0, int ks, int half) { return d0 * 512 + ks * 4096 + half * 2048; }
__device__ __forceinline__ int crow(int r, int hi) { return (r & 3) + 8 * (r >> 2) + 4 * hi; }
__device__ __forceinline__ unsigned cvtpk(float lo, float hi) { unsigned r; asm volatile("v_cvt_pk_bf16_f32 %0, %1, %2" : "=v"(r) : "v"(lo), "v"(hi)); return r; }
__device__ __forceinline__ bf16x8 load8(const bf16* p) { return *reinterpret_cast<const bf16x8*>(p); }

#define PK4(P, B_, OUT) do { unsigned a0 = cvtpk(P[B_+0], P[B_+1]), a1 = cvtpk(P[B_+2], P[B_+3]);                          \
        unsigned b0 = cvtpk(P[B_+4], P[B_+5]), b1 = cvtpk(P[B_+6], P[B_+7]);                                             \
        auto r0 = __builtin_amdgcn_permlane32_swap(a0, b0, false, false); auto r1 = __builtin_amdgcn_permlane32_swap(a1, b1, false, false); \
        u32x4 w = {r0[0], r1[0], r0[1], r1[1]}; OUT = *reinterpret_cast<bf16x8*>(&w); } while (0)

__device__ __forceinline__ void qkt_rt(f32x16& p0, f32x16& p1, const char* Kt, int r32, int hi, const bf16x8* qr) {
    p0 = f32x16{}; p1 = f32x16{};
    const char* kb[4];
#pragma unroll
    for (int dd = 0; dd < 4; ++dd) kb[dd] = Kt + KSWZ(r32, (dd * 16 + hi * 8) * 2);
#pragma unroll
    for (int d0 = 0; d0 < 8; ++d0) { const char* a = kb[d0 & 3] + (d0 >> 2) * 128;
        bf16x8 b0 = *reinterpret_cast<const bf16x8*>(a);
        bf16x8 b1 = *reinterpret_cast<const bf16x8*>(a + 32 * 256);
        p0 = __builtin_amdgcn_mfma_f32_32x32x16_bf16(b0, qr[d0], p0, 0, 0, 0);
        p1 = __builtin_amdgcn_mfma_f32_32x32x16_bf16(b1, qr[d0], p1, 0, 0, 0); }
}
__device__ __forceinline__ void pv_rt(f32x16* o, int vb, bf16x8 pa0, bf16x8 pa1, bf16x8 pa2, bf16x8 pa3) {
#define TRRD(dst, off) asm volatile("ds_read_b64_tr_b16 %0, %1 offset:%2" : "=&v"(dst) : "v"(vb), "i"(off) : "memory")
#define PV_D0(d0) do { s16x4 l0, l1, l2, l3, h0, h1, h2, h3; constexpr int b_ = v_rd_off(d0, 0, 0); \
        TRRD(l0, b_); TRRD(h0, b_ + 2048); TRRD(l1, b_ + 4096); TRRD(h1, b_ + 6144); TRRD(l2, b_ + 8192); TRRD(h2, b_ + 10240); TRRD(l3, b_ + 12288); TRRD(h3, b_ + 14336); \
        asm volatile("s_waitcnt lgkmcnt(0)" ::: "memory"); SBAR();   \
        o[d0] = __builtin_amdgcn_mfma_f32_32x32x16_bf16(pa0, (bf16x8){l0[0], l0[1], l0[2], l0[3], h0[0], h0[1], h0[2], h0[3]}, o[d0], 0, 0, 0);   \
        o[d0] = __builtin_amdgcn_mfma_f32_32x32x16_bf16(pa1, (bf16x8){l1[0], l1[1], l1[2], l1[3], h1[0], h1[1], h1[2], h1[3]}, o[d0], 0, 0, 0);   \
        o[d0] = __builtin_amdgcn_mfma_f32_32x32x16_bf16(pa2, (bf16x8){l2[0], l2[1], l2[2], l2[3], h2[0], h2[1], h2[2], h2[3]}, o[d0], 0, 0, 0);   \
        o[d0] = __builtin_amdgcn_mfma_f32_32x32x16_bf16(pa3, (bf16x8){l3[0], l3[1], l3[2], l3[3], h3[0], h3[1], h3[2], h3[3]}, o[d0], 0, 0, 0); } while (0)
    PV_D0(0); PV_D0(1); PV_D0(2); PV_D0(3);
#undef PV_D0
#undef TRRD
}

constexpr float SB_DONE = 1e-30f;
__device__ __forceinline__ void sb_half(f32x16& p, float& carry, int dq, bool needmask, bool lane_hi) {
    float kp[16];
#pragma unroll
    for (int r = 0; r < 16; ++r) {
        const float zz = fminf(p[r], 100.f);
        const float e = __builtin_amdgcn_exp2f(zz);
        float k = __builtin_amdgcn_rcpf(1.f + e);
        float be = e * k;
        if (needmask) { const int c = 8 * (r >> 2) + (r & 3); const bool valid = (dq - c) > 0; k = valid ? k : 1.f; be = valid ? be : 0.f; }
        kp[r] = k; p[r] = be;
    }
    float L[4], H[4];
#pragma unroll
    for (int j = 0; j < 4; ++j) { const float g = (kp[4 * j] * kp[4 * j + 1]) * (kp[4 * j + 2] * kp[4 * j + 3]);
        auto rr = __builtin_amdgcn_permlane32_swap(__float_as_uint(g), __float_as_uint(g), false, false);
        L[j] = __uint_as_float(rr[0]); H[j] = __uint_as_float(rr[1]); }
    float U[4]; U[3] = 1.f; U[2] = L[3] * H[3]; U[1] = U[2] * (L[2] * H[2]); U[0] = U[1] * (L[1] * H[1]);
    const float tot = U[0] * (L[0] * H[0]);
#pragma unroll
    for (int j = 0; j < 4; ++j) {
        const float a3 = carry * U[j] * (lane_hi ? 1.f : H[j]);
        const float a2 = a3 * kp[4 * j + 3], a1 = a2 * kp[4 * j + 2], a0 = a1 * kp[4 * j + 1];
        p[4 * j + 3] *= a3; p[4 * j + 2] *= a2; p[4 * j + 1] *= a1; p[4 * j] *= a0;
    }
    carry *= tot;
}

template <int PQ, int PK, int PV, int PO>
__device__ __forceinline__ void sb_block(const bf16* Q, const bf16* K, const bf16* V, bf16* O, int P0, char* lds, volatile __attribute__((address_space(3))) unsigned* flags) {
    const int tid = threadIdx.x, wid = __builtin_amdgcn_readfirstlane(tid >> 6), lane = tid & 63, r32 = lane & 31, hi = lane >> 5;
    char* K_lds = lds; char* V_lds = lds + 2 * SHM_K;
    const int sr = tid >> 4, sc = (tid & 15) * 8, vst0 = v_st(sr, sc), vst1 = v_st(32 + sr, sc), kws = KSWZ(sr, sc * 2);
    const int vb0 = (int)(uintptr_t)V_lds + v_rd_base(lane);
    bf16x8 qr[8];
#pragma unroll
    for (int d0 = 0; d0 < 8; ++d0) qr[d0] = load8(Q + (size_t)(wid * QBLK + r32) * PQ + d0 * 16 + hi * 8);
    f32x16 o[4] = {};
    float carry = 1.f;
    const int qlo = P0 + wid * QBLK, qpos = qlo + r32;
    int j = P0 / KVBLK + 3;
    bf16x8 st_k0, st_k1, st_v0, st_v1;
#define SB_LOAD(jt) do { const size_t k0_ = (size_t)(jt) * KVBLK; st_k0 = load8(K + (k0_ + sr) * PK + sc); st_k1 = load8(K + (k0_ + 32 + sr) * PK + sc); \
                         st_v0 = load8(V + (k0_ + sr) * PV + sc); st_v1 = load8(V + (k0_ + 32 + sr) * PV + sc); } while (0)
#define SB_WRITE(bf) do { *(bf16x8*)(K_lds + (bf) * SHM_K + kws) = st_k0; *(bf16x8*)(K_lds + (bf) * SHM_K + kws + 32 * 256) = st_k1; \
                          *(bf16x8*)(V_lds + (bf) * SHM_V + vst0) = st_v0; *(bf16x8*)(V_lds + (bf) * SHM_V + vst1) = st_v1; } while (0)
    SB_LOAD(j); asm volatile("s_waitcnt vmcnt(0)" ::: "memory"); SB_WRITE(0);
    __syncthreads();
    int buf = 0, it = 0; bool wdone = false;
    for (;;) {
        const int kb = j * KVBLK; const bool more = j > 0;
        if (more) SB_LOAD(j - 1);
        const bool act = !wdone && (kb < qlo + QBLK - 1);
        if (act) {
            f32x16 p0, p1;
            qkt_rt(p0, p1, K_lds + buf * SHM_K, r32, hi, qr);
            const bool needmask = kb + KVBLK - 1 >= qlo;
            sb_half(p1, carry, qpos - (kb + 32) - 4 * hi, needmask, hi != 0);
            sb_half(p0, carry, qpos - kb - 4 * hi, needmask, hi != 0);
            bf16x8 pa0, pa1, pa2, pa3;
            PK4(p0, 0, pa0); PK4(p0, 8, pa1); PK4(p1, 0, pa2); PK4(p1, 8, pa3);
            SBAR();
            pv_rt(o, vb0 + buf * SHM_V, pa0, pa1, pa2, pa3);
            wdone = __all(carry < SB_DONE);
        }
        if (more) { asm volatile("s_waitcnt vmcnt(0)" ::: "memory"); SB_WRITE(buf ^ 1); }
        if (lane == 0) flags[(it & 1) * 8 + wid] = wdone ? 1u : 0u;
        __syncthreads();
        unsigned alld = 1u;
#pragma unroll
        for (int w = 0; w < NW; ++w) alld &= flags[(it & 1) * 8 + w];
        if (!more || alld) break;
        --j; buf ^= 1; ++it;
    }
#undef SB_LOAD
#undef SB_WRITE
    bf16* Ow = O + (size_t)(wid * QBLK) * PO;
#pragma unroll
    for (int r = 0; r < 16; ++r) { const int orow = crow(r, hi);
#pragma unroll
        for (int d0 = 0; d0 < 4; ++d0) { const float v = o[d0][r]; const float vn = __shfl_xor(v, 1);
            if ((r32 & 1) == 0) *(unsigned*)(Ow + (size_t)orow * PO + d0 * 32 + r32) = cvtpk(v, vn); } }
    __syncthreads();
}

constexpr float THR2 = 8.f * 1.4426950408889634f;
struct DiffRef { const bf16* Q; const bf16* K; const bf16* V; bf16* O; int P0; int mode; };
struct DiffConst { float lam; float omli; float eps; const float* gain; float* scr; };
template <int PQ, int PK, int PV, int PO>
__device__ __forceinline__ void sm_block(const DiffRef& cur, const DiffConst& C, char* lds) {
    const int tid = threadIdx.x, wid = __builtin_amdgcn_readfirstlane(tid >> 6), lane = tid & 63, r32 = lane & 31, hi = lane >> 5;
    char* K_lds = lds; char* V_lds = lds + 2 * SHM_K; float* al_l = (float*)(lds + 2 * SHM_K + 2 * SHM_V) + wid * 32;
    const int sr = tid >> 4, sc = (tid & 15) * 8, vst0 = v_st(sr, sc), vst1 = v_st(32 + sr, sc), kws = KSWZ(sr, sc * 2);
    const int vb0 = (int)(uintptr_t)V_lds + v_rd_base(lane);
    const bf16* Q = cur.Q; const bf16* K = cur.K; const bf16* V = cur.V; const int P0 = cur.P0;
    bf16x8 qr[8];
#pragma unroll
    for (int d0 = 0; d0 < 8; ++d0) qr[d0] = load8(Q + (size_t)(wid * QBLK + r32) * PQ + d0 * 16 + hi * 8);
    f32x16 o[4] = {};
    float m_reg = -1e30f, l_reg = 0.f;
    const int qlo = P0 + wid * QBLK, qm = qlo + r32 - 4 * hi;
    const int NT = P0 / KVBLK + 4;
    bf16x8 st_k0, st_k1, st_v0, st_v1;
#define SM_LOAD(jt) do { const size_t k0_ = (size_t)(jt) * KVBLK; st_k0 = load8(K + (k0_ + sr) * PK + sc); st_k1 = load8(K + (k0_ + 32 + sr) * PK + sc); \
                         st_v0 = load8(V + (k0_ + sr) * PV + sc); st_v1 = load8(V + (k0_ + 32 + sr) * PV + sc); } while (0)
#define SM_WRITE(bf) do { *(bf16x8*)(K_lds + (bf) * SHM_K + kws) = st_k0; *(bf16x8*)(K_lds + (bf) * SHM_K + kws + 32 * 256) = st_k1; \
                          *(bf16x8*)(V_lds + (bf) * SHM_V + vst0) = st_v0; *(bf16x8*)(V_lds + (bf) * SHM_V + vst1) = st_v1; } while (0)
    SM_LOAD(0); asm volatile("s_waitcnt vmcnt(0)" ::: "memory"); SM_WRITE(0);
    __syncthreads();
    int buf = 0;
    for (int t = 0; t < NT; ++t) {
        const int kb = t * KVBLK; const bool more = t + 1 < NT;
        if (more) SM_LOAD(t + 1);
        if (kb <= qlo + QBLK - 1) {
            f32x16 p0, p1;
            qkt_rt(p0, p1, K_lds + buf * SHM_K, r32, hi, qr);
            if (kb + KVBLK - 1 > qlo) {
                const int dq = qm - kb; const float NEG = -__builtin_inff();
#pragma unroll
                for (int r = 0; r < 16; ++r) { const int c = (r & 3) + 8 * (r >> 2); if ((dq - c) < 0) p0[r] = NEG; if ((dq - c - 32) < 0) p1[r] = NEG; }
            }
            float pmax = p0[0];
#pragma unroll
            for (int r = 1; r < 16; ++r) pmax = fmaxf(pmax, p0[r]);
#pragma unroll
            for (int r = 0; r < 16; ++r) pmax = fmaxf(pmax, p1[r]);
            { auto rr = __builtin_amdgcn_permlane32_swap(__float_as_uint(pmax), __float_as_uint(pmax), false, false); pmax = fmaxf(__uint_as_float(rr[0]), __uint_as_float(rr[1])); }
            float alpha = 1.f;
            if (!__all((pmax - m_reg) <= THR2)) {
                const float mn = fmaxf(m_reg, pmax); alpha = __builtin_amdgcn_exp2f(m_reg - mn); m_reg = mn;
                if (hi == 0) al_l[r32] = alpha; asm volatile("s_waitcnt lgkmcnt(0)" ::: "memory");
#pragma unroll
                for (int d_ = 0; d_ < 4; ++d_)
#pragma unroll
                    for (int r = 0; r < 16; ++r) o[d_][r] *= al_l[crow(r, hi)];
            }
            float ps = 0.f;
#pragma unroll
            for (int r = 0; r < 16; ++r) { p0[r] = __builtin_amdgcn_exp2f(p0[r] - m_reg); ps += p0[r]; }
#pragma unroll
            for (int r = 0; r < 16; ++r) { p1[r] = __builtin_amdgcn_exp2f(p1[r] - m_reg); ps += p1[r]; }
            { auto rr = __builtin_amdgcn_permlane32_swap(__float_as_uint(ps), __float_as_uint(ps), false, false); ps = __uint_as_float(rr[0]) + __uint_as_float(rr[1]); }
            l_reg = l_reg * alpha + ps;
            bf16x8 pa0, pa1, pa2, pa3;
            PK4(p0, 0, pa0); PK4(p0, 8, pa1); PK4(p1, 0, pa2); PK4(p1, 8, pa3);
            SBAR();
            pv_rt(o, vb0 + buf * SHM_V, pa0, pa1, pa2, pa3);
        }
        if (more) { asm volatile("s_waitcnt vmcnt(0)" ::: "memory"); SM_WRITE(buf ^ 1); }
        __syncthreads();
        buf ^= 1;
    }
#undef SM_LOAD
#undef SM_WRITE
    if (hi == 0) al_l[r32] = l_reg; asm volatile("s_waitcnt lgkmcnt(0)" ::: "memory");
    float rli[16];
#pragma unroll
    for (int r = 0; r < 16; ++r) rli[r] = __builtin_amdgcn_rcpf(al_l[crow(r, hi)]);
#define OPQ(v) asm volatile("" : "+v"(v))
    char* sA = (char*)C.scr; char* sB = sA + 16384;
    const unsigned lo16 = (unsigned)lane * 16u;
    const int mode = cur.mode;
    if (mode == 0 || mode == 1) { char* s = mode ? sB : sA;
#pragma unroll
        for (int r = 0; r < 16; ++r) { unsigned vo = lo16; OPQ(vo);
            const f32x4 v = {o[0][r] * rli[r], o[1][r] * rli[r], o[2][r] * rli[r], o[3][r] * rli[r]};
            *(f32x4*)(s + (size_t)(vo + r * 1024)) = v; }
    } else if (mode == 2) {
#pragma unroll
        for (int r = 0; r < 16; ++r) { unsigned vo = lo16; OPQ(vo);
            f32x4* ap = (f32x4*)(sA + (size_t)(vo + r * 1024)); const f32x4 a = *ap;
            const f32x4 v = {a[0] - C.lam * (o[0][r] * rli[r]), a[1] - C.lam * (o[1][r] * rli[r]), a[2] - C.lam * (o[2][r] * rli[r]), a[3] - C.lam * (o[3][r] * rli[r])};
            *ap = v;
            if ((r & 3) == 3) asm volatile("" ::: "memory"); }
    } else {
        float g0[4], g1[4];
#pragma unroll
        for (int d0 = 0; d0 < 4; ++d0) { g0[d0] = C.gain[d0 * 32 + r32]; g1[d0] = C.gain[128 + d0 * 32 + r32]; }
        char* Ow = (char*)(cur.O + (size_t)(wid * QBLK) * PO);
        const unsigned lo_o = (unsigned)((4 * hi) * PO + r32) * 2u;
#pragma unroll
        for (int r = 0; r < 16; ++r) { unsigned vo = lo16; OPQ(vo);
            const f32x4 a = *(const f32x4*)(sA + (size_t)(vo + r * 1024)); const f32x4 b = *(const f32x4*)(sB + (size_t)(vo + r * 1024));
            float d1[4], ss = 0.f;
#pragma unroll
            for (int d0 = 0; d0 < 4; ++d0) { d1[d0] = b[d0] - C.lam * (o[d0][r] * rli[r]); ss += d1[d0] * d1[d0] + a[d0] * a[d0]; }
            ss += __shfl_xor(ss, 1); ss += __shfl_xor(ss, 2); ss += __shfl_xor(ss, 4); ss += __shfl_xor(ss, 8); ss += __shfl_xor(ss, 16);
            const float scl = rsqrtf(ss * (1.f / 256.f) + C.eps) * C.omli;
            unsigned wo = lo_o; OPQ(wo);
            char* rowp = Ow + (size_t)(wo + (unsigned)(((r & 3) + 8 * (r >> 2)) * PO * 2));
#pragma unroll
            for (int d0 = 0; d0 < 4; ++d0) {
                const float v0 = a[d0] * scl * g0[d0], v1 = d1[d0] * scl * g1[d0];
                const float v0n = __shfl_xor(v0, 1), v1n = __shfl_xor(v1, 1);
                if ((r32 & 1) == 0) { *(unsigned*)(rowp + d0 * 64) = cvtpk(v0, v0n); *(unsigned*)(rowp + 256 + d0 * 64) = cvtpk(v1, v1n); }
            }
            if ((r & 1) == 1) asm volatile("" ::: "memory");
        }
    }
#undef OPQ
    __syncthreads();
}

constexpr int K2 = 32;
constexpr int ST2_K0 = 0, ST2_K1 = 8192, ST2_V = 16384, ST2_BYTES = 32768;
__device__ __forceinline__ int v_st2(int k, int c) { const int kk = (k & ~0xC) | ((k & 4) << 1) | ((k & 8) >> 1); return ((kk >> 3) * 8 + (c >> 5)) * 512 + ((kk & 7) * 32 + (c & 31)) * 2; }
struct Diff2Const { float lam; float omli; float eps; float mb; const float* gain; };
template <int PQ, int PK, int PV, int PO>
__device__ __forceinline__ void diff2_block(const bf16* Qb  , const bf16* Kb  , const bf16* Vb  ,
                                            bf16* Ob, int P0, const Diff2Const& C, char* lds) {
    const int tid = threadIdx.x, wid = __builtin_amdgcn_readfirstlane(tid >> 6), lane = tid & 63, r32 = lane & 31, hi = lane >> 5;
    const int rg = wid & 3, cc = wid >> 2;
    const int krow = tid >> 4, kcol = (tid & 15) * 8, kws = KSWZ(krow, kcol * 2);
    const int vrow0 = tid >> 5, vcol = (tid & 31) * 8, vst0 = v_st2(vrow0, vcol), vst1 = v_st2(16 + vrow0, vcol);
    const int vb0 = (int)(uintptr_t)lds + ST2_V + v_rd_base(lane);
    const char* Kmine = lds + (cc ? ST2_K1 : ST2_K0);
    bf16x8 qr[8];
    { unsigned qo = (unsigned)((rg * QBLK + r32) * PQ + cc * 128 + hi * 8) * 2u; asm volatile("" : "+v"(qo));
#pragma unroll
      for (int d0 = 0; d0 < 8; ++d0) qr[d0] = *(const bf16x8*)((const char*)Qb + (size_t)qo + d0 * 32); }
    f32x16 o[8];
#pragma unroll
    for (int d0 = 0; d0 < 8; ++d0) o[d0] = f32x16{};
    float l_reg = 0.f;
    const int qlo = P0 + rg * QBLK, qm = qlo + r32 - 4 * hi;
    const int NT = P0 / K2 + 4;
    bf16x8 st_k0, st_k1, st_v0, st_v1;
    const unsigned koff = (unsigned)(krow * PK + kcol) * 2u, voffa = (unsigned)(vrow0 * PV + vcol) * 2u, voffb = (unsigned)((16 + vrow0) * PV + vcol) * 2u;
#define D2_LOAD(jt) do { const char* kt_ = (const char*)Kb + (size_t)(jt) * (K2 * PK * 2); const char* vt_ = (const char*)Vb + (size_t)(jt) * (K2 * PV * 2); \
                         unsigned ko_ = koff, va_ = voffa, vb_ = voffb; asm volatile("" : "+v"(ko_), "+v"(va_), "+v"(vb_)); \
                         st_k0 = *(const bf16x8*)(kt_ + (size_t)ko_); st_k1 = *(const bf16x8*)(kt_ + (size_t)ko_ + 256); \
                         st_v0 = *(const bf16x8*)(vt_ + (size_t)va_); st_v1 = *(const bf16x8*)(vt_ + (size_t)vb_); } while (0)
#define D2_WRITE(bf) do { char* st_ = lds + (bf) * ST2_BYTES; *(bf16x8*)(st_ + ST2_K0 + kws) = st_k0; *(bf16x8*)(st_ + ST2_K1 + kws) = st_k1; \
                          *(bf16x8*)(st_ + ST2_V + vst0) = st_v0; *(bf16x8*)(st_ + ST2_V + vst1) = st_v1; } while (0)
    D2_LOAD(0); asm volatile("s_waitcnt vmcnt(0)" ::: "memory"); D2_WRITE(0);
    __syncthreads();
    int buf = 0;
    for (int t = 0; t < NT; ++t) {
        const int kb = t * K2; const bool more = t + 1 < NT;
        if (more) D2_LOAD(t + 1);
        if (kb <= qlo + QBLK - 1) {
            f32x16 p0 = f32x16{};
            { const char* Kt = Kmine + buf * ST2_BYTES; const char* kbp[4];
#pragma unroll
              for (int dd = 0; dd < 4; ++dd) kbp[dd] = Kt + KSWZ(r32, (dd * 16 + hi * 8) * 2);
#pragma unroll
              for (int d0 = 0; d0 < 8; ++d0) { const bf16x8 b0 = *reinterpret_cast<const bf16x8*>(kbp[d0 & 3] + (d0 >> 2) * 128); p0 = __builtin_amdgcn_mfma_f32_32x32x16_bf16(b0, qr[d0], p0, 0, 0, 0); } }
            const float mb = C.mb;
            if (kb + K2 - 1 > qlo) {
                const int dq = qm - kb;
#pragma unroll
                for (int r = 0; r < 16; ++r) { const int c = (r & 3) + 8 * (r >> 2); const float e = __builtin_amdgcn_exp2f(p0[r] - mb); p0[r] = (dq - c) >= 0 ? e : 0.f; }
            } else {
#pragma unroll
                for (int r = 0; r < 16; ++r) p0[r] = __builtin_amdgcn_exp2f(p0[r] - mb);
            }
            float ps = 0.f;
#pragma unroll
            for (int r = 0; r < 16; ++r) ps += p0[r];
            l_reg += ps;
            bf16x8 pa0, pa1;
            PK4(p0, 0, pa0); PK4(p0, 8, pa1);
            SBAR();
            const int vb = vb0 + buf * ST2_BYTES;
#define TRRD(dst, off) asm volatile("ds_read_b64_tr_b16 %0, %1 offset:%2" : "=&v"(dst) : "v"(vb), "i"(off) : "memory")
#define PV2_RD(d0, L0, H0, L1, H1) do { constexpr int b_ = (d0) * 512; TRRD(L0, b_); TRRD(H0, b_ + 4096); TRRD(L1, b_ + 8192); TRRD(H1, b_ + 12288); } while (0)
#define PV2_MM(d0, L0, H0, L1, H1) do { \
        o[d0] = __builtin_amdgcn_mfma_f32_32x32x16_bf16(pa0, (bf16x8){L0[0], L0[1], L0[2], L0[3], H0[0], H0[1], H0[2], H0[3]}, o[d0], 0, 0, 0); \
        o[d0] = __builtin_amdgcn_mfma_f32_32x32x16_bf16(pa1, (bf16x8){L1[0], L1[1], L1[2], L1[3], H1[0], H1[1], H1[2], H1[3]}, o[d0], 0, 0, 0); } while (0)
#define LGK(n) do { asm volatile("s_waitcnt lgkmcnt(" #n ")" ::: "memory"); SBAR(); } while (0)
            { s16x4 la0, ha0, la1, ha1, lb0, hb0, lb1, hb1;
              PV2_RD(0, la0, ha0, la1, ha1);
              PV2_RD(1, lb0, hb0, lb1, hb1); LGK(4); PV2_MM(0, la0, ha0, la1, ha1);
              PV2_RD(2, la0, ha0, la1, ha1); LGK(4); PV2_MM(1, lb0, hb0, lb1, hb1);
              PV2_RD(3, lb0, hb0, lb1, hb1); LGK(4); PV2_MM(2, la0, ha0, la1, ha1);
              PV2_RD(4, la0, ha0, la1, ha1); LGK(4); PV2_MM(3, lb0, hb0, lb1, hb1);
              PV2_RD(5, lb0, hb0, lb1, hb1); LGK(4); PV2_MM(4, la0, ha0, la1, ha1);
              PV2_RD(6, la0, ha0, la1, ha1); LGK(4); PV2_MM(5, lb0, hb0, lb1, hb1);
              PV2_RD(7, lb0, hb0, lb1, hb1); LGK(4); PV2_MM(6, la0, ha0, la1, ha1);
              LGK(0); PV2_MM(7, lb0, hb0, lb1, hb1); }
#undef PV2_RD
#undef PV2_MM
#undef LGK
#undef TRRD
        }
        if (more) { asm volatile("s_waitcnt vmcnt(0)" ::: "memory"); D2_WRITE(buf ^ 1); }
        __syncthreads();
        buf ^= 1;
    }
#undef D2_LOAD
#undef D2_WRITE
    { auto rr = __builtin_amdgcn_permlane32_swap(__float_as_uint(l_reg), __float_as_uint(l_reg), false, false); l_reg = __uint_as_float(rr[0]) + __uint_as_float(rr[1]); }
    float* lw = (float*)(lds + 132096) + wid * 32;
    if (hi == 0) lw[r32] = l_reg; asm volatile("s_waitcnt lgkmcnt(0)" ::: "memory");
    float rli[16];
#pragma unroll
    for (int r = 0; r < 16; ++r) rli[r] = __builtin_amdgcn_rcpf(lw[crow(r, hi)]);
    float* X = (float*)lds + rg * 8192;
#define OPQ(v) asm volatile("" : "+v"(v))
    if (cc == 1) {
#pragma unroll
        for (int r = 0; r < 16; ++r) { const float f = C.lam * rli[r]; unsigned vo = (unsigned)lane; OPQ(vo);
#pragma unroll
            for (int d0 = 0; d0 < 8; ++d0) X[(r * 8 + d0) * 64 + vo] = o[d0][r] * f; }
    }
    __syncthreads();
    if (cc == 0) {
        float g[8];
        { unsigned go = (unsigned)r32 * 4u; OPQ(go);
#pragma unroll
          for (int d0 = 0; d0 < 8; ++d0) g[d0] = *(const float*)((const char*)C.gain + (size_t)go + d0 * 128); }
        char* Ow = (char*)(Ob + (size_t)(rg * QBLK) * PO);
        const unsigned lo_o = (unsigned)((4 * hi) * PO + r32) * 2u;
#pragma unroll
        for (int r = 0; r < 16; ++r) { unsigned vo = (unsigned)lane; OPQ(vo);
            float d[8], ss = 0.f;
#pragma unroll
            for (int d0 = 0; d0 < 8; ++d0) { d[d0] = o[d0][r] * rli[r] - X[(r * 8 + d0) * 64 + vo]; ss += d[d0] * d[d0]; }
            ss += __shfl_xor(ss, 1); ss += __shfl_xor(ss, 2); ss += __shfl_xor(ss, 4); ss += __shfl_xor(ss, 8); ss += __shfl_xor(ss, 16);
            const float scl = rsqrtf(ss * (1.f / 256.f) + C.eps) * C.omli;
            unsigned wo = lo_o; OPQ(wo);
            char* rowp = Ow + (size_t)(wo + (unsigned)(((r & 3) + 8 * (r >> 2)) * PO * 2));
#pragma unroll
            for (int d0 = 0; d0 < 8; ++d0) { const float v = d[d0] * scl * g[d0]; const float vn = __shfl_xor(v, 1);
                if ((r32 & 1) == 0) *(unsigned*)(rowp + d0 * 64) = cvtpk(v, vn); }
        }
    }
#undef OPQ
    __syncthreads();
}
}
#ifndef PG8_SP2
#define PG8_SP2 true
#endif
#ifndef PG8_ALIGN
#define PG8_ALIGN true
#endif
#ifndef MK_SPLIT
#define MK_SPLIT 0
#endif
#ifndef MK_CHECK
#define MK_CHECK 0
#endif
constexpr int NWAVES = 8;
constexpr int BATCH = 2, SEQ = 4096, DM = 4096, MROWS = BATCH * SEQ, FF = 11008, FF2 = 2 * FF, NQKV = 3 * DM;
constexpr int SB_H = 32, DF_H = 16, HD = 128;
constexpr float RMS_EPS = 1e-6f;
constexpr float LOG2E = 1.4426950408889634f;
constexpr float QSCALE = 0.08838834764831845f * LOG2E;
constexpr int NPH = 14;
constexpr size_t MiB = 1u << 20;
constexpr size_t WS_CTL = 0, CTL_ZERO_BYTES = 1 * MiB;
constexpr size_t WS_WQKV0 = 2 * MiB;
constexpr size_t WS_WO0   = WS_WQKV0 + 96 * MiB;
constexpr size_t WS_WQKV1 = WS_WO0 + 32 * MiB;
constexpr size_t WS_WO1   = WS_WQKV1 + 96 * MiB;
constexpr size_t WS_WUP0  = WS_WO1 + 32 * MiB;
constexpr size_t WS_WUP1  = WS_WUP0 + 172 * MiB;
constexpr size_t WS_WDN0  = WS_WUP1 + 172 * MiB;
constexpr size_t WS_WDN1  = WS_WDN0 + 86 * MiB;
constexpr size_t WS_XN    = WS_WDN1 + 86 * MiB;
constexpr size_t WS_PART  = WS_XN + 64 * MiB;
constexpr size_t WS_QKV   = WS_PART + 2 * MiB;
constexpr size_t WS_QKN   = WS_QKV + 192 * MiB;
constexpr size_t WS_AO    = WS_QKN + 128 * MiB;
constexpr size_t WS_U     = WS_AO + 64 * MiB;
constexpr size_t WS_ACT   = WS_U + 344 * MiB;
constexpr size_t WS_SCR   = WS_ACT + 172 * MiB;
constexpr size_t WS_HALO  = WS_SCR + 64 * MiB;
constexpr size_t WS_X1    = WS_HALO + 44 * MiB;
constexpr size_t WS_END   = WS_X1 + (MK_CHECK ? 3 * 128 * MiB : 0);
constexpr int CW_TMO = 0, CW_CODE = 1, CW_FAIL = 2, CW_BAR = 4096;

constexpr int RING_OFF = 0, RING_BYTES = 131072;
constexpr int LDSCTL_OFF = RING_BYTES, MISC_OFF = LDSCTL_OFF + 320;
constexpr int LDS_BYTES = 147456;
static_assert(MISC_OFF + 128 <= LDS_BYTES, "LDS map");

#define GAS __attribute__((address_space(1)))
#define LAS __attribute__((address_space(3)))
typedef unsigned short bf16;
typedef unsigned v4u __attribute__((ext_vector_type(4)));
typedef unsigned v2u __attribute__((ext_vector_type(2)));
typedef float f32x4 __attribute__((ext_vector_type(4)));
typedef short bf16x8 __attribute__((ext_vector_type(8)));
typedef GAS unsigned gu32;
#define RLX_AGENT __ATOMIC_RELAXED, __HIP_MEMORY_SCOPE_AGENT
#define LDS_WAIT() asm volatile("s_waitcnt lgkmcnt(0)" ::: "memory")
#define VM_WAIT() asm volatile("s_waitcnt vmcnt(0)" ::: "memory")
__device__ __forceinline__ unsigned f2bf(float f) { unsigned u = __builtin_bit_cast(unsigned, f); return (u + 0x7fffu + ((u >> 16) & 1u)) >> 16; }
__device__ __forceinline__ unsigned pk2(float lo, float hi) { return f2bf(lo) | (f2bf(hi) << 16); }
__device__ __forceinline__ float bf2f(unsigned short b) { return __builtin_bit_cast(float, (unsigned)b << 16); }

#define XB_TMO      128
#define XB_XCNT(j)  (256  + 64 * (j))
#define XB_XSUB(j)  (1280 + 64 * (j))
#define XB_XGEN(j)  (2304 + 64 * (j))
#define XB_TOP      3328
#define XB_TOPGEN   3392
#define XCD_BAR_WORDS 3456
#define XB_SPIN_CAP (1u << 18)
__device__ __forceinline__ unsigned xb_ld(unsigned* p)              { return __hip_atomic_load(p, __ATOMIC_RELAXED, __HIP_MEMORY_SCOPE_AGENT); }
__device__ __forceinline__ unsigned xb_add(unsigned* p, unsigned v) { return __hip_atomic_fetch_add(p, v, __ATOMIC_RELAXED, __HIP_MEMORY_SCOPE_AGENT); }
__device__ __forceinline__ unsigned xb_xcc_id() { return (unsigned)__builtin_amdgcn_s_getreg((3 << 11) | 20) & 0xFu; }
#define XB_SPIN(cond, bar) do { unsigned _sp = 0; while (cond) { __builtin_amdgcn_s_sleep(1); \
    if ((++_sp & 255u) == 0u) { if (xb_ld(&(bar)[XB_TMO])) break; if (_sp > XB_SPIN_CAP) { atomicAdd(&(bar)[XB_TMO], 1u); break; } } } } while (0)
struct XcdBarrier { unsigned* bar; unsigned x; volatile LAS unsigned* st; };
__device__ __forceinline__ XcdBarrier xcd_barrier_post(unsigned* bar, volatile LAS unsigned* st) {
    XcdBarrier b; b.bar = bar; b.x = xb_xcc_id(); b.st = st;
    if (threadIdx.x == 0) (void)xb_add(&bar[XB_XCNT(b.x)], 1u);
    return b;
}
__device__ __forceinline__ void xcd_barrier_complete(unsigned* bar, unsigned x, unsigned& nloc, unsigned& nx) {
    const unsigned G = gridDim.x * gridDim.y * gridDim.z;
    unsigned sum, cnt, mine, sp = 0u;
    for (;;) {
        sum = 0u; cnt = 0u; mine = 0u;
#pragma unroll
        for (unsigned j = 0; j < 16; ++j) { const unsigned c = xb_ld(&bar[XB_XCNT(j)]); sum += c; cnt += (c > 0u) ? 1u : 0u; mine = (j == x) ? c : mine; }
        if (sum == G) break;
        __builtin_amdgcn_s_sleep(1);
        if ((++sp & 255u) == 0u) { if (xb_ld(&bar[XB_TMO])) break; if (sp > XB_SPIN_CAP) { atomicAdd(&bar[XB_TMO], 1u); break; } }
    }
    nloc = mine > 0u ? mine : 1u; nx = cnt > 0u ? cnt : 1u;
}
__device__ __forceinline__ void xcd_barrier(const XcdBarrier& b) {
    asm volatile("s_waitcnt vmcnt(0)" ::: "memory");
    __syncthreads();
    if (threadIdx.x == 0) {
        unsigned* bar = b.bar;
        __builtin_amdgcn_s_waitcnt(0);
        unsigned nloc = b.st[0], nx = b.st[1];
        if (nloc == 0u) { xcd_barrier_complete(bar, b.x, nloc, nx); b.st[0] = nloc; b.st[1] = nx; }
        const unsigned old = xb_add(&bar[XB_XSUB(b.x)], 1u);
        const unsigned gen = old / nloc;
        if (old + 1u == (gen + 1u) * nloc) {
            __builtin_amdgcn_fence(__ATOMIC_RELEASE, "agent");
            asm volatile("s_waitcnt vmcnt(0)" ::: "memory");
            const unsigned og = xb_add(&bar[XB_TOP], 1u);
            const unsigned tg = og / nx;
            if (og + 1u == (tg + 1u) * nx) xb_add(&bar[XB_TOPGEN], 1u);
            else XB_SPIN(xb_ld(&bar[XB_TOPGEN]) == tg, bar);
            __builtin_amdgcn_fence(__ATOMIC_ACQUIRE, "agent");
            xb_add(&bar[XB_XGEN(b.x)], 1u);
            asm volatile("s_waitcnt vmcnt(0)" ::: "memory");
        } else {
            XB_SPIN(xb_ld(&bar[XB_XGEN(b.x)]) == gen, bar);
            __builtin_amdgcn_fence(__ATOMIC_ACQUIRE, "agent");
            asm volatile("s_waitcnt vmcnt(0)" ::: "memory");
        }
    }
    __syncthreads();
}

__device__ __forceinline__ float wave_sum(float v) {
#pragma unroll
    for (int o = 1; o < 64; o <<= 1) v += __shfl_xor(v, o);
    return v;
}

constexpr int TR_STRIDE = 33;
__device__ __forceinline__ void transpose_item(const float* W, const float* gain, int K, int N, bf16* WT, LAS unsigned* scr, int item, int lane, bool gateperm) {
    const int nblk = N / 64, kb = item / nblk, nb = item % nblk, k0 = 64 * kb, n0 = 64 * nb;
    const int h_ = N / 2, nd0 = gateperm ? ((n0 % h_) / 128) * 256 + (n0 / h_) * 128 + (n0 % 128) : n0;
    const int kp = lane >> 4, c = lane & 15;
    f32x4 va[8], vb[8];
#pragma unroll
    for (int i = 0; i < 8; ++i) { const GAS float* src = (const GAS float*)W + (size_t)(k0 + 8 * i + 2 * kp) * N + n0 + 4 * c; va[i] = __builtin_nontemporal_load((const GAS f32x4*)src); vb[i] = __builtin_nontemporal_load((const GAS f32x4*)(src + N)); }
#pragma unroll
    for (int i = 0; i < 8; ++i) { float ga = 1.f, gb = 1.f; if (gain) { ga = gain[k0 + 8 * i + 2 * kp]; gb = gain[k0 + 8 * i + 2 * kp + 1]; }
        LAS unsigned* d = scr + (4 * c) * TR_STRIDE + 4 * i + kp;
        d[0 * TR_STRIDE] = pk2(va[i].x * ga, vb[i].x * gb); d[1 * TR_STRIDE] = pk2(va[i].y * ga, vb[i].y * gb);
        d[2 * TR_STRIDE] = pk2(va[i].z * ga, vb[i].z * gb); d[3 * TR_STRIDE] = pk2(va[i].w * ga, vb[i].w * gb); }
    LDS_WAIT(); asm volatile("" ::: "memory");
    const int c8 = lane & 7, nr = lane >> 3;
#pragma unroll
    for (int j = 0; j < 8; ++j) { const int n = nr + 8 * j; const LAS unsigned* s = scr + n * TR_STRIDE + 4 * c8;
        v4u o; o.x = s[0]; o.y = s[1]; o.z = s[2]; o.w = s[3];
        *(GAS v4u*)(WT + (size_t)(nd0 + n) * K + k0 + 8 * c8) = o; }
    LDS_WAIT(); asm volatile("" ::: "memory");
}
__device__ __forceinline__ void xrow_to_bf16(const float* xrow, bf16* orow, float* prow, int lane) {
    const GAS f32x4* xr = (const GAS f32x4*)xrow + lane;
    float s = 0.f; GAS unsigned long long* o8 = (GAS unsigned long long*)orow + lane;
#pragma unroll
    for (int j = 0; j < 16; ++j) { const f32x4 v = xr[64 * j]; s += (v.x * v.x + v.y * v.y) + (v.z * v.z + v.w * v.w);
        o8[64 * j] = (unsigned long long)pk2(v.x, v.y) | ((unsigned long long)pk2(v.z, v.w) << 32); }
    s = wave_sum(s);
    prow[lane] = lane == 0 ? s : 0.f;
}

__device__ __forceinline__ void cvt8(const v4u w, float (&f)[8]) {
    f[0] = __builtin_bit_cast(float, w.x << 16); f[1] = __builtin_bit_cast(float, w.x & 0xffff0000u); f[2] = __builtin_bit_cast(float, w.y << 16); f[3] = __builtin_bit_cast(float, w.y & 0xffff0000u);
    f[4] = __builtin_bit_cast(float, w.z << 16); f[5] = __builtin_bit_cast(float, w.z & 0xffff0000u); f[6] = __builtin_bit_cast(float, w.w << 16); f[7] = __builtin_bit_cast(float, w.w & 0xffff0000u);
}
constexpr int CG_ROWS = 32, CG_NCG = FF / 8, CG_ITEMS = (MROWS / CG_ROWS) * CG_NCG;
__device__ __forceinline__ void convgate_item(const bf16* U, const float* cw, const float* cb, bf16* ACT, int item) {
    const int chunk = item / CG_NCG, cg = item % CG_NCG, m0 = chunk * CG_ROWS, t0 = m0 % SEQ, j0 = cg * 8;
    float wg[3][8], wv[3][8], bg[8], bv[8];
#pragma unroll
    for (int i = 0; i < 3; ++i)
#pragma unroll
        for (int h = 0; h < 2; ++h) { const f32x4 a = *(const f32x4*)(cw + (size_t)i * FF2 + j0 + 4 * h), b = *(const f32x4*)(cw + (size_t)i * FF2 + FF + j0 + 4 * h);
            wg[i][4 * h] = a.x; wg[i][4 * h + 1] = a.y; wg[i][4 * h + 2] = a.z; wg[i][4 * h + 3] = a.w; wv[i][4 * h] = b.x; wv[i][4 * h + 1] = b.y; wv[i][4 * h + 2] = b.z; wv[i][4 * h + 3] = b.w; }
#pragma unroll
    for (int h = 0; h < 2; ++h) { const f32x4 a = *(const f32x4*)(cb + j0 + 4 * h), b = *(const f32x4*)(cb + FF + j0 + 4 * h);
        bg[4 * h] = a.x; bg[4 * h + 1] = a.y; bg[4 * h + 2] = a.z; bg[4 * h + 3] = a.w; bv[4 * h] = b.x; bv[4 * h + 1] = b.y; bv[4 * h + 2] = b.z; bv[4 * h + 3] = b.w; }
    float g2[8], g1[8], v2[8], v1[8];
    const v4u z4 = {0u, 0u, 0u, 0u};
    { const v4u a = t0 >= 2 ? *(const GAS v4u*)(U + (size_t)(m0 - 2) * FF2 + j0) : z4, b = t0 >= 2 ? *(const GAS v4u*)(U + (size_t)(m0 - 2) * FF2 + FF + j0) : z4; cvt8(a, g2); cvt8(b, v2); }
    { const v4u a = t0 >= 1 ? *(const GAS v4u*)(U + (size_t)(m0 - 1) * FF2 + j0) : z4, b = t0 >= 1 ? *(const GAS v4u*)(U + (size_t)(m0 - 1) * FF2 + FF + j0) : z4; cvt8(a, g1); cvt8(b, v1); }
#pragma unroll 4
    for (int r = 0; r < CG_ROWS; ++r) {
        float g0[8], v0[8]; cvt8(*(const GAS v4u*)(U + (size_t)(m0 + r) * FF2 + j0), g0); cvt8(*(const GAS v4u*)(U + (size_t)(m0 + r) * FF2 + FF + j0), v0);
        float o[8];
#pragma unroll
        for (int e = 0; e < 8; ++e) { const float cgv = bg[e] + wg[0][e] * g2[e] + wg[1][e] * g1[e] + wg[2][e] * g0[e]; const float cvv = bv[e] + wv[0][e] * v2[e] + wv[1][e] * v1[e] + wv[2][e] * v0[e];
            const float sg = cgv * __builtin_amdgcn_rcpf(1.f + __builtin_amdgcn_exp2f(-cgv * LOG2E)); o[e] = sg * cvv; g2[e] = g1[e]; g1[e] = g0[e]; v2[e] = v1[e]; v1[e] = v0[e]; }
        v4u w; w.x = pk2(o[0], o[1]); w.y = pk2(o[2], o[3]); w.z = pk2(o[4], o[5]); w.w = pk2(o[6], o[7]);
        *(GAS v4u*)(ACT + (size_t)(m0 + r) * FF + j0) = w;
    }
}

constexpr int FX_ITEMS = (MROWS / 64) * CG_NCG;
__device__ __forceinline__ void ld8(const float* p, float (&f)[8]) { const f32x4 a = *(const GAS f32x4*)p, b = *(const GAS f32x4*)(p + 4); f[0] = a.x; f[1] = a.y; f[2] = a.z; f[3] = a.w; f[4] = b.x; f[5] = b.y; f[6] = b.z; f[7] = b.w; }
__device__ __forceinline__ void fixup_item(const float* halo, const float* cw, const float* cb, bf16* ACT, int item) {
    const int grp = item / CG_NCG, cg = item % CG_NCG, j0 = cg * 8; const bool first = (grp % (SEQ / 64)) == 0;
    float wg[3][8], wv[3][8], bg[8], bv[8];
#pragma unroll
    for (int i = 0; i < 3; ++i) { ld8(cw + (size_t)i * FF2 + j0, wg[i]); ld8(cw + (size_t)i * FF2 + FF + j0, wv[i]); }
    ld8(cb + j0, bg); ld8(cb + FF + j0, bv);
    float h0g[8], h0v[8], h1g[8], h1v[8], t0g[8], t0v[8], t1g[8], t1v[8];
    const float* hb = halo + (size_t)grp * 4 * FF2 + j0;
    ld8(hb, h0g); ld8(hb + FF, h0v); ld8(hb + FF2, h1g); ld8(hb + FF2 + FF, h1v);
    if (!first) { const float* pb = hb - 4 * (size_t)FF2; ld8(pb + 2 * (size_t)FF2, t0g); ld8(pb + 2 * (size_t)FF2 + FF, t0v); ld8(pb + 3 * (size_t)FF2, t1g); ld8(pb + 3 * (size_t)FF2 + FF, t1v); }
    else {
#pragma unroll
        for (int e = 0; e < 8; ++e) { t0g[e] = 0.f; t0v[e] = 0.f; t1g[e] = 0.f; t1v[e] = 0.f; } }
    float o0[8], o1[8];
#pragma unroll
    for (int e = 0; e < 8; ++e) {
        const float cg0 = bg[e] + wg[0][e] * t0g[e] + wg[1][e] * t1g[e] + wg[2][e] * h0g[e], cv0 = bv[e] + wv[0][e] * t0v[e] + wv[1][e] * t1v[e] + wv[2][e] * h0v[e];
        const float cg1 = bg[e] + wg[0][e] * t1g[e] + wg[1][e] * h0g[e] + wg[2][e] * h1g[e], cv1 = bv[e] + wv[0][e] * t1v[e] + wv[1][e] * h0v[e] + wv[2][e] * h1v[e];
        o0[e] = cg0 * __builtin_amdgcn_rcpf(1.f + __builtin_amdgcn_exp2f(-cg0 * LOG2E)) * cv0; o1[e] = cg1 * __builtin_amdgcn_rcpf(1.f + __builtin_amdgcn_exp2f(-cg1 * LOG2E)) * cv1; }
    v4u w0, w1; w0.x = pk2(o0[0], o0[1]); w0.y = pk2(o0[2], o0[3]); w0.z = pk2(o0[4], o0[5]); w0.w = pk2(o0[6], o0[7]);
    w1.x = pk2(o1[0], o1[1]); w1.y = pk2(o1[2], o1[3]); w1.z = pk2(o1[4], o1[5]); w1.w = pk2(o1[6], o1[7]);
    *(GAS v4u*)(ACT + (size_t)(grp * 64) * FF + j0) = w0; *(GAS v4u*)(ACT + (size_t)(grp * 64 + 1) * FF + j0) = w1;
}

__device__ __forceinline__ void sincos_rev(float ang, float& s, float& c) {
    const float I1 = 0.15915493667125702f, I2 = 6.420638326565253e-09f;
    const float r1 = ang * I1; const float e1 = __builtin_fmaf(ang, I1, -r1); const float r2 = __builtin_fmaf(ang, I2, e1);
    const float fr = (r1 - __builtin_rintf(r1)) + r2;
    s = __builtin_amdgcn_sinf(fr); c = __builtin_amdgcn_cosf(fr);
}
__device__ __forceinline__ void qknorm_row(const bf16* qkv_row, bf16* qkn_row, const float* gq, const float* gk, int t, int lane) {
    const int c = lane & 7, gs = lane >> 3;
    float cs[8], sn[8];
#pragma unroll
    for (int e = 0; e < 8; ++e) { const int i = 8 * c + e; const float invf = __builtin_amdgcn_exp2f(-(float)i * (13.287712379549449f / 64.f));
        sincos_rev((float)t * invf, sn[e], cs[e]); }
    float gA[8], gB[8];
#pragma unroll 1
    for (int qk = 0; qk < 2; ++qk) {
        const float* gn = qk ? gk : gq; const float sc = qk ? 1.f : QSCALE;
#pragma unroll
        for (int e = 0; e < 8; ++e) { gA[e] = gn[8 * c + e]; gB[e] = gn[64 + 8 * c + e]; }
        v4u ra[4], rb[4];
#pragma unroll
        for (int it = 0; it < 4; ++it) { const int col = qk * 4096 + (it * 8 + gs) * 128 + 8 * c; ra[it] = *(const GAS v4u*)(qkv_row + col); rb[it] = *(const GAS v4u*)(qkv_row + col + 64); }
#pragma unroll
        for (int it = 0; it < 4; ++it) {
            const int col = qk * 4096 + (it * 8 + gs) * 128 + 8 * c;
            float xa[8], xb[8]; cvt8(ra[it], xa); cvt8(rb[it], xb);
            float ss = 0.f;
#pragma unroll
            for (int e = 0; e < 8; ++e) ss += xa[e] * xa[e] + xb[e] * xb[e];
            ss += __shfl_xor(ss, 1); ss += __shfl_xor(ss, 2); ss += __shfl_xor(ss, 4);
            const float inv = rsqrtf(ss * (1.f / 128.f) + RMS_EPS);
            float oa[8], ob[8];
#pragma unroll
            for (int e = 0; e < 8; ++e) { const float ya = xa[e] * inv * gA[e], yb = xb[e] * inv * gB[e]; oa[e] = (ya * cs[e] - yb * sn[e]) * sc; ob[e] = (yb * cs[e] + ya * sn[e]) * sc; }
            v4u wa, wb; wa.x = pk2(oa[0], oa[1]); wa.y = pk2(oa[2], oa[3]); wa.z = pk2(oa[4], oa[5]); wa.w = pk2(oa[6], oa[7]);
            wb.x = pk2(ob[0], ob[1]); wb.y = pk2(ob[2], ob[3]); wb.z = pk2(ob[4], ob[5]); wb.w = pk2(ob[6], ob[7]);
            *(GAS v4u*)(qkn_row + col) = wa; *(GAS v4u*)(qkn_row + col + 64) = wb;
        }
    }
}
struct Args { const float* in[18]; float* out; unsigned char* ws; int ph_lo, ph_hi; };
static_assert(sizeof(Args) == 18 * 8 + 8 + 8 + 8, "Args has no padding");

struct MatDesc { int in_idx; size_t in_off; int gain_idx; size_t gain_off; int K, N; size_t ws_off; int gateperm; };
__device__ __forceinline__ MatDesc mat_desc(int i) {
    switch (i) {
    case 0: return MatDesc{2, 0, 1, 0, DM, NQKV, WS_WQKV0, 0};
    case 1: return MatDesc{3, 0, -1, 0, DM, DM, WS_WO0, 0};
    case 2: return MatDesc{14, 0, 13, 0, DM, FF2, WS_WUP0, 1};
    case 3: return MatDesc{17, 0, -1, 0, FF, DM, WS_WDN0, 0};
    case 4: return MatDesc{4, 0, 1, (size_t)DM, DM, NQKV, WS_WQKV1, 0};
    case 5: return MatDesc{5, 0, -1, 0, DM, DM, WS_WO1, 0};
    case 6: return MatDesc{14, (size_t)DM * FF2, 13, (size_t)DM, DM, FF2, WS_WUP1, 1};
    default: return MatDesc{17, (size_t)FF * DM, -1, 0, FF, DM, WS_WDN1, 0};
    }
}

__global__ void __launch_bounds__(NWAVES * 64, 2) mk_fwd(Args args) {
    extern __shared__ __attribute__((aligned(16))) unsigned char lds[];
    LAS unsigned char* ldsl = (LAS unsigned char*)lds;
    volatile LAS unsigned* MISC = (volatile LAS unsigned*)(ldsl + MISC_OFF);
    const int tid = threadIdx.x, lane = tid & 63, wave = __builtin_amdgcn_readfirstlane(tid >> 6);
    const int G = gridDim.x, bx = blockIdx.x;
    const int gw = bx * NWAVES + wave, NGW = G * NWAVES;
    unsigned char* ws = args.ws;
    gu32* ctl = (gu32*)(ws + WS_CTL);
    for (int u = tid; u < (LDS_BYTES - LDSCTL_OFF) / 4; u += NWAVES * 64) ((LAS unsigned*)(ldsl + LDSCTL_OFF))[u] = 0u;
    __syncthreads();
    XcdBarrier bar; bar.bar = (unsigned*)(ctl + CW_BAR); bar.x = 0; bar.st = nullptr;
    const int lo = args.ph_lo, hi = args.ph_hi;
    if (hi - lo > 1) bar = xcd_barrier_post((unsigned*)(ctl + CW_BAR), MISC + 8);
#ifndef PH_MASK
#define PH_MASK 0x3fff
#endif
#define IN(k) (((PH_MASK >> (k)) & 1) && lo <= (k) && (k) < hi)
#define SEAM(k) do { if (IN(k) && IN((k) + 1)) xcd_barrier(bar); STAMP((k) + 1); } while (0)
#ifndef REPEAT_PHASE
#define REPEAT_PHASE -1
#endif
#ifndef REPEAT_N
#define REPEAT_N 1
#endif
#ifndef LEAK_A
#define LEAK_A -1
#endif
#ifndef LEAK_B
#define LEAK_B 14
#endif
#ifndef LEAK_OFF
#define LEAK_OFF 0
#endif
    unsigned long long tA = 0, tB = 0;
#define STAMP(k) do { if (LEAK_A >= 0 && bx == 0 && tid == 0) { if ((k) == LEAK_A) tA = __builtin_amdgcn_s_memrealtime(); if ((k) == LEAK_B) tB = __builtin_amdgcn_s_memrealtime(); } } while (0)
#define NREP(k) (REPEAT_PHASE == (k) ? 1 + REPEAT_N : 1)
    float* DUMMY = (float*)(ws + WS_END);

    bf16* XN = (bf16*)(ws + WS_XN); float* PART = (float*)(ws + WS_PART);
    bf16* QKV = (bf16*)(ws + WS_QKV); bf16* QKN = (bf16*)(ws + WS_QKN); bf16* AO = (bf16*)(ws + WS_AO);
    bf16* ACT = (bf16*)(ws + WS_ACT); float* HALO = (float*)(ws + WS_HALO);
    const float* x_in = args.in[0];

#ifndef JIT_CONV
#define JIT_CONV 1
#endif
#define CONVERT_MAT(MI) do { const MatDesc md = mat_desc(MI); LAS unsigned* scr_ = (LAS unsigned*)(ldsl + RING_OFF + wave * 16384); \
        const float* W_ = args.in[md.in_idx] + md.in_off; const float* gain_ = md.gain_idx >= 0 ? args.in[md.gain_idx] + md.gain_off : nullptr; \
        bf16* WT_ = (bf16*)(ws + md.ws_off); const int nitems_ = (md.K / 64) * (md.N / 64); \
        for (int it_ = gw; it_ < nitems_; it_ += NGW) transpose_item(W_, gain_, md.K, md.N, WT_, scr_, it_, lane, md.gateperm != 0); } while (0)
#define CONVERT_MAT_RANGE(MI, I0, I1, WG0) do { const MatDesc md = mat_desc(MI); LAS unsigned* scr_ = (LAS unsigned*)(ldsl + RING_OFF + wave * 16384); \
        const float* W_ = args.in[md.in_idx] + md.in_off; const float* gain_ = md.gain_idx >= 0 ? args.in[md.gain_idx] + md.gain_off : nullptr; \
        bf16* WT_ = (bf16*)(ws + md.ws_off); const int i1_ = (I1); \
        for (int it_ = (I0) + (bx - (WG0)) * NWAVES + wave; it_ < i1_; it_ += (G - (WG0)) * NWAVES) transpose_item(W_, gain_, md.K, md.N, WT_, scr_, it_, lane, md.gateperm != 0); } while (0)
#ifndef TAILFILL
#define TAILFILL 1
#endif
#ifndef DN_NUM
#define DN_NUM 52
#endif
constexpr int DN_ITEMS = (FF / 64) * (DM / 64), DN_SPLIT = TAILFILL ? (DN_ITEMS * DN_NUM) / 100 : 0;
#ifndef SPLIT_CONV
#define SPLIT_CONV 1
#endif
#ifdef PROBE_XCC
    if (tid == 0) __hip_atomic_store(ctl + 2048 + bx, 1u + xb_xcc_id(), RLX_AGENT);
#endif
    STAMP(0);
    if (IN(0)) _Pragma("unroll") for (int rep = 0; rep < NREP(0); ++rep) { if (rep) xcd_barrier(bar);
        LAS unsigned* scr = (LAS unsigned*)(ldsl + RING_OFF + wave * 16384);
#pragma unroll 1
#if JIT_CONV
        for (int m = gw; m < MROWS; m += NGW) xrow_to_bf16(x_in + (size_t)m * DM, XN + (size_t)m * DM, PART + (size_t)m * pg8::NPART, lane);
        CONVERT_MAT(0);
    }
#else
        for (int mo = 0; mo < (SPLIT_CONV ? 4 : 8); ++mo) { const int mi = SPLIT_CONV ? ((mo + 1) & 3) : ((mo + 1) & 7); const MatDesc md = mat_desc(mi);
            if (mi == 0) { for (int m = gw; m < MROWS; m += NGW) xrow_to_bf16(x_in + (size_t)m * DM, XN + (size_t)m * DM, PART + (size_t)m * pg8::NPART, lane); }
            const float* W = args.in[md.in_idx] + md.in_off; const float* gain = md.gain_idx >= 0 ? args.in[md.gain_idx] + md.gain_off : nullptr;
            bf16* WT = (bf16*)(ws + md.ws_off); const int nitems = (md.K / 64) * (md.N / 64);
            for (int it = gw; it < nitems; it += NGW) transpose_item(W, gain, md.K, md.N, WT, scr, it, lane, md.gateperm != 0); }
    }
#endif
    SEAM(0);
    if (IN(1)) _Pragma("unroll") for (int rep = 0; rep < NREP(1); ++rep) { if (rep) xcd_barrier(bar);
        pg8::Gemm g{XN, (const bf16*)(ws + WS_WQKV0), MROWS, NQKV, DM}; pg8::StaticOrder S; S.init(MROWS, NQKV, G, bx);
        pg8::EpiScale E{QKV, NQKV, PART, 1.f / DM, RMS_EPS, DM, QSCALE};
        pg8::gemm_phase<pg8::EpiScale, pg8::StaticOrder, PG8_ALIGN, PG8_SP2>(ldsl + RING_OFF, g, S, E);
    }
    SEAM(1);
    if (IN(2)) _Pragma("unroll") for (int rep = 0; rep < NREP(2); ++rep) { if (rep) xcd_barrier(bar);
        constexpr int NBLK = BATCH * SB_H * (SEQ / 256);
        for (int L = bx; L < NBLK; L += G) { const int qb = L % 16, bh = L / 16, b = bh / SB_H, h = bh % SB_H;
            const bf16* kvbase = QKV + (size_t)(b * SEQ) * NQKV + h * HD;
            att::sb_block<NQKV, NQKV, NQKV, DM>(kvbase + (size_t)(qb * 256) * NQKV, kvbase + DM, kvbase + 2 * DM, AO + (size_t)(b * SEQ + qb * 256) * DM + h * HD, qb * 256, (char*)lds + RING_OFF, (volatile LAS unsigned*)(ldsl + RING_OFF + 65536)); }
        if (JIT_CONV) CONVERT_MAT(1);
    }
    SEAM(2);
    if (IN(3)) _Pragma("unroll") for (int rep = 0; rep < NREP(3); ++rep) { if (rep) xcd_barrier(bar);
        pg8::Gemm g{AO, (const bf16*)(ws + WS_WO0), MROWS, DM, DM}; pg8::StaticOrder S; S.init(MROWS, DM, G, bx);
        pg8::EpiResid<false, false> E{nullptr, nullptr, XN, PART, DM};
        pg8::gemm_phase<pg8::EpiResid<false, false>, pg8::StaticOrder, PG8_ALIGN, PG8_SP2>(ldsl + RING_OFF, g, S, E);
        if (JIT_CONV) CONVERT_MAT(2);
    }
    SEAM(3);
#define UP_PHASE(WOFF, LAYER) do { pg8::Gemm g{XN, (const bf16*)(ws + (WOFF)), MROWS, FF2, DM}; pg8::StaticOrder S; S.init(MROWS, FF2, G, bx); \
        pg8::EpiConvGate E{ACT, FF, PART, 1.f / DM, RMS_EPS, args.in[15] + (size_t)(LAYER) * 3 * FF2, args.in[16] + (size_t)(LAYER) * FF2, HALO}; \
        pg8::gemm_phase<pg8::EpiConvGate, pg8::StaticOrder, PG8_ALIGN, PG8_SP2>(ldsl + RING_OFF, g, S, E); } while (0)
#define CG_PHASE(LAYER) do { const float* cw = args.in[15] + (size_t)(LAYER) * 3 * FF2; const float* cb = args.in[16] + (size_t)(LAYER) * FF2; \
        for (int it = bx * (NWAVES * 64) + tid; it < FX_ITEMS; it += G * NWAVES * 64) fixup_item(HALO, cw, cb, ACT, it); } while (0)
#ifndef DOWN_WGM
#define DOWN_WGM 8
#endif
#define DOWN_PHASE(WOFF, OUT, LAST) do { pg8::Gemm g{ACT, (const bf16*)(ws + (WOFF)), MROWS, DM, FF}; pg8::StaticOrder S; S.init(MROWS, DM, G, bx, DOWN_WGM); \
        pg8::EpiResid<false, LAST> E{nullptr, OUT, XN, PART, DM}; \
        pg8::gemm_phase<pg8::EpiResid<false, LAST>, pg8::StaticOrder, PG8_ALIGN, PG8_SP2>(ldsl + RING_OFF, g, S, E); } while (0)
    const int up_units = (MROWS / 256) * (FF2 / 256), up_full = up_units % G;
    if (IN(4)) _Pragma("unroll") for (int rep = 0; rep < NREP(4); ++rep) { if (rep) xcd_barrier(bar); UP_PHASE(WS_WUP0, 0); if (JIT_CONV && TAILFILL && up_full && bx >= up_full) CONVERT_MAT_RANGE(3, 0, DN_SPLIT, up_full); }
    SEAM(4);
    if (IN(5)) _Pragma("unroll") for (int rep = 0; rep < NREP(5); ++rep) { if (rep) xcd_barrier(bar); CG_PHASE(0); if (JIT_CONV) { if (TAILFILL && up_full) CONVERT_MAT_RANGE(3, DN_SPLIT, DN_ITEMS, 0); else CONVERT_MAT(3); } }
    SEAM(5);
    if (IN(6)) { DOWN_PHASE(WS_WDN0, nullptr, false); for (int rep = 1; rep < NREP(6); ++rep) { xcd_barrier(bar); DOWN_PHASE(WS_WDN0, DUMMY, true); } if (JIT_CONV) CONVERT_MAT(4); }
    SEAM(6);
#ifdef PROBE_LATE_QKV
    { pg8::Gemm g{XN, (const bf16*)(ws + WS_WQKV0), MROWS, NQKV, DM}; pg8::StaticOrder S; S.init(MROWS, NQKV, G, bx);
      pg8::EpiScale E{QKV, NQKV, PART, 1.f / DM, RMS_EPS, DM, QSCALE};
      pg8::gemm_phase<pg8::EpiScale, pg8::StaticOrder, PG8_ALIGN, PG8_SP2>(ldsl + RING_OFF, g, S, E); xcd_barrier(bar); }
#if PROBE_LATE_QKV == 2
    { pg8::Gemm g{XN, (const bf16*)(ws + WS_WQKV0), MROWS, NQKV, DM}; pg8::StaticOrder S; S.init(MROWS, NQKV, G, bx);
      pg8::EpiScale E{QKV, NQKV, PART, 1.f / DM, RMS_EPS, DM, QSCALE};
      pg8::gemm_phase<pg8::EpiScale, pg8::StaticOrder, PG8_ALIGN, PG8_SP2>(ldsl + RING_OFF, g, S, E); xcd_barrier(bar); }
#endif
#endif
    if (IN(7)) _Pragma("unroll") for (int rep = 0; rep < NREP(7); ++rep) { if (rep) xcd_barrier(bar);
        pg8::Gemm g{XN, (const bf16*)(ws + WS_WQKV1), MROWS, NQKV, DM}; pg8::StaticOrder S; S.init(MROWS, NQKV, G, bx);
        pg8::EpiScale E{QKV, NQKV, PART, 1.f / DM, RMS_EPS, 0, 1.f};
        pg8::gemm_phase<pg8::EpiScale, pg8::StaticOrder, PG8_ALIGN, PG8_SP2>(ldsl + RING_OFF, g, S, E);
    }
    SEAM(7);
    if (IN(8)) _Pragma("unroll") for (int rep = 0; rep < NREP(8); ++rep) { if (rep) xcd_barrier(bar); for (int m = gw; m < MROWS; m += NGW) qknorm_row(QKV + (size_t)m * NQKV, QKN + (size_t)m * 8192, args.in[6], args.in[7], m % SEQ, lane); }
    SEAM(8);
    if (IN(9)) _Pragma("unroll") for (int rep = 0; rep < NREP(9); ++rep) { if (rep) xcd_barrier(bar);
        float lam, omli;
        { const float a1 = wave_sum(args.in[8][lane] * args.in[9][lane] + args.in[8][lane + 64] * args.in[9][lane + 64]);
          const float a2 = wave_sum(args.in[10][lane] * args.in[11][lane] + args.in[10][lane + 64] * args.in[11][lane + 64]);
          const float li = 0.8f - 0.6f * 0.7408182206817179f;
          lam = __expf(a1) - __expf(a2) + li; omli = 1.f - li; }
        float mq = fmaxf(fabsf(args.in[6][lane]), fabsf(args.in[6][lane + 64])), mk = fmaxf(fabsf(args.in[7][lane]), fabsf(args.in[7][lane + 64]));
#pragma unroll
        for (int o_ = 1; o_ < 64; o_ <<= 1) { mq = fmaxf(mq, __shfl_xor(mq, o_)); mk = fmaxf(mk, __shfl_xor(mk, o_)); }
        att::Diff2Const C{lam, omli, RMS_EPS, QSCALE * 128.f * mq * mk * 1.02f, args.in[12]};
        constexpr int NITEM = BATCH * DF_H * 16;
        for (int w = bx; w < NITEM; w += G) {
            const int bh = (w & 7) * 4 + ((w >> 3) >> 4), xq = (w >> 3) & 15, b = bh / DF_H, h = bh % DF_H;
            const bf16* qn = QKN + (size_t)(b * SEQ) * 8192 + h * 256; const bf16* vb = QKV + (size_t)(b * SEQ) * NQKV + 2 * DM + h * 256;
#pragma unroll 1
            for (int ps = 0; ps < 2; ++ps) { const int qb = ps ? 31 - xq : xq;
                att::diff2_block<8192, 8192, NQKV, DM>(qn + (size_t)(qb * 128) * 8192, qn + 4096, vb, AO + (size_t)(b * SEQ + qb * 128) * DM + h * 256, qb * 128, C, (char*)lds + RING_OFF); }
        }
        if (JIT_CONV) CONVERT_MAT(5);
    }
    SEAM(9);
    if (IN(10)) {
        pg8::Gemm g{AO, (const bf16*)(ws + WS_WO1), MROWS, DM, DM}; pg8::StaticOrder S; S.init(MROWS, DM, G, bx);
        pg8::EpiResid<false, false> E{nullptr, nullptr, XN, PART, DM};
        pg8::gemm_phase<pg8::EpiResid<false, false>, pg8::StaticOrder, PG8_ALIGN, PG8_SP2>(ldsl + RING_OFF, g, S, E);
        if (JIT_CONV) CONVERT_MAT(6);
    }
    SEAM(10);
    if (IN(11)) { UP_PHASE(WS_WUP1, 1); if (JIT_CONV && TAILFILL && up_full && bx >= up_full) CONVERT_MAT_RANGE(7, 0, DN_SPLIT, up_full); }
    SEAM(11);
    if (IN(12)) { CG_PHASE(1); if (JIT_CONV) { if (TAILFILL && up_full) CONVERT_MAT_RANGE(7, DN_SPLIT, DN_ITEMS, 0); else CONVERT_MAT(7); } }
    SEAM(12);
    if (IN(13)) DOWN_PHASE(WS_WDN1, args.out, true);
#ifdef PROBE_XCC
    { xcd_barrier(bar);
      if (bx == 0 && tid == 0) { unsigned bad = 0; for (int i = 0; i < G; ++i) { const unsigned xi = __hip_atomic_load(ctl + 2048 + i, RLX_AGENT), xr = __hip_atomic_load(ctl + 2048 + (i & 7), RLX_AGENT); if (xi != xr || xi == 0u) ++bad; }
          for (int r = 0; r < 8; ++r) for (int q = r + 1; q < 8; ++q) if (__hip_atomic_load(ctl + 2048 + r, RLX_AGENT) == __hip_atomic_load(ctl + 2048 + q, RLX_AGENT)) bad += 1000;
          if (bad) args.out[0] = 1000.f * (float)bad; } }
#endif
    if (LEAK_A >= 0) { xcd_barrier(bar); STAMP(14); if (bx == 0 && tid == 0) args.out[0] = 1000.f * ((float)(long long)(tB - tA) * 0.01f - (float)(LEAK_OFF)); }
#undef IN
#undef SEAM
}
#if MK_CHECK
#include "check.inc"
#endif
extern "C" void kernel_launch(void* const* d_in, const int* in_sizes, int n_in, void* d_out, int out_size, void* d_ws, size_t ws_size, hipStream_t stream) {
    static int grid = 0;
    if (grid == 0) {
        if (n_in != 18 || in_sizes[0] != MROWS * DM || out_size != MROWS * DM || ws_size < WS_END) {
            fprintf(stderr, "kernel_launch: built for 18 inputs, x/out of %d floats, >= %zu bytes of workspace; got n_in %d, in0 %d, out %d, ws %zu; nothing launched\n", MROWS * DM, (size_t)WS_END, n_in, n_in > 0 ? in_sizes[0] : -1, out_size, ws_size); grid = -1; return; }
        int dev = 0, cus = 0, per_cu = 0;
        if (hipGetDevice(&dev) != hipSuccess || hipDeviceGetAttribute(&cus, hipDeviceAttributeMultiprocessorCount, dev) != hipSuccess) { fprintf(stderr, "kernel_launch: device query failed\n"); grid = -1; return; }
        if (hipFuncSetAttribute((const void*)mk_fwd, hipFuncAttributeMaxDynamicSharedMemorySize, LDS_BYTES) != hipSuccess) { fprintf(stderr, "kernel_launch: hipFuncSetAttribute failed\n"); grid = -1; return; }
        if (hipOccupancyMaxActiveBlocksPerMultiprocessor(&per_cu, (const void*)mk_fwd, NWAVES * 64, LDS_BYTES) != hipSuccess || per_cu < 1)
            fprintf(stderr, "kernel_launch: note: occupancy query reports %d workgroups per CU\n", per_cu);
        (void)hipGetLastError();
        grid = cus;
    }
    if (grid < 0) return;
    if (hipMemsetAsync((char*)d_ws + WS_CTL, 0, CTL_ZERO_BYTES, stream) != hipSuccess) { fprintf(stderr, "kernel_launch: memset failed\n"); return; }
    Args a{};
    for (int i = 0; i < 18; ++i) a.in[i] = (const float*)d_in[i];
    a.out = (float*)d_out; a.ws = (unsigned char*)d_ws;
#if MK_CHECK
    for (int p = 0; p < NPH; ++p) { a.ph_lo = p; a.ph_hi = p + 1;
        hipLaunchKernelGGL(mk_fwd, dim3(grid), dim3(NWAVES * 64), LDS_BYTES, stream, a);
        hipLaunchKernelGGL(mk_check, dim3(256), dim3(256), 0, stream, a, p); }
    hipLaunchKernelGGL(mk_report, dim3(1), dim3(64), 0, stream, a);
#elif MK_SPLIT
    for (int p = 0; p < NPH; ++p) { a.ph_lo = p; a.ph_hi = p + 1; hipLaunchKernelGGL(mk_fwd, dim3(grid), dim3(NWAVES * 64), LDS_BYTES, stream, a); }
#else
    a.ph_lo = 0; a.ph_hi = NPH;
    hipLaunchKernelGGL(mk_fwd, dim3(grid), dim3(NWAVES * 64), LDS_BYTES, stream, a);
#ifdef PROBE_TWICE
    (void)hipMemsetAsync((char*)d_ws + WS_CTL, 0, CTL_ZERO_BYTES, stream);
    hipLaunchKernelGGL(mk_fwd, dim3(grid), dim3(NWAVES * 64), LDS_BYTES, stream, a);
#endif
#endif
    const hipError_t le = hipPeekAtLastError();
    if (le != hipSuccess) fprintf(stderr, "kernel_launch: launch failed: %s\n", hipGetErrorName(le));
}
```

```cpp
#define PRIO_BEFORE_BAR 1
#include <hip/hip_runtime.h>
#include <cstdio>
#include <cstdint>
namespace pg8 {
__device__ __forceinline__ int tid_opaque() { int t = (int)threadIdx.x; asm volatile("" : "+v"(t)); return t; }
#define PG8_LAS __attribute__((address_space(3)))
typedef unsigned short bf16_t;
typedef short bf16x8 __attribute__((ext_vector_type(8)));
typedef float f32x4 __attribute__((ext_vector_type(4)));
typedef unsigned u32x4 __attribute__((ext_vector_type(4)));
constexpr int BM = 256, BK = 64, HALF = 128, HTB = HALF * BK * 2  , STAGE_BYTES = 8 * HTB, NXCD = 8, WGM = 8;

__host__ __device__ __forceinline__ int lds_byte(int r, int c) { const int st = (r >> 4) * 2 + (c >> 5), rr = r & 15, cc = c & 31, ob = rr * 64 + cc * 2; return st * 1024 + (ob ^ (((ob >> 9) & 1) << 5)); }
__host__ __device__ __forceinline__ void stage_rc(int b, int& R, int& C) { const int st = b / 1024, sb = b % 1024, swz = sb ^ (((sb >> 9) & 1) << 5); R = (st >> 1) * 16 + swz / 64; C = (st & 1) * 32 + (swz % 64) / 2; }
__host__ __device__ __forceinline__ int perm32(int rho) { const int n = rho >> 4, i = rho & 15; return 8 * (i >> 2) + 4 * n + (i & 3); }

struct Unit { int pm, pn; };
struct Gemm { const bf16_t* A; const bf16_t* Bt; int M, N, K; };

struct StaticOrder {
    int nM, nN, nwg, G, c, wgm;
    __host__ __device__ void init(int M, int N, int G_, int c_, int wgm_ = WGM) { nM = M / BM; nN = N / BM; nwg = nM * nN; G = G_; c = c_; wgm = wgm_; }
    __host__ __device__ bool next(int i, Unit& u) const {
        const long L = (long)i * G + c; if (L >= nwg) return false;
        int wgid = (int)L; { const int q = nwg / NXCD, r = nwg % NXCD, xcd = wgid % NXCD, off = wgid / NXCD; wgid = (xcd < r ? xcd * (q + 1) : r * (q + 1) + (xcd - r) * q) + off; }
        const int nig = wgm * nN, gid = wgid / nig, fm = gid * wgm, gsz = (nM - fm) < wgm ? (nM - fm) : wgm;
        u.pm = fm + ((wgid % nig) % gsz); u.pn = (wgid % nig) / gsz; return true;
    }
    __device__ __forceinline__ void a_ready(const Unit&) const {}
    __device__ __forceinline__ void done(const Unit&) const {}
};
struct RangeOrder : StaticOrder {
    int i0, i1;
    __host__ __device__ bool next(int i, Unit& u) const { return (i0 + i < i1) && StaticOrder::next(i0 + i, u); }
};


__device__ __forceinline__ unsigned cvt_pk_bf16(float lo, float hi) { unsigned r; asm volatile("v_cvt_pk_bf16_f32 %0, %1, %2" : "=v"(r) : "v"(lo), "v"(hi)); return r; }

constexpr int NPART = 64;

struct EpiScale {
    static constexpr bool PERM = true, AFTER_DRAIN = false;
    bf16_t* O; int ldc; const float* part; float inv_k; float eps; int qcols; float qs;
    __device__ __forceinline__ void operator()(const f32x4 (&acc)[2][2][4][2], const Unit& u, int wr, int wc, int fr, int fq) const {
        const int row0 = u.pm * BM + wr * 64 + fr; const int col0 = u.pn * BM + wc * 32 + 8 * fq;
        const float sc = (u.pn * BM < qcols) ? qs : 1.f;
#pragma unroll
        for (int ai = 0; ai < 2; ++ai)
#pragma unroll
            for (int m = 0; m < 4; ++m) {
                const int row = row0 + ai * HALF + m * 16;
                const f32x4* pp = (const f32x4*)(part + (size_t)row * NPART + fq * 16);
                const f32x4 a = pp[0], b = pp[1], c = pp[2], d = pp[3];
                float s = ((a[0] + a[1]) + (a[2] + a[3])) + ((b[0] + b[1]) + (b[2] + b[3])) + (((c[0] + c[1]) + (c[2] + c[3])) + ((d[0] + d[1]) + (d[2] + d[3])));
                s += __shfl_xor(s, 16); s += __shfl_xor(s, 32);
                const float r = rsqrtf(s * inv_k + eps) * sc;
                bf16_t* rowp = O + (size_t)row * ldc + col0;
#pragma unroll
                for (int bj = 0; bj < 2; ++bj) { const f32x4 v0 = acc[ai][bj][m][0] * r, v1 = acc[ai][bj][m][1] * r;
                    u32x4 w; w.x = cvt_pk_bf16(v0[0], v0[1]); w.y = cvt_pk_bf16(v0[2], v0[3]); w.z = cvt_pk_bf16(v1[0], v1[1]); w.w = cvt_pk_bf16(v1[2], v1[3]);
                    *(u32x4*)(rowp + bj * HALF) = w; }
            }
    }
};

template <bool BASE_F32, bool OUT_F32> struct EpiResid {
    static constexpr bool PERM = false, AFTER_DRAIN = false;
    const float* basef; float* outf; bf16_t* xn; float* part; int ldc;
    __device__ __forceinline__ void operator()(const f32x4 (&acc)[2][2][4][2], const Unit& u, int wr, int wc, int fr, int fq) const {
        typedef unsigned u32x2v __attribute__((ext_vector_type(2)));
        const int row0 = u.pm * BM + wr * 64 + fr; const int col0 = u.pn * BM + wc * 32 + 4 * fq;
#pragma unroll
        for (int ai = 0; ai < 2; ++ai)
#pragma unroll
            for (int m = 0; m < 4; ++m) {
                const int row = row0 + ai * HALF + m * 16; const size_t off = (size_t)row * ldc + col0; float ss = 0.f;
#pragma unroll
                for (int bj = 0; bj < 2; ++bj)
#pragma unroll
                    for (int n = 0; n < 2; ++n) { const size_t o2 = off + bj * HALF + n * 16;
                        f32x4 bs;
                        if (BASE_F32) bs = *(const f32x4*)(basef + o2);
                        else { const u32x2v b = *(const u32x2v*)(xn + o2); bs[0] = __builtin_bit_cast(float, b.x << 16); bs[1] = __builtin_bit_cast(float, b.x & 0xffff0000u); bs[2] = __builtin_bit_cast(float, b.y << 16); bs[3] = __builtin_bit_cast(float, b.y & 0xffff0000u); }
                        const f32x4 o = bs + acc[ai][bj][m][n];
                        if (OUT_F32) *(f32x4*)(outf + o2) = o;
                        else { u32x2v w; w.x = cvt_pk_bf16(o[0], o[1]); w.y = cvt_pk_bf16(o[2], o[3]); *(u32x2v*)(xn + o2) = w;
                            ss += (o[0] * o[0] + o[1] * o[1]) + (o[2] * o[2] + o[3] * o[3]); } }
                if (!OUT_F32) { ss += __shfl_xor(ss, 16); ss += __shfl_xor(ss, 32); if (fq == 0) part[(size_t)row * NPART + u.pn * 4 + wc] = ss; }
            }
    }
};

struct EpiResidRT {
    static constexpr bool PERM = false, AFTER_DRAIN = false;
    float* outf; bf16_t* xn; float* part; int ldc;
    __device__ __forceinline__ void operator()(const f32x4 (&acc)[2][2][4][2], const Unit& u, int wr, int wc, int fr, int fq) const {
        typedef unsigned u32x2v __attribute__((ext_vector_type(2)));
        const int row0 = u.pm * BM + wr * 64 + fr; const int col0 = u.pn * BM + wc * 32 + 4 * fq; const bool last = outf != nullptr;
#pragma unroll
        for (int ai = 0; ai < 2; ++ai)
#pragma unroll
            for (int m = 0; m < 4; ++m) {
                const int row = row0 + ai * HALF + m * 16; const size_t off = (size_t)row * ldc + col0; float ss = 0.f;
#pragma unroll
                for (int bj = 0; bj < 2; ++bj)
#pragma unroll
                    for (int n = 0; n < 2; ++n) { const size_t o2 = off + bj * HALF + n * 16;
                        const u32x2v b = *(const u32x2v*)(xn + o2); f32x4 bs; bs[0] = __builtin_bit_cast(float, b.x << 16); bs[1] = __builtin_bit_cast(float, b.x & 0xffff0000u); bs[2] = __builtin_bit_cast(float, b.y << 16); bs[3] = __builtin_bit_cast(float, b.y & 0xffff0000u);
                        const f32x4 o = bs + acc[ai][bj][m][n];
                        if (last) *(f32x4*)(outf + o2) = o;
                        else { u32x2v w; w.x = cvt_pk_bf16(o[0], o[1]); w.y = cvt_pk_bf16(o[2], o[3]); *(u32x2v*)(xn + o2) = w; }
                        ss += (o[0] * o[0] + o[1] * o[1]) + (o[2] * o[2] + o[3] * o[3]); }
                if (!last) { ss += __shfl_xor(ss, 16); ss += __shfl_xor(ss, 32); if (fq == 0) part[(size_t)row * NPART + u.pn * 4 + wc] = ss; }
            }
    }
};

__device__ __forceinline__ float dpp_ror1(float v) { return __builtin_bit_cast(float, __builtin_amdgcn_update_dpp(0, __builtin_bit_cast(int, v), 0x121, 0xf, 0xf, false)); }
__device__ __forceinline__ float dpp_ror2(float v) { return __builtin_bit_cast(float, __builtin_amdgcn_update_dpp(0, __builtin_bit_cast(int, v), 0x122, 0xf, 0xf, false)); }
__device__ __forceinline__ float dpp_shr1(float old, float v) { return __builtin_bit_cast(float, __builtin_amdgcn_update_dpp(__builtin_bit_cast(int, old), __builtin_bit_cast(int, v), 0x111, 0xf, 0xf, false)); }
__device__ __forceinline__ float dpp_shr2(float old, float v) { return __builtin_bit_cast(float, __builtin_amdgcn_update_dpp(__builtin_bit_cast(int, old), __builtin_bit_cast(int, v), 0x112, 0xf, 0xf, false)); }
__device__ __forceinline__ void conv_taps(float& acc, float cur, float prev, float w1, float w0) {
    asm("s_nop 1\n\t"
        "v_fmac_f32_dpp %0, %1, %3 row_shr:1 row_mask:0xf bank_mask:0xf\n\t"
        "v_fmac_f32_dpp %0, %1, %4 row_shr:2 row_mask:0xf bank_mask:0xf\n\t"
        "v_fmac_f32_dpp %0, %2, %3 row_shl:15 row_mask:0xf bank_mask:0xf\n\t"
        "v_fmac_f32_dpp %0, %2, %4 row_shl:14 row_mask:0xf bank_mask:0xf"
        : "+v"(acc) : "v"(cur), "v"(prev), "v"(w1), "v"(w0));
}
template <int CTRL> __device__ __forceinline__ float dppz(float v) { return __builtin_bit_cast(float, __builtin_amdgcn_update_dpp(0, __builtin_bit_cast(int, v), CTRL, 0xf, 0xf, true)); }
struct EpiConvGate {
    static constexpr bool PERM = true, AFTER_DRAIN = false;
    bf16_t* ACT; int ff; const float* part; float inv_k; float eps; const float* cw; const float* cb; float* halo;
    __device__ __forceinline__ void operator()(const f32x4 (&acc)[2][2][4][2], const Unit& u, int wr, int wc, int fr, int fq) const {
        typedef unsigned u32x2v __attribute__((ext_vector_type(2)));
        const int ff2 = 2 * ff;
        const int row0 = u.pm * BM + wr * 64 + fr; const int ch0 = u.pn * HALF + wc * 32 + 8 * fq;
        float rs[2][4];
#pragma unroll
        for (int ai = 0; ai < 2; ++ai)
#pragma unroll
            for (int m = 0; m < 4; ++m) { const int row = row0 + ai * HALF + m * 16;
                const f32x4* pp = (const f32x4*)(part + (size_t)row * NPART + fq * 16);
                const f32x4 a = pp[0], b = pp[1], c = pp[2], d = pp[3];
                float s = ((a[0] + a[1]) + (a[2] + a[3])) + ((b[0] + b[1]) + (b[2] + b[3])) + (((c[0] + c[1]) + (c[2] + c[3])) + ((d[0] + d[1]) + (d[2] + d[3])));
                s += __shfl_xor(s, 16); s += __shfl_xor(s, 32);
                rs[ai][m] = rsqrtf(s * inv_k + eps); }
        u32x2v lo[2][4];
#pragma unroll
        for (int n = 0; n < 2; ++n) {
            const int ch = ch0 + 4 * n;
            const f32x4 wg0 = *(const f32x4*)(cw + ch), wg1 = *(const f32x4*)(cw + ff2 + ch), wg2 = *(const f32x4*)(cw + 2 * ff2 + ch), bg = *(const f32x4*)(cb + ch);
            const f32x4 wv0 = *(const f32x4*)(cw + ff + ch), wv1 = *(const f32x4*)(cw + ff2 + ff + ch), wv2 = *(const f32x4*)(cw + 2 * ff2 + ff + ch), bv = *(const f32x4*)(cb + ff + ch);
#pragma unroll
            for (int ai = 0; ai < 2; ++ai) {
                f32x4 gq = {0.f, 0.f, 0.f, 0.f}, vq = gq;
                const int grp = (u.pm * BM + ai * HALF + wr * 64) >> 6;
#pragma unroll
                for (int m = 0; m < 4; ++m) {
                    const f32x4 g = acc[ai][0][m][n] * rs[ai][m], v = acc[ai][1][m][n] * rs[ai][m];
                    f32x4 cg, cv;
#pragma unroll
                    for (int e = 0; e < 4; ++e) {
                        float a = __builtin_fmaf(wg2[e], g[e], bg[e]), b = __builtin_fmaf(wv2[e], v[e], bv[e]);
                        conv_taps(a, g[e], gq[e], wg1[e], wg0[e]); conv_taps(b, v[e], vq[e], wv1[e], wv0[e]);
                        cg[e] = a; cv[e] = b; }
                    gq = g; vq = v;
                    f32x4 o;
#pragma unroll
                    for (int e = 0; e < 4; ++e) o[e] = cg[e] * __builtin_amdgcn_rcpf(1.f + __builtin_amdgcn_exp2f(-1.4426950408889634f * cg[e])) * cv[e];
                    u32x2v w; w.x = cvt_pk_bf16(o[0], o[1]); w.y = cvt_pk_bf16(o[2], o[3]);
                    const int row = row0 + ai * HALF + m * 16;
                    if (n == 0) lo[ai][m] = w;
                    else if (!(m == 0 && fr < 2)) { u32x4 w4; w4.x = lo[ai][m].x; w4.y = lo[ai][m].y; w4.z = w.x; w4.w = w.y; *(u32x4*)(ACT + (size_t)row * ff + ch0) = w4; }
                    if ((m == 0 && fr < 2) || (m == 3 && fr >= 14)) { float* hp = halo + ((size_t)grp * 4 + (m == 0 ? fr : fr - 12)) * ff2 + ch; *(f32x4*)hp = g; *(f32x4*)(hp + ff) = v; }
                }
            }
        }
    }
};
template <class Epi, class Sched, bool ALIGN_EPI = false, bool SP2 = false>
__device__ __forceinline__ void gemm_phase(PG8_LAS unsigned char* lds, const Gemm g, const Sched& S, const Epi& E) {
    const int tid = tid_opaque(), wid = __builtin_amdgcn_readfirstlane(tid >> 6), lane = tid & 63, wr = wid >> 2, wc = wid & 3, fr = lane & 15, fq = lane >> 4;
    const int K = g.K, nt = K / BK;
    unsigned voffA[2], voffB[2];
#pragma unroll
    for (int i = 0; i < 2; ++i) { int R, C; stage_rc(tid * 16 + i * 8192, R, C); const int Rb = Epi::PERM ? ((R & ~31) + perm32(R & 31)) : R;
        voffA[i] = (unsigned)(R * K + C) * 2u; voffB[i] = (unsigned)(Rb * K + C) * 2u; }
    const size_t kstep = (size_t)(BK * 2);
    const size_t hstep = (size_t)HALF * K * 2;
    const size_t tstep = 2 * hstep;
    const unsigned ldsw = (unsigned)wid * 1024u;
    const int aoff = lds_byte(wr * 64 + fr, fq * 8), boff = lds_byte(wc * 32 + fr, fq * 8);
#define PG8_SA(b, h) (((b) * 2 + (h)) * HTB)
#define PG8_SB(b, h) ((4 + (b) * 2 + (h)) * HTB)
#define PG8_STAGE(bufoff, gbase, voff) do { _Pragma("unroll") for (int _i = 0; _i < 2; ++_i) \
        __builtin_amdgcn_global_load_lds((const unsigned*)((const char*)(gbase) + (voff)[_i]), (PG8_LAS unsigned*)(lds + (bufoff) + ldsw + _i * 8192), 16, 0, 0); } while (0)
#define PG8_LDA(dst, b, h) do { _Pragma("unroll") for (int m = 0; m < 4; ++m) _Pragma("unroll") for (int k = 0; k < 2; ++k) dst[m][k] = *(const PG8_LAS bf16x8*)(lds + PG8_SA(b, h) + aoff + m * 2048 + k * 1024); } while (0)
#define PG8_LDB(dst, b, h) do { _Pragma("unroll") for (int n = 0; n < 2; ++n) _Pragma("unroll") for (int k = 0; k < 2; ++k) dst[n][k] = *(const PG8_LAS bf16x8*)(lds + PG8_SB(b, h) + boff + n * 2048 + k * 1024); } while (0)
#define PG8_MMA(ai, bj, At, Bt) do { if (!SP2) __builtin_amdgcn_s_setprio(1); _Pragma("unroll") for (int m = 0; m < 4; ++m) _Pragma("unroll") for (int n = 0; n < 2; ++n) _Pragma("unroll") for (int k = 0; k < 2; ++k) \
        acc[ai][bj][m][n] = __builtin_amdgcn_mfma_f32_16x16x32_bf16(Bt[n][k], At[m][k], acc[ai][bj][m][n], 0, 0, 0); if (!SP2) __builtin_amdgcn_s_setprio(0); } while (0)
#ifdef PRIO_BEFORE_BAR
#define PG8_PRIO_UP_PRE __builtin_amdgcn_s_setprio(1)
#define PG8_PRIO_UP_POST do { } while (0)
#else
#define PG8_PRIO_UP_PRE do { } while (0)
#define PG8_PRIO_UP_POST __builtin_amdgcn_s_setprio(1)
#endif
#define PG8_WAIT_V(n) asm volatile("s_waitcnt vmcnt(" #n ")" ::: "memory")
#define PG8_WAIT_L(n) asm volatile("s_waitcnt lgkmcnt(" #n ")" ::: "memory")
#define PG8_BAR __builtin_amdgcn_s_barrier()
#define PG8_SCHED __builtin_amdgcn_sched_barrier(0)
    Unit cur, nxt; int ui = 0;
    if (!S.next(0, cur)) return;
    f32x4 acc[2][2][4][2];
#pragma unroll
    for (int a = 0; a < 2; ++a)
#pragma unroll
        for (int b = 0; b < 2; ++b)
#pragma unroll
            for (int m = 0; m < 4; ++m)
#pragma unroll
                for (int n = 0; n < 2; ++n) acc[a][b][m][n] = (f32x4){0.f, 0.f, 0.f, 0.f};
    bf16x8 At[4][2], B0[2][2], B1[2][2];
    const char* cA = (const char*)g.A + (size_t)cur.pm * tstep; const char* cB = (const char*)g.Bt + (size_t)cur.pn * tstep;
    S.a_ready(cur);
    if constexpr (SP2) {
        PG8_STAGE(PG8_SB(0, 0), cB, voffB); PG8_STAGE(PG8_SB(0, 1), cB + hstep, voffB); PG8_STAGE(PG8_SA(0, 0), cA, voffA); PG8_STAGE(PG8_SA(0, 1), cA + hstep, voffA);
        if (wr == 1) PG8_BAR;
        PG8_WAIT_V(2); PG8_BAR;
        PG8_STAGE(PG8_SB(1, 0), cB + kstep, voffB); PG8_STAGE(PG8_SA(1, 0), cA + kstep, voffA); PG8_STAGE(PG8_SB(1, 1), cB + hstep + kstep, voffB);
        PG8_WAIT_V(6); PG8_BAR;
    } else {
        PG8_STAGE(PG8_SB(0, 0), cB, voffB); PG8_STAGE(PG8_SA(0, 0), cA, voffA); PG8_STAGE(PG8_SB(0, 1), cB + hstep, voffB); PG8_STAGE(PG8_SA(0, 1), cA + hstep, voffA);
        if (wr == 1) PG8_BAR;
        PG8_WAIT_V(4); PG8_BAR;
        PG8_STAGE(PG8_SB(1, 0), cB + kstep, voffB); PG8_STAGE(PG8_SA(1, 0), cA + kstep, voffA); PG8_STAGE(PG8_SB(1, 1), cB + hstep + kstep, voffB);
        PG8_WAIT_V(6); PG8_BAR;
    }
    for (;;) {
        const bool has_next = S.next(ui + 1, nxt);
        const char* nA = has_next ? (const char*)g.A + (size_t)nxt.pm * tstep : cA; const char* nB = has_next ? (const char*)g.Bt + (size_t)nxt.pn * tstep : cB;
        for (int t = 0; t < nt; t += 2) {
            const bool last = (t == nt - 2);
            const char* a1 = cA + (size_t)(t + 1) * kstep;
            const char* a2 = last ? nA : cA + (size_t)(t + 2) * kstep; const char* b2 = last ? nB : cB + (size_t)(t + 2) * kstep;
            const char* a3 = a2 + kstep; const char* b3 = b2 + kstep;
            if (last && has_next) S.a_ready(nxt);
            if constexpr (SP2) {
            PG8_LDB(B0, 0, 0); PG8_LDB(B1, 0, 1); PG8_SCHED; PG8_LDA(At, 0, 0); PG8_STAGE(PG8_SA(1, 1), a1 + hstep, voffA);
            PG8_WAIT_V(8); PG8_WAIT_L(0); PG8_PRIO_UP_PRE; PG8_BAR; PG8_PRIO_UP_POST; PG8_MMA(0, 0, At, B0); PG8_MMA(0, 1, At, B1); __builtin_amdgcn_s_setprio(0); PG8_BAR; PG8_SCHED;
            PG8_LDA(At, 0, 1); PG8_STAGE(PG8_SB(0, 0), b2, voffB); PG8_STAGE(PG8_SB(0, 1), b2 + hstep, voffB); PG8_STAGE(PG8_SA(0, 0), a2, voffA);
            PG8_WAIT_V(8); PG8_WAIT_L(0); PG8_PRIO_UP_PRE; PG8_BAR; PG8_PRIO_UP_POST; PG8_MMA(1, 0, At, B0); PG8_MMA(1, 1, At, B1); __builtin_amdgcn_s_setprio(0); PG8_BAR; PG8_SCHED;
            PG8_LDB(B0, 1, 0); PG8_LDB(B1, 1, 1); PG8_SCHED; PG8_LDA(At, 1, 0); PG8_STAGE(PG8_SA(0, 1), a2 + hstep, voffA);
            PG8_WAIT_V(8); PG8_WAIT_L(0); PG8_PRIO_UP_PRE; PG8_BAR; PG8_PRIO_UP_POST; PG8_MMA(0, 0, At, B0); PG8_MMA(0, 1, At, B1); __builtin_amdgcn_s_setprio(0); PG8_BAR; PG8_SCHED;
            PG8_LDA(At, 1, 1); PG8_STAGE(PG8_SB(1, 0), b3, voffB); PG8_STAGE(PG8_SB(1, 1), b3 + hstep, voffB); PG8_STAGE(PG8_SA(1, 0), a3, voffA);
            PG8_WAIT_V(8); PG8_WAIT_L(0); PG8_PRIO_UP_PRE; PG8_BAR; PG8_PRIO_UP_POST; PG8_MMA(1, 0, At, B0); PG8_MMA(1, 1, At, B1); __builtin_amdgcn_s_setprio(0); PG8_BAR; PG8_SCHED;
            } else {
            PG8_LDB(B0, 0, 0); PG8_SCHED; PG8_LDA(At, 0, 0); PG8_STAGE(PG8_SA(1, 1), a1 + hstep, voffA);
            PG8_WAIT_L(8); PG8_BAR; PG8_WAIT_L(0); PG8_MMA(0, 0, At, B0); PG8_BAR; PG8_SCHED;
            PG8_LDB(B1, 0, 1); PG8_STAGE(PG8_SB(0, 0), b2, voffB);
            PG8_BAR; PG8_WAIT_L(0); PG8_MMA(0, 1, At, B1); PG8_BAR;
            PG8_LDA(At, 0, 1); PG8_STAGE(PG8_SA(0, 0), a2, voffA);
            PG8_BAR; PG8_WAIT_L(0); PG8_MMA(1, 0, At, B0); PG8_BAR; PG8_SCHED;
            PG8_STAGE(PG8_SB(0, 1), b2 + hstep, voffB);
            PG8_WAIT_V(6); PG8_BAR; PG8_MMA(1, 1, At, B1); PG8_BAR;
            PG8_LDB(B0, 1, 0); PG8_SCHED; PG8_LDA(At, 1, 0); PG8_STAGE(PG8_SA(0, 1), a2 + hstep, voffA);
            PG8_WAIT_L(8); PG8_BAR; PG8_WAIT_L(0); PG8_MMA(0, 0, At, B0); PG8_BAR; PG8_SCHED;
            PG8_LDB(B1, 1, 1); PG8_STAGE(PG8_SB(1, 0), b3, voffB);
            PG8_BAR; PG8_WAIT_L(0); PG8_MMA(0, 1, At, B1); PG8_BAR;
            PG8_LDA(At, 1, 1); PG8_STAGE(PG8_SA(1, 0), a3, voffA);
            PG8_BAR; PG8_WAIT_L(0); PG8_MMA(1, 0, At, B0); PG8_BAR; PG8_SCHED;
            PG8_STAGE(PG8_SB(1, 1), b3 + hstep, voffB);
            PG8_WAIT_V(6); PG8_BAR; PG8_MMA(1, 1, At, B1); PG8_BAR;
            }
        }
        if constexpr (ALIGN_EPI) { if (wr == 0) PG8_BAR; }
        if constexpr (!Epi::AFTER_DRAIN) { E(acc, cur, wr, wc, fr, fq); S.done(cur); }
        if (!has_next) break;
#pragma unroll
        for (int a = 0; a < 2; ++a)
#pragma unroll
            for (int b = 0; b < 2; ++b)
#pragma unroll
                for (int m = 0; m < 4; ++m)
#pragma unroll
                    for (int n = 0; n < 2; ++n) acc[a][b][m][n] = (f32x4){0.f, 0.f, 0.f, 0.f};
        cur = nxt; cA = nA; cB = nB; ++ui;
        if constexpr (ALIGN_EPI) { if (wr == 1) PG8_BAR; }
    }
    PG8_WAIT_V(0);
    if constexpr (!ALIGN_EPI) { if (wr == 0) PG8_BAR; }
    PG8_BAR;
    if constexpr (Epi::AFTER_DRAIN) { E.fused(acc, cur, wr, wc, fr, fq, lds, wid, lane); S.done(cur); }
#undef PG8_SA
#undef PG8_SB
#undef PG8_STAGE
#undef PG8_LDA
#undef PG8_LDB
#undef PG8_MMA
#undef PG8_WAIT_V
#undef PG8_WAIT_L
#undef PG8_BAR
#undef PG8_SCHED
}
}
namespace att {
using bf16 = unsigned short;
typedef short bf16x8 __attribute__((ext_vector_type(8)));
typedef short s16x4 __attribute__((ext_vector_type(4)));
typedef float f32x16 __attribute__((ext_vector_type(16)));
typedef float f32x4 __attribute__((ext_vector_type(4)));
typedef unsigned u32x4 __attribute__((ext_vector_type(4)));
constexpr int D = 128, NW = 8, QBLK = 32, KVBLK = 64, QB = NW * QBLK;
constexpr int SHM_V = KVBLK * D * 2, SHM_K = KVBLK * D * 2;
constexpr int LDS_BYTES = 2 * SHM_V + 2 * SHM_K + NW * 64 * 4;
#define KSWZ(row, colB) ((row) * 256 + ((colB) ^ (((row) & 7) << 4)))
#define SBAR() __builtin_amdgcn_sched_barrier(0)
__device__ __forceinline__ int v_st(int k, int c) { const int kk = (k & ~0xC) | ((k & 4) << 1) | ((k & 8) >> 1); return ((kk >> 3) * 4 + (c >> 5)) * 512 + ((kk & 7) * 32 + (c & 31)) * 2; }
__device__ __forceinline__ int v_rd_base(int lane) { return ((lane & 3) << 3) | (((lane >> 2) & 3) << 6) | (((lane >> 4) & 1) << 5) | (((lane >> 5) & 1) << 8); }
constexpr int v_rd_off(int d0, int ks, int half) { return d0 * 512 + ks * 4096 + half * 2048; }
__device__ __forceinline__ int crow(int r, int hi) { return (r & 3) + 8 * (r >> 2) + 4 * hi; }
__device__ __forceinline__ unsigned cvtpk(float lo, float hi) { unsigned r; asm volatile("v_cvt_pk_bf16_f32 %0, %1, %2" : "=v"(r) : "v"(lo), "v"(hi)); return r; }
__device__ __forceinline__ bf16x8 load8(const bf16* p) { return *reinterpret_cast<const bf16x8*>(p); }

#define PK4(P, B_, OUT) do { unsigned a0 = cvtpk(P[B_+0], P[B_+1]), a1 = cvtpk(P[B_+2], P[B_+3]);                          \
        unsigned b0 = cvtpk(P[B_+4], P[B_+5]), b1 = cvtpk(P[B_+6], P[B_+7]);                                             \
        auto r0 = __builtin_amdgcn_permlane32_swap(a0, b0, false, false); auto r1 = __builtin_amdgcn_permlane32_swap(a1, b1, false, false); \
        u32x4 w = {r0[0], r1[0], r0[1], r1[1]}; OUT = *reinterpret_cast<bf16x8*>(&w); } while (0)

__device__ __forceinline__ void qkt_rt(f32x16& p0, f32x16& p1, const char* Kt, int r32, int hi, const bf16x8* qr) {
    p0 = f32x16{}; p1 = f32x16{};
    const char* kb[4];
#pragma unroll
    for (int dd = 0; dd < 4; ++dd) kb[dd] = Kt + KSWZ(r32, (dd * 16 + hi * 8) * 2);
#pragma unroll
    for (int d0 = 0; d0 < 8; ++d0) { const char* a = kb[d0 & 3] + (d0 >> 2) * 128;
        bf16x8 b0 = *reinterpret_cast<const bf16x8*>(a);
        bf16x8 b1 = *reinterpret_cast<const bf16x8*>(a + 32 * 256);
        p0 = __builtin_amdgcn_mfma_f32_32x32x16_bf16(b0, qr[d0], p0, 0, 0, 0);
        p1 = __builtin_amdgcn_mfma_f32_32x32x16_bf16(b1, qr[d0], p1, 0, 0, 0); }
}
__device__ __forceinline__ void pv_rt(f32x16* o, int vb, bf16x8 pa0, bf16x8 pa1, bf16x8 pa2, bf16x8 pa3) {
#define TRRD(dst, off) asm volatile("ds_read_b64_tr_b16 %0, %1 offset:%2" : "=&v"(dst) : "v"(vb), "i"(off) : "memory")
#define PV_D0(d0) do { s16x4 l0, l1, l2, l3, h0, h1, h2, h3; constexpr int b_ = v_rd_off(d0, 0, 0); \
        TRRD(l0, b_); TRRD(h0, b_ + 2048); TRRD(l1, b_ + 4096); TRRD(h1, b_ + 6144); TRRD(l2, b_ + 8192); TRRD(h2, b_ + 10240); TRRD(l3, b_ + 12288); TRRD(h3, b_ + 14336); \
        asm volatile("s_waitcnt lgkmcnt(0)" ::: "memory"); SBAR();   \
        o[d0] = __builtin_amdgcn_mfma_f32_32x32x16_bf16(pa0, (bf16x8){l0[0], l0[1], l0[2], l0[3], h0[0], h0[1], h0[2], h0[3]}, o[d0], 0, 0, 0);   \
        o[d0] = __builtin_amdgcn_mfma_f32_32x32x16_bf16(pa1, (bf16x8){l1[0], l1[1], l1[2], l1[3], h1[0], h1[1], h1[2], h1[3]}, o[d0], 0, 0, 0);   \
        o[d0] = __builtin_amdgcn_mfma_f32_32x32x16_bf16(pa2, (bf16x8){l2[0], l2[1], l2[2], l2[3], h2[0], h2[1], h2[2], h2[3]}, o[d0], 0, 0, 0);   \
        o[d0] = __builtin_amdgcn_mfma_f32_32x32x16_bf16(pa3, (bf16x8){l3[0], l3[1], l3[2], l3[3], h3[0], h3[1], h3[2], h3[3]}, o[d0], 0, 0, 0); } while (0)
    PV_D0(0); PV_D0(1); PV_D0(2); PV_D0(3);
#undef PV_D0
#undef TRRD
}

constexpr float SB_DONE = 1e-30f;
__device__ __forceinline__ void sb_half(f32x16& p, float& carry, int dq, bool needmask, bool lane_hi) {
    float kp[16];
#pragma unroll
    for (int r = 0; r < 16; ++r) {
        const float zz = fminf(p[r], 100.f);
        const float e = __builtin_amdgcn_exp2f(zz);
        float k = __builtin_amdgcn_rcpf(1.f + e);
        float be = e * k;
        if (needmask) { const int c = 8 * (r >> 2) + (r & 3); const bool valid = (dq - c) > 0; k = valid ? k : 1.f; be = valid ? be : 0.f; }
        kp[r] = k; p[r] = be;
    }
    float L[4], H[4];
#pragma unroll
    for (int j = 0; j < 4; ++j) { const float g = (kp[4 * j] * kp[4 * j + 1]) * (kp[4 * j + 2] * kp[4 * j + 3]);
        auto rr = __builtin_amdgcn_permlane32_swap(__float_as_uint(g), __float_as_uint(g), false, false);
        L[j] = __uint_as_float(rr[0]); H[j] = __uint_as_float(rr[1]); }
    float U[4]; U[3] = 1.f; U[2] = L[3] * H[3]; U[1] = U[2] * (L[2] * H[2]); U[0] = U[1] * (L[1] * H[1]);
    const float tot = U[0] * (L[0] * H[0]);
#pragma unroll
    for (int j = 0; j < 4; ++j) {
        const float a3 = carry * U[j] * (lane_hi ? 1.f : H[j]);
        const float a2 = a3 * kp[4 * j + 3], a1 = a2 * kp[4 * j + 2], a0 = a1 * kp[4 * j + 1];
        p[4 * j + 3] *= a3; p[4 * j + 2] *= a2; p[4 * j + 1] *= a1; p[4 * j] *= a0;
    }
    carry *= tot;
}

template <int PQ, int PK, int PV, int PO>
__device__ __forceinline__ void sb_block(const bf16* Q, const bf16* K, const bf16* V, bf16* O, int P0, char* lds, volatile __attribute__((address_space(3))) unsigned* flags) {
    const int tid = pg8::tid_opaque(), wid = __builtin_amdgcn_readfirstlane(tid >> 6), lane = tid & 63, r32 = lane & 31, hi = lane >> 5;
    char* K_lds = lds; char* V_lds = lds + 2 * SHM_K;
    const int sr = tid >> 4, sc = (tid & 15) * 8, vst0 = v_st(sr, sc), vst1 = v_st(32 + sr, sc), kws = KSWZ(sr, sc * 2);
    const int vb0 = (int)(uintptr_t)V_lds + v_rd_base(lane);
    bf16x8 qr[8];
#pragma unroll
    for (int d0 = 0; d0 < 8; ++d0) qr[d0] = load8(Q + (size_t)(wid * QBLK + r32) * PQ + d0 * 16 + hi * 8);
    f32x16 o[4] = {};
    float carry = 1.f;
    const int qlo = P0 + wid * QBLK, qpos = qlo + r32;
    int j = P0 / KVBLK + 3;
    bf16x8 st_k0, st_k1, st_v0, st_v1;
#define SB_LOAD(jt) do { const size_t k0_ = (size_t)(jt) * KVBLK; st_k0 = load8(K + (k0_ + sr) * PK + sc); st_k1 = load8(K + (k0_ + 32 + sr) * PK + sc); \
                         st_v0 = load8(V + (k0_ + sr) * PV + sc); st_v1 = load8(V + (k0_ + 32 + sr) * PV + sc); } while (0)
#define SB_WRITE(bf) do { *(bf16x8*)(K_lds + (bf) * SHM_K + kws) = st_k0; *(bf16x8*)(K_lds + (bf) * SHM_K + kws + 32 * 256) = st_k1; \
                          *(bf16x8*)(V_lds + (bf) * SHM_V + vst0) = st_v0; *(bf16x8*)(V_lds + (bf) * SHM_V + vst1) = st_v1; } while (0)
    SB_LOAD(j); asm volatile("s_waitcnt vmcnt(0)" ::: "memory"); SB_WRITE(0);
    __syncthreads();
    int buf = 0, it = 0; bool wdone = false;
    for (;;) {
        const int kb = j * KVBLK; const bool more = j > 0;
        if (more) SB_LOAD(j - 1);
        const bool act = !wdone && (kb < qlo + QBLK - 1);
        if (act) {
            f32x16 p0, p1;
            qkt_rt(p0, p1, K_lds + buf * SHM_K, r32, hi, qr);
            const bool needmask = kb + KVBLK - 1 >= qlo;
            sb_half(p1, carry, qpos - (kb + 32) - 4 * hi, needmask, hi != 0);
            sb_half(p0, carry, qpos - kb - 4 * hi, needmask, hi != 0);
            bf16x8 pa0, pa1, pa2, pa3;
            PK4(p0, 0, pa0); PK4(p0, 8, pa1); PK4(p1, 0, pa2); PK4(p1, 8, pa3);
            SBAR();
            pv_rt(o, vb0 + buf * SHM_V, pa0, pa1, pa2, pa3);
            wdone = __all(carry < SB_DONE);
        }
        if (more) { asm volatile("s_waitcnt vmcnt(0)" ::: "memory"); SB_WRITE(buf ^ 1); }
        if (lane == 0) flags[(it & 1) * 8 + wid] = wdone ? 1u : 0u;
        __syncthreads();
        unsigned alld = 1u;
#pragma unroll
        for (int w = 0; w < NW; ++w) alld &= flags[(it & 1) * 8 + w];
        if (!more || alld) break;
        --j; buf ^= 1; ++it;
    }
#undef SB_LOAD
#undef SB_WRITE
    bf16* Ow = O + (size_t)(wid * QBLK) * PO;
#pragma unroll
    for (int r = 0; r < 16; ++r) { const int orow = crow(r, hi);
#pragma unroll
        for (int d0 = 0; d0 < 4; ++d0) { const float v = o[d0][r]; const float vn = __shfl_xor(v, 1);
            if ((r32 & 1) == 0) *(unsigned*)(Ow + (size_t)orow * PO + d0 * 32 + r32) = cvtpk(v, vn); } }
    __syncthreads();
}

constexpr float THR2 = 8.f * 1.4426950408889634f;
struct DiffRef { const bf16* Q; const bf16* K; const bf16* V; bf16* O; int P0; int mode; };
struct DiffConst { float lam; float omli; float eps; const float* gain; float* scr; };
template <int PQ, int PK, int PV, int PO>
__device__ __forceinline__ void sm_block(const DiffRef& cur, const DiffConst& C, char* lds) {
    const int tid = pg8::tid_opaque(), wid = __builtin_amdgcn_readfirstlane(tid >> 6), lane = tid & 63, r32 = lane & 31, hi = lane >> 5;
    char* K_lds = lds; char* V_lds = lds + 2 * SHM_K; float* al_l = (float*)(lds + 2 * SHM_K + 2 * SHM_V) + wid * 32;
    const int sr = tid >> 4, sc = (tid & 15) * 8, vst0 = v_st(sr, sc), vst1 = v_st(32 + sr, sc), kws = KSWZ(sr, sc * 2);
    const int vb0 = (int)(uintptr_t)V_lds + v_rd_base(lane);
    const bf16* Q = cur.Q; const bf16* K = cur.K; const bf16* V = cur.V; const int P0 = cur.P0;
    bf16x8 qr[8];
#pragma unroll
    for (int d0 = 0; d0 < 8; ++d0) qr[d0] = load8(Q + (size_t)(wid * QBLK + r32) * PQ + d0 * 16 + hi * 8);
    f32x16 o[4] = {};
    float m_reg = -1e30f, l_reg = 0.f;
    const int qlo = P0 + wid * QBLK, qm = qlo + r32 - 4 * hi;
    const int NT = P0 / KVBLK + 4;
    bf16x8 st_k0, st_k1, st_v0, st_v1;
#define SM_LOAD(jt) do { const size_t k0_ = (size_t)(jt) * KVBLK; st_k0 = load8(K + (k0_ + sr) * PK + sc); st_k1 = load8(K + (k0_ + 32 + sr) * PK + sc); \
                         st_v0 = load8(V + (k0_ + sr) * PV + sc); st_v1 = load8(V + (k0_ + 32 + sr) * PV + sc); } while (0)
#define SM_WRITE(bf) do { *(bf16x8*)(K_lds + (bf) * SHM_K + kws) = st_k0; *(bf16x8*)(K_lds + (bf) * SHM_K + kws + 32 * 256) = st_k1; \
                          *(bf16x8*)(V_lds + (bf) * SHM_V + vst0) = st_v0; *(bf16x8*)(V_lds + (bf) * SHM_V + vst1) = st_v1; } while (0)
    SM_LOAD(0); asm volatile("s_waitcnt vmcnt(0)" ::: "memory"); SM_WRITE(0);
    __syncthreads();
    int buf = 0;
    for (int t = 0; t < NT; ++t) {
        const int kb = t * KVBLK; const bool more = t + 1 < NT;
        if (more) SM_LOAD(t + 1);
        if (kb <= qlo + QBLK - 1) {
            f32x16 p0, p1;
            qkt_rt(p0, p1, K_lds + buf * SHM_K, r32, hi, qr);
            if (kb + KVBLK - 1 > qlo) {
                const int dq = qm - kb; const float NEG = -__builtin_inff();
#pragma unroll
                for (int r = 0; r < 16; ++r) { const int c = (r & 3) + 8 * (r >> 2); if ((dq - c) < 0) p0[r] = NEG; if ((dq - c - 32) < 0) p1[r] = NEG; }
            }
            float pmax = p0[0];
#pragma unroll
            for (int r = 1; r < 16; ++r) pmax = fmaxf(pmax, p0[r]);
#pragma unroll
            for (int r = 0; r < 16; ++r) pmax = fmaxf(pmax, p1[r]);
            { auto rr = __builtin_amdgcn_permlane32_swap(__float_as_uint(pmax), __float_as_uint(pmax), false, false); pmax = fmaxf(__uint_as_float(rr[0]), __uint_as_float(rr[1])); }
            float alpha = 1.f;
            if (!__all((pmax - m_reg) <= THR2)) {
                const float mn = fmaxf(m_reg, pmax); alpha = __builtin_amdgcn_exp2f(m_reg - mn); m_reg = mn;
                if (hi == 0) al_l[r32] = alpha; asm volatile("s_waitcnt lgkmcnt(0)" ::: "memory");
#pragma unroll
                for (int d_ = 0; d_ < 4; ++d_)
#pragma unroll
                    for (int r = 0; r < 16; ++r) o[d_][r] *= al_l[crow(r, hi)];
            }
            float ps = 0.f;
#pragma unroll
            for (int r = 0; r < 16; ++r) { p0[r] = __builtin_amdgcn_exp2f(p0[r] - m_reg); ps += p0[r]; }
#pragma unroll
            for (int r = 0; r < 16; ++r) { p1[r] = __builtin_amdgcn_exp2f(p1[r] - m_reg); ps += p1[r]; }
            { auto rr = __builtin_amdgcn_permlane32_swap(__float_as_uint(ps), __float_as_uint(ps), false, false); ps = __uint_as_float(rr[0]) + __uint_as_float(rr[1]); }
            l_reg = l_reg * alpha + ps;
            bf16x8 pa0, pa1, pa2, pa3;
            PK4(p0, 0, pa0); PK4(p0, 8, pa1); PK4(p1, 0, pa2); PK4(p1, 8, pa3);
            SBAR();
            pv_rt(o, vb0 + buf * SHM_V, pa0, pa1, pa2, pa3);
        }
        if (more) { asm volatile("s_waitcnt vmcnt(0)" ::: "memory"); SM_WRITE(buf ^ 1); }
        __syncthreads();
        buf ^= 1;
    }
#undef SM_LOAD
#undef SM_WRITE
    if (hi == 0) al_l[r32] = l_reg; asm volatile("s_waitcnt lgkmcnt(0)" ::: "memory");
    float rli[16];
#pragma unroll
    for (int r = 0; r < 16; ++r) rli[r] = __builtin_amdgcn_rcpf(al_l[crow(r, hi)]);
#define OPQ(v) asm volatile("" : "+v"(v))
    char* sA = (char*)C.scr; char* sB = sA + 16384;
    const unsigned lo16 = (unsigned)lane * 16u;
    const int mode = cur.mode;
    if (mode == 0 || mode == 1) { char* s = mode ? sB : sA;
#pragma unroll
        for (int r = 0; r < 16; ++r) { unsigned vo = lo16; OPQ(vo);
            const f32x4 v = {o[0][r] * rli[r], o[1][r] * rli[r], o[2][r] * rli[r], o[3][r] * rli[r]};
            *(f32x4*)(s + (size_t)(vo + r * 1024)) = v; }
    } else if (mode == 2) {
#pragma unroll
        for (int r = 0; r < 16; ++r) { unsigned vo = lo16; OPQ(vo);
            f32x4* ap = (f32x4*)(sA + (size_t)(vo + r * 1024)); const f32x4 a = *ap;
            const f32x4 v = {a[0] - C.lam * (o[0][r] * rli[r]), a[1] - C.lam * (o[1][r] * rli[r]), a[2] - C.lam * (o[2][r] * rli[r]), a[3] - C.lam * (o[3][r] * rli[r])};
            *ap = v;
            if ((r & 3) == 3) asm volatile("" ::: "memory"); }
    } else {
        float g0[4], g1[4];
#pragma unroll
        for (int d0 = 0; d0 < 4; ++d0) { g0[d0] = C.gain[d0 * 32 + r32]; g1[d0] = C.gain[128 + d0 * 32 + r32]; }
        char* Ow = (char*)(cur.O + (size_t)(wid * QBLK) * PO);
        const unsigned lo_o = (unsigned)((4 * hi) * PO + r32) * 2u;
#pragma unroll
        for (int r = 0; r < 16; ++r) { unsigned vo = lo16; OPQ(vo);
            const f32x4 a = *(const f32x4*)(sA + (size_t)(vo + r * 1024)); const f32x4 b = *(const f32x4*)(sB + (size_t)(vo + r * 1024));
            float d1[4], ss = 0.f;
#pragma unroll
            for (int d0 = 0; d0 < 4; ++d0) { d1[d0] = b[d0] - C.lam * (o[d0][r] * rli[r]); ss += d1[d0] * d1[d0] + a[d0] * a[d0]; }
            ss += __shfl_xor(ss, 1); ss += __shfl_xor(ss, 2); ss += __shfl_xor(ss, 4); ss += __shfl_xor(ss, 8); ss += __shfl_xor(ss, 16);
            const float scl = rsqrtf(ss * (1.f / 256.f) + C.eps) * C.omli;
            unsigned wo = lo_o; OPQ(wo);
            char* rowp = Ow + (size_t)(wo + (unsigned)(((r & 3) + 8 * (r >> 2)) * PO * 2));
#pragma unroll
            for (int d0 = 0; d0 < 4; ++d0) {
                const float v0 = a[d0] * scl * g0[d0], v1 = d1[d0] * scl * g1[d0];
                const float v0n = __shfl_xor(v0, 1), v1n = __shfl_xor(v1, 1);
                if ((r32 & 1) == 0) { *(unsigned*)(rowp + d0 * 64) = cvtpk(v0, v0n); *(unsigned*)(rowp + 256 + d0 * 64) = cvtpk(v1, v1n); }
            }
            if ((r & 1) == 1) asm volatile("" ::: "memory");
        }
    }
#undef OPQ
    __syncthreads();
}

constexpr int K2 = 32;
constexpr int ST2_K0 = 0, ST2_K1 = 8192, ST2_V = 16384, ST2_BYTES = 32768;
__device__ __forceinline__ int v_st2(int k, int c) { const int kk = (k & ~0xC) | ((k & 4) << 1) | ((k & 8) >> 1); return ((kk >> 3) * 8 + (c >> 5)) * 512 + ((kk & 7) * 32 + (c & 31)) * 2; }
struct Diff2Const { float lam; float omli; float eps; float mb; const float* gain; };
template <int PQ, int PK, int PV, int PO>
__device__ __forceinline__ void diff2_block(const bf16* Qb  , const bf16* Kb  , const bf16* Vb  ,
                                            bf16* Ob, int P0, const Diff2Const& C, char* lds) {
    const int tid = pg8::tid_opaque(), wid = __builtin_amdgcn_readfirstlane(tid >> 6), lane = tid & 63, r32 = lane & 31, hi = lane >> 5;
    const int rg = wid & 3, cc = wid >> 2;
    const int krow = tid >> 4, kcol = (tid & 15) * 8, kws = KSWZ(krow, kcol * 2);
    const int vrow0 = tid >> 5, vcol = (tid & 31) * 8, vst0 = v_st2(vrow0, vcol), vst1 = v_st2(16 + vrow0, vcol);
    const int vb0 = (int)(uintptr_t)lds + ST2_V + v_rd_base(lane);
    const char* Kmine = lds + (cc ? ST2_K1 : ST2_K0);
    bf16x8 qr[8];
    { unsigned qo = (unsigned)((rg * QBLK + r32) * PQ + cc * 128 + hi * 8) * 2u; asm volatile("" : "+v"(qo));
#pragma unroll
      for (int d0 = 0; d0 < 8; ++d0) qr[d0] = *(const bf16x8*)((const char*)Qb + (size_t)qo + d0 * 32); }
    f32x16 o[8];
#pragma unroll
    for (int d0 = 0; d0 < 8; ++d0) o[d0] = f32x16{};
    float l_reg = 0.f;
    const int qlo = P0 + rg * QBLK, qm = qlo + r32 - 4 * hi;
    const int NT = P0 / K2 + 4;
    bf16x8 st_k0, st_k1, st_v0, st_v1;
    const unsigned koff = (unsigned)(krow * PK + kcol) * 2u, voffa = (unsigned)(vrow0 * PV + vcol) * 2u, voffb = (unsigned)((16 + vrow0) * PV + vcol) * 2u;
#define D2_LOAD(jt) do { const char* kt_ = (const char*)Kb + (size_t)(jt) * (K2 * PK * 2); const char* vt_ = (const char*)Vb + (size_t)(jt) * (K2 * PV * 2); \
                         unsigned ko_ = koff, va_ = voffa, vb_ = voffb; asm volatile("" : "+v"(ko_), "+v"(va_), "+v"(vb_)); \
                         st_k0 = *(const bf16x8*)(kt_ + (size_t)ko_); st_k1 = *(const bf16x8*)(kt_ + (size_t)ko_ + 256); \
                         st_v0 = *(const bf16x8*)(vt_ + (size_t)va_); st_v1 = *(const bf16x8*)(vt_ + (size_t)vb_); } while (0)
#define D2_WRITE(bf) do { char* st_ = lds + (bf) * ST2_BYTES; *(bf16x8*)(st_ + ST2_K0 + kws) = st_k0; *(bf16x8*)(st_ + ST2_K1 + kws) = st_k1; \
                          *(bf16x8*)(st_ + ST2_V + vst0) = st_v0; *(bf16x8*)(st_ + ST2_V + vst1) = st_v1; } while (0)
    D2_LOAD(0); asm volatile("s_waitcnt vmcnt(0)" ::: "memory"); D2_WRITE(0);
    __syncthreads();
    int buf = 0;
    for (int t = 0; t < NT; ++t) {
        const int kb = t * K2; const bool more = t + 1 < NT;
        if (more) D2_LOAD(t + 1);
        if (kb <= qlo + QBLK - 1) {
            f32x16 p0 = f32x16{};
            { const char* Kt = Kmine + buf * ST2_BYTES; const char* kbp[4];
#pragma unroll
              for (int dd = 0; dd < 4; ++dd) kbp[dd] = Kt + KSWZ(r32, (dd * 16 + hi * 8) * 2);
#pragma unroll
              for (int d0 = 0; d0 < 8; ++d0) { const bf16x8 b0 = *reinterpret_cast<const bf16x8*>(kbp[d0 & 3] + (d0 >> 2) * 128); p0 = __builtin_amdgcn_mfma_f32_32x32x16_bf16(b0, qr[d0], p0, 0, 0, 0); } }
            const float mb = C.mb;
            if (kb + K2 - 1 > qlo) {
                const int dq = qm - kb;
#pragma unroll
                for (int r = 0; r < 16; ++r) { const int c = (r & 3) + 8 * (r >> 2); const float e = __builtin_amdgcn_exp2f(p0[r] - mb); p0[r] = (dq - c) >= 0 ? e : 0.f; }
            } else {
#pragma unroll
                for (int r = 0; r < 16; ++r) p0[r] = __builtin_amdgcn_exp2f(p0[r] - mb);
            }
            float ps = 0.f;
#pragma unroll
            for (int r = 0; r < 16; ++r) ps += p0[r];
            l_reg += ps;
            bf16x8 pa0, pa1;
            PK4(p0, 0, pa0); PK4(p0, 8, pa1);
            SBAR();
            const int vb = vb0 + buf * ST2_BYTES;
#define TRRD(dst, off) asm volatile("ds_read_b64_tr_b16 %0, %1 offset:%2" : "=&v"(dst) : "v"(vb), "i"(off) : "memory")
#define PV2_RD(d0, L0, H0, L1, H1) do { constexpr int b_ = (d0) * 512; TRRD(L0, b_); TRRD(H0, b_ + 4096); TRRD(L1, b_ + 8192); TRRD(H1, b_ + 12288); } while (0)
#define PV2_MM(d0, L0, H0, L1, H1) do { \
        o[d0] = __builtin_amdgcn_mfma_f32_32x32x16_bf16(pa0, (bf16x8){L0[0], L0[1], L0[2], L0[3], H0[0], H0[1], H0[2], H0[3]}, o[d0], 0, 0, 0); \
        o[d0] = __builtin_amdgcn_mfma_f32_32x32x16_bf16(pa1, (bf16x8){L1[0], L1[1], L1[2], L1[3], H1[0], H1[1], H1[2], H1[3]}, o[d0], 0, 0, 0); } while (0)
#define LGK(n) do { asm volatile("s_waitcnt lgkmcnt(" #n ")" ::: "memory"); SBAR(); } while (0)
            { s16x4 la0, ha0, la1, ha1, lb0, hb0, lb1, hb1;
              PV2_RD(0, la0, ha0, la1, ha1);
              PV2_RD(1, lb0, hb0, lb1, hb1); LGK(4); PV2_MM(0, la0, ha0, la1, ha1);
              PV2_RD(2, la0, ha0, la1, ha1); LGK(4); PV2_MM(1, lb0, hb0, lb1, hb1);
              PV2_RD(3, lb0, hb0, lb1, hb1); LGK(4); PV2_MM(2, la0, ha0, la1, ha1);
              PV2_RD(4, la0, ha0, la1, ha1); LGK(4); PV2_MM(3, lb0, hb0, lb1, hb1);
              PV2_RD(5, lb0, hb0, lb1, hb1); LGK(4); PV2_MM(4, la0, ha0, la1, ha1);
              PV2_RD(6, la0, ha0, la1, ha1); LGK(4); PV2_MM(5, lb0, hb0, lb1, hb1);
              PV2_RD(7, lb0, hb0, lb1, hb1); LGK(4); PV2_MM(6, la0, ha0, la1, ha1);
              LGK(0); PV2_MM(7, lb0, hb0, lb1, hb1); }
#undef PV2_RD
#undef PV2_MM
#undef LGK
#undef TRRD
        }
        if (more) { asm volatile("s_waitcnt vmcnt(0)" ::: "memory"); D2_WRITE(buf ^ 1); }
        __syncthreads();
        buf ^= 1;
    }
#undef D2_LOAD
#undef D2_WRITE
    { auto rr = __builtin_amdgcn_permlane32_swap(__float_as_uint(l_reg), __float_as_uint(l_reg), false, false); l_reg = __uint_as_float(rr[0]) + __uint_as_float(rr[1]); }
    float* lw = (float*)(lds + 132096) + wid * 32;
    if (hi == 0) lw[r32] = l_reg; asm volatile("s_waitcnt lgkmcnt(0)" ::: "memory");
    float rli[16];
#pragma unroll
    for (int r = 0; r < 16; ++r) rli[r] = __builtin_amdgcn_rcpf(lw[crow(r, hi)]);
    float* X = (float*)lds + rg * 8192;
#define OPQ(v) asm volatile("" : "+v"(v))
    if (cc == 1) {
#pragma unroll
        for (int r = 0; r < 16; ++r) { const float f = C.lam * rli[r]; unsigned vo = (unsigned)lane; OPQ(vo);
#pragma unroll
            for (int d0 = 0; d0 < 8; ++d0) X[(r * 8 + d0) * 64 + vo] = o[d0][r] * f; }
    }
    __syncthreads();
    if (cc == 0) {
        float g[8];
        { unsigned go = (unsigned)r32 * 4u; OPQ(go);
#pragma unroll
          for (int d0 = 0; d0 < 8; ++d0) g[d0] = *(const float*)((const char*)C.gain + (size_t)go + d0 * 128); }
        char* Ow = (char*)(Ob + (size_t)(rg * QBLK) * PO);
        const unsigned lo_o = (unsigned)((4 * hi) * PO + r32) * 2u;
#pragma unroll
        for (int r = 0; r < 16; ++r) { unsigned vo = (unsigned)lane; OPQ(vo);
            float d[8], ss = 0.f;
#pragma unroll
            for (int d0 = 0; d0 < 8; ++d0) { d[d0] = o[d0][r] * rli[r] - X[(r * 8 + d0) * 64 + vo]; ss += d[d0] * d[d0]; }
            ss += __shfl_xor(ss, 1); ss += __shfl_xor(ss, 2); ss += __shfl_xor(ss, 4); ss += __shfl_xor(ss, 8); ss += __shfl_xor(ss, 16);
            const float scl = rsqrtf(ss * (1.f / 256.f) + C.eps) * C.omli;
            unsigned wo = lo_o; OPQ(wo);
            char* rowp = Ow + (size_t)(wo + (unsigned)(((r & 3) + 8 * (r >> 2)) * PO * 2));
#pragma unroll
            for (int d0 = 0; d0 < 8; ++d0) { const float v = d[d0] * scl * g[d0]; const float vn = __shfl_xor(v, 1);
                if ((r32 & 1) == 0) *(unsigned*)(rowp + d0 * 64) = cvtpk(v, vn); }
        }
    }
#undef OPQ
    __syncthreads();
}
}
#ifndef PG8_SP2
#define PG8_SP2 true
#endif
#ifndef PG8_ALIGN
#define PG8_ALIGN true
#endif
#ifndef MK_SPLIT
#define MK_SPLIT 0
#endif
#ifndef MK_CHECK
#define MK_CHECK 0
#endif
constexpr int NWAVES = 8;
constexpr int BATCH = 2, SEQ = 4096, DM = 4096, MROWS = BATCH * SEQ, FF = 11008, FF2 = 2 * FF, NQKV = 3 * DM;
constexpr int SB_H = 32, DF_H = 16, HD = 128;
constexpr float RMS_EPS = 1e-6f;
constexpr float LOG2E = 1.4426950408889634f;
constexpr float QSCALE = 0.08838834764831845f * LOG2E;
constexpr int NPH = 14;
constexpr size_t MiB = 1u << 20;
constexpr size_t WS_CTL = 0, CTL_ZERO_BYTES = 1 * MiB;
constexpr size_t WS_WQKV0 = 2 * MiB;
constexpr size_t WS_WO0   = WS_WQKV0 + 96 * MiB;
constexpr size_t WS_WQKV1 = WS_WO0 + 32 * MiB;
constexpr size_t WS_WO1   = WS_WQKV1 + 96 * MiB;
constexpr size_t WS_WUP0  = WS_WO1 + 32 * MiB;
constexpr size_t WS_WUP1  = WS_WUP0 + 172 * MiB;
constexpr size_t WS_WDN0  = WS_WUP1 + 172 * MiB;
constexpr size_t WS_WDN1  = WS_WDN0 + 86 * MiB;
constexpr size_t WS_XN    = WS_WDN1 + 86 * MiB;
constexpr size_t WS_PART  = WS_XN + 64 * MiB;
constexpr size_t WS_QKV   = WS_PART + 2 * MiB;
constexpr size_t WS_QKN   = WS_QKV + 192 * MiB;
constexpr size_t WS_AO    = WS_QKN + 128 * MiB;
constexpr size_t WS_U     = WS_AO + 64 * MiB;
constexpr size_t WS_ACT   = WS_U + 344 * MiB;
constexpr size_t WS_SCR   = WS_ACT + 172 * MiB;
constexpr size_t WS_HALO  = WS_SCR + 64 * MiB;
constexpr size_t WS_X1    = WS_HALO + 44 * MiB;
constexpr size_t WS_END   = WS_X1 + (MK_CHECK ? 3 * 128 * MiB : 0);
constexpr int CW_TMO = 0, CW_CODE = 1, CW_FAIL = 2, CW_BAR = 4096;

constexpr int RING_OFF = 0, RING_BYTES = 131072;
constexpr int LDSCTL_OFF = RING_BYTES, MISC_OFF = LDSCTL_OFF + 320;
constexpr int LDS_BYTES = 147456;
static_assert(MISC_OFF + 128 <= LDS_BYTES, "LDS map");

#define GAS __attribute__((address_space(1)))
#define LAS __attribute__((address_space(3)))
typedef unsigned short bf16;
typedef unsigned v4u __attribute__((ext_vector_type(4)));
typedef unsigned v2u __attribute__((ext_vector_type(2)));
typedef float f32x4 __attribute__((ext_vector_type(4)));
typedef short bf16x8 __attribute__((ext_vector_type(8)));
typedef GAS unsigned gu32;
#define RLX_AGENT __ATOMIC_RELAXED, __HIP_MEMORY_SCOPE_AGENT
#define LDS_WAIT() asm volatile("s_waitcnt lgkmcnt(0)" ::: "memory")
#define VM_WAIT() asm volatile("s_waitcnt vmcnt(0)" ::: "memory")
__device__ __forceinline__ unsigned f2bf(float f) { unsigned u = __builtin_bit_cast(unsigned, f); return (u + 0x7fffu + ((u >> 16) & 1u)) >> 16; }
__device__ __forceinline__ unsigned pk2(float lo, float hi) { return f2bf(lo) | (f2bf(hi) << 16); }
__device__ __forceinline__ float bf2f(unsigned short b) { return __builtin_bit_cast(float, (unsigned)b << 16); }

#define XB_TMO      128
#define XB_XCNT(j)  (256  + 64 * (j))
#define XB_XSUB(j)  (1280 + 64 * (j))
#define XB_XGEN(j)  (2304 + 64 * (j))
#define XB_TOP      3328
#define XB_TOPGEN   3392
#define XCD_BAR_WORDS 3456
#define XB_SPIN_CAP (1u << 18)
__device__ __forceinline__ unsigned xb_ld(unsigned* p)              { return __hip_atomic_load(p, __ATOMIC_RELAXED, __HIP_MEMORY_SCOPE_AGENT); }
__device__ __forceinline__ unsigned xb_add(unsigned* p, unsigned v) { return __hip_atomic_fetch_add(p, v, __ATOMIC_RELAXED, __HIP_MEMORY_SCOPE_AGENT); }
__device__ __forceinline__ unsigned xb_xcc_id() { return (unsigned)__builtin_amdgcn_s_getreg((3 << 11) | 20) & 0xFu; }
#define XB_SPIN(cond, bar) do { unsigned _sp = 0; while (cond) { __builtin_amdgcn_s_sleep(1); \
    if ((++_sp & 255u) == 0u) { if (xb_ld(&(bar)[XB_TMO])) break; if (_sp > XB_SPIN_CAP) { atomicAdd(&(bar)[XB_TMO], 1u); break; } } } } while (0)
struct XcdBarrier { unsigned* bar; unsigned x; volatile LAS unsigned* st; };
__device__ __forceinline__ XcdBarrier xcd_barrier_post(unsigned* bar, volatile LAS unsigned* st) {
    XcdBarrier b; b.bar = bar; b.x = xb_xcc_id(); b.st = st;
    if (threadIdx.x == 0) (void)xb_add(&bar[XB_XCNT(b.x)], 1u);
    return b;
}
__device__ __forceinline__ void xcd_barrier_complete(unsigned* bar, unsigned x, unsigned& nloc, unsigned& nx) {
    const unsigned G = gridDim.x * gridDim.y * gridDim.z;
    unsigned sum, cnt, mine, sp = 0u;
    for (;;) {
        sum = 0u; cnt = 0u; mine = 0u;
#pragma unroll
        for (unsigned j = 0; j < 16; ++j) { const unsigned c = xb_ld(&bar[XB_XCNT(j)]); sum += c; cnt += (c > 0u) ? 1u : 0u; mine = (j == x) ? c : mine; }
        if (sum == G) break;
        __builtin_amdgcn_s_sleep(1);
        if ((++sp & 255u) == 0u) { if (xb_ld(&bar[XB_TMO])) break; if (sp > XB_SPIN_CAP) { atomicAdd(&bar[XB_TMO], 1u); break; } }
    }
    nloc = mine > 0u ? mine : 1u; nx = cnt > 0u ? cnt : 1u;
}
__device__ __forceinline__ void xcd_barrier(const XcdBarrier& b) {
    asm volatile("s_waitcnt vmcnt(0)" ::: "memory");
    __syncthreads();
    if (threadIdx.x == 0) {
        unsigned* bar = b.bar; const unsigned myx = xb_xcc_id();
        __builtin_amdgcn_s_waitcnt(0);
        unsigned nloc = b.st[0], nx = b.st[1];
        if (nloc == 0u) { xcd_barrier_complete(bar, myx, nloc, nx); b.st[0] = nloc; b.st[1] = nx; }
        const unsigned old = xb_add(&bar[XB_XSUB(myx)], 1u);
        const unsigned gen = old / nloc;
        if (old + 1u == (gen + 1u) * nloc) {
            __builtin_amdgcn_fence(__ATOMIC_RELEASE, "agent");
            asm volatile("s_waitcnt vmcnt(0)" ::: "memory");
            const unsigned og = xb_add(&bar[XB_TOP], 1u);
            const unsigned tg = og / nx;
            if (og + 1u == (tg + 1u) * nx) xb_add(&bar[XB_TOPGEN], 1u);
            else XB_SPIN(xb_ld(&bar[XB_TOPGEN]) == tg, bar);
            __builtin_amdgcn_fence(__ATOMIC_ACQUIRE, "agent");
            xb_add(&bar[XB_XGEN(myx)], 1u);
            asm volatile("s_waitcnt vmcnt(0)" ::: "memory");
        } else {
            XB_SPIN(xb_ld(&bar[XB_XGEN(myx)]) == gen, bar);
            __builtin_amdgcn_fence(__ATOMIC_ACQUIRE, "agent");
            asm volatile("s_waitcnt vmcnt(0)" ::: "memory");
        }
    }
    __syncthreads();
}

__device__ __forceinline__ float wave_sum(float v) {
#pragma unroll
    for (int o = 1; o < 64; o <<= 1) v += __shfl_xor(v, o);
    return v;
}

constexpr int TR_STRIDE = 33;
__device__ __forceinline__ void transpose_item(const float* W, const float* gain, int K, int N, bf16* WT, LAS unsigned* scr, int item, int lane, bool gateperm) {
    const int nblk = N / 64, kb = item / nblk, nb = item % nblk, k0 = 64 * kb, n0 = 64 * nb;
    const int h_ = N / 2, nd0 = gateperm ? ((n0 % h_) / 128) * 256 + (n0 / h_) * 128 + (n0 % 128) : n0;
    const int kp = lane >> 4, c = lane & 15;
    f32x4 va[8], vb[8];
#pragma unroll
    for (int i = 0; i < 8; ++i) { const GAS float* src = (const GAS float*)W + (size_t)(k0 + 8 * i + 2 * kp) * N + n0 + 4 * c; va[i] = __builtin_nontemporal_load((const GAS f32x4*)src); vb[i] = __builtin_nontemporal_load((const GAS f32x4*)(src + N)); }
#pragma unroll
    for (int i = 0; i < 8; ++i) { float ga = 1.f, gb = 1.f; if (gain) { ga = gain[k0 + 8 * i + 2 * kp]; gb = gain[k0 + 8 * i + 2 * kp + 1]; }
        LAS unsigned* d = scr + (4 * c) * TR_STRIDE + 4 * i + kp;
        d[0 * TR_STRIDE] = pk2(va[i].x * ga, vb[i].x * gb); d[1 * TR_STRIDE] = pk2(va[i].y * ga, vb[i].y * gb);
        d[2 * TR_STRIDE] = pk2(va[i].z * ga, vb[i].z * gb); d[3 * TR_STRIDE] = pk2(va[i].w * ga, vb[i].w * gb); }
    LDS_WAIT(); asm volatile("" ::: "memory");
    const int c8 = lane & 7, nr = lane >> 3;
#pragma unroll
    for (int j = 0; j < 8; ++j) { const int n = nr + 8 * j; const LAS unsigned* s = scr + n * TR_STRIDE + 4 * c8;
        v4u o; o.x = s[0]; o.y = s[1]; o.z = s[2]; o.w = s[3];
        *(GAS v4u*)(WT + (size_t)(nd0 + n) * K + k0 + 8 * c8) = o; }
    LDS_WAIT(); asm volatile("" ::: "memory");
}
__device__ __forceinline__ void xrow_to_bf16(const float* xrow, bf16* orow, float* prow, int lane) {
    const GAS f32x4* xr = (const GAS f32x4*)xrow + lane;
    float s = 0.f; GAS unsigned long long* o8 = (GAS unsigned long long*)orow + lane;
#pragma unroll
    for (int j = 0; j < 16; ++j) { const f32x4 v = xr[64 * j]; s += (v.x * v.x + v.y * v.y) + (v.z * v.z + v.w * v.w);
        o8[64 * j] = (unsigned long long)pk2(v.x, v.y) | ((unsigned long long)pk2(v.z, v.w) << 32); }
    s = wave_sum(s);
    prow[lane] = lane == 0 ? s : 0.f;
}

__device__ __forceinline__ void cvt8(const v4u w, float (&f)[8]) {
    f[0] = __builtin_bit_cast(float, w.x << 16); f[1] = __builtin_bit_cast(float, w.x & 0xffff0000u); f[2] = __builtin_bit_cast(float, w.y << 16); f[3] = __builtin_bit_cast(float, w.y & 0xffff0000u);
    f[4] = __builtin_bit_cast(float, w.z << 16); f[5] = __builtin_bit_cast(float, w.z & 0xffff0000u); f[6] = __builtin_bit_cast(float, w.w << 16); f[7] = __builtin_bit_cast(float, w.w & 0xffff0000u);
}
constexpr int CG_ROWS = 32, CG_NCG = FF / 8, CG_ITEMS = (MROWS / CG_ROWS) * CG_NCG;
__device__ __forceinline__ void convgate_item(const bf16* U, const float* cw, const float* cb, bf16* ACT, int item) {
    const int chunk = item / CG_NCG, cg = item % CG_NCG, m0 = chunk * CG_ROWS, t0 = m0 % SEQ, j0 = cg * 8;
    float wg[3][8], wv[3][8], bg[8], bv[8];
#pragma unroll
    for (int i = 0; i < 3; ++i)
#pragma unroll
        for (int h = 0; h < 2; ++h) { const f32x4 a = *(const f32x4*)(cw + (size_t)i * FF2 + j0 + 4 * h), b = *(const f32x4*)(cw + (size_t)i * FF2 + FF + j0 + 4 * h);
            wg[i][4 * h] = a.x; wg[i][4 * h + 1] = a.y; wg[i][4 * h + 2] = a.z; wg[i][4 * h + 3] = a.w; wv[i][4 * h] = b.x; wv[i][4 * h + 1] = b.y; wv[i][4 * h + 2] = b.z; wv[i][4 * h + 3] = b.w; }
#pragma unroll
    for (int h = 0; h < 2; ++h) { const f32x4 a = *(const f32x4*)(cb + j0 + 4 * h), b = *(const f32x4*)(cb + FF + j0 + 4 * h);
        bg[4 * h] = a.x; bg[4 * h + 1] = a.y; bg[4 * h + 2] = a.z; bg[4 * h + 3] = a.w; bv[4 * h] = b.x; bv[4 * h + 1] = b.y; bv[4 * h + 2] = b.z; bv[4 * h + 3] = b.w; }
    float g2[8], g1[8], v2[8], v1[8];
    const v4u z4 = {0u, 0u, 0u, 0u};
    { const v4u a = t0 >= 2 ? *(const GAS v4u*)(U + (size_t)(m0 - 2) * FF2 + j0) : z4, b = t0 >= 2 ? *(const GAS v4u*)(U + (size_t)(m0 - 2) * FF2 + FF + j0) : z4; cvt8(a, g2); cvt8(b, v2); }
    { const v4u a = t0 >= 1 ? *(const GAS v4u*)(U + (size_t)(m0 - 1) * FF2 + j0) : z4, b = t0 >= 1 ? *(const GAS v4u*)(U + (size_t)(m0 - 1) * FF2 + FF + j0) : z4; cvt8(a, g1); cvt8(b, v1); }
#pragma unroll 4
    for (int r = 0; r < CG_ROWS; ++r) {
        float g0[8], v0[8]; cvt8(*(const GAS v4u*)(U + (size_t)(m0 + r) * FF2 + j0), g0); cvt8(*(const GAS v4u*)(U + (size_t)(m0 + r) * FF2 + FF + j0), v0);
        float o[8];
#pragma unroll
        for (int e = 0; e < 8; ++e) { const float cgv = bg[e] + wg[0][e] * g2[e] + wg[1][e] * g1[e] + wg[2][e] * g0[e]; const float cvv = bv[e] + wv[0][e] * v2[e] + wv[1][e] * v1[e] + wv[2][e] * v0[e];
            const float sg = cgv * __builtin_amdgcn_rcpf(1.f + __builtin_amdgcn_exp2f(-cgv * LOG2E)); o[e] = sg * cvv; g2[e] = g1[e]; g1[e] = g0[e]; v2[e] = v1[e]; v1[e] = v0[e]; }
        v4u w; w.x = pk2(o[0], o[1]); w.y = pk2(o[2], o[3]); w.z = pk2(o[4], o[5]); w.w = pk2(o[6], o[7]);
        *(GAS v4u*)(ACT + (size_t)(m0 + r) * FF + j0) = w;
    }
}

constexpr int FX_ITEMS = (MROWS / 64) * CG_NCG;
__device__ __forceinline__ void ld8(const float* p, float (&f)[8]) { const f32x4 a = *(const GAS f32x4*)p, b = *(const GAS f32x4*)(p + 4); f[0] = a.x; f[1] = a.y; f[2] = a.z; f[3] = a.w; f[4] = b.x; f[5] = b.y; f[6] = b.z; f[7] = b.w; }
__device__ __forceinline__ void fixup_item(const float* halo, const float* cw, const float* cb, bf16* ACT, int item) {
    const int grp = item / CG_NCG, cg = item % CG_NCG, j0 = cg * 8; const bool first = (grp % (SEQ / 64)) == 0;
    float wg[3][8], wv[3][8], bg[8], bv[8];
#pragma unroll
    for (int i = 0; i < 3; ++i) { ld8(cw + (size_t)i * FF2 + j0, wg[i]); ld8(cw + (size_t)i * FF2 + FF + j0, wv[i]); }
    ld8(cb + j0, bg); ld8(cb + FF + j0, bv);
    float h0g[8], h0v[8], h1g[8], h1v[8], t0g[8], t0v[8], t1g[8], t1v[8];
    const float* hb = halo + (size_t)grp * 4 * FF2 + j0;
    ld8(hb, h0g); ld8(hb + FF, h0v); ld8(hb + FF2, h1g); ld8(hb + FF2 + FF, h1v);
    if (!first) { const float* pb = hb - 4 * (size_t)FF2; ld8(pb + 2 * (size_t)FF2, t0g); ld8(pb + 2 * (size_t)FF2 + FF, t0v); ld8(pb + 3 * (size_t)FF2, t1g); ld8(pb + 3 * (size_t)FF2 + FF, t1v); }
    else {
#pragma unroll
        for (int e = 0; e < 8; ++e) { t0g[e] = 0.f; t0v[e] = 0.f; t1g[e] = 0.f; t1v[e] = 0.f; } }
    float o0[8], o1[8];
#pragma unroll
    for (int e = 0; e < 8; ++e) {
        const float cg0 = bg[e] + wg[0][e] * t0g[e] + wg[1][e] * t1g[e] + wg[2][e] * h0g[e], cv0 = bv[e] + wv[0][e] * t0v[e] + wv[1][e] * t1v[e] + wv[2][e] * h0v[e];
        const float cg1 = bg[e] + wg[0][e] * t1g[e] + wg[1][e] * h0g[e] + wg[2][e] * h1g[e], cv1 = bv[e] + wv[0][e] * t1v[e] + wv[1][e] * h0v[e] + wv[2][e] * h1v[e];
        o0[e] = cg0 * __builtin_amdgcn_rcpf(1.f + __builtin_amdgcn_exp2f(-cg0 * LOG2E)) * cv0; o1[e] = cg1 * __builtin_amdgcn_rcpf(1.f + __builtin_amdgcn_exp2f(-cg1 * LOG2E)) * cv1; }
    v4u w0, w1; w0.x = pk2(o0[0], o0[1]); w0.y = pk2(o0[2], o0[3]); w0.z = pk2(o0[4], o0[5]); w0.w = pk2(o0[6], o0[7]);
    w1.x = pk2(o1[0], o1[1]); w1.y = pk2(o1[2], o1[3]); w1.z = pk2(o1[4], o1[5]); w1.w = pk2(o1[6], o1[7]);
    *(GAS v4u*)(ACT + (size_t)(grp * 64) * FF + j0) = w0; *(GAS v4u*)(ACT + (size_t)(grp * 64 + 1) * FF + j0) = w1;
}

__device__ __forceinline__ void sincos_rev(float ang, float& s, float& c) {
    const float I1 = 0.15915493667125702f, I2 = 6.420638326565253e-09f;
    const float r1 = ang * I1; const float e1 = __builtin_fmaf(ang, I1, -r1); const float r2 = __builtin_fmaf(ang, I2, e1);
    const float fr = (r1 - __builtin_rintf(r1)) + r2;
    s = __builtin_amdgcn_sinf(fr); c = __builtin_amdgcn_cosf(fr);
}
__device__ __forceinline__ void qknorm_row(const bf16* qkv_row, bf16* qkn_row, const float* gq, const float* gk, int t, int lane) {
    const int c = lane & 7, gs = lane >> 3;
    float cs[8], sn[8];
#pragma unroll
    for (int e = 0; e < 8; ++e) { const int i = 8 * c + e; const float invf = __builtin_amdgcn_exp2f(-(float)i * (13.287712379549449f / 64.f));
        sincos_rev((float)t * invf, sn[e], cs[e]); }
    float gA[8], gB[8];
#pragma unroll 1
    for (int qk = 0; qk < 2; ++qk) {
        const float* gn = qk ? gk : gq; const float sc = qk ? 1.f : QSCALE;
#pragma unroll
        for (int e = 0; e < 8; ++e) { gA[e] = gn[8 * c + e]; gB[e] = gn[64 + 8 * c + e]; }
        v4u ra[4], rb[4];
#pragma unroll
        for (int it = 0; it < 4; ++it) { const int col = qk * 4096 + (it * 8 + gs) * 128 + 8 * c; ra[it] = *(const GAS v4u*)(qkv_row + col); rb[it] = *(const GAS v4u*)(qkv_row + col + 64); }
#pragma unroll
        for (int it = 0; it < 4; ++it) {
            const int col = qk * 4096 + (it * 8 + gs) * 128 + 8 * c;
            float xa[8], xb[8]; cvt8(ra[it], xa); cvt8(rb[it], xb);
            float ss = 0.f;
#pragma unroll
            for (int e = 0; e < 8; ++e) ss += xa[e] * xa[e] + xb[e] * xb[e];
            ss += __shfl_xor(ss, 1); ss += __shfl_xor(ss, 2); ss += __shfl_xor(ss, 4);
            const float inv = rsqrtf(ss * (1.f / 128.f) + RMS_EPS);
            float oa[8], ob[8];
#pragma unroll
            for (int e = 0; e < 8; ++e) { const float ya = xa[e] * inv * gA[e], yb = xb[e] * inv * gB[e]; oa[e] = (ya * cs[e] - yb * sn[e]) * sc; ob[e] = (yb * cs[e] + ya * sn[e]) * sc; }
            v4u wa, wb; wa.x = pk2(oa[0], oa[1]); wa.y = pk2(oa[2], oa[3]); wa.z = pk2(oa[4], oa[5]); wa.w = pk2(oa[6], oa[7]);
            wb.x = pk2(ob[0], ob[1]); wb.y = pk2(ob[2], ob[3]); wb.z = pk2(ob[4], ob[5]); wb.w = pk2(ob[6], ob[7]);
            *(GAS v4u*)(qkn_row + col) = wa; *(GAS v4u*)(qkn_row + col + 64) = wb;
        }
    }
}
struct Args { const float* in[18]; float* out; unsigned char* ws; int ph_lo, ph_hi; };
static_assert(sizeof(Args) == 18 * 8 + 8 + 8 + 8, "Args has no padding");

struct MatDesc { int in_idx; size_t in_off; int gain_idx; size_t gain_off; int K, N; size_t ws_off; int gateperm; };
__device__ __forceinline__ MatDesc mat_desc(int i) {
    switch (i) {
    case 0: return MatDesc{2, 0, 1, 0, DM, NQKV, WS_WQKV0, 0};
    case 1: return MatDesc{3, 0, -1, 0, DM, DM, WS_WO0, 0};
    case 2: return MatDesc{14, 0, 13, 0, DM, FF2, WS_WUP0, 1};
    case 3: return MatDesc{17, 0, -1, 0, FF, DM, WS_WDN0, 0};
    case 4: return MatDesc{4, 0, 1, (size_t)DM, DM, NQKV, WS_WQKV1, 0};
    case 5: return MatDesc{5, 0, -1, 0, DM, DM, WS_WO1, 0};
    case 6: return MatDesc{14, (size_t)DM * FF2, 13, (size_t)DM, DM, FF2, WS_WUP1, 1};
    default: return MatDesc{17, (size_t)FF * DM, -1, 0, FF, DM, WS_WDN1, 0};
    }
}

__global__ void __launch_bounds__(NWAVES * 64, 2) mk_fwd(Args args) {
    extern __shared__ __attribute__((aligned(16))) unsigned char lds[];
    LAS unsigned char* ldsl = (LAS unsigned char*)lds;
    volatile LAS unsigned* MISC = (volatile LAS unsigned*)(ldsl + MISC_OFF);
    const int tid = threadIdx.x, lane = tid & 63, wave = __builtin_amdgcn_readfirstlane(tid >> 6);
    const int G = gridDim.x, bx = blockIdx.x;
    const int gw = bx * NWAVES + wave, NGW = G * NWAVES;
    unsigned char* ws = args.ws;
    gu32* ctl = (gu32*)(ws + WS_CTL);
    for (int u = tid; u < (LDS_BYTES - LDSCTL_OFF) / 4; u += NWAVES * 64) ((LAS unsigned*)(ldsl + LDSCTL_OFF))[u] = 0u;
    __syncthreads();
    XcdBarrier bar; bar.bar = (unsigned*)(ctl + CW_BAR); bar.x = 0; bar.st = nullptr;
    const int lo = args.ph_lo, hi = args.ph_hi;
    if (hi - lo > 1) bar = xcd_barrier_post((unsigned*)(ctl + CW_BAR), MISC + 8);
#ifndef PH_MASK
#define PH_MASK 0x3fff
#endif
#define IN(k) (((PH_MASK >> (k)) & 1) && lo <= (k) && (k) < hi)
#define SEAM(k) do { if (IN(k) && IN((k) + 1)) xcd_barrier(bar); STAMP((k) + 1); } while (0)
#ifndef REPEAT_PHASE
#define REPEAT_PHASE -1
#endif
#ifndef REPEAT_N
#define REPEAT_N 1
#endif
#ifndef LEAK_A
#define LEAK_A -1
#endif
#ifndef LEAK_B
#define LEAK_B 14
#endif
#ifndef LEAK_OFF
#define LEAK_OFF 0
#endif
    unsigned long long tA = 0, tB = 0;
#define STAMP(k) do { if (LEAK_A >= 0 && bx == 0 && tid == 0) { if ((k) == LEAK_A) tA = __builtin_amdgcn_s_memrealtime(); if ((k) == LEAK_B) tB = __builtin_amdgcn_s_memrealtime(); } } while (0)
#define NREP(k) (REPEAT_PHASE == (k) ? 1 + REPEAT_N : 1)
    float* DUMMY = (float*)(ws + WS_END);

    bf16* XN = (bf16*)(ws + WS_XN); float* PART = (float*)(ws + WS_PART);
    bf16* QKV = (bf16*)(ws + WS_QKV); bf16* QKN = (bf16*)(ws + WS_QKN); bf16* AO = (bf16*)(ws + WS_AO);
    bf16* ACT = (bf16*)(ws + WS_ACT); float* HALO = (float*)(ws + WS_HALO);
    const float* x_in = args.in[0];

#ifndef JIT_CONV
#define JIT_CONV 1
#endif
#define CONVERT_MAT(MI) do { const MatDesc md = mat_desc(MI); LAS unsigned* scr_ = (LAS unsigned*)(ldsl + RING_OFF + wave * 16384); \
        const float* W_ = args.in[md.in_idx] + md.in_off; const float* gain_ = md.gain_idx >= 0 ? args.in[md.gain_idx] + md.gain_off : nullptr; \
        bf16* WT_ = (bf16*)(ws + md.ws_off); const int nitems_ = (md.K / 64) * (md.N / 64); \
        for (int it_ = gw; it_ < nitems_; it_ += NGW) transpose_item(W_, gain_, md.K, md.N, WT_, scr_, it_, lane, md.gateperm != 0); } while (0)
#define CONVERT_MAT_RANGE(MI, I0, I1, WG0) do { const MatDesc md = mat_desc(MI); LAS unsigned* scr_ = (LAS unsigned*)(ldsl + RING_OFF + wave * 16384); \
        const float* W_ = args.in[md.in_idx] + md.in_off; const float* gain_ = md.gain_idx >= 0 ? args.in[md.gain_idx] + md.gain_off : nullptr; \
        bf16* WT_ = (bf16*)(ws + md.ws_off); const int i1_ = (I1); \
        for (int it_ = (I0) + (bx - (WG0)) * NWAVES + wave; it_ < i1_; it_ += (G - (WG0)) * NWAVES) transpose_item(W_, gain_, md.K, md.N, WT_, scr_, it_, lane, md.gateperm != 0); } while (0)
#ifndef TAILFILL
#define TAILFILL 1
#endif
#ifndef DN_NUM
#define DN_NUM 52
#endif
constexpr int DN_ITEMS = (FF / 64) * (DM / 64), DN_SPLIT = TAILFILL ? (DN_ITEMS * DN_NUM) / 100 : 0;
#ifndef SPLIT_CONV
#define SPLIT_CONV 1
#endif
#ifdef PROBE_XCC
    if (tid == 0) __hip_atomic_store(ctl + 2048 + bx, 1u + xb_xcc_id(), RLX_AGENT);
#endif
    STAMP(0);
    if (IN(0)) _Pragma("unroll") for (int rep = 0; rep < NREP(0); ++rep) { if (rep) xcd_barrier(bar);
        LAS unsigned* scr = (LAS unsigned*)(ldsl + RING_OFF + wave * 16384);
#pragma unroll 1
#if JIT_CONV
        for (int m = gw; m < MROWS; m += NGW) xrow_to_bf16(x_in + (size_t)m * DM, XN + (size_t)m * DM, PART + (size_t)m * pg8::NPART, lane);
        CONVERT_MAT(0);
    }
#else
        for (int mo = 0; mo < (SPLIT_CONV ? 4 : 8); ++mo) { const int mi = SPLIT_CONV ? ((mo + 1) & 3) : ((mo + 1) & 7); const MatDesc md = mat_desc(mi);
            if (mi == 0) { for (int m = gw; m < MROWS; m += NGW) xrow_to_bf16(x_in + (size_t)m * DM, XN + (size_t)m * DM, PART + (size_t)m * pg8::NPART, lane); }
            const float* W = args.in[md.in_idx] + md.in_off; const float* gain = md.gain_idx >= 0 ? args.in[md.gain_idx] + md.gain_off : nullptr;
            bf16* WT = (bf16*)(ws + md.ws_off); const int nitems = (md.K / 64) * (md.N / 64);
            for (int it = gw; it < nitems; it += NGW) transpose_item(W, gain, md.K, md.N, WT, scr, it, lane, md.gateperm != 0); }
    }
#endif
    SEAM(0);
    if (IN(1)) _Pragma("unroll") for (int rep = 0; rep < NREP(1); ++rep) { if (rep) xcd_barrier(bar);
        pg8::Gemm g{XN, (const bf16*)(ws + WS_WQKV0), MROWS, NQKV, DM}; pg8::StaticOrder S; S.init(MROWS, NQKV, G, bx);
        pg8::EpiScale E{QKV, NQKV, PART, 1.f / DM, RMS_EPS, DM, QSCALE};
        pg8::gemm_phase<pg8::EpiScale, pg8::StaticOrder, PG8_ALIGN, PG8_SP2>(ldsl + RING_OFF, g, S, E);
    }
    SEAM(1);
    if (IN(2)) _Pragma("unroll") for (int rep = 0; rep < NREP(2); ++rep) { if (rep) xcd_barrier(bar);
        constexpr int NBLK = BATCH * SB_H * (SEQ / 256);
        for (int L = bx; L < NBLK; L += G) { const int qb = L % 16, bh = L / 16, b = bh / SB_H, h = bh % SB_H;
            const bf16* kvbase = QKV + (size_t)(b * SEQ) * NQKV + h * HD;
            att::sb_block<NQKV, NQKV, NQKV, DM>(kvbase + (size_t)(qb * 256) * NQKV, kvbase + DM, kvbase + 2 * DM, AO + (size_t)(b * SEQ + qb * 256) * DM + h * HD, qb * 256, (char*)lds + RING_OFF, (volatile LAS unsigned*)(ldsl + RING_OFF + 65536)); }
        if (JIT_CONV) CONVERT_MAT(1);
    }
    SEAM(2);
    if (IN(3)) _Pragma("unroll") for (int rep = 0; rep < NREP(3); ++rep) { if (rep) xcd_barrier(bar);
        pg8::Gemm g{AO, (const bf16*)(ws + WS_WO0), MROWS, DM, DM}; pg8::StaticOrder S; S.init(MROWS, DM, G, bx);
        pg8::EpiResid<false, false> E{nullptr, nullptr, XN, PART, DM};
        pg8::gemm_phase<pg8::EpiResid<false, false>, pg8::StaticOrder, PG8_ALIGN, PG8_SP2>(ldsl + RING_OFF, g, S, E);
        if (JIT_CONV) CONVERT_MAT(2);
    }
    SEAM(3);
#define UP_PHASE(WOFF, LAYER) do { pg8::Gemm g{XN, (const bf16*)(ws + (WOFF)), MROWS, FF2, DM}; pg8::StaticOrder S; S.init(MROWS, FF2, G, bx); \
        pg8::EpiConvGate E{ACT, FF, PART, 1.f / DM, RMS_EPS, args.in[15] + (size_t)(LAYER) * 3 * FF2, args.in[16] + (size_t)(LAYER) * FF2, HALO}; \
        pg8::gemm_phase<pg8::EpiConvGate, pg8::StaticOrder, PG8_ALIGN, PG8_SP2>(ldsl + RING_OFF, g, S, E); } while (0)
#define CG_PHASE(LAYER) do { const float* cw = args.in[15] + (size_t)(LAYER) * 3 * FF2; const float* cb = args.in[16] + (size_t)(LAYER) * FF2; \
        for (int it = bx * (NWAVES * 64) + tid; it < FX_ITEMS; it += G * NWAVES * 64) fixup_item(HALO, cw, cb, ACT, it); } while (0)
#ifndef DOWN_WGM
#define DOWN_WGM 8
#endif
#define DOWN_PHASE(WOFF, OUT, LAST) do { pg8::Gemm g{ACT, (const bf16*)(ws + (WOFF)), MROWS, DM, FF}; pg8::StaticOrder S; S.init(MROWS, DM, G, bx, DOWN_WGM); \
        pg8::EpiResid<false, LAST> E{nullptr, OUT, XN, PART, DM}; \
        pg8::gemm_phase<pg8::EpiResid<false, LAST>, pg8::StaticOrder, PG8_ALIGN, PG8_SP2>(ldsl + RING_OFF, g, S, E); } while (0)
    const int up_units = (MROWS / 256) * (FF2 / 256), up_full = up_units % G;
    if (IN(4)) _Pragma("unroll") for (int rep = 0; rep < NREP(4); ++rep) { if (rep) xcd_barrier(bar); UP_PHASE(WS_WUP0, 0); if (JIT_CONV && TAILFILL && up_full && bx >= up_full) CONVERT_MAT_RANGE(3, 0, DN_SPLIT, up_full); }
    SEAM(4);
    if (IN(5)) _Pragma("unroll") for (int rep = 0; rep < NREP(5); ++rep) { if (rep) xcd_barrier(bar); CG_PHASE(0); if (JIT_CONV) { if (TAILFILL && up_full) CONVERT_MAT_RANGE(3, DN_SPLIT, DN_ITEMS, 0); else CONVERT_MAT(3); } }
    SEAM(5);
    if (IN(6)) { DOWN_PHASE(WS_WDN0, nullptr, false); for (int rep = 1; rep < NREP(6); ++rep) { xcd_barrier(bar); DOWN_PHASE(WS_WDN0, DUMMY, true); } if (JIT_CONV) CONVERT_MAT(4); }
    SEAM(6);
#ifdef PROBE_LATE_QKV
    { pg8::Gemm g{XN, (const bf16*)(ws + WS_WQKV0), MROWS, NQKV, DM}; pg8::StaticOrder S; S.init(MROWS, NQKV, G, bx);
      pg8::EpiScale E{QKV, NQKV, PART, 1.f / DM, RMS_EPS, DM, QSCALE};
      pg8::gemm_phase<pg8::EpiScale, pg8::StaticOrder, PG8_ALIGN, PG8_SP2>(ldsl + RING_OFF, g, S, E); xcd_barrier(bar); }
#if PROBE_LATE_QKV == 2
    { pg8::Gemm g{XN, (const bf16*)(ws + WS_WQKV0), MROWS, NQKV, DM}; pg8::StaticOrder S; S.init(MROWS, NQKV, G, bx);
      pg8::EpiScale E{QKV, NQKV, PART, 1.f / DM, RMS_EPS, DM, QSCALE};
      pg8::gemm_phase<pg8::EpiScale, pg8::StaticOrder, PG8_ALIGN, PG8_SP2>(ldsl + RING_OFF, g, S, E); xcd_barrier(bar); }
#endif
#endif
    if (IN(7)) _Pragma("unroll") for (int rep = 0; rep < NREP(7); ++rep) { if (rep) xcd_barrier(bar);
        pg8::Gemm g{XN, (const bf16*)(ws + WS_WQKV1), MROWS, NQKV, DM}; pg8::StaticOrder S; S.init(MROWS, NQKV, G, bx);
        pg8::EpiScale E{QKV, NQKV, PART, 1.f / DM, RMS_EPS, 0, 1.f};
        pg8::gemm_phase<pg8::EpiScale, pg8::StaticOrder, PG8_ALIGN, PG8_SP2>(ldsl + RING_OFF, g, S, E);
    }
    SEAM(7);
    if (IN(8)) _Pragma("unroll") for (int rep = 0; rep < NREP(8); ++rep) { if (rep) xcd_barrier(bar); for (int m = gw; m < MROWS; m += NGW) qknorm_row(QKV + (size_t)m * NQKV, QKN + (size_t)m * 8192, args.in[6], args.in[7], m % SEQ, lane); }
    SEAM(8);
    if (IN(9)) _Pragma("unroll") for (int rep = 0; rep < NREP(9); ++rep) { if (rep) xcd_barrier(bar);
        float lam, omli;
        { const float a1 = wave_sum(args.in[8][lane] * args.in[9][lane] + args.in[8][lane + 64] * args.in[9][lane + 64]);
          const float a2 = wave_sum(args.in[10][lane] * args.in[11][lane] + args.in[10][lane + 64] * args.in[11][lane + 64]);
          const float li = 0.8f - 0.6f * 0.7408182206817179f;
          lam = __expf(a1) - __expf(a2) + li; omli = 1.f - li; }
        float mq = fmaxf(fabsf(args.in[6][lane]), fabsf(args.in[6][lane + 64])), mk = fmaxf(fabsf(args.in[7][lane]), fabsf(args.in[7][lane + 64]));
#pragma unroll
        for (int o_ = 1; o_ < 64; o_ <<= 1) { mq = fmaxf(mq, __shfl_xor(mq, o_)); mk = fmaxf(mk, __shfl_xor(mk, o_)); }
        att::Diff2Const C{lam, omli, RMS_EPS, QSCALE * 128.f * mq * mk * 1.02f, args.in[12]};
        constexpr int NITEM = BATCH * DF_H * 16;
        for (int w = bx; w < NITEM; w += G) {
            const int bh = (w & 7) * 4 + ((w >> 3) >> 4), xq = (w >> 3) & 15, b = bh / DF_H, h = bh % DF_H;
            const bf16* qn = QKN + (size_t)(b * SEQ) * 8192 + h * 256; const bf16* vb = QKV + (size_t)(b * SEQ) * NQKV + 2 * DM + h * 256;
#pragma unroll 1
            for (int ps = 0; ps < 2; ++ps) { const int qb = ps ? 31 - xq : xq;
                att::diff2_block<8192, 8192, NQKV, DM>(qn + (size_t)(qb * 128) * 8192, qn + 4096, vb, AO + (size_t)(b * SEQ + qb * 128) * DM + h * 256, qb * 128, C, (char*)lds + RING_OFF); }
        }
        if (JIT_CONV) CONVERT_MAT(5);
    }
    SEAM(9);
    if (IN(10)) {
        pg8::Gemm g{AO, (const bf16*)(ws + WS_WO1), MROWS, DM, DM}; pg8::StaticOrder S; S.init(MROWS, DM, G, bx);
        pg8::EpiResid<false, false> E{nullptr, nullptr, XN, PART, DM};
        pg8::gemm_phase<pg8::EpiResid<false, false>, pg8::StaticOrder, PG8_ALIGN, PG8_SP2>(ldsl + RING_OFF, g, S, E);
        if (JIT_CONV) CONVERT_MAT(6);
    }
    SEAM(10);
    if (IN(11)) { UP_PHASE(WS_WUP1, 1); if (JIT_CONV && TAILFILL && up_full && bx >= up_full) CONVERT_MAT_RANGE(7, 0, DN_SPLIT, up_full); }
    SEAM(11);
    if (IN(12)) { CG_PHASE(1); if (JIT_CONV) { if (TAILFILL && up_full) CONVERT_MAT_RANGE(7, DN_SPLIT, DN_ITEMS, 0); else CONVERT_MAT(7); } }
    SEAM(12);
    if (IN(13)) DOWN_PHASE(WS_WDN1, args.out, true);
#ifdef PROBE_XCC
    { xcd_barrier(bar);
      if (bx == 0 && tid == 0) { unsigned bad = 0; for (int i = 0; i < G; ++i) { const unsigned xi = __hip_atomic_load(ctl + 2048 + i, RLX_AGENT), xr = __hip_atomic_load(ctl + 2048 + (i & 7), RLX_AGENT); if (xi != xr || xi == 0u) ++bad; }
          for (int r = 0; r < 8; ++r) for (int q = r + 1; q < 8; ++q) if (__hip_atomic_load(ctl + 2048 + r, RLX_AGENT) == __hip_atomic_load(ctl + 2048 + q, RLX_AGENT)) bad += 1000;
          if (bad) args.out[0] = 1000.f * (float)bad; } }
#endif
    if (LEAK_A >= 0) { xcd_barrier(bar); STAMP(14); if (bx == 0 && tid == 0) args.out[0] = 1000.f * ((float)(long long)(tB - tA) * 0.01f - (float)(LEAK_OFF)); }
#undef IN
#undef SEAM
}
#if MK_CHECK
#include "check.inc"
#endif
extern "C" void kernel_launch(void* const* d_in, const int* in_sizes, int n_in, void* d_out, int out_size, void* d_ws, size_t ws_size, hipStream_t stream) {
    static int grid = 0;
    if (grid == 0) {
        if (n_in != 18 || in_sizes[0] != MROWS * DM || out_size != MROWS * DM || ws_size < WS_END) {
            fprintf(stderr, "kernel_launch: built for 18 inputs, x/out of %d floats, >= %zu bytes of workspace; got n_in %d, in0 %d, out %d, ws %zu; nothing launched\n", MROWS * DM, (size_t)WS_END, n_in, n_in > 0 ? in_sizes[0] : -1, out_size, ws_size); grid = -1; return; }
        int dev = 0, cus = 0, per_cu = 0;
        if (hipGetDevice(&dev) != hipSuccess || hipDeviceGetAttribute(&cus, hipDeviceAttributeMultiprocessorCount, dev) != hipSuccess) { fprintf(stderr, "kernel_launch: device query failed\n"); grid = -1; return; }
        if (hipFuncSetAttribute((const void*)mk_fwd, hipFuncAttributeMaxDynamicSharedMemorySize, LDS_BYTES) != hipSuccess) { fprintf(stderr, "kernel_launch: hipFuncSetAttribute failed\n"); grid = -1; return; }
        if (hipOccupancyMaxActiveBlocksPerMultiprocessor(&per_cu, (const void*)mk_fwd, NWAVES * 64, LDS_BYTES) != hipSuccess || per_cu < 1)
            fprintf(stderr, "kernel_launch: note: occupancy query reports %d workgroups per CU\n", per_cu);
        (void)hipGetLastError();
        grid = cus;
    }
    if (grid < 0) return;
    if (hipMemsetAsync((char*)d_ws + WS_CTL, 0, CTL_ZERO_BYTES, stream) != hipSuccess) { fprintf(stderr, "kernel_launch: memset failed\n"); return; }
    Args a{};
    for (int i = 0; i < 18; ++i) a.in[i] = (const float*)d_in[i];
    a.out = (float*)d_out; a.ws = (unsigned char*)d_ws;
#if MK_CHECK
    for (int p = 0; p < NPH; ++p) { a.ph_lo = p; a.ph_hi = p + 1;
        hipLaunchKernelGGL(mk_fwd, dim3(grid), dim3(NWAVES * 64), LDS_BYTES, stream, a);
        hipLaunchKernelGGL(mk_check, dim3(256), dim3(256), 0, stream, a, p); }
    hipLaunchKernelGGL(mk_report, dim3(1), dim3(64), 0, stream, a);
#elif MK_SPLIT
    for (int p = 0; p < NPH; ++p) { a.ph_lo = p; a.ph_hi = p + 1; hipLaunchKernelGGL(mk_fwd, dim3(grid), dim3(NWAVES * 64), LDS_BYTES, stream, a); }
#else
    a.ph_lo = 0; a.ph_hi = NPH;
    hipLaunchKernelGGL(mk_fwd, dim3(grid), dim3(NWAVES * 64), LDS_BYTES, stream, a);
#ifdef PROBE_TWICE
    (void)hipMemsetAsync((char*)d_ws + WS_CTL, 0, CTL_ZERO_BYTES, stream);
    hipLaunchKernelGGL(mk_fwd, dim3(grid), dim3(NWAVES * 64), LDS_BYTES, stream, a);
#endif
#endif
    const hipError_t le = hipPeekAtLastError();
    if (le != hipSuccess) fprintf(stderr, "kernel_launch: launch failed: %s\n", hipGetErrorName(le));
}
```

```cpp
#define PRIO_BEFORE_BAR 1
#define RS_LDS 1
#include <hip/hip_runtime.h>
#include <cstdio>
#include <cstdint>
namespace pg8 {
__device__ __forceinline__ int tid_opaque() { int t = (int)threadIdx.x; asm volatile("" : "+v"(t)); return t; }
#define PG8_LAS __attribute__((address_space(3)))
typedef unsigned short bf16_t;
typedef short bf16x8 __attribute__((ext_vector_type(8)));
typedef float f32x4 __attribute__((ext_vector_type(4)));
typedef unsigned u32x4 __attribute__((ext_vector_type(4)));
constexpr int BM = 256, BK = 64, HALF = 128, HTB = HALF * BK * 2  , STAGE_BYTES = 8 * HTB, NXCD = 8, WGM = 8;

__host__ __device__ __forceinline__ int lds_byte(int r, int c) { const int st = (r >> 4) * 2 + (c >> 5), rr = r & 15, cc = c & 31, ob = rr * 64 + cc * 2; return st * 1024 + (ob ^ (((ob >> 9) & 1) << 5)); }
__host__ __device__ __forceinline__ void stage_rc(int b, int& R, int& C) { const int st = b / 1024, sb = b % 1024, swz = sb ^ (((sb >> 9) & 1) << 5); R = (st >> 1) * 16 + swz / 64; C = (st & 1) * 32 + (swz % 64) / 2; }
__host__ __device__ __forceinline__ int perm32(int rho) { const int n = rho >> 4, i = rho & 15; return 8 * (i >> 2) + 4 * n + (i & 3); }

struct Unit { int pm, pn; };
struct Gemm { const bf16_t* A; const bf16_t* Bt; int M, N, K; };

struct StaticOrder {
    int nM, nN, nwg, G, c, wgm;
    __host__ __device__ void init(int M, int N, int G_, int c_, int wgm_ = WGM) { nM = M / BM; nN = N / BM; nwg = nM * nN; G = G_; c = c_; wgm = wgm_; }
    __host__ __device__ bool next(int i, Unit& u) const {
        const long L = (long)i * G + c; if (L >= nwg) return false;
        int wgid = (int)L; { const int q = nwg / NXCD, r = nwg % NXCD, xcd = wgid % NXCD, off = wgid / NXCD; wgid = (xcd < r ? xcd * (q + 1) : r * (q + 1) + (xcd - r) * q) + off; }
        const int nig = wgm * nN, gid = wgid / nig, fm = gid * wgm, gsz = (nM - fm) < wgm ? (nM - fm) : wgm;
        u.pm = fm + ((wgid % nig) % gsz); u.pn = (wgid % nig) / gsz; return true;
    }
    __device__ __forceinline__ void a_ready(const Unit&) const {}
    __device__ __forceinline__ void done(const Unit&) const {}
};
struct RangeOrder : StaticOrder {
    int i0, i1;
    __host__ __device__ bool next(int i, Unit& u) const { return (i0 + i < i1) && StaticOrder::next(i0 + i, u); }
};


__device__ __forceinline__ unsigned cvt_pk_bf16(float lo, float hi) { unsigned r; asm volatile("v_cvt_pk_bf16_f32 %0, %1, %2" : "=v"(r) : "v"(lo), "v"(hi)); return r; }

constexpr int NPART = 64;

__device__ __forceinline__ void row_scales_lds(float (&rs)[2][4], PG8_LAS float* rl, const float* part, int urow0  , float inv_k, float eps, int wr, int wc, int fr, int fq) {
#pragma unroll
    for (int ai = 0; ai < 2; ++ai) { const int lr = ai * HALF + wr * 64 + wc * 16 + fr;
        const f32x4* pp = (const f32x4*)(part + (size_t)(urow0 + lr) * NPART + fq * 16);
        const f32x4 a = pp[0], b = pp[1], c = pp[2], d = pp[3];
        float s = ((a[0] + a[1]) + (a[2] + a[3])) + ((b[0] + b[1]) + (b[2] + b[3])) + (((c[0] + c[1]) + (c[2] + c[3])) + ((d[0] + d[1]) + (d[2] + d[3])));
        s += __shfl_xor(s, 16); s += __shfl_xor(s, 32);
        if (fq == 0) rl[lr] = rsqrtf(s * inv_k + eps); }
    asm volatile("s_waitcnt lgkmcnt(0)" ::: "memory");
    __builtin_amdgcn_s_barrier();
#pragma unroll
    for (int ai = 0; ai < 2; ++ai)
#pragma unroll
        for (int m = 0; m < 4; ++m) rs[ai][m] = rl[ai * HALF + wr * 64 + m * 16 + fr];
}

struct EpiScale {
    static constexpr bool PERM = true, AFTER_DRAIN = false;
    bf16_t* O; int ldc; const float* part; float inv_k; float eps; int qcols; float qs; PG8_LAS float* rl;
    __device__ __forceinline__ void operator()(const f32x4 (&acc)[2][2][4][2], const Unit& u, int wr, int wc, int fr, int fq) const {
        const int row0 = u.pm * BM + wr * 64 + fr; const int col0 = u.pn * BM + wc * 32 + 8 * fq;
        const float sc = (u.pn * BM < qcols) ? qs : 1.f;
#ifdef RS_LDS
        float rsl[2][4]; row_scales_lds(rsl, rl, part, u.pm * BM, inv_k, eps, wr, wc, fr, fq);
#endif
#pragma unroll
        for (int ai = 0; ai < 2; ++ai)
#pragma unroll
            for (int m = 0; m < 4; ++m) {
                const int row = row0 + ai * HALF + m * 16;
#ifdef RS_LDS
                const float r = rsl[ai][m] * sc;
#else
                const f32x4* pp = (const f32x4*)(part + (size_t)row * NPART + fq * 16);
                const f32x4 a = pp[0], b = pp[1], c = pp[2], d = pp[3];
                float s = ((a[0] + a[1]) + (a[2] + a[3])) + ((b[0] + b[1]) + (b[2] + b[3])) + (((c[0] + c[1]) + (c[2] + c[3])) + ((d[0] + d[1]) + (d[2] + d[3])));
                s += __shfl_xor(s, 16); s += __shfl_xor(s, 32);
                const float r = rsqrtf(s * inv_k + eps) * sc;
#endif
                bf16_t* rowp = O + (size_t)row * ldc + col0;
#pragma unroll
                for (int bj = 0; bj < 2; ++bj) { const f32x4 v0 = acc[ai][bj][m][0] * r, v1 = acc[ai][bj][m][1] * r;
                    u32x4 w; w.x = cvt_pk_bf16(v0[0], v0[1]); w.y = cvt_pk_bf16(v0[2], v0[3]); w.z = cvt_pk_bf16(v1[0], v1[1]); w.w = cvt_pk_bf16(v1[2], v1[3]);
                    *(u32x4*)(rowp + bj * HALF) = w; }
            }
    }
};

template <bool BASE_F32, bool OUT_F32> struct EpiResid {
    static constexpr bool PERM = false, AFTER_DRAIN = false;
    const float* basef; float* outf; bf16_t* xn; float* part; int ldc;
    __device__ __forceinline__ void operator()(const f32x4 (&acc)[2][2][4][2], const Unit& u, int wr, int wc, int fr, int fq) const {
        typedef unsigned u32x2v __attribute__((ext_vector_type(2)));
        const int row0 = u.pm * BM + wr * 64 + fr; const int col0 = u.pn * BM + wc * 32 + 4 * fq;
#pragma unroll
        for (int ai = 0; ai < 2; ++ai)
#pragma unroll
            for (int m = 0; m < 4; ++m) {
                const int row = row0 + ai * HALF + m * 16; const size_t off = (size_t)row * ldc + col0; float ss = 0.f;
#pragma unroll
                for (int bj = 0; bj < 2; ++bj)
#pragma unroll
                    for (int n = 0; n < 2; ++n) { const size_t o2 = off + bj * HALF + n * 16;
                        f32x4 bs;
                        if (BASE_F32) bs = *(const f32x4*)(basef + o2);
                        else { const u32x2v b = *(const u32x2v*)(xn + o2); bs[0] = __builtin_bit_cast(float, b.x << 16); bs[1] = __builtin_bit_cast(float, b.x & 0xffff0000u); bs[2] = __builtin_bit_cast(float, b.y << 16); bs[3] = __builtin_bit_cast(float, b.y & 0xffff0000u); }
                        const f32x4 o = bs + acc[ai][bj][m][n];
                        if (OUT_F32) *(f32x4*)(outf + o2) = o;
                        else { u32x2v w; w.x = cvt_pk_bf16(o[0], o[1]); w.y = cvt_pk_bf16(o[2], o[3]); *(u32x2v*)(xn + o2) = w;
                            ss += (o[0] * o[0] + o[1] * o[1]) + (o[2] * o[2] + o[3] * o[3]); } }
                if (!OUT_F32) { ss += __shfl_xor(ss, 16); ss += __shfl_xor(ss, 32); if (fq == 0) part[(size_t)row * NPART + u.pn * 4 + wc] = ss; }
            }
    }
};

struct EpiResidRT {
    static constexpr bool PERM = false, AFTER_DRAIN = false;
    float* outf; bf16_t* xn; float* part; int ldc;
    __device__ __forceinline__ void operator()(const f32x4 (&acc)[2][2][4][2], const Unit& u, int wr, int wc, int fr, int fq) const {
        typedef unsigned u32x2v __attribute__((ext_vector_type(2)));
        const int row0 = u.pm * BM + wr * 64 + fr; const int col0 = u.pn * BM + wc * 32 + 4 * fq; const bool last = outf != nullptr;
#pragma unroll
        for (int ai = 0; ai < 2; ++ai)
#pragma unroll
            for (int m = 0; m < 4; ++m) {
                const int row = row0 + ai * HALF + m * 16; const size_t off = (size_t)row * ldc + col0; float ss = 0.f;
#pragma unroll
                for (int bj = 0; bj < 2; ++bj)
#pragma unroll
                    for (int n = 0; n < 2; ++n) { const size_t o2 = off + bj * HALF + n * 16;
                        const u32x2v b = *(const u32x2v*)(xn + o2); f32x4 bs; bs[0] = __builtin_bit_cast(float, b.x << 16); bs[1] = __builtin_bit_cast(float, b.x & 0xffff0000u); bs[2] = __builtin_bit_cast(float, b.y << 16); bs[3] = __builtin_bit_cast(float, b.y & 0xffff0000u);
                        const f32x4 o = bs + acc[ai][bj][m][n];
                        if (last) *(f32x4*)(outf + o2) = o;
                        else { u32x2v w; w.x = cvt_pk_bf16(o[0], o[1]); w.y = cvt_pk_bf16(o[2], o[3]); *(u32x2v*)(xn + o2) = w; }
                        ss += (o[0] * o[0] + o[1] * o[1]) + (o[2] * o[2] + o[3] * o[3]); }
                if (!last) { ss += __shfl_xor(ss, 16); ss += __shfl_xor(ss, 32); if (fq == 0) part[(size_t)row * NPART + u.pn * 4 + wc] = ss; }
            }
    }
};

__device__ __forceinline__ float dpp_ror1(float v) { return __builtin_bit_cast(float, __builtin_amdgcn_update_dpp(0, __builtin_bit_cast(int, v), 0x121, 0xf, 0xf, false)); }
__device__ __forceinline__ float dpp_ror2(float v) { return __builtin_bit_cast(float, __builtin_amdgcn_update_dpp(0, __builtin_bit_cast(int, v), 0x122, 0xf, 0xf, false)); }
__device__ __forceinline__ float dpp_shr1(float old, float v) { return __builtin_bit_cast(float, __builtin_amdgcn_update_dpp(__builtin_bit_cast(int, old), __builtin_bit_cast(int, v), 0x111, 0xf, 0xf, false)); }
__device__ __forceinline__ float dpp_shr2(float old, float v) { return __builtin_bit_cast(float, __builtin_amdgcn_update_dpp(__builtin_bit_cast(int, old), __builtin_bit_cast(int, v), 0x112, 0xf, 0xf, false)); }
__device__ __forceinline__ void conv_taps(float& acc, float cur, float prev, float w1, float w0) {
    asm("s_nop 1\n\t"
        "v_fmac_f32_dpp %0, %1, %3 row_shr:1 row_mask:0xf bank_mask:0xf\n\t"
        "v_fmac_f32_dpp %0, %1, %4 row_shr:2 row_mask:0xf bank_mask:0xf\n\t"
        "v_fmac_f32_dpp %0, %2, %3 row_shl:15 row_mask:0xf bank_mask:0xf\n\t"
        "v_fmac_f32_dpp %0, %2, %4 row_shl:14 row_mask:0xf bank_mask:0xf"
        : "+v"(acc) : "v"(cur), "v"(prev), "v"(w1), "v"(w0));
}
template <int CTRL> __device__ __forceinline__ float dppz(float v) { return __builtin_bit_cast(float, __builtin_amdgcn_update_dpp(0, __builtin_bit_cast(int, v), CTRL, 0xf, 0xf, true)); }
struct EpiConvGate {
    static constexpr bool PERM = true, AFTER_DRAIN = false;
    bf16_t* ACT; int ff; const float* part; float inv_k; float eps; const float* cw; const float* cb; float* halo; PG8_LAS float* rl;
    __device__ __forceinline__ void operator()(const f32x4 (&acc)[2][2][4][2], const Unit& u, int wr, int wc, int fr, int fq) const {
        typedef unsigned u32x2v __attribute__((ext_vector_type(2)));
        const int ff2 = 2 * ff;
        const int row0 = u.pm * BM + wr * 64 + fr; const int ch0 = u.pn * HALF + wc * 32 + 8 * fq;
        float rs[2][4];
#ifdef RS_LDS
        row_scales_lds(rs, rl, part, u.pm * BM, inv_k, eps, wr, wc, fr, fq);
#else
#pragma unroll
        for (int ai = 0; ai < 2; ++ai)
#pragma unroll
            for (int m = 0; m < 4; ++m) { const int row = row0 + ai * HALF + m * 16;
                const f32x4* pp = (const f32x4*)(part + (size_t)row * NPART + fq * 16);
                const f32x4 a = pp[0], b = pp[1], c = pp[2], d = pp[3];
                float s = ((a[0] + a[1]) + (a[2] + a[3])) + ((b[0] + b[1]) + (b[2] + b[3])) + (((c[0] + c[1]) + (c[2] + c[3])) + ((d[0] + d[1]) + (d[2] + d[3])));
                s += __shfl_xor(s, 16); s += __shfl_xor(s, 32);
                rs[ai][m] = rsqrtf(s * inv_k + eps); }
#endif
        u32x2v lo[2][4];
#pragma unroll
        for (int n = 0; n < 2; ++n) {
            const int ch = ch0 + 4 * n;
            const f32x4 wg0 = *(const f32x4*)(cw + ch), wg1 = *(const f32x4*)(cw + ff2 + ch), wg2 = *(const f32x4*)(cw + 2 * ff2 + ch), bg = *(const f32x4*)(cb + ch);
            const f32x4 wv0 = *(const f32x4*)(cw + ff + ch), wv1 = *(const f32x4*)(cw + ff2 + ff + ch), wv2 = *(const f32x4*)(cw + 2 * ff2 + ff + ch), bv = *(const f32x4*)(cb + ff + ch);
#pragma unroll
            for (int ai = 0; ai < 2; ++ai) {
                f32x4 gq = {0.f, 0.f, 0.f, 0.f}, vq = gq;
                const int grp = (u.pm * BM + ai * HALF + wr * 64) >> 6;
#pragma unroll
                for (int m = 0; m < 4; ++m) {
                    const f32x4 g = acc[ai][0][m][n] * rs[ai][m], v = acc[ai][1][m][n] * rs[ai][m];
                    f32x4 cg, cv;
#pragma unroll
                    for (int e = 0; e < 4; ++e) {
                        float a = __builtin_fmaf(wg2[e], g[e], bg[e]), b = __builtin_fmaf(wv2[e], v[e], bv[e]);
                        conv_taps(a, g[e], gq[e], wg1[e], wg0[e]); conv_taps(b, v[e], vq[e], wv1[e], wv0[e]);
                        cg[e] = a; cv[e] = b; }
                    gq = g; vq = v;
                    f32x4 o;
#pragma unroll
                    for (int e = 0; e < 4; ++e) o[e] = cg[e] * __builtin_amdgcn_rcpf(1.f + __builtin_amdgcn_exp2f(-1.4426950408889634f * cg[e])) * cv[e];
                    u32x2v w; w.x = cvt_pk_bf16(o[0], o[1]); w.y = cvt_pk_bf16(o[2], o[3]);
                    const int row = row0 + ai * HALF + m * 16;
                    if (n == 0) lo[ai][m] = w;
                    else if (!(m == 0 && fr < 2)) { u32x4 w4; w4.x = lo[ai][m].x; w4.y = lo[ai][m].y; w4.z = w.x; w4.w = w.y; *(u32x4*)(ACT + (size_t)row * ff + ch0) = w4; }
                    if ((m == 0 && fr < 2) || (m == 3 && fr >= 14)) { float* hp = halo + ((size_t)grp * 4 + (m == 0 ? fr : fr - 12)) * ff2 + ch; *(f32x4*)hp = g; *(f32x4*)(hp + ff) = v; }
                }
            }
        }
    }
};
template <class Epi, class Sched, bool ALIGN_EPI = false, bool SP2 = false>
__device__ __forceinline__ void gemm_phase(PG8_LAS unsigned char* lds, const Gemm g, const Sched& S, const Epi& E) {
    const int tid = tid_opaque(), wid = __builtin_amdgcn_readfirstlane(tid >> 6), lane = tid & 63, wr = wid >> 2, wc = wid & 3, fr = lane & 15, fq = lane >> 4;
    const int K = g.K, nt = K / BK;
    unsigned voffA[2], voffB[2];
#pragma unroll
    for (int i = 0; i < 2; ++i) { int R, C; stage_rc(tid * 16 + i * 8192, R, C); const int Rb = Epi::PERM ? ((R & ~31) + perm32(R & 31)) : R;
        voffA[i] = (unsigned)(R * K + C) * 2u; voffB[i] = (unsigned)(Rb * K + C) * 2u; }
    const size_t kstep = (size_t)(BK * 2);
    const size_t hstep = (size_t)HALF * K * 2;
    const size_t tstep = 2 * hstep;
    const unsigned ldsw = (unsigned)wid * 1024u;
    const int aoff = lds_byte(wr * 64 + fr, fq * 8), boff = lds_byte(wc * 32 + fr, fq * 8);
#define PG8_SA(b, h) (((b) * 2 + (h)) * HTB)
#define PG8_SB(b, h) ((4 + (b) * 2 + (h)) * HTB)
#define PG8_STAGE(bufoff, gbase, voff) do { _Pragma("unroll") for (int _i = 0; _i < 2; ++_i) \
        __builtin_amdgcn_global_load_lds((const unsigned*)((const char*)(gbase) + (voff)[_i]), (PG8_LAS unsigned*)(lds + (bufoff) + ldsw + _i * 8192), 16, 0, 0); } while (0)
#define PG8_LDA(dst, b, h) do { _Pragma("unroll") for (int m = 0; m < 4; ++m) _Pragma("unroll") for (int k = 0; k < 2; ++k) dst[m][k] = *(const PG8_LAS bf16x8*)(lds + PG8_SA(b, h) + aoff + m * 2048 + k * 1024); } while (0)
#define PG8_LDB(dst, b, h) do { _Pragma("unroll") for (int n = 0; n < 2; ++n) _Pragma("unroll") for (int k = 0; k < 2; ++k) dst[n][k] = *(const PG8_LAS bf16x8*)(lds + PG8_SB(b, h) + boff + n * 2048 + k * 1024); } while (0)
#define PG8_MMA(ai, bj, At, Bt) do { if (!SP2) __builtin_amdgcn_s_setprio(1); _Pragma("unroll") for (int m = 0; m < 4; ++m) _Pragma("unroll") for (int n = 0; n < 2; ++n) _Pragma("unroll") for (int k = 0; k < 2; ++k) \
        acc[ai][bj][m][n] = __builtin_amdgcn_mfma_f32_16x16x32_bf16(Bt[n][k], At[m][k], acc[ai][bj][m][n], 0, 0, 0); if (!SP2) __builtin_amdgcn_s_setprio(0); } while (0)
#ifdef PRIO_BEFORE_BAR
#define PG8_PRIO_UP_PRE __builtin_amdgcn_s_setprio(1)
#define PG8_PRIO_UP_POST do { } while (0)
#else
#define PG8_PRIO_UP_PRE do { } while (0)
#define PG8_PRIO_UP_POST __builtin_amdgcn_s_setprio(1)
#endif
#define PG8_WAIT_V(n) asm volatile("s_waitcnt vmcnt(" #n ")" ::: "memory")
#define PG8_WAIT_L(n) asm volatile("s_waitcnt lgkmcnt(" #n ")" ::: "memory")
#define PG8_BAR __builtin_amdgcn_s_barrier()
#define PG8_SCHED __builtin_amdgcn_sched_barrier(0)
    Unit cur, nxt; int ui = 0;
    if (!S.next(0, cur)) return;
    f32x4 acc[2][2][4][2];
#pragma unroll
    for (int a = 0; a < 2; ++a)
#pragma unroll
        for (int b = 0; b < 2; ++b)
#pragma unroll
            for (int m = 0; m < 4; ++m)
#pragma unroll
                for (int n = 0; n < 2; ++n) acc[a][b][m][n] = (f32x4){0.f, 0.f, 0.f, 0.f};
    bf16x8 At[4][2], B0[2][2], B1[2][2];
    const char* cA = (const char*)g.A + (size_t)cur.pm * tstep; const char* cB = (const char*)g.Bt + (size_t)cur.pn * tstep;
    S.a_ready(cur);
    if constexpr (SP2) {
        PG8_STAGE(PG8_SB(0, 0), cB, voffB); PG8_STAGE(PG8_SB(0, 1), cB + hstep, voffB); PG8_STAGE(PG8_SA(0, 0), cA, voffA); PG8_STAGE(PG8_SA(0, 1), cA + hstep, voffA);
        if (wr == 1) PG8_BAR;
        PG8_WAIT_V(2); PG8_BAR;
        PG8_STAGE(PG8_SB(1, 0), cB + kstep, voffB); PG8_STAGE(PG8_SA(1, 0), cA + kstep, voffA); PG8_STAGE(PG8_SB(1, 1), cB + hstep + kstep, voffB);
        PG8_WAIT_V(6); PG8_BAR;
    } else {
        PG8_STAGE(PG8_SB(0, 0), cB, voffB); PG8_STAGE(PG8_SA(0, 0), cA, voffA); PG8_STAGE(PG8_SB(0, 1), cB + hstep, voffB); PG8_STAGE(PG8_SA(0, 1), cA + hstep, voffA);
        if (wr == 1) PG8_BAR;
        PG8_WAIT_V(4); PG8_BAR;
        PG8_STAGE(PG8_SB(1, 0), cB + kstep, voffB); PG8_STAGE(PG8_SA(1, 0), cA + kstep, voffA); PG8_STAGE(PG8_SB(1, 1), cB + hstep + kstep, voffB);
        PG8_WAIT_V(6); PG8_BAR;
    }
    for (;;) {
        const bool has_next = S.next(ui + 1, nxt);
        const char* nA = has_next ? (const char*)g.A + (size_t)nxt.pm * tstep : cA; const char* nB = has_next ? (const char*)g.Bt + (size_t)nxt.pn * tstep : cB;
        for (int t = 0; t < nt; t += 2) {
            const bool last = (t == nt - 2);
            const char* a1 = cA + (size_t)(t + 1) * kstep;
            const char* a2 = last ? nA : cA + (size_t)(t + 2) * kstep; const char* b2 = last ? nB : cB + (size_t)(t + 2) * kstep;
            const char* a3 = a2 + kstep; const char* b3 = b2 + kstep;
            if (last && has_next) S.a_ready(nxt);
            if constexpr (SP2) {
            PG8_LDB(B0, 0, 0); PG8_LDB(B1, 0, 1); PG8_SCHED; PG8_LDA(At, 0, 0); PG8_STAGE(PG8_SA(1, 1), a1 + hstep, voffA);
            PG8_WAIT_V(8); PG8_WAIT_L(0); PG8_PRIO_UP_PRE; PG8_BAR; PG8_PRIO_UP_POST; PG8_MMA(0, 0, At, B0); PG8_MMA(0, 1, At, B1); __builtin_amdgcn_s_setprio(0); PG8_BAR; PG8_SCHED;
            PG8_LDA(At, 0, 1); PG8_STAGE(PG8_SB(0, 0), b2, voffB); PG8_STAGE(PG8_SB(0, 1), b2 + hstep, voffB); PG8_STAGE(PG8_SA(0, 0), a2, voffA);
            PG8_WAIT_V(8); PG8_WAIT_L(0); PG8_PRIO_UP_PRE; PG8_BAR; PG8_PRIO_UP_POST; PG8_MMA(1, 0, At, B0); PG8_MMA(1, 1, At, B1); __builtin_amdgcn_s_setprio(0); PG8_BAR; PG8_SCHED;
            PG8_LDB(B0, 1, 0); PG8_LDB(B1, 1, 1); PG8_SCHED; PG8_LDA(At, 1, 0); PG8_STAGE(PG8_SA(0, 1), a2 + hstep, voffA);
            PG8_WAIT_V(8); PG8_WAIT_L(0); PG8_PRIO_UP_PRE; PG8_BAR; PG8_PRIO_UP_POST; PG8_MMA(0, 0, At, B0); PG8_MMA(0, 1, At, B1); __builtin_amdgcn_s_setprio(0); PG8_BAR; PG8_SCHED;
            PG8_LDA(At, 1, 1); PG8_STAGE(PG8_SB(1, 0), b3, voffB); PG8_STAGE(PG8_SB(1, 1), b3 + hstep, voffB); PG8_STAGE(PG8_SA(1, 0), a3, voffA);
            PG8_WAIT_V(8); PG8_WAIT_L(0); PG8_PRIO_UP_PRE; PG8_BAR; PG8_PRIO_UP_POST; PG8_MMA(1, 0, At, B0); PG8_MMA(1, 1, At, B1); __builtin_amdgcn_s_setprio(0); PG8_BAR; PG8_SCHED;
            } else {
            PG8_LDB(B0, 0, 0); PG8_SCHED; PG8_LDA(At, 0, 0); PG8_STAGE(PG8_SA(1, 1), a1 + hstep, voffA);
            PG8_WAIT_L(8); PG8_BAR; PG8_WAIT_L(0); PG8_MMA(0, 0, At, B0); PG8_BAR; PG8_SCHED;
            PG8_LDB(B1, 0, 1); PG8_STAGE(PG8_SB(0, 0), b2, voffB);
            PG8_BAR; PG8_WAIT_L(0); PG8_MMA(0, 1, At, B1); PG8_BAR;
            PG8_LDA(At, 0, 1); PG8_STAGE(PG8_SA(0, 0), a2, voffA);
            PG8_BAR; PG8_WAIT_L(0); PG8_MMA(1, 0, At, B0); PG8_BAR; PG8_SCHED;
            PG8_STAGE(PG8_SB(0, 1), b2 + hstep, voffB);
            PG8_WAIT_V(6); PG8_BAR; PG8_MMA(1, 1, At, B1); PG8_BAR;
            PG8_LDB(B0, 1, 0); PG8_SCHED; PG8_LDA(At, 1, 0); PG8_STAGE(PG8_SA(0, 1), a2 + hstep, voffA);
            PG8_WAIT_L(8); PG8_BAR; PG8_WAIT_L(0); PG8_MMA(0, 0, At, B0); PG8_BAR; PG8_SCHED;
            PG8_LDB(B1, 1, 1); PG8_STAGE(PG8_SB(1, 0), b3, voffB);
            PG8_BAR; PG8_WAIT_L(0); PG8_MMA(0, 1, At, B1); PG8_BAR;
            PG8_LDA(At, 1, 1); PG8_STAGE(PG8_SA(1, 0), a3, voffA);
            PG8_BAR; PG8_WAIT_L(0); PG8_MMA(1, 0, At, B0); PG8_BAR; PG8_SCHED;
            PG8_STAGE(PG8_SB(1, 1), b3 + hstep, voffB);
            PG8_WAIT_V(6); PG8_BAR; PG8_MMA(1, 1, At, B1); PG8_BAR;
            }
        }
        if constexpr (ALIGN_EPI) { if (wr == 0) PG8_BAR; }
        if constexpr (!Epi::AFTER_DRAIN) { E(acc, cur, wr, wc, fr, fq); S.done(cur); }
        if (!has_next) break;
#pragma unroll
        for (int a = 0; a < 2; ++a)
#pragma unroll
            for (int b = 0; b < 2; ++b)
#pragma unroll
                for (int m = 0; m < 4; ++m)
#pragma unroll
                    for (int n = 0; n < 2; ++n) acc[a][b][m][n] = (f32x4){0.f, 0.f, 0.f, 0.f};
        cur = nxt; cA = nA; cB = nB; ++ui;
        if constexpr (ALIGN_EPI) { if (wr == 1) PG8_BAR; }
    }
    PG8_WAIT_V(0);
    if constexpr (!ALIGN_EPI) { if (wr == 0) PG8_BAR; }
    PG8_BAR;
    if constexpr (Epi::AFTER_DRAIN) { E.fused(acc, cur, wr, wc, fr, fq, lds, wid, lane); S.done(cur); }
#undef PG8_SA
#undef PG8_SB
#undef PG8_STAGE
#undef PG8_LDA
#undef PG8_LDB
#undef PG8_MMA
#undef PG8_WAIT_V
#undef PG8_WAIT_L
#undef PG8_BAR
#undef PG8_SCHED
}
}
namespace att {
using bf16 = unsigned short;
typedef short bf16x8 __attribute__((ext_vector_type(8)));
typedef short s16x4 __attribute__((ext_vector_type(4)));
typedef float f32x16 __attribute__((ext_vector_type(16)));
typedef float f32x4 __attribute__((ext_vector_type(4)));
typedef unsigned u32x4 __attribute__((ext_vector_type(4)));
constexpr int D = 128, NW = 8, QBLK = 32, KVBLK = 64, QB = NW * QBLK;
constexpr int SHM_V = KVBLK * D * 2, SHM_K = KVBLK * D * 2;
constexpr int LDS_BYTES = 2 * SHM_V + 2 * SHM_K + NW * 64 * 4;
#define KSWZ(row, colB) ((row) * 256 + ((colB) ^ (((row) & 7) << 4)))
#define SBAR() __builtin_amdgcn_sched_barrier(0)
__device__ __forceinline__ int v_st(int k, int c) { const int kk = (k & ~0xC) | ((k & 4) << 1) | ((k & 8) >> 1); return ((kk >> 3) * 4 + (c >> 5)) * 512 + ((kk & 7) * 32 + (c & 31)) * 2; }
__device__ __forceinline__ int v_rd_base(int lane) { return ((lane & 3) << 3) | (((lane >> 2) & 3) << 6) | (((lane >> 4) & 1) << 5) | (((lane >> 5) & 1) << 8); }
constexpr int v_rd_off(int d0, int ks, int half) { return d0 * 512 + ks * 4096 + half * 2048; }
__device__ __forceinline__ int crow(int r, int hi) { return (r & 3) + 8 * (r >> 2) + 4 * hi; }
__device__ __forceinline__ unsigned cvtpk(float lo, float hi) { unsigned r; asm volatile("v_cvt_pk_bf16_f32 %0, %1, %2" : "=v"(r) : "v"(lo), "v"(hi)); return r; }
__device__ __forceinline__ bf16x8 load8(const bf16* p) { return *reinterpret_cast<const bf16x8*>(p); }

#define PK4(P, B_, OUT) do { unsigned a0 = cvtpk(P[B_+0], P[B_+1]), a1 = cvtpk(P[B_+2], P[B_+3]);                          \
        unsigned b0 = cvtpk(P[B_+4], P[B_+5]), b1 = cvtpk(P[B_+6], P[B_+7]);                                             \
        auto r0 = __builtin_amdgcn_permlane32_swap(a0, b0, false, false); auto r1 = __builtin_amdgcn_permlane32_swap(a1, b1, false, false); \
        u32x4 w = {r0[0], r1[0], r0[1], r1[1]}; OUT = *reinterpret_cast<bf16x8*>(&w); } while (0)

__device__ __forceinline__ void qkt_rt(f32x16& p0, f32x16& p1, const char* Kt, int r32, int hi, const bf16x8* qr) {
    p0 = f32x16{}; p1 = f32x16{};
    const char* kb[4];
#pragma unroll
    for (int dd = 0; dd < 4; ++dd) kb[dd] = Kt + KSWZ(r32, (dd * 16 + hi * 8) * 2);
#pragma unroll
    for (int d0 = 0; d0 < 8; ++d0) { const char* a = kb[d0 & 3] + (d0 >> 2) * 128;
        bf16x8 b0 = *reinterpret_cast<const bf16x8*>(a);
        bf16x8 b1 = *reinterpret_cast<const bf16x8*>(a + 32 * 256);
        p0 = __builtin_amdgcn_mfma_f32_32x32x16_bf16(b0, qr[d0], p0, 0, 0, 0);
        p1 = __builtin_amdgcn_mfma_f32_32x32x16_bf16(b1, qr[d0], p1, 0, 0, 0); }
}
__device__ __forceinline__ void pv_rt(f32x16* o, int vb, bf16x8 pa0, bf16x8 pa1, bf16x8 pa2, bf16x8 pa3) {
#define TRRD(dst, off) asm volatile("ds_read_b64_tr_b16 %0, %1 offset:%2" : "=&v"(dst) : "v"(vb), "i"(off) : "memory")
#define PV_D0(d0) do { s16x4 l0, l1, l2, l3, h0, h1, h2, h3; constexpr int b_ = v_rd_off(d0, 0, 0); \
        TRRD(l0, b_); TRRD(h0, b_ + 2048); TRRD(l1, b_ + 4096); TRRD(h1, b_ + 6144); TRRD(l2, b_ + 8192); TRRD(h2, b_ + 10240); TRRD(l3, b_ + 12288); TRRD(h3, b_ + 14336); \
        asm volatile("s_waitcnt lgkmcnt(0)" ::: "memory"); SBAR();   \
        o[d0] = __builtin_amdgcn_mfma_f32_32x32x16_bf16(pa0, (bf16x8){l0[0], l0[1], l0[2], l0[3], h0[0], h0[1], h0[2], h0[3]}, o[d0], 0, 0, 0);   \
        o[d0] = __builtin_amdgcn_mfma_f32_32x32x16_bf16(pa1, (bf16x8){l1[0], l1[1], l1[2], l1[3], h1[0], h1[1], h1[2], h1[3]}, o[d0], 0, 0, 0);   \
        o[d0] = __builtin_amdgcn_mfma_f32_32x32x16_bf16(pa2, (bf16x8){l2[0], l2[1], l2[2], l2[3], h2[0], h2[1], h2[2], h2[3]}, o[d0], 0, 0, 0);   \
        o[d0] = __builtin_amdgcn_mfma_f32_32x32x16_bf16(pa3, (bf16x8){l3[0], l3[1], l3[2], l3[3], h3[0], h3[1], h3[2], h3[3]}, o[d0], 0, 0, 0); } while (0)
    PV_D0(0); PV_D0(1); PV_D0(2); PV_D0(3);
#undef PV_D0
#undef TRRD
}

constexpr float SB_DONE = 1e-30f;
__device__ __forceinline__ void sb_half(f32x16& p, float& carry, int dq, bool needmask, bool lane_hi) {
    float kp[16];
#pragma unroll
    for (int r = 0; r < 16; ++r) {
        const float zz = fminf(p[r], 100.f);
        const float e = __builtin_amdgcn_exp2f(zz);
        float k = __builtin_amdgcn_rcpf(1.f + e);
        float be = e * k;
        if (needmask) { const int c = 8 * (r >> 2) + (r & 3); const bool valid = (dq - c) > 0; k = valid ? k : 1.f; be = valid ? be : 0.f; }
        kp[r] = k; p[r] = be;
    }
    float L[4], H[4];
#pragma unroll
    for (int j = 0; j < 4; ++j) { const float g = (kp[4 * j] * kp[4 * j + 1]) * (kp[4 * j + 2] * kp[4 * j + 3]);
        auto rr = __builtin_amdgcn_permlane32_swap(__float_as_uint(g), __float_as_uint(g), false, false);
        L[j] = __uint_as_float(rr[0]); H[j] = __uint_as_float(rr[1]); }
    float U[4]; U[3] = 1.f; U[2] = L[3] * H[3]; U[1] = U[2] * (L[2] * H[2]); U[0] = U[1] * (L[1] * H[1]);
    const float tot = U[0] * (L[0] * H[0]);
#pragma unroll
    for (int j = 0; j < 4; ++j) {
        const float a3 = carry * U[j] * (lane_hi ? 1.f : H[j]);
        const float a2 = a3 * kp[4 * j + 3], a1 = a2 * kp[4 * j + 2], a0 = a1 * kp[4 * j + 1];
        p[4 * j + 3] *= a3; p[4 * j + 2] *= a2; p[4 * j + 1] *= a1; p[4 * j] *= a0;
    }
    carry *= tot;
}

template <int PQ, int PK, int PV, int PO>
__device__ __forceinline__ void sb_block(const bf16* Q, const bf16* K, const bf16* V, bf16* O, int P0, char* lds, volatile __attribute__((address_space(3))) unsigned* flags) {
    const int tid = pg8::tid_opaque(), wid = __builtin_amdgcn_readfirstlane(tid >> 6), lane = tid & 63, r32 = lane & 31, hi = lane >> 5;
    char* K_lds = lds; char* V_lds = lds + 2 * SHM_K;
    const int sr = tid >> 4, sc = (tid & 15) * 8, vst0 = v_st(sr, sc), vst1 = v_st(32 + sr, sc), kws = KSWZ(sr, sc * 2);
    const int vb0 = (int)(uintptr_t)V_lds + v_rd_base(lane);
    bf16x8 qr[8];
#pragma unroll
    for (int d0 = 0; d0 < 8; ++d0) qr[d0] = load8(Q + (size_t)(wid * QBLK + r32) * PQ + d0 * 16 + hi * 8);
    f32x16 o[4] = {};
    float carry = 1.f;
    const int qlo = P0 + wid * QBLK, qpos = qlo + r32;
    int j = P0 / KVBLK + 3;
    bf16x8 st_k0, st_k1, st_v0, st_v1;
#define SB_LOAD(jt) do { const size_t k0_ = (size_t)(jt) * KVBLK; st_k0 = load8(K + (k0_ + sr) * PK + sc); st_k1 = load8(K + (k0_ + 32 + sr) * PK + sc); \
                         st_v0 = load8(V + (k0_ + sr) * PV + sc); st_v1 = load8(V + (k0_ + 32 + sr) * PV + sc); } while (0)
#define SB_WRITE(bf) do { *(bf16x8*)(K_lds + (bf) * SHM_K + kws) = st_k0; *(bf16x8*)(K_lds + (bf) * SHM_K + kws + 32 * 256) = st_k1; \
                          *(bf16x8*)(V_lds + (bf) * SHM_V + vst0) = st_v0; *(bf16x8*)(V_lds + (bf) * SHM_V + vst1) = st_v1; } while (0)
    SB_LOAD(j); asm volatile("s_waitcnt vmcnt(0)" ::: "memory"); SB_WRITE(0);
    __syncthreads();
    int buf = 0, it = 0; bool wdone = false;
    for (;;) {
        const int kb = j * KVBLK; const bool more = j > 0;
        if (more) SB_LOAD(j - 1);
        const bool act = !wdone && (kb < qlo + QBLK - 1);
        if (act) {
            f32x16 p0, p1;
            qkt_rt(p0, p1, K_lds + buf * SHM_K, r32, hi, qr);
            const bool needmask = kb + KVBLK - 1 >= qlo;
            sb_half(p1, carry, qpos - (kb + 32) - 4 * hi, needmask, hi != 0);
            sb_half(p0, carry, qpos - kb - 4 * hi, needmask, hi != 0);
            bf16x8 pa0, pa1, pa2, pa3;
            PK4(p0, 0, pa0); PK4(p0, 8, pa1); PK4(p1, 0, pa2); PK4(p1, 8, pa3);
            SBAR();
            pv_rt(o, vb0 + buf * SHM_V, pa0, pa1, pa2, pa3);
            wdone = __all(carry < SB_DONE);
        }
        if (more) { asm volatile("s_waitcnt vmcnt(0)" ::: "memory"); SB_WRITE(buf ^ 1); }
        if (lane == 0) flags[(it & 1) * 8 + wid] = wdone ? 1u : 0u;
        __syncthreads();
        unsigned alld = 1u;
#pragma unroll
        for (int w = 0; w < NW; ++w) alld &= flags[(it & 1) * 8 + w];
        if (!more || alld) break;
        --j; buf ^= 1; ++it;
    }
#undef SB_LOAD
#undef SB_WRITE
    bf16* Ow = O + (size_t)(wid * QBLK) * PO;
#pragma unroll
    for (int r = 0; r < 16; ++r) { const int orow = crow(r, hi);
#pragma unroll
        for (int d0 = 0; d0 < 4; ++d0) { const float v = o[d0][r]; const float vn = __shfl_xor(v, 1);
            if ((r32 & 1) == 0) *(unsigned*)(Ow + (size_t)orow * PO + d0 * 32 + r32) = cvtpk(v, vn); } }
    __syncthreads();
}

constexpr float THR2 = 8.f * 1.4426950408889634f;
struct DiffRef { const bf16* Q; const bf16* K; const bf16* V; bf16* O; int P0; int mode; };
struct DiffConst { float lam; float omli; float eps; const float* gain; float* scr; };
template <int PQ, int PK, int PV, int PO>
__device__ __forceinline__ void sm_block(const DiffRef& cur, const DiffConst& C, char* lds) {
    const int tid = pg8::tid_opaque(), wid = __builtin_amdgcn_readfirstlane(tid >> 6), lane = tid & 63, r32 = lane & 31, hi = lane >> 5;
    char* K_lds = lds; char* V_lds = lds + 2 * SHM_K; float* al_l = (float*)(lds + 2 * SHM_K + 2 * SHM_V) + wid * 32;
    const int sr = tid >> 4, sc = (tid & 15) * 8, vst0 = v_st(sr, sc), vst1 = v_st(32 + sr, sc), kws = KSWZ(sr, sc * 2);
    const int vb0 = (int)(uintptr_t)V_lds + v_rd_base(lane);
    const bf16* Q = cur.Q; const bf16* K = cur.K; const bf16* V = cur.V; const int P0 = cur.P0;
    bf16x8 qr[8];
#pragma unroll
    for (int d0 = 0; d0 < 8; ++d0) qr[d0] = load8(Q + (size_t)(wid * QBLK + r32) * PQ + d0 * 16 + hi * 8);
    f32x16 o[4] = {};
    float m_reg = -1e30f, l_reg = 0.f;
    const int qlo = P0 + wid * QBLK, qm = qlo + r32 - 4 * hi;
    const int NT = P0 / KVBLK + 4;
    bf16x8 st_k0, st_k1, st_v0, st_v1;
#define SM_LOAD(jt) do { const size_t k0_ = (size_t)(jt) * KVBLK; st_k0 = load8(K + (k0_ + sr) * PK + sc); st_k1 = load8(K + (k0_ + 32 + sr) * PK + sc); \
                         st_v0 = load8(V + (k0_ + sr) * PV + sc); st_v1 = load8(V + (k0_ + 32 + sr) * PV + sc); } while (0)
#define SM_WRITE(bf) do { *(bf16x8*)(K_lds + (bf) * SHM_K + kws) = st_k0; *(bf16x8*)(K_lds + (bf) * SHM_K + kws + 32 * 256) = st_k1; \
                          *(bf16x8*)(V_lds + (bf) * SHM_V + vst0) = st_v0; *(bf16x8*)(V_lds + (bf) * SHM_V + vst1) = st_v1; } while (0)
    SM_LOAD(0); asm volatile("s_waitcnt vmcnt(0)" ::: "memory"); SM_WRITE(0);
    __syncthreads();
    int buf = 0;
    for (int t = 0; t < NT; ++t) {
        const int kb = t * KVBLK; const bool more = t + 1 < NT;
        if (more) SM_LOAD(t + 1);
        if (kb <= qlo + QBLK - 1) {
            f32x16 p0, p1;
            qkt_rt(p0, p1, K_lds + buf * SHM_K, r32, hi, qr);
            if (kb + KVBLK - 1 > qlo) {
                const int dq = qm - kb; const float NEG = -__builtin_inff();
#pragma unroll
                for (int r = 0; r < 16; ++r) { const int c = (r & 3) + 8 * (r >> 2); if ((dq - c) < 0) p0[r] = NEG; if ((dq - c - 32) < 0) p1[r] = NEG; }
            }
            float pmax = p0[0];
#pragma unroll
            for (int r = 1; r < 16; ++r) pmax = fmaxf(pmax, p0[r]);
#pragma unroll
            for (int r = 0; r < 16; ++r) pmax = fmaxf(pmax, p1[r]);
            { auto rr = __builtin_amdgcn_permlane32_swap(__float_as_uint(pmax), __float_as_uint(pmax), false, false); pmax = fmaxf(__uint_as_float(rr[0]), __uint_as_float(rr[1])); }
            float alpha = 1.f;
            if (!__all((pmax - m_reg) <= THR2)) {
                const float mn = fmaxf(m_reg, pmax); alpha = __builtin_amdgcn_exp2f(m_reg - mn); m_reg = mn;
                if (hi == 0) al_l[r32] = alpha; asm volatile("s_waitcnt lgkmcnt(0)" ::: "memory");
#pragma unroll
                for (int d_ = 0; d_ < 4; ++d_)
#pragma unroll
                    for (int r = 0; r < 16; ++r) o[d_][r] *= al_l[crow(r, hi)];
            }
            float ps = 0.f;
#pragma unroll
            for (int r = 0; r < 16; ++r) { p0[r] = __builtin_amdgcn_exp2f(p0[r] - m_reg); ps += p0[r]; }
#pragma unroll
            for (int r = 0; r < 16; ++r) { p1[r] = __builtin_amdgcn_exp2f(p1[r] - m_reg); ps += p1[r]; }
            { auto rr = __builtin_amdgcn_permlane32_swap(__float_as_uint(ps), __float_as_uint(ps), false, false); ps = __uint_as_float(rr[0]) + __uint_as_float(rr[1]); }
            l_reg = l_reg * alpha + ps;
            bf16x8 pa0, pa1, pa2, pa3;
            PK4(p0, 0, pa0); PK4(p0, 8, pa1); PK4(p1, 0, pa2); PK4(p1, 8, pa3);
            SBAR();
            pv_rt(o, vb0 + buf * SHM_V, pa0, pa1, pa2, pa3);
        }
        if (more) { asm volatile("s_waitcnt vmcnt(0)" ::: "memory"); SM_WRITE(buf ^ 1); }
        __syncthreads();
        buf ^= 1;
    }
#undef SM_LOAD
#undef SM_WRITE
    if (hi == 0) al_l[r32] = l_reg; asm volatile("s_waitcnt lgkmcnt(0)" ::: "memory");
    float rli[16];
#pragma unroll
    for (int r = 0; r < 16; ++r) rli[r] = __builtin_amdgcn_rcpf(al_l[crow(r, hi)]);
#define OPQ(v) asm volatile("" : "+v"(v))
    char* sA = (char*)C.scr; char* sB = sA + 16384;
    const unsigned lo16 = (unsigned)lane * 16u;
    const int mode = cur.mode;
    if (mode == 0 || mode == 1) { char* s = mode ? sB : sA;
#pragma unroll
        for (int r = 0; r < 16; ++r) { unsigned vo = lo16; OPQ(vo);
            const f32x4 v = {o[0][r] * rli[r], o[1][r] * rli[r], o[2][r] * rli[r], o[3][r] * rli[r]};
            *(f32x4*)(s + (size_t)(vo + r * 1024)) = v; }
    } else if (mode == 2) {
#pragma unroll
        for (int r = 0; r < 16; ++r) { unsigned vo = lo16; OPQ(vo);
            f32x4* ap = (f32x4*)(sA + (size_t)(vo + r * 1024)); const f32x4 a = *ap;
            const f32x4 v = {a[0] - C.lam * (o[0][r] * rli[r]), a[1] - C.lam * (o[1][r] * rli[r]), a[2] - C.lam * (o[2][r] * rli[r]), a[3] - C.lam * (o[3][r] * rli[r])};
            *ap = v;
            if ((r & 3) == 3) asm volatile("" ::: "memory"); }
    } else {
        float g0[4], g1[4];
#pragma unroll
        for (int d0 = 0; d0 < 4; ++d0) { g0[d0] = C.gain[d0 * 32 + r32]; g1[d0] = C.gain[128 + d0 * 32 + r32]; }
        char* Ow = (char*)(cur.O + (size_t)(wid * QBLK) * PO);
        const unsigned lo_o = (unsigned)((4 * hi) * PO + r32) * 2u;
#pragma unroll
        for (int r = 0; r < 16; ++r) { unsigned vo = lo16; OPQ(vo);
            const f32x4 a = *(const f32x4*)(sA + (size_t)(vo + r * 1024)); const f32x4 b = *(const f32x4*)(sB + (size_t)(vo + r * 1024));
            float d1[4], ss = 0.f;
#pragma unroll
            for (int d0 = 0; d0 < 4; ++d0) { d1[d0] = b[d0] - C.lam * (o[d0][r] * rli[r]); ss += d1[d0] * d1[d0] + a[d0] * a[d0]; }
            ss += __shfl_xor(ss, 1); ss += __shfl_xor(ss, 2); ss += __shfl_xor(ss, 4); ss += __shfl_xor(ss, 8); ss += __shfl_xor(ss, 16);
            const float scl = rsqrtf(ss * (1.f / 256.f) + C.eps) * C.omli;
            unsigned wo = lo_o; OPQ(wo);
            char* rowp = Ow + (size_t)(wo + (unsigned)(((r & 3) + 8 * (r >> 2)) * PO * 2));
#pragma unroll
            for (int d0 = 0; d0 < 4; ++d0) {
                const float v0 = a[d0] * scl * g0[d0], v1 = d1[d0] * scl * g1[d0];
                const float v0n = __shfl_xor(v0, 1), v1n = __shfl_xor(v1, 1);
                if ((r32 & 1) == 0) { *(unsigned*)(rowp + d0 * 64) = cvtpk(v0, v0n); *(unsigned*)(rowp + 256 + d0 * 64) = cvtpk(v1, v1n); }
            }
            if ((r & 1) == 1) asm volatile("" ::: "memory");
        }
    }
#undef OPQ
    __syncthreads();
}

constexpr int K2 = 32;
constexpr int ST2_K0 = 0, ST2_K1 = 8192, ST2_V = 16384, ST2_BYTES = 32768;
__device__ __forceinline__ int v_st2(int k, int c) { const int kk = (k & ~0xC) | ((k & 4) << 1) | ((k & 8) >> 1); return ((kk >> 3) * 8 + (c >> 5)) * 512 + ((kk & 7) * 32 + (c & 31)) * 2; }
struct Diff2Const { float lam; float omli; float eps; float mb; const float* gain; };
template <int PQ, int PK, int PV, int PO>
__device__ __forceinline__ void diff2_block(const bf16* Qb  , const bf16* Kb  , const bf16* Vb  ,
                                            bf16* Ob, int P0, const Diff2Const& C, char* lds) {
    const int tid = pg8::tid_opaque(), wid = __builtin_amdgcn_readfirstlane(tid >> 6), lane = tid & 63, r32 = lane & 31, hi = lane >> 5;
    const int rg = wid & 3, cc = wid >> 2;
    const int krow = tid >> 4, kcol = (tid & 15) * 8, kws = KSWZ(krow, kcol * 2);
    const int vrow0 = tid >> 5, vcol = (tid & 31) * 8, vst0 = v_st2(vrow0, vcol), vst1 = v_st2(16 + vrow0, vcol);
    const int vb0 = (int)(uintptr_t)lds + ST2_V + v_rd_base(lane);
    const char* Kmine = lds + (cc ? ST2_K1 : ST2_K0);
    bf16x8 qr[8];
    { unsigned qo = (unsigned)((rg * QBLK + r32) * PQ + cc * 128 + hi * 8) * 2u; asm volatile("" : "+v"(qo));
#pragma unroll
      for (int d0 = 0; d0 < 8; ++d0) qr[d0] = *(const bf16x8*)((const char*)Qb + (size_t)qo + d0 * 32); }
    f32x16 o[8];
#pragma unroll
    for (int d0 = 0; d0 < 8; ++d0) o[d0] = f32x16{};
    float l_reg = 0.f;
    const int qlo = P0 + rg * QBLK, qm = qlo + r32 - 4 * hi;
    const int NT = P0 / K2 + 4;
    bf16x8 st_k0, st_k1, st_v0, st_v1;
    const unsigned koff = (unsigned)(krow * PK + kcol) * 2u, voffa = (unsigned)(vrow0 * PV + vcol) * 2u, voffb = (unsigned)((16 + vrow0) * PV + vcol) * 2u;
#define D2_LOAD(jt) do { const char* kt_ = (const char*)Kb + (size_t)(jt) * (K2 * PK * 2); const char* vt_ = (const char*)Vb + (size_t)(jt) * (K2 * PV * 2); \
                         unsigned ko_ = koff, va_ = voffa, vb_ = voffb; asm volatile("" : "+v"(ko_), "+v"(va_), "+v"(vb_)); \
                         st_k0 = *(const bf16x8*)(kt_ + (size_t)ko_); st_k1 = *(const bf16x8*)(kt_ + (size_t)ko_ + 256); \
                         st_v0 = *(const bf16x8*)(vt_ + (size_t)va_); st_v1 = *(const bf16x8*)(vt_ + (size_t)vb_); } while (0)
#define D2_WRITE(bf) do { char* st_ = lds + (bf) * ST2_BYTES; *(bf16x8*)(st_ + ST2_K0 + kws) = st_k0; *(bf16x8*)(st_ + ST2_K1 + kws) = st_k1; \
                          *(bf16x8*)(st_ + ST2_V + vst0) = st_v0; *(bf16x8*)(st_ + ST2_V + vst1) = st_v1; } while (0)
    D2_LOAD(0); asm volatile("s_waitcnt vmcnt(0)" ::: "memory"); D2_WRITE(0);
    __syncthreads();
    int buf = 0;
    for (int t = 0; t < NT; ++t) {
        const int kb = t * K2; const bool more = t + 1 < NT;
        if (more) D2_LOAD(t + 1);
        if (kb <= qlo + QBLK - 1) {
            f32x16 p0 = f32x16{};
            { const char* Kt = Kmine + buf * ST2_BYTES; const char* kbp[4];
#pragma unroll
              for (int dd = 0; dd < 4; ++dd) kbp[dd] = Kt + KSWZ(r32, (dd * 16 + hi * 8) * 2);
#pragma unroll
              for (int d0 = 0; d0 < 8; ++d0) { const bf16x8 b0 = *reinterpret_cast<const bf16x8*>(kbp[d0 & 3] + (d0 >> 2) * 128); p0 = __builtin_amdgcn_mfma_f32_32x32x16_bf16(b0, qr[d0], p0, 0, 0, 0); } }
            const float mb = C.mb;
            if (kb + K2 - 1 > qlo) {
                const int dq = qm - kb;
#pragma unroll
                for (int r = 0; r < 16; ++r) { const int c = (r & 3) + 8 * (r >> 2); const float e = __builtin_amdgcn_exp2f(p0[r] - mb); p0[r] = (dq - c) >= 0 ? e : 0.f; }
            } else {
#pragma unroll
                for (int r = 0; r < 16; ++r) p0[r] = __builtin_amdgcn_exp2f(p0[r] - mb);
            }
            float ps = 0.f;
#pragma unroll
            for (int r = 0; r < 16; ++r) ps += p0[r];
            l_reg += ps;
            bf16x8 pa0, pa1;
            PK4(p0, 0, pa0); PK4(p0, 8, pa1);
            SBAR();
            const int vb = vb0 + buf * ST2_BYTES;
#define TRRD(dst, off) asm volatile("ds_read_b64_tr_b16 %0, %1 offset:%2" : "=&v"(dst) : "v"(vb), "i"(off) : "memory")
#define PV2_RD(d0, L0, H0, L1, H1) do { constexpr int b_ = (d0) * 512; TRRD(L0, b_); TRRD(H0, b_ + 4096); TRRD(L1, b_ + 8192); TRRD(H1, b_ + 12288); } while (0)
#define PV2_MM(d0, L0, H0, L1, H1) do { \
        o[d0] = __builtin_amdgcn_mfma_f32_32x32x16_bf16(pa0, (bf16x8){L0[0], L0[1], L0[2], L0[3], H0[0], H0[1], H0[2], H0[3]}, o[d0], 0, 0, 0); \
        o[d0] = __builtin_amdgcn_mfma_f32_32x32x16_bf16(pa1, (bf16x8){L1[0], L1[1], L1[2], L1[3], H1[0], H1[1], H1[2], H1[3]}, o[d0], 0, 0, 0); } while (0)
#define LGK(n) do { asm volatile("s_waitcnt lgkmcnt(" #n ")" ::: "memory"); SBAR(); } while (0)
            { s16x4 la0, ha0, la1, ha1, lb0, hb0, lb1, hb1;
              PV2_RD(0, la0, ha0, la1, ha1);
              PV2_RD(1, lb0, hb0, lb1, hb1); LGK(4); PV2_MM(0, la0, ha0, la1, ha1);
              PV2_RD(2, la0, ha0, la1, ha1); LGK(4); PV2_MM(1, lb0, hb0, lb1, hb1);
              PV2_RD(3, lb0, hb0, lb1, hb1); LGK(4); PV2_MM(2, la0, ha0, la1, ha1);
              PV2_RD(4, la0, ha0, la1, ha1); LGK(4); PV2_MM(3, lb0, hb0, lb1, hb1);
              PV2_RD(5, lb0, hb0, lb1, hb1); LGK(4); PV2_MM(4, la0, ha0, la1, ha1);
              PV2_RD(6, la0, ha0, la1, ha1); LGK(4); PV2_MM(5, lb0, hb0, lb1, hb1);
              PV2_RD(7, lb0, hb0, lb1, hb1); LGK(4); PV2_MM(6, la0, ha0, la1, ha1);
              LGK(0); PV2_MM(7, lb0, hb0, lb1, hb1); }
#undef PV2_RD
#undef PV2_MM
#undef LGK
#undef TRRD
        }
        if (more) { asm volatile("s_waitcnt vmcnt(0)" ::: "memory"); D2_WRITE(buf ^ 1); }
        __syncthreads();
        buf ^= 1;
    }
#undef D2_LOAD
#undef D2_WRITE
    { auto rr = __builtin_amdgcn_permlane32_swap(__float_as_uint(l_reg), __float_as_uint(l_reg), false, false); l_reg = __uint_as_float(rr[0]) + __uint_as_float(rr[1]); }
    float* lw = (float*)(lds + 132096) + wid * 32;
    if (hi == 0) lw[r32] = l_reg; asm volatile("s_waitcnt lgkmcnt(0)" ::: "memory");
    float rli[16];
#pragma unroll
    for (int r = 0; r < 16; ++r) rli[r] = __builtin_amdgcn_rcpf(lw[crow(r, hi)]);
    float* X = (float*)lds + rg * 8192;
#define OPQ(v) asm volatile("" : "+v"(v))
    if (cc == 1) {
#pragma unroll
        for (int r = 0; r < 16; ++r) { const float f = C.lam * rli[r]; unsigned vo = (unsigned)lane; OPQ(vo);
#pragma unroll
            for (int d0 = 0; d0 < 8; ++d0) X[(r * 8 + d0) * 64 + vo] = o[d0][r] * f; }
    }
    __syncthreads();
    if (cc == 0) {
        float g[8];
        { unsigned go = (unsigned)r32 * 4u; OPQ(go);
#pragma unroll
          for (int d0 = 0; d0 < 8; ++d0) g[d0] = *(const float*)((const char*)C.gain + (size_t)go + d0 * 128); }
        char* Ow = (char*)(Ob + (size_t)(rg * QBLK) * PO);
        const unsigned lo_o = (unsigned)((4 * hi) * PO + r32) * 2u;
#pragma unroll
        for (int r = 0; r < 16; ++r) { unsigned vo = (unsigned)lane; OPQ(vo);
            float d[8], ss = 0.f;
#pragma unroll
            for (int d0 = 0; d0 < 8; ++d0) { d[d0] = o[d0][r] * rli[r] - X[(r * 8 + d0) * 64 + vo]; ss += d[d0] * d[d0]; }
            ss += __shfl_xor(ss, 1); ss += __shfl_xor(ss, 2); ss += __shfl_xor(ss, 4); ss += __shfl_xor(ss, 8); ss += __shfl_xor(ss, 16);
            const float scl = rsqrtf(ss * (1.f / 256.f) + C.eps) * C.omli;
            unsigned wo = lo_o; OPQ(wo);
            char* rowp = Ow + (size_t)(wo + (unsigned)(((r & 3) + 8 * (r >> 2)) * PO * 2));
#pragma unroll
            for (int d0 = 0; d0 < 8; ++d0) { const float v = d[d0] * scl * g[d0]; const float vn = __shfl_xor(v, 1);
                if ((r32 & 1) == 0) *(unsigned*)(rowp + d0 * 64) = cvtpk(v, vn); }
        }
    }
#undef OPQ
    __syncthreads();
}
}
#ifndef PG8_SP2
#define PG8_SP2 true
#endif
#ifndef PG8_ALIGN
#define PG8_ALIGN true
#endif
#ifndef MK_SPLIT
#define MK_SPLIT 0
#endif
#ifndef MK_CHECK
#define MK_CHECK 0
#endif
constexpr int NWAVES = 8;
constexpr int BATCH = 2, SEQ = 4096, DM = 4096, MROWS = BATCH * SEQ, FF = 11008, FF2 = 2 * FF, NQKV = 3 * DM;
constexpr int SB_H = 32, DF_H = 16, HD = 128;
constexpr float RMS_EPS = 1e-6f;
constexpr float LOG2E = 1.4426950408889634f;
constexpr float QSCALE = 0.08838834764831845f * LOG2E;
constexpr int NPH = 14;
constexpr size_t MiB = 1u << 20;
constexpr size_t WS_CTL = 0, CTL_ZERO_BYTES = 1 * MiB;
constexpr size_t WS_WQKV0 = 2 * MiB;
constexpr size_t WS_WO0   = WS_WQKV0 + 96 * MiB;
constexpr size_t WS_WQKV1 = WS_WO0 + 32 * MiB;
constexpr size_t WS_WO1   = WS_WQKV1 + 96 * MiB;
constexpr size_t WS_WUP0  = WS_WO1 + 32 * MiB;
constexpr size_t WS_WUP1  = WS_WUP0 + 172 * MiB;
constexpr size_t WS_WDN0  = WS_WUP1 + 172 * MiB;
constexpr size_t WS_WDN1  = WS_WDN0 + 86 * MiB;
constexpr size_t WS_XN    = WS_WDN1 + 86 * MiB;
constexpr size_t WS_PART  = WS_XN + 64 * MiB;
constexpr size_t WS_QKV   = WS_PART + 2 * MiB;
constexpr size_t WS_QKN   = WS_QKV + 192 * MiB;
constexpr size_t WS_AO    = WS_QKN + 128 * MiB;
constexpr size_t WS_U     = WS_AO + 64 * MiB;
constexpr size_t WS_ACT   = WS_U + 344 * MiB;
constexpr size_t WS_SCR   = WS_ACT + 172 * MiB;
constexpr size_t WS_HALO  = WS_SCR + 64 * MiB;
constexpr size_t WS_X1    = WS_HALO + 44 * MiB;
constexpr size_t WS_END   = WS_X1 + (MK_CHECK ? 3 * 128 * MiB : 0);
constexpr int CW_TMO = 0, CW_CODE = 1, CW_FAIL = 2, CW_BAR = 4096;

constexpr int RING_OFF = 0, RING_BYTES = 131072;
constexpr int LDSCTL_OFF = RING_BYTES, MISC_OFF = LDSCTL_OFF + 320;
constexpr int LDS_BYTES = 147456;
constexpr int RS_OFF = MISC_OFF + 128;
static_assert(RS_OFF % 16 == 0 && RS_OFF + 1024 <= LDS_BYTES, "LDS map");

#define GAS __attribute__((address_space(1)))
#define LAS __attribute__((address_space(3)))
typedef unsigned short bf16;
typedef unsigned v4u __attribute__((ext_vector_type(4)));
typedef unsigned v2u __attribute__((ext_vector_type(2)));
typedef float f32x4 __attribute__((ext_vector_type(4)));
typedef short bf16x8 __attribute__((ext_vector_type(8)));
typedef GAS unsigned gu32;
#define RLX_AGENT __ATOMIC_RELAXED, __HIP_MEMORY_SCOPE_AGENT
#define LDS_WAIT() asm volatile("s_waitcnt lgkmcnt(0)" ::: "memory")
#define VM_WAIT() asm volatile("s_waitcnt vmcnt(0)" ::: "memory")
__device__ __forceinline__ unsigned f2bf(float f) { unsigned u = __builtin_bit_cast(unsigned, f); return (u + 0x7fffu + ((u >> 16) & 1u)) >> 16; }
__device__ __forceinline__ unsigned pk2(float lo, float hi) { return f2bf(lo) | (f2bf(hi) << 16); }
__device__ __forceinline__ float bf2f(unsigned short b) { return __builtin_bit_cast(float, (unsigned)b << 16); }

#define XB_TMO      128
#define XB_XCNT(j)  (256  + 64 * (j))
#define XB_XSUB(j)  (1280 + 64 * (j))
#define XB_XGEN(j)  (2304 + 64 * (j))
#define XB_TOP      3328
#define XB_TOPGEN   3392
#define XCD_BAR_WORDS 3456
#define XB_SPIN_CAP (1u << 18)
__device__ __forceinline__ unsigned xb_ld(unsigned* p)              { return __hip_atomic_load(p, __ATOMIC_RELAXED, __HIP_MEMORY_SCOPE_AGENT); }
__device__ __forceinline__ unsigned xb_add(unsigned* p, unsigned v) { return __hip_atomic_fetch_add(p, v, __ATOMIC_RELAXED, __HIP_MEMORY_SCOPE_AGENT); }
__device__ __forceinline__ unsigned xb_xcc_id() { return (unsigned)__builtin_amdgcn_s_getreg((3 << 11) | 20) & 0xFu; }
#define XB_SPIN(cond, bar) do { unsigned _sp = 0; while (cond) { __builtin_amdgcn_s_sleep(1); \
    if ((++_sp & 255u) == 0u) { if (xb_ld(&(bar)[XB_TMO])) break; if (_sp > XB_SPIN_CAP) { atomicAdd(&(bar)[XB_TMO], 1u); break; } } } } while (0)
struct XcdBarrier { unsigned* bar; unsigned x; volatile LAS unsigned* st; };
__device__ __forceinline__ XcdBarrier xcd_barrier_post(unsigned* bar, volatile LAS unsigned* st) {
    XcdBarrier b; b.bar = bar; b.x = xb_xcc_id(); b.st = st;
    if (threadIdx.x == 0) (void)xb_add(&bar[XB_XCNT(b.x)], 1u);
    return b;
}
__device__ __forceinline__ void xcd_barrier_complete(unsigned* bar, unsigned x, unsigned& nloc, unsigned& nx) {
    const unsigned G = gridDim.x * gridDim.y * gridDim.z;
    unsigned sum, cnt, mine, sp = 0u;
    for (;;) {
        sum = 0u; cnt = 0u; mine = 0u;
#pragma unroll
        for (unsigned j = 0; j < 16; ++j) { const unsigned c = xb_ld(&bar[XB_XCNT(j)]); sum += c; cnt += (c > 0u) ? 1u : 0u; mine = (j == x) ? c : mine; }
        if (sum == G) break;
        __builtin_amdgcn_s_sleep(1);
        if ((++sp & 255u) == 0u) { if (xb_ld(&bar[XB_TMO])) break; if (sp > XB_SPIN_CAP) { atomicAdd(&bar[XB_TMO], 1u); break; } }
    }
    nloc = mine > 0u ? mine : 1u; nx = cnt > 0u ? cnt : 1u;
}
__device__ __forceinline__ void xcd_barrier(const XcdBarrier& b) {
    asm volatile("s_waitcnt vmcnt(0)" ::: "memory");
    __syncthreads();
    if (threadIdx.x == 0) {
        unsigned* bar = b.bar; const unsigned myx = xb_xcc_id();
        __builtin_amdgcn_s_waitcnt(0);
        unsigned nloc = b.st[0], nx = b.st[1];
        if (nloc == 0u) { xcd_barrier_complete(bar, myx, nloc, nx); b.st[0] = nloc; b.st[1] = nx; }
        const unsigned old = xb_add(&bar[XB_XSUB(myx)], 1u);
        const unsigned gen = old / nloc;
        if (old + 1u == (gen + 1u) * nloc) {
            __builtin_amdgcn_fence(__ATOMIC_RELEASE, "agent");
            asm volatile("s_waitcnt vmcnt(0)" ::: "memory");
            const unsigned og = xb_add(&bar[XB_TOP], 1u);
            const unsigned tg = og / nx;
            if (og + 1u == (tg + 1u) * nx) xb_add(&bar[XB_TOPGEN], 1u);
            else XB_SPIN(xb_ld(&bar[XB_TOPGEN]) == tg, bar);
            __builtin_amdgcn_fence(__ATOMIC_ACQUIRE, "agent");
            xb_add(&bar[XB_XGEN(myx)], 1u);
            asm volatile("s_waitcnt vmcnt(0)" ::: "memory");
        } else {
            XB_SPIN(xb_ld(&bar[XB_XGEN(myx)]) == gen, bar);
            __builtin_amdgcn_fence(__ATOMIC_ACQUIRE, "agent");
            asm volatile("s_waitcnt vmcnt(0)" ::: "memory");
        }
    }
    __syncthreads();
}

__device__ __forceinline__ float wave_sum(float v) {
#pragma unroll
    for (int o = 1; o < 64; o <<= 1) v += __shfl_xor(v, o);
    return v;
}

constexpr int TR_STRIDE = 33;
__device__ __forceinline__ void transpose_item(const float* W, const float* gain, int K, int N, bf16* WT, LAS unsigned* scr, int item, int lane, bool gateperm) {
    const int nblk = N / 64, kb = item / nblk, nb = item % nblk, k0 = 64 * kb, n0 = 64 * nb;
    const int h_ = N / 2, nd0 = gateperm ? ((n0 % h_) / 128) * 256 + (n0 / h_) * 128 + (n0 % 128) : n0;
    const int kp = lane >> 4, c = lane & 15;
    f32x4 va[8], vb[8];
#pragma unroll
    for (int i = 0; i < 8; ++i) { const GAS float* src = (const GAS float*)W + (size_t)(k0 + 8 * i + 2 * kp) * N + n0 + 4 * c; va[i] = __builtin_nontemporal_load((const GAS f32x4*)src); vb[i] = __builtin_nontemporal_load((const GAS f32x4*)(src + N)); }
#pragma unroll
    for (int i = 0; i < 8; ++i) { float ga = 1.f, gb = 1.f; if (gain) { ga = gain[k0 + 8 * i + 2 * kp]; gb = gain[k0 + 8 * i + 2 * kp + 1]; }
        LAS unsigned* d = scr + (4 * c) * TR_STRIDE + 4 * i + kp;
        d[0 * TR_STRIDE] = pk2(va[i].x * ga, vb[i].x * gb); d[1 * TR_STRIDE] = pk2(va[i].y * ga, vb[i].y * gb);
        d[2 * TR_STRIDE] = pk2(va[i].z * ga, vb[i].z * gb); d[3 * TR_STRIDE] = pk2(va[i].w * ga, vb[i].w * gb); }
    LDS_WAIT(); asm volatile("" ::: "memory");
    const int c8 = lane & 7, nr = lane >> 3;
#pragma unroll
    for (int j = 0; j < 8; ++j) { const int n = nr + 8 * j; const LAS unsigned* s = scr + n * TR_STRIDE + 4 * c8;
        v4u o; o.x = s[0]; o.y = s[1]; o.z = s[2]; o.w = s[3];
        *(GAS v4u*)(WT + (size_t)(nd0 + n) * K + k0 + 8 * c8) = o; }
    LDS_WAIT(); asm volatile("" ::: "memory");
}
__device__ __forceinline__ void xrow_to_bf16(const float* xrow, bf16* orow, float* prow, int lane) {
    const GAS f32x4* xr = (const GAS f32x4*)xrow + lane;
    float s = 0.f; GAS unsigned long long* o8 = (GAS unsigned long long*)orow + lane;
#pragma unroll
    for (int j = 0; j < 16; ++j) { const f32x4 v = xr[64 * j]; s += (v.x * v.x + v.y * v.y) + (v.z * v.z + v.w * v.w);
        o8[64 * j] = (unsigned long long)pk2(v.x, v.y) | ((unsigned long long)pk2(v.z, v.w) << 32); }
    s = wave_sum(s);
    prow[lane] = lane == 0 ? s : 0.f;
}

__device__ __forceinline__ void cvt8(const v4u w, float (&f)[8]) {
    f[0] = __builtin_bit_cast(float, w.x << 16); f[1] = __builtin_bit_cast(float, w.x & 0xffff0000u); f[2] = __builtin_bit_cast(float, w.y << 16); f[3] = __builtin_bit_cast(float, w.y & 0xffff0000u);
    f[4] = __builtin_bit_cast(float, w.z << 16); f[5] = __builtin_bit_cast(float, w.z & 0xffff0000u); f[6] = __builtin_bit_cast(float, w.w << 16); f[7] = __builtin_bit_cast(float, w.w & 0xffff0000u);
}
constexpr int CG_ROWS = 32, CG_NCG = FF / 8, CG_ITEMS = (MROWS / CG_ROWS) * CG_NCG;
__device__ __forceinline__ void convgate_item(const bf16* U, const float* cw, const float* cb, bf16* ACT, int item) {
    const int chunk = item / CG_NCG, cg = item % CG_NCG, m0 = chunk * CG_ROWS, t0 = m0 % SEQ, j0 = cg * 8;
    float wg[3][8], wv[3][8], bg[8], bv[8];
#pragma unroll
    for (int i = 0; i < 3; ++i)
#pragma unroll
        for (int h = 0; h < 2; ++h) { const f32x4 a = *(const f32x4*)(cw + (size_t)i * FF2 + j0 + 4 * h), b = *(const f32x4*)(cw + (size_t)i * FF2 + FF + j0 + 4 * h);
            wg[i][4 * h] = a.x; wg[i][4 * h + 1] = a.y; wg[i][4 * h + 2] = a.z; wg[i][4 * h + 3] = a.w; wv[i][4 * h] = b.x; wv[i][4 * h + 1] = b.y; wv[i][4 * h + 2] = b.z; wv[i][4 * h + 3] = b.w; }
#pragma unroll
    for (int h = 0; h < 2; ++h) { const f32x4 a = *(const f32x4*)(cb + j0 + 4 * h), b = *(const f32x4*)(cb + FF + j0 + 4 * h);
        bg[4 * h] = a.x; bg[4 * h + 1] = a.y; bg[4 * h + 2] = a.z; bg[4 * h + 3] = a.w; bv[4 * h] = b.x; bv[4 * h + 1] = b.y; bv[4 * h + 2] = b.z; bv[4 * h + 3] = b.w; }
    float g2[8], g1[8], v2[8], v1[8];
    const v4u z4 = {0u, 0u, 0u, 0u};
    { const v4u a = t0 >= 2 ? *(const GAS v4u*)(U + (size_t)(m0 - 2) * FF2 + j0) : z4, b = t0 >= 2 ? *(const GAS v4u*)(U + (size_t)(m0 - 2) * FF2 + FF + j0) : z4; cvt8(a, g2); cvt8(b, v2); }
    { const v4u a = t0 >= 1 ? *(const GAS v4u*)(U + (size_t)(m0 - 1) * FF2 + j0) : z4, b = t0 >= 1 ? *(const GAS v4u*)(U + (size_t)(m0 - 1) * FF2 + FF + j0) : z4; cvt8(a, g1); cvt8(b, v1); }
#pragma unroll 4
    for (int r = 0; r < CG_ROWS; ++r) {
        float g0[8], v0[8]; cvt8(*(const GAS v4u*)(U + (size_t)(m0 + r) * FF2 + j0), g0); cvt8(*(const GAS v4u*)(U + (size_t)(m0 + r) * FF2 + FF + j0), v0);
        float o[8];
#pragma unroll
        for (int e = 0; e < 8; ++e) { const float cgv = bg[e] + wg[0][e] * g2[e] + wg[1][e] * g1[e] + wg[2][e] * g0[e]; const float cvv = bv[e] + wv[0][e] * v2[e] + wv[1][e] * v1[e] + wv[2][e] * v0[e];
            const float sg = cgv * __builtin_amdgcn_rcpf(1.f + __builtin_amdgcn_exp2f(-cgv * LOG2E)); o[e] = sg * cvv; g2[e] = g1[e]; g1[e] = g0[e]; v2[e] = v1[e]; v1[e] = v0[e]; }
        v4u w; w.x = pk2(o[0], o[1]); w.y = pk2(o[2], o[3]); w.z = pk2(o[4], o[5]); w.w = pk2(o[6], o[7]);
        *(GAS v4u*)(ACT + (size_t)(m0 + r) * FF + j0) = w;
    }
}

constexpr int FX_ITEMS = (MROWS / 64) * CG_NCG;
__device__ __forceinline__ void ld8(const float* p, float (&f)[8]) { const f32x4 a = *(const GAS f32x4*)p, b = *(const GAS f32x4*)(p + 4); f[0] = a.x; f[1] = a.y; f[2] = a.z; f[3] = a.w; f[4] = b.x; f[5] = b.y; f[6] = b.z; f[7] = b.w; }
__device__ __forceinline__ void fixup_item(const float* halo, const float* cw, const float* cb, bf16* ACT, int item) {
    const int grp = item / CG_NCG, cg = item % CG_NCG, j0 = cg * 8; const bool first = (grp % (SEQ / 64)) == 0;
    float wg[3][8], wv[3][8], bg[8], bv[8];
#pragma unroll
    for (int i = 0; i < 3; ++i) { ld8(cw + (size_t)i * FF2 + j0, wg[i]); ld8(cw + (size_t)i * FF2 + FF + j0, wv[i]); }
    ld8(cb + j0, bg); ld8(cb + FF + j0, bv);
    float h0g[8], h0v[8], h1g[8], h1v[8], t0g[8], t0v[8], t1g[8], t1v[8];
    const float* hb = halo + (size_t)grp * 4 * FF2 + j0;
    ld8(hb, h0g); ld8(hb + FF, h0v); ld8(hb + FF2, h1g); ld8(hb + FF2 + FF, h1v);
    if (!first) { const float* pb = hb - 4 * (size_t)FF2; ld8(pb + 2 * (size_t)FF2, t0g); ld8(pb + 2 * (size_t)FF2 + FF, t0v); ld8(pb + 3 * (size_t)FF2, t1g); ld8(pb + 3 * (size_t)FF2 + FF, t1v); }
    else {
#pragma unroll
        for (int e = 0; e < 8; ++e) { t0g[e] = 0.f; t0v[e] = 0.f; t1g[e] = 0.f; t1v[e] = 0.f; } }
    float o0[8], o1[8];
#pragma unroll
    for (int e = 0; e < 8; ++e) {
        const float cg0 = bg[e] + wg[0][e] * t0g[e] + wg[1][e] * t1g[e] + wg[2][e] * h0g[e], cv0 = bv[e] + wv[0][e] * t0v[e] + wv[1][e] * t1v[e] + wv[2][e] * h0v[e];
        const float cg1 = bg[e] + wg[0][e] * t1g[e] + wg[1][e] * h0g[e] + wg[2][e] * h1g[e], cv1 = bv[e] + wv[0][e] * t1v[e] + wv[1][e] * h0v[e] + wv[2][e] * h1v[e];
        o0[e] = cg0 * __builtin_amdgcn_rcpf(1.f + __builtin_amdgcn_exp2f(-cg0 * LOG2E)) * cv0; o1[e] = cg1 * __builtin_amdgcn_rcpf(1.f + __builtin_amdgcn_exp2f(-cg1 * LOG2E)) * cv1; }
    v4u w0, w1; w0.x = pk2(o0[0], o0[1]); w0.y = pk2(o0[2], o0[3]); w0.z = pk2(o0[4], o0[5]); w0.w = pk2(o0[6], o0[7]);
    w1.x = pk2(o1[0], o1[1]); w1.y = pk2(o1[2], o1[3]); w1.z = pk2(o1[4], o1[5]); w1.w = pk2(o1[6], o1[7]);
    *(GAS v4u*)(ACT + (size_t)(grp * 64) * FF + j0) = w0; *(GAS v4u*)(ACT + (size_t)(grp * 64 + 1) * FF + j0) = w1;
}

__device__ __forceinline__ void sincos_rev(float ang, float& s, float& c) {
    const float I1 = 0.15915493667125702f, I2 = 6.420638326565253e-09f;
    const float r1 = ang * I1; const float e1 = __builtin_fmaf(ang, I1, -r1); const float r2 = __builtin_fmaf(ang, I2, e1);
    const float fr = (r1 - __builtin_rintf(r1)) + r2;
    s = __builtin_amdgcn_sinf(fr); c = __builtin_amdgcn_cosf(fr);
}
__device__ __forceinline__ void qknorm_row(const bf16* qkv_row, bf16* qkn_row, const float* gq, const float* gk, int t, int lane) {
    const int c = lane & 7, gs = lane >> 3;
    float cs[8], sn[8];
#pragma unroll
    for (int e = 0; e < 8; ++e) { const int i = 8 * c + e; const float invf = __builtin_amdgcn_exp2f(-(float)i * (13.287712379549449f / 64.f));
        sincos_rev((float)t * invf, sn[e], cs[e]); }
    float gA[8], gB[8];
#pragma unroll 1
    for (int qk = 0; qk < 2; ++qk) {
        const float* gn = qk ? gk : gq; const float sc = qk ? 1.f : QSCALE;
#pragma unroll
        for (int e = 0; e < 8; ++e) { gA[e] = gn[8 * c + e]; gB[e] = gn[64 + 8 * c + e]; }
        v4u ra[4], rb[4];
#pragma unroll
        for (int it = 0; it < 4; ++it) { const int col = qk * 4096 + (it * 8 + gs) * 128 + 8 * c; ra[it] = *(const GAS v4u*)(qkv_row + col); rb[it] = *(const GAS v4u*)(qkv_row + col + 64); }
#pragma unroll
        for (int it = 0; it < 4; ++it) {
            const int col = qk * 4096 + (it * 8 + gs) * 128 + 8 * c;
            float xa[8], xb[8]; cvt8(ra[it], xa); cvt8(rb[it], xb);
            float ss = 0.f;
#pragma unroll
            for (int e = 0; e < 8; ++e) ss += xa[e] * xa[e] + xb[e] * xb[e];
            ss += __shfl_xor(ss, 1); ss += __shfl_xor(ss, 2); ss += __shfl_xor(ss, 4);
            const float inv = rsqrtf(ss * (1.f / 128.f) + RMS_EPS);
            float oa[8], ob[8];
#pragma unroll
            for (int e = 0; e < 8; ++e) { const float ya = xa[e] * inv * gA[e], yb = xb[e] * inv * gB[e]; oa[e] = (ya * cs[e] - yb * sn[e]) * sc; ob[e] = (yb * cs[e] + ya * sn[e]) * sc; }
            v4u wa, wb; wa.x = pk2(oa[0], oa[1]); wa.y = pk2(oa[2], oa[3]); wa.z = pk2(oa[4], oa[5]); wa.w = pk2(oa[6], oa[7]);
            wb.x = pk2(ob[0], ob[1]); wb.y = pk2(ob[2], ob[3]); wb.z = pk2(ob[4], ob[5]); wb.w = pk2(ob[6], ob[7]);
            *(GAS v4u*)(qkn_row + col) = wa; *(GAS v4u*)(qkn_row + col + 64) = wb;
        }
    }
}
struct Args { const float* in[18]; float* out; unsigned char* ws; int ph_lo, ph_hi; };
static_assert(sizeof(Args) == 18 * 8 + 8 + 8 + 8, "Args has no padding");

struct MatDesc { int in_idx; size_t in_off; int gain_idx; size_t gain_off; int K, N; size_t ws_off; int gateperm; };
__device__ __forceinline__ MatDesc mat_desc(int i) {
    switch (i) {
    case 0: return MatDesc{2, 0, 1, 0, DM, NQKV, WS_WQKV0, 0};
    case 1: return MatDesc{3, 0, -1, 0, DM, DM, WS_WO0, 0};
    case 2: return MatDesc{14, 0, 13, 0, DM, FF2, WS_WUP0, 1};
    case 3: return MatDesc{17, 0, -1, 0, FF, DM, WS_WDN0, 0};
    case 4: return MatDesc{4, 0, 1, (size_t)DM, DM, NQKV, WS_WQKV1, 0};
    case 5: return MatDesc{5, 0, -1, 0, DM, DM, WS_WO1, 0};
    case 6: return MatDesc{14, (size_t)DM * FF2, 13, (size_t)DM, DM, FF2, WS_WUP1, 1};
    default: return MatDesc{17, (size_t)FF * DM, -1, 0, FF, DM, WS_WDN1, 0};
    }
}

__global__ void __launch_bounds__(NWAVES * 64, 2) mk_fwd(Args args) {
    extern __shared__ __attribute__((aligned(16))) unsigned char lds[];
    LAS unsigned char* ldsl = (LAS unsigned char*)lds;
    volatile LAS unsigned* MISC = (volatile LAS unsigned*)(ldsl + MISC_OFF);
    const int tid = threadIdx.x, lane = tid & 63, wave = __builtin_amdgcn_readfirstlane(tid >> 6);
    const int G = gridDim.x, bx = blockIdx.x;
    const int gw = bx * NWAVES + wave, NGW = G * NWAVES;
    unsigned char* ws = args.ws;
    gu32* ctl = (gu32*)(ws + WS_CTL);
    for (int u = tid; u < (LDS_BYTES - LDSCTL_OFF) / 4; u += NWAVES * 64) ((LAS unsigned*)(ldsl + LDSCTL_OFF))[u] = 0u;
    __syncthreads();
    XcdBarrier bar; bar.bar = (unsigned*)(ctl + CW_BAR); bar.x = 0; bar.st = nullptr;
    const int lo = args.ph_lo, hi = args.ph_hi;
    if (hi - lo > 1) bar = xcd_barrier_post((unsigned*)(ctl + CW_BAR), MISC + 8);
#ifndef PH_MASK
#define PH_MASK 0x3fff
#endif
#define IN(k) (((PH_MASK >> (k)) & 1) && lo <= (k) && (k) < hi)
#define SEAM(k) do { if (IN(k) && IN((k) + 1)) xcd_barrier(bar); STAMP((k) + 1); } while (0)
#ifndef REPEAT_PHASE
#define REPEAT_PHASE -1
#endif
#ifndef REPEAT_N
#define REPEAT_N 1
#endif
#ifndef LEAK_A
#define LEAK_A -1
#endif
#ifndef LEAK_B
#define LEAK_B 14
#endif
#ifndef LEAK_OFF
#define LEAK_OFF 0
#endif
    unsigned long long tA = 0, tB = 0;
#define STAMP(k) do { if (LEAK_A >= 0 && bx == 0 && tid == 0) { if ((k) == LEAK_A) tA = __builtin_amdgcn_s_memrealtime(); if ((k) == LEAK_B) tB = __builtin_amdgcn_s_memrealtime(); } } while (0)
#define NREP(k) (REPEAT_PHASE == (k) ? 1 + REPEAT_N : 1)
    float* DUMMY = (float*)(ws + WS_END);

    bf16* XN = (bf16*)(ws + WS_XN); float* PART = (float*)(ws + WS_PART);
    bf16* QKV = (bf16*)(ws + WS_QKV); bf16* QKN = (bf16*)(ws + WS_QKN); bf16* AO = (bf16*)(ws + WS_AO);
    bf16* ACT = (bf16*)(ws + WS_ACT); float* HALO = (float*)(ws + WS_HALO);
    const float* x_in = args.in[0];

#ifndef JIT_CONV
#define JIT_CONV 1
#endif
#define CONVERT_MAT(MI) do { const MatDesc md = mat_desc(MI); LAS unsigned* scr_ = (LAS unsigned*)(ldsl + RING_OFF + wave * 16384); \
        const float* W_ = args.in[md.in_idx] + md.in_off; const float* gain_ = md.gain_idx >= 0 ? args.in[md.gain_idx] + md.gain_off : nullptr; \
        bf16* WT_ = (bf16*)(ws + md.ws_off); const int nitems_ = (md.K / 64) * (md.N / 64); \
        for (int it_ = gw; it_ < nitems_; it_ += NGW) transpose_item(W_, gain_, md.K, md.N, WT_, scr_, it_, lane, md.gateperm != 0); } while (0)
#define CONVERT_MAT_RANGE(MI, I0, I1, WG0) do { const MatDesc md = mat_desc(MI); LAS unsigned* scr_ = (LAS unsigned*)(ldsl + RING_OFF + wave * 16384); \
        const float* W_ = args.in[md.in_idx] + md.in_off; const float* gain_ = md.gain_idx >= 0 ? args.in[md.gain_idx] + md.gain_off : nullptr; \
        bf16* WT_ = (bf16*)(ws + md.ws_off); const int i1_ = (I1); \
        for (int it_ = (I0) + (bx - (WG0)) * NWAVES + wave; it_ < i1_; it_ += (G - (WG0)) * NWAVES) transpose_item(W_, gain_, md.K, md.N, WT_, scr_, it_, lane, md.gateperm != 0); } while (0)
#ifndef TAILFILL
#define TAILFILL 1
#endif
#ifndef DN_NUM
#define DN_NUM 52
#endif
constexpr int DN_ITEMS = (FF / 64) * (DM / 64), DN_SPLIT = TAILFILL ? (DN_ITEMS * DN_NUM) / 100 : 0;
#ifndef SPLIT_CONV
#define SPLIT_CONV 1
#endif
#ifdef PROBE_XCC
    if (tid == 0) __hip_atomic_store(ctl + 2048 + bx, 1u + xb_xcc_id(), RLX_AGENT);
#endif
    STAMP(0);
    if (IN(0)) _Pragma("unroll") for (int rep = 0; rep < NREP(0); ++rep) { if (rep) xcd_barrier(bar);
        LAS unsigned* scr = (LAS unsigned*)(ldsl + RING_OFF + wave * 16384);
#pragma unroll 1
#if JIT_CONV
        for (int m = gw; m < MROWS; m += NGW) xrow_to_bf16(x_in + (size_t)m * DM, XN + (size_t)m * DM, PART + (size_t)m * pg8::NPART, lane);
        CONVERT_MAT(0);
    }
#else
        for (int mo = 0; mo < (SPLIT_CONV ? 4 : 8); ++mo) { const int mi = SPLIT_CONV ? ((mo + 1) & 3) : ((mo + 1) & 7); const MatDesc md = mat_desc(mi);
            if (mi == 0) { for (int m = gw; m < MROWS; m += NGW) xrow_to_bf16(x_in + (size_t)m * DM, XN + (size_t)m * DM, PART + (size_t)m * pg8::NPART, lane); }
            const float* W = args.in[md.in_idx] + md.in_off; const float* gain = md.gain_idx >= 0 ? args.in[md.gain_idx] + md.gain_off : nullptr;
            bf16* WT = (bf16*)(ws + md.ws_off); const int nitems = (md.K / 64) * (md.N / 64);
            for (int it = gw; it < nitems; it += NGW) transpose_item(W, gain, md.K, md.N, WT, scr, it, lane, md.gateperm != 0); }
    }
#endif
    SEAM(0);
    if (IN(1)) _Pragma("unroll") for (int rep = 0; rep < NREP(1); ++rep) { if (rep) xcd_barrier(bar);
        pg8::Gemm g{XN, (const bf16*)(ws + WS_WQKV0), MROWS, NQKV, DM}; pg8::StaticOrder S; S.init(MROWS, NQKV, G, bx);
        pg8::EpiScale E{QKV, NQKV, PART, 1.f / DM, RMS_EPS, DM, QSCALE, (LAS float*)(ldsl + RS_OFF)};
        pg8::gemm_phase<pg8::EpiScale, pg8::StaticOrder, PG8_ALIGN, PG8_SP2>(ldsl + RING_OFF, g, S, E);
    }
    SEAM(1);
    if (IN(2)) _Pragma("unroll") for (int rep = 0; rep < NREP(2); ++rep) { if (rep) xcd_barrier(bar);
        constexpr int NBLK = BATCH * SB_H * (SEQ / 256);
        for (int L = bx; L < NBLK; L += G) { const int qb = L % 16, bh = L / 16, b = bh / SB_H, h = bh % SB_H;
            const bf16* kvbase = QKV + (size_t)(b * SEQ) * NQKV + h * HD;
            att::sb_block<NQKV, NQKV, NQKV, DM>(kvbase + (size_t)(qb * 256) * NQKV, kvbase + DM, kvbase + 2 * DM, AO + (size_t)(b * SEQ + qb * 256) * DM + h * HD, qb * 256, (char*)lds + RING_OFF, (volatile LAS unsigned*)(ldsl + RING_OFF + 65536)); }
        if (JIT_CONV) CONVERT_MAT(1);
    }
    SEAM(2);
    if (IN(3)) _Pragma("unroll") for (int rep = 0; rep < NREP(3); ++rep) { if (rep) xcd_barrier(bar);
        pg8::Gemm g{AO, (const bf16*)(ws + WS_WO0), MROWS, DM, DM}; pg8::StaticOrder S; S.init(MROWS, DM, G, bx);
        pg8::EpiResid<false, false> E{nullptr, nullptr, XN, PART, DM};
        pg8::gemm_phase<pg8::EpiResid<false, false>, pg8::StaticOrder, PG8_ALIGN, PG8_SP2>(ldsl + RING_OFF, g, S, E);
        if (JIT_CONV) CONVERT_MAT(2);
    }
    SEAM(3);
#define UP_PHASE(WOFF, LAYER) do { pg8::Gemm g{XN, (const bf16*)(ws + (WOFF)), MROWS, FF2, DM}; pg8::StaticOrder S; S.init(MROWS, FF2, G, bx); \
        pg8::EpiConvGate E{ACT, FF, PART, 1.f / DM, RMS_EPS, args.in[15] + (size_t)(LAYER) * 3 * FF2, args.in[16] + (size_t)(LAYER) * FF2, HALO, (LAS float*)(ldsl + RS_OFF)}; \
        pg8::gemm_phase<pg8::EpiConvGate, pg8::StaticOrder, PG8_ALIGN, PG8_SP2>(ldsl + RING_OFF, g, S, E); } while (0)
#define CG_PHASE(LAYER) do { const float* cw = args.in[15] + (size_t)(LAYER) * 3 * FF2; const float* cb = args.in[16] + (size_t)(LAYER) * FF2; \
        for (int it = bx * (NWAVES * 64) + tid; it < FX_ITEMS; it += G * NWAVES * 64) fixup_item(HALO, cw, cb, ACT, it); } while (0)
#ifndef DOWN_WGM
#define DOWN_WGM 8
#endif
#define DOWN_PHASE(WOFF, OUT, LAST) do { pg8::Gemm g{ACT, (const bf16*)(ws + (WOFF)), MROWS, DM, FF}; pg8::StaticOrder S; S.init(MROWS, DM, G, bx, DOWN_WGM); \
        pg8::EpiResid<false, LAST> E{nullptr, OUT, XN, PART, DM}; \
        pg8::gemm_phase<pg8::EpiResid<false, LAST>, pg8::StaticOrder, PG8_ALIGN, PG8_SP2>(ldsl + RING_OFF, g, S, E); } while (0)
    const int up_units = (MROWS / 256) * (FF2 / 256), up_full = up_units % G;
    if (IN(4)) _Pragma("unroll") for (int rep = 0; rep < NREP(4); ++rep) { if (rep) xcd_barrier(bar); UP_PHASE(WS_WUP0, 0); if (JIT_CONV && TAILFILL && up_full && bx >= up_full) CONVERT_MAT_RANGE(3, 0, DN_SPLIT, up_full); }
    SEAM(4);
    if (IN(5)) _Pragma("unroll") for (int rep = 0; rep < NREP(5); ++rep) { if (rep) xcd_barrier(bar); CG_PHASE(0); if (JIT_CONV) { if (TAILFILL && up_full) CONVERT_MAT_RANGE(3, DN_SPLIT, DN_ITEMS, 0); else CONVERT_MAT(3); } }
    SEAM(5);
    if (IN(6)) { DOWN_PHASE(WS_WDN0, nullptr, false); for (int rep = 1; rep < NREP(6); ++rep) { xcd_barrier(bar); DOWN_PHASE(WS_WDN0, DUMMY, true); } if (JIT_CONV) CONVERT_MAT(4); }
    SEAM(6);
#ifdef PROBE_LATE_QKV
    { pg8::Gemm g{XN, (const bf16*)(ws + WS_WQKV0), MROWS, NQKV, DM}; pg8::StaticOrder S; S.init(MROWS, NQKV, G, bx);
      pg8::EpiScale E{QKV, NQKV, PART, 1.f / DM, RMS_EPS, DM, QSCALE, (LAS float*)(ldsl + RS_OFF)};
      pg8::gemm_phase<pg8::EpiScale, pg8::StaticOrder, PG8_ALIGN, PG8_SP2>(ldsl + RING_OFF, g, S, E); xcd_barrier(bar); }
#if PROBE_LATE_QKV == 2
    { pg8::Gemm g{XN, (const bf16*)(ws + WS_WQKV0), MROWS, NQKV, DM}; pg8::StaticOrder S; S.init(MROWS, NQKV, G, bx);
      pg8::EpiScale E{QKV, NQKV, PART, 1.f / DM, RMS_EPS, DM, QSCALE, (LAS float*)(ldsl + RS_OFF)};
      pg8::gemm_phase<pg8::EpiScale, pg8::StaticOrder, PG8_ALIGN, PG8_SP2>(ldsl + RING_OFF, g, S, E); xcd_barrier(bar); }
#endif
#endif
    if (IN(7)) _Pragma("unroll") for (int rep = 0; rep < NREP(7); ++rep) { if (rep) xcd_barrier(bar);
        pg8::Gemm g{XN, (const bf16*)(ws + WS_WQKV1), MROWS, NQKV, DM}; pg8::StaticOrder S; S.init(MROWS, NQKV, G, bx);
        pg8::EpiScale E{QKV, NQKV, PART, 1.f / DM, RMS_EPS, 0, 1.f, (LAS float*)(ldsl + RS_OFF)};
        pg8::gemm_phase<pg8::EpiScale, pg8::StaticOrder, PG8_ALIGN, PG8_SP2>(ldsl + RING_OFF, g, S, E);
    }
    SEAM(7);
    if (IN(8)) _Pragma("unroll") for (int rep = 0; rep < NREP(8); ++rep) { if (rep) xcd_barrier(bar); for (int m = gw; m < MROWS; m += NGW) qknorm_row(QKV + (size_t)m * NQKV, QKN + (size_t)m * 8192, args.in[6], args.in[7], m % SEQ, lane); }
    SEAM(8);
    if (IN(9)) _Pragma("unroll") for (int rep = 0; rep < NREP(9); ++rep) { if (rep) xcd_barrier(bar);
        float lam, omli;
        { const float a1 = wave_sum(args.in[8][lane] * args.in[9][lane] + args.in[8][lane + 64] * args.in[9][lane + 64]);
          const float a2 = wave_sum(args.in[10][lane] * args.in[11][lane] + args.in[10][lane + 64] * args.in[11][lane + 64]);
          const float li = 0.8f - 0.6f * 0.7408182206817179f;
          lam = __expf(a1) - __expf(a2) + li; omli = 1.f - li; }
        float mq = fmaxf(fabsf(args.in[6][lane]), fabsf(args.in[6][lane + 64])), mk = fmaxf(fabsf(args.in[7][lane]), fabsf(args.in[7][lane + 64]));
#pragma unroll
        for (int o_ = 1; o_ < 64; o_ <<= 1) { mq = fmaxf(mq, __shfl_xor(mq, o_)); mk = fmaxf(mk, __shfl_xor(mk, o_)); }
        att::Diff2Const C{lam, omli, RMS_EPS, QSCALE * 128.f * mq * mk * 1.02f, args.in[12]};
        constexpr int NITEM = BATCH * DF_H * 16;
        for (int w = bx; w < NITEM; w += G) {
            const int bh = (w & 7) * 4 + ((w >> 3) >> 4), xq = (w >> 3) & 15, b = bh / DF_H, h = bh % DF_H;
            const bf16* qn = QKN + (size_t)(b * SEQ) * 8192 + h * 256; const bf16* vb = QKV + (size_t)(b * SEQ) * NQKV + 2 * DM + h * 256;
#pragma unroll 1
            for (int ps = 0; ps < 2; ++ps) { const int qb = ps ? 31 - xq : xq;
                att::diff2_block<8192, 8192, NQKV, DM>(qn + (size_t)(qb * 128) * 8192, qn + 4096, vb, AO + (size_t)(b * SEQ + qb * 128) * DM + h * 256, qb * 128, C, (char*)lds + RING_OFF); }
        }
        if (JIT_CONV) CONVERT_MAT(5);
    }
    SEAM(9);
    if (IN(10)) {
        pg8::Gemm g{AO, (const bf16*)(ws + WS_WO1), MROWS, DM, DM}; pg8::StaticOrder S; S.init(MROWS, DM, G, bx);
        pg8::EpiResid<false, false> E{nullptr, nullptr, XN, PART, DM};
        pg8::gemm_phase<pg8::EpiResid<false, false>, pg8::StaticOrder, PG8_ALIGN, PG8_SP2>(ldsl + RING_OFF, g, S, E);
        if (JIT_CONV) CONVERT_MAT(6);
    }
    SEAM(10);
    if (IN(11)) { UP_PHASE(WS_WUP1, 1); if (JIT_CONV && TAILFILL && up_full && bx >= up_full) CONVERT_MAT_RANGE(7, 0, DN_SPLIT, up_full); }
    SEAM(11);
    if (IN(12)) { CG_PHASE(1); if (JIT_CONV) { if (TAILFILL && up_full) CONVERT_MAT_RANGE(7, DN_SPLIT, DN_ITEMS, 0); else CONVERT_MAT(7); } }
    SEAM(12);
    if (IN(13)) DOWN_PHASE(WS_WDN1, args.out, true);
#ifdef PROBE_XCC
    { xcd_barrier(bar);
      if (bx == 0 && tid == 0) { unsigned bad = 0; for (int i = 0; i < G; ++i) { const unsigned xi = __hip_atomic_load(ctl + 2048 + i, RLX_AGENT), xr = __hip_atomic_load(ctl + 2048 + (i & 7), RLX_AGENT); if (xi != xr || xi == 0u) ++bad; }
          for (int r = 0; r < 8; ++r) for (int q = r + 1; q < 8; ++q) if (__hip_atomic_load(ctl + 2048 + r, RLX_AGENT) == __hip_atomic_load(ctl + 2048 + q, RLX_AGENT)) bad += 1000;
          if (bad) args.out[0] = 1000.f * (float)bad; } }
#endif
    if (LEAK_A >= 0) { xcd_barrier(bar); STAMP(14); if (bx == 0 && tid == 0) args.out[0] = 1000.f * ((float)(long long)(tB - tA) * 0.01f - (float)(LEAK_OFF)); }
#undef IN
#undef SEAM
}
#if MK_CHECK
#include "check.inc"
#endif
extern "C" void kernel_launch(void* const* d_in, const int* in_sizes, int n_in, void* d_out, int out_size, void* d_ws, size_t ws_size, hipStream_t stream) {
    static int grid = 0;
    if (grid == 0) {
        if (n_in != 18 || in_sizes[0] != MROWS * DM || out_size != MROWS * DM || ws_size < WS_END) {
            fprintf(stderr, "kernel_launch: built for 18 inputs, x/out of %d floats, >= %zu bytes of workspace; got n_in %d, in0 %d, out %d, ws %zu; nothing launched\n", MROWS * DM, (size_t)WS_END, n_in, n_in > 0 ? in_sizes[0] : -1, out_size, ws_size); grid = -1; return; }
        int dev = 0, cus = 0, per_cu = 0;
        if (hipGetDevice(&dev) != hipSuccess || hipDeviceGetAttribute(&cus, hipDeviceAttributeMultiprocessorCount, dev) != hipSuccess) { fprintf(stderr, "kernel_launch: device query failed\n"); grid = -1; return; }
        if (hipFuncSetAttribute((const void*)mk_fwd, hipFuncAttributeMaxDynamicSharedMemorySize, LDS_BYTES) != hipSuccess) { fprintf(stderr, "kernel_launch: hipFuncSetAttribute failed\n"); grid = -1; return; }
        if (hipOccupancyMaxActiveBlocksPerMultiprocessor(&per_cu, (const void*)mk_fwd, NWAVES * 64, LDS_BYTES) != hipSuccess || per_cu < 1)
            fprintf(stderr, "kernel_launch: note: occupancy query reports %d workgroups per CU\n", per_cu);
        (void)hipGetLastError();
        grid = cus;
    }
    if (grid < 0) return;
    if (hipMemsetAsync((char*)d_ws + WS_CTL, 0, CTL_ZERO_BYTES, stream) != hipSuccess) { fprintf(stderr, "kernel_launch: memset failed\n"); return; }
    Args a{};
    for (int i = 0; i < 18; ++i) a.in[i] = (const float*)d_in[i];
    a.out = (float*)d_out; a.ws = (unsigned char*)d_ws;
#if MK_CHECK
    for (int p = 0; p < NPH; ++p) { a.ph_lo = p; a.ph_hi = p + 1;
        hipLaunchKernelGGL(mk_fwd, dim3(grid), dim3(NWAVES * 64), LDS_BYTES, stream, a);
        hipLaunchKernelGGL(mk_check, dim3(256), dim3(256), 0, stream, a, p); }
    hipLaunchKernelGGL(mk_report, dim3(1), dim3(64), 0, stream, a);
#elif MK_SPLIT
    for (int p = 0; p < NPH; ++p) { a.ph_lo = p; a.ph_hi = p + 1; hipLaunchKernelGGL(mk_fwd, dim3(grid), dim3(NWAVES * 64), LDS_BYTES, stream, a); }
#else
    a.ph_lo = 0; a.ph_hi = NPH;
    hipLaunchKernelGGL(mk_fwd, dim3(grid), dim3(NWAVES * 64), LDS_BYTES, stream, a);
#ifdef PROBE_TWICE
    (void)hipMemsetAsync((char*)d_ws + WS_CTL, 0, CTL_ZERO_BYTES, stream);
    hipLaunchKernelGGL(mk_fwd, dim3(grid), dim3(NWAVES * 64), LDS_BYTES, stream, a);
#endif
#endif
    const hipError_t le = hipPeekAtLastError();
    if (le != hipSuccess) fprintf(stderr, "kernel_launch: launch failed: %s\n", hipGetErrorName(le));
}
```

```cpp
#define PRIO_BEFORE_BAR 1
#define RS_LDS 1
#define RESID_PERM 1
#include <hip/hip_runtime.h>
#include <cstdio>
#include <cstdint>
namespace pg8 {
__device__ __forceinline__ int tid_opaque() { int t = (int)threadIdx.x; asm volatile("" : "+v"(t)); return t; }
#define PG8_LAS __attribute__((address_space(3)))
typedef unsigned short bf16_t;
typedef short bf16x8 __attribute__((ext_vector_type(8)));
typedef float f32x4 __attribute__((ext_vector_type(4)));
typedef unsigned u32x4 __attribute__((ext_vector_type(4)));
constexpr int BM = 256, BK = 64, HALF = 128, HTB = HALF * BK * 2  , STAGE_BYTES = 8 * HTB, NXCD = 8, WGM = 8;

__host__ __device__ __forceinline__ int lds_byte(int r, int c) { const int st = (r >> 4) * 2 + (c >> 5), rr = r & 15, cc = c & 31, ob = rr * 64 + cc * 2; return st * 1024 + (ob ^ (((ob >> 9) & 1) << 5)); }
__host__ __device__ __forceinline__ void stage_rc(int b, int& R, int& C) { const int st = b / 1024, sb = b % 1024, swz = sb ^ (((sb >> 9) & 1) << 5); R = (st >> 1) * 16 + swz / 64; C = (st & 1) * 32 + (swz % 64) / 2; }
__host__ __device__ __forceinline__ int perm32(int rho) { const int n = rho >> 4, i = rho & 15; return 8 * (i >> 2) + 4 * n + (i & 3); }

struct Unit { int pm, pn; };
struct Gemm { const bf16_t* A; const bf16_t* Bt; int M, N, K; };

struct StaticOrder {
    int nM, nN, nwg, G, c, wgm;
    __host__ __device__ void init(int M, int N, int G_, int c_, int wgm_ = WGM) { nM = M / BM; nN = N / BM; nwg = nM * nN; G = G_; c = c_; wgm = wgm_; }
    __host__ __device__ bool next(int i, Unit& u) const {
        const long L = (long)i * G + c; if (L >= nwg) return false;
        int wgid = (int)L; { const int q = nwg / NXCD, r = nwg % NXCD, xcd = wgid % NXCD, off = wgid / NXCD; wgid = (xcd < r ? xcd * (q + 1) : r * (q + 1) + (xcd - r) * q) + off; }
        const int nig = wgm * nN, gid = wgid / nig, fm = gid * wgm, gsz = (nM - fm) < wgm ? (nM - fm) : wgm;
        u.pm = fm + ((wgid % nig) % gsz); u.pn = (wgid % nig) / gsz; return true;
    }
    __device__ __forceinline__ void a_ready(const Unit&) const {}
    __device__ __forceinline__ void done(const Unit&) const {}
};
struct RangeOrder : StaticOrder {
    int i0, i1;
    __host__ __device__ bool next(int i, Unit& u) const { return (i0 + i < i1) && StaticOrder::next(i0 + i, u); }
};


__device__ __forceinline__ unsigned cvt_pk_bf16(float lo, float hi) { unsigned r; asm volatile("v_cvt_pk_bf16_f32 %0, %1, %2" : "=v"(r) : "v"(lo), "v"(hi)); return r; }

constexpr int NPART = 64;

__device__ __forceinline__ void row_scales_lds(float (&rs)[2][4], PG8_LAS float* rl, const float* part, int urow0  , float inv_k, float eps, int wr, int wc, int fr, int fq) {
#pragma unroll
    for (int ai = 0; ai < 2; ++ai) { const int lr = ai * HALF + wr * 64 + wc * 16 + fr;
        const f32x4* pp = (const f32x4*)(part + (size_t)(urow0 + lr) * NPART + fq * 16);
        const f32x4 a = pp[0], b = pp[1], c = pp[2], d = pp[3];
        float s = ((a[0] + a[1]) + (a[2] + a[3])) + ((b[0] + b[1]) + (b[2] + b[3])) + (((c[0] + c[1]) + (c[2] + c[3])) + ((d[0] + d[1]) + (d[2] + d[3])));
        s += __shfl_xor(s, 16); s += __shfl_xor(s, 32);
        if (fq == 0) rl[lr] = rsqrtf(s * inv_k + eps); }
    asm volatile("s_waitcnt lgkmcnt(0)" ::: "memory");
    __builtin_amdgcn_s_barrier();
#pragma unroll
    for (int ai = 0; ai < 2; ++ai)
#pragma unroll
        for (int m = 0; m < 4; ++m) rs[ai][m] = rl[ai * HALF + wr * 64 + m * 16 + fr];
}

struct EpiScale {
    static constexpr bool PERM = true, AFTER_DRAIN = false;
    bf16_t* O; int ldc; const float* part; float inv_k; float eps; int qcols; float qs; PG8_LAS float* rl;
    __device__ __forceinline__ void operator()(const f32x4 (&acc)[2][2][4][2], const Unit& u, int wr, int wc, int fr, int fq) const {
        const int row0 = u.pm * BM + wr * 64 + fr; const int col0 = u.pn * BM + wc * 32 + 8 * fq;
        const float sc = (u.pn * BM < qcols) ? qs : 1.f;
#ifdef RS_LDS
        float rsl[2][4]; row_scales_lds(rsl, rl, part, u.pm * BM, inv_k, eps, wr, wc, fr, fq);
#endif
#pragma unroll
        for (int ai = 0; ai < 2; ++ai)
#pragma unroll
            for (int m = 0; m < 4; ++m) {
                const int row = row0 + ai * HALF + m * 16;
#ifdef RS_LDS
                const float r = rsl[ai][m] * sc;
#else
                const f32x4* pp = (const f32x4*)(part + (size_t)row * NPART + fq * 16);
                const f32x4 a = pp[0], b = pp[1], c = pp[2], d = pp[3];
                float s = ((a[0] + a[1]) + (a[2] + a[3])) + ((b[0] + b[1]) + (b[2] + b[3])) + (((c[0] + c[1]) + (c[2] + c[3])) + ((d[0] + d[1]) + (d[2] + d[3])));
                s += __shfl_xor(s, 16); s += __shfl_xor(s, 32);
                const float r = rsqrtf(s * inv_k + eps) * sc;
#endif
                bf16_t* rowp = O + (size_t)row * ldc + col0;
#pragma unroll
                for (int bj = 0; bj < 2; ++bj) { const f32x4 v0 = acc[ai][bj][m][0] * r, v1 = acc[ai][bj][m][1] * r;
                    u32x4 w; w.x = cvt_pk_bf16(v0[0], v0[1]); w.y = cvt_pk_bf16(v0[2], v0[3]); w.z = cvt_pk_bf16(v1[0], v1[1]); w.w = cvt_pk_bf16(v1[2], v1[3]);
                    *(u32x4*)(rowp + bj * HALF) = w; }
            }
    }
};

#ifndef RESID_PERM
#define RESID_PERM 0
#endif
template <bool BASE_F32, bool OUT_F32> struct EpiResid {
    static constexpr bool PERM = RESID_PERM != 0, AFTER_DRAIN = false;
    const float* basef; float* outf; bf16_t* xn; float* part; int ldc;
    __device__ __forceinline__ void operator()(const f32x4 (&acc)[2][2][4][2], const Unit& u, int wr, int wc, int fr, int fq) const {
        typedef unsigned u32x2v __attribute__((ext_vector_type(2)));
        const int row0 = u.pm * BM + wr * 64 + fr; const int col0 = u.pn * BM + wc * 32 + (PERM ? 8 : 4) * fq;
#pragma unroll
        for (int ai = 0; ai < 2; ++ai)
#pragma unroll
            for (int m = 0; m < 4; ++m) {
                const int row = row0 + ai * HALF + m * 16; const size_t off = (size_t)row * ldc + col0; float ss = 0.f;
                if constexpr (PERM) {
#pragma unroll
                    for (int bj = 0; bj < 2; ++bj) { const size_t o2 = off + bj * HALF;
                        f32x4 b0, b1;
                        if (BASE_F32) { b0 = *(const f32x4*)(basef + o2); b1 = *(const f32x4*)(basef + o2 + 4); }
                        else { const u32x4 b = *(const u32x4*)(xn + o2);
                            b0[0] = __builtin_bit_cast(float, b.x << 16); b0[1] = __builtin_bit_cast(float, b.x & 0xffff0000u); b0[2] = __builtin_bit_cast(float, b.y << 16); b0[3] = __builtin_bit_cast(float, b.y & 0xffff0000u);
                            b1[0] = __builtin_bit_cast(float, b.z << 16); b1[1] = __builtin_bit_cast(float, b.z & 0xffff0000u); b1[2] = __builtin_bit_cast(float, b.w << 16); b1[3] = __builtin_bit_cast(float, b.w & 0xffff0000u); }
                        const f32x4 o0 = b0 + acc[ai][bj][m][0], o1 = b1 + acc[ai][bj][m][1];
                        if (OUT_F32) { *(f32x4*)(outf + o2) = o0; *(f32x4*)(outf + o2 + 4) = o1; }
                        else { u32x4 w; w.x = cvt_pk_bf16(o0[0], o0[1]); w.y = cvt_pk_bf16(o0[2], o0[3]); w.z = cvt_pk_bf16(o1[0], o1[1]); w.w = cvt_pk_bf16(o1[2], o1[3]); *(u32x4*)(xn + o2) = w;
                            ss += ((o0[0] * o0[0] + o0[1] * o0[1]) + (o0[2] * o0[2] + o0[3] * o0[3])) + ((o1[0] * o1[0] + o1[1] * o1[1]) + (o1[2] * o1[2] + o1[3] * o1[3])); } }
                } else {
#pragma unroll
                for (int bj = 0; bj < 2; ++bj)
#pragma unroll
                    for (int n = 0; n < 2; ++n) { const size_t o2 = off + bj * HALF + n * 16;
                        f32x4 bs;
                        if (BASE_F32) bs = *(const f32x4*)(basef + o2);
                        else { const u32x2v b = *(const u32x2v*)(xn + o2); bs[0] = __builtin_bit_cast(float, b.x << 16); bs[1] = __builtin_bit_cast(float, b.x & 0xffff0000u); bs[2] = __builtin_bit_cast(float, b.y << 16); bs[3] = __builtin_bit_cast(float, b.y & 0xffff0000u); }
                        const f32x4 o = bs + acc[ai][bj][m][n];
                        if (OUT_F32) *(f32x4*)(outf + o2) = o;
                        else { u32x2v w; w.x = cvt_pk_bf16(o[0], o[1]); w.y = cvt_pk_bf16(o[2], o[3]); *(u32x2v*)(xn + o2) = w;
                            ss += (o[0] * o[0] + o[1] * o[1]) + (o[2] * o[2] + o[3] * o[3]); } }
                }
                if (!OUT_F32) { ss += __shfl_xor(ss, 16); ss += __shfl_xor(ss, 32); if (fq == 0) part[(size_t)row * NPART + u.pn * 4 + wc] = ss; }
            }
    }
};

struct EpiResidRT {
    static constexpr bool PERM = false, AFTER_DRAIN = false;
    float* outf; bf16_t* xn; float* part; int ldc;
    __device__ __forceinline__ void operator()(const f32x4 (&acc)[2][2][4][2], const Unit& u, int wr, int wc, int fr, int fq) const {
        typedef unsigned u32x2v __attribute__((ext_vector_type(2)));
        const int row0 = u.pm * BM + wr * 64 + fr; const int col0 = u.pn * BM + wc * 32 + 4 * fq; const bool last = outf != nullptr;
#pragma unroll
        for (int ai = 0; ai < 2; ++ai)
#pragma unroll
            for (int m = 0; m < 4; ++m) {
                const int row = row0 + ai * HALF + m * 16; const size_t off = (size_t)row * ldc + col0; float ss = 0.f;
#pragma unroll
                for (int bj = 0; bj < 2; ++bj)
#pragma unroll
                    for (int n = 0; n < 2; ++n) { const size_t o2 = off + bj * HALF + n * 16;
                        const u32x2v b = *(const u32x2v*)(xn + o2); f32x4 bs; bs[0] = __builtin_bit_cast(float, b.x << 16); bs[1] = __builtin_bit_cast(float, b.x & 0xffff0000u); bs[2] = __builtin_bit_cast(float, b.y << 16); bs[3] = __builtin_bit_cast(float, b.y & 0xffff0000u);
                        const f32x4 o = bs + acc[ai][bj][m][n];
                        if (last) *(f32x4*)(outf + o2) = o;
                        else { u32x2v w; w.x = cvt_pk_bf16(o[0], o[1]); w.y = cvt_pk_bf16(o[2], o[3]); *(u32x2v*)(xn + o2) = w; }
                        ss += (o[0] * o[0] + o[1] * o[1]) + (o[2] * o[2] + o[3] * o[3]); }
                if (!last) { ss += __shfl_xor(ss, 16); ss += __shfl_xor(ss, 32); if (fq == 0) part[(size_t)row * NPART + u.pn * 4 + wc] = ss; }
            }
    }
};

__device__ __forceinline__ float dpp_ror1(float v) { return __builtin_bit_cast(float, __builtin_amdgcn_update_dpp(0, __builtin_bit_cast(int, v), 0x121, 0xf, 0xf, false)); }
__device__ __forceinline__ float dpp_ror2(float v) { return __builtin_bit_cast(float, __builtin_amdgcn_update_dpp(0, __builtin_bit_cast(int, v), 0x122, 0xf, 0xf, false)); }
__device__ __forceinline__ float dpp_shr1(float old, float v) { return __builtin_bit_cast(float, __builtin_amdgcn_update_dpp(__builtin_bit_cast(int, old), __builtin_bit_cast(int, v), 0x111, 0xf, 0xf, false)); }
__device__ __forceinline__ float dpp_shr2(float old, float v) { return __builtin_bit_cast(float, __builtin_amdgcn_update_dpp(__builtin_bit_cast(int, old), __builtin_bit_cast(int, v), 0x112, 0xf, 0xf, false)); }
__device__ __forceinline__ void conv_taps(float& acc, float cur, float prev, float w1, float w0) {
    asm("s_nop 1\n\t"
        "v_fmac_f32_dpp %0, %1, %3 row_shr:1 row_mask:0xf bank_mask:0xf\n\t"
        "v_fmac_f32_dpp %0, %1, %4 row_shr:2 row_mask:0xf bank_mask:0xf\n\t"
        "v_fmac_f32_dpp %0, %2, %3 row_shl:15 row_mask:0xf bank_mask:0xf\n\t"
        "v_fmac_f32_dpp %0, %2, %4 row_shl:14 row_mask:0xf bank_mask:0xf"
        : "+v"(acc) : "v"(cur), "v"(prev), "v"(w1), "v"(w0));
}
template <int CTRL> __device__ __forceinline__ float dppz(float v) { return __builtin_bit_cast(float, __builtin_amdgcn_update_dpp(0, __builtin_bit_cast(int, v), CTRL, 0xf, 0xf, true)); }
struct EpiConvGate {
    static constexpr bool PERM = true, AFTER_DRAIN = false;
    bf16_t* ACT; int ff; const float* part; float inv_k; float eps; const float* cw; const float* cb; float* halo; PG8_LAS float* rl;
    __device__ __forceinline__ void operator()(const f32x4 (&acc)[2][2][4][2], const Unit& u, int wr, int wc, int fr, int fq) const {
        typedef unsigned u32x2v __attribute__((ext_vector_type(2)));
        const int ff2 = 2 * ff;
        const int row0 = u.pm * BM + wr * 64 + fr; const int ch0 = u.pn * HALF + wc * 32 + 8 * fq;
        float rs[2][4];
#ifdef RS_LDS
        row_scales_lds(rs, rl, part, u.pm * BM, inv_k, eps, wr, wc, fr, fq);
#else
#pragma unroll
        for (int ai = 0; ai < 2; ++ai)
#pragma unroll
            for (int m = 0; m < 4; ++m) { const int row = row0 + ai * HALF + m * 16;
                const f32x4* pp = (const f32x4*)(part + (size_t)row * NPART + fq * 16);
                const f32x4 a = pp[0], b = pp[1], c = pp[2], d = pp[3];
                float s = ((a[0] + a[1]) + (a[2] + a[3])) + ((b[0] + b[1]) + (b[2] + b[3])) + (((c[0] + c[1]) + (c[2] + c[3])) + ((d[0] + d[1]) + (d[2] + d[3])));
                s += __shfl_xor(s, 16); s += __shfl_xor(s, 32);
                rs[ai][m] = rsqrtf(s * inv_k + eps); }
#endif
        u32x2v lo[2][4];
#pragma unroll
        for (int n = 0; n < 2; ++n) {
            const int ch = ch0 + 4 * n;
            const f32x4 wg0 = *(const f32x4*)(cw + ch), wg1 = *(const f32x4*)(cw + ff2 + ch), wg2 = *(const f32x4*)(cw + 2 * ff2 + ch), bg = *(const f32x4*)(cb + ch);
            const f32x4 wv0 = *(const f32x4*)(cw + ff + ch), wv1 = *(const f32x4*)(cw + ff2 + ff + ch), wv2 = *(const f32x4*)(cw + 2 * ff2 + ff + ch), bv = *(const f32x4*)(cb + ff + ch);
#pragma unroll
            for (int ai = 0; ai < 2; ++ai) {
                f32x4 gq = {0.f, 0.f, 0.f, 0.f}, vq = gq;
                const int grp = (u.pm * BM + ai * HALF + wr * 64) >> 6;
#pragma unroll
                for (int m = 0; m < 4; ++m) {
                    const f32x4 g = acc[ai][0][m][n] * rs[ai][m], v = acc[ai][1][m][n] * rs[ai][m];
                    f32x4 cg, cv;
#pragma unroll
                    for (int e = 0; e < 4; ++e) {
                        float a = __builtin_fmaf(wg2[e], g[e], bg[e]), b = __builtin_fmaf(wv2[e], v[e], bv[e]);
                        conv_taps(a, g[e], gq[e], wg1[e], wg0[e]); conv_taps(b, v[e], vq[e], wv1[e], wv0[e]);
                        cg[e] = a; cv[e] = b; }
                    gq = g; vq = v;
                    f32x4 o;
#pragma unroll
                    for (int e = 0; e < 4; ++e) o[e] = cg[e] * __builtin_amdgcn_rcpf(1.f + __builtin_amdgcn_exp2f(-1.4426950408889634f * cg[e])) * cv[e];
                    u32x2v w; w.x = cvt_pk_bf16(o[0], o[1]); w.y = cvt_pk_bf16(o[2], o[3]);
                    const int row = row0 + ai * HALF + m * 16;
                    if (n == 0) lo[ai][m] = w;
                    else if (!(m == 0 && fr < 2)) { u32x4 w4; w4.x = lo[ai][m].x; w4.y = lo[ai][m].y; w4.z = w.x; w4.w = w.y; *(u32x4*)(ACT + (size_t)row * ff + ch0) = w4; }
                    if ((m == 0 && fr < 2) || (m == 3 && fr >= 14)) { float* hp = halo + ((size_t)grp * 4 + (m == 0 ? fr : fr - 12)) * ff2 + ch; *(f32x4*)hp = g; *(f32x4*)(hp + ff) = v; }
                }
            }
        }
    }
};
template <class Epi, class Sched, bool ALIGN_EPI = false, bool SP2 = false>
__device__ __forceinline__ void gemm_phase(PG8_LAS unsigned char* lds, const Gemm g, const Sched& S, const Epi& E) {
    const int tid = tid_opaque(), wid = __builtin_amdgcn_readfirstlane(tid >> 6), lane = tid & 63, wr = wid >> 2, wc = wid & 3, fr = lane & 15, fq = lane >> 4;
    const int K = g.K, nt = K / BK;
    unsigned voffA[2], voffB[2];
#pragma unroll
    for (int i = 0; i < 2; ++i) { int R, C; stage_rc(tid * 16 + i * 8192, R, C); const int Rb = Epi::PERM ? ((R & ~31) + perm32(R & 31)) : R;
        voffA[i] = (unsigned)(R * K + C) * 2u; voffB[i] = (unsigned)(Rb * K + C) * 2u; }
    const size_t kstep = (size_t)(BK * 2);
    const size_t hstep = (size_t)HALF * K * 2;
    const size_t tstep = 2 * hstep;
    const unsigned ldsw = (unsigned)wid * 1024u;
    const int aoff = lds_byte(wr * 64 + fr, fq * 8), boff = lds_byte(wc * 32 + fr, fq * 8);
#define PG8_SA(b, h) (((b) * 2 + (h)) * HTB)
#define PG8_SB(b, h) ((4 + (b) * 2 + (h)) * HTB)
#define PG8_STAGE(bufoff, gbase, voff) do { _Pragma("unroll") for (int _i = 0; _i < 2; ++_i) \
        __builtin_amdgcn_global_load_lds((const unsigned*)((const char*)(gbase) + (voff)[_i]), (PG8_LAS unsigned*)(lds + (bufoff) + ldsw + _i * 8192), 16, 0, 0); } while (0)
#define PG8_LDA(dst, b, h) do { _Pragma("unroll") for (int m = 0; m < 4; ++m) _Pragma("unroll") for (int k = 0; k < 2; ++k) dst[m][k] = *(const PG8_LAS bf16x8*)(lds + PG8_SA(b, h) + aoff + m * 2048 + k * 1024); } while (0)
#define PG8_LDB(dst, b, h) do { _Pragma("unroll") for (int n = 0; n < 2; ++n) _Pragma("unroll") for (int k = 0; k < 2; ++k) dst[n][k] = *(const PG8_LAS bf16x8*)(lds + PG8_SB(b, h) + boff + n * 2048 + k * 1024); } while (0)
#define PG8_MMA(ai, bj, At, Bt) do { if (!SP2) __builtin_amdgcn_s_setprio(1); _Pragma("unroll") for (int m = 0; m < 4; ++m) _Pragma("unroll") for (int n = 0; n < 2; ++n) _Pragma("unroll") for (int k = 0; k < 2; ++k) \
        acc[ai][bj][m][n] = __builtin_amdgcn_mfma_f32_16x16x32_bf16(Bt[n][k], At[m][k], acc[ai][bj][m][n], 0, 0, 0); if (!SP2) __builtin_amdgcn_s_setprio(0); } while (0)
#ifdef PRIO_BEFORE_BAR
#define PG8_PRIO_UP_PRE __builtin_amdgcn_s_setprio(1)
#define PG8_PRIO_UP_POST do { } while (0)
#else
#define PG8_PRIO_UP_PRE do { } while (0)
#define PG8_PRIO_UP_POST __builtin_amdgcn_s_setprio(1)
#endif
#define PG8_WAIT_V(n) asm volatile("s_waitcnt vmcnt(" #n ")" ::: "memory")
#define PG8_WAIT_L(n) asm volatile("s_waitcnt lgkmcnt(" #n ")" ::: "memory")
#define PG8_BAR __builtin_amdgcn_s_barrier()
#define PG8_SCHED __builtin_amdgcn_sched_barrier(0)
    Unit cur, nxt; int ui = 0;
    if (!S.next(0, cur)) return;
    f32x4 acc[2][2][4][2];
#pragma unroll
    for (int a = 0; a < 2; ++a)
#pragma unroll
        for (int b = 0; b < 2; ++b)
#pragma unroll
            for (int m = 0; m < 4; ++m)
#pragma unroll
                for (int n = 0; n < 2; ++n) acc[a][b][m][n] = (f32x4){0.f, 0.f, 0.f, 0.f};
    bf16x8 At[4][2], B0[2][2], B1[2][2];
    const char* cA = (const char*)g.A + (size_t)cur.pm * tstep; const char* cB = (const char*)g.Bt + (size_t)cur.pn * tstep;
    S.a_ready(cur);
    if constexpr (SP2) {
        PG8_STAGE(PG8_SB(0, 0), cB, voffB); PG8_STAGE(PG8_SB(0, 1), cB + hstep, voffB); PG8_STAGE(PG8_SA(0, 0), cA, voffA); PG8_STAGE(PG8_SA(0, 1), cA + hstep, voffA);
        if (wr == 1) PG8_BAR;
        PG8_WAIT_V(2); PG8_BAR;
        PG8_STAGE(PG8_SB(1, 0), cB + kstep, voffB); PG8_STAGE(PG8_SA(1, 0), cA + kstep, voffA); PG8_STAGE(PG8_SB(1, 1), cB + hstep + kstep, voffB);
        PG8_WAIT_V(6); PG8_BAR;
    } else {
        PG8_STAGE(PG8_SB(0, 0), cB, voffB); PG8_STAGE(PG8_SA(0, 0), cA, voffA); PG8_STAGE(PG8_SB(0, 1), cB + hstep, voffB); PG8_STAGE(PG8_SA(0, 1), cA + hstep, voffA);
        if (wr == 1) PG8_BAR;
        PG8_WAIT_V(4); PG8_BAR;
        PG8_STAGE(PG8_SB(1, 0), cB + kstep, voffB); PG8_STAGE(PG8_SA(1, 0), cA + kstep, voffA); PG8_STAGE(PG8_SB(1, 1), cB + hstep + kstep, voffB);
        PG8_WAIT_V(6); PG8_BAR;
    }
    for (;;) {
        const bool has_next = S.next(ui + 1, nxt);
        const char* nA = has_next ? (const char*)g.A + (size_t)nxt.pm * tstep : cA; const char* nB = has_next ? (const char*)g.Bt + (size_t)nxt.pn * tstep : cB;
        for (int t = 0; t < nt; t += 2) {
            const bool last = (t == nt - 2);
            const char* a1 = cA + (size_t)(t + 1) * kstep;
            const char* a2 = last ? nA : cA + (size_t)(t + 2) * kstep; const char* b2 = last ? nB : cB + (size_t)(t + 2) * kstep;
            const char* a3 = a2 + kstep; const char* b3 = b2 + kstep;
            if (last && has_next) S.a_ready(nxt);
            if constexpr (SP2) {
            PG8_LDB(B0, 0, 0); PG8_LDB(B1, 0, 1); PG8_SCHED; PG8_LDA(At, 0, 0); PG8_STAGE(PG8_SA(1, 1), a1 + hstep, voffA);
            PG8_WAIT_V(8); PG8_WAIT_L(0); PG8_PRIO_UP_PRE; PG8_BAR; PG8_PRIO_UP_POST; PG8_MMA(0, 0, At, B0); PG8_MMA(0, 1, At, B1); __builtin_amdgcn_s_setprio(0); PG8_BAR; PG8_SCHED;
            PG8_LDA(At, 0, 1); PG8_STAGE(PG8_SB(0, 0), b2, voffB); PG8_STAGE(PG8_SB(0, 1), b2 + hstep, voffB); PG8_STAGE(PG8_SA(0, 0), a2, voffA);
            PG8_WAIT_V(8); PG8_WAIT_L(0); PG8_PRIO_UP_PRE; PG8_BAR; PG8_PRIO_UP_POST; PG8_MMA(1, 0, At, B0); PG8_MMA(1, 1, At, B1); __builtin_amdgcn_s_setprio(0); PG8_BAR; PG8_SCHED;
            PG8_LDB(B0, 1, 0); PG8_LDB(B1, 1, 1); PG8_SCHED; PG8_LDA(At, 1, 0); PG8_STAGE(PG8_SA(0, 1), a2 + hstep, voffA);
            PG8_WAIT_V(8); PG8_WAIT_L(0); PG8_PRIO_UP_PRE; PG8_BAR; PG8_PRIO_UP_POST; PG8_MMA(0, 0, At, B0); PG8_MMA(0, 1, At, B1); __builtin_amdgcn_s_setprio(0); PG8_BAR; PG8_SCHED;
            PG8_LDA(At, 1, 1); PG8_STAGE(PG8_SB(1, 0), b3, voffB); PG8_STAGE(PG8_SB(1, 1), b3 + hstep, voffB); PG8_STAGE(PG8_SA(1, 0), a3, voffA);
            PG8_WAIT_V(8); PG8_WAIT_L(0); PG8_PRIO_UP_PRE; PG8_BAR; PG8_PRIO_UP_POST; PG8_MMA(1, 0, At, B0); PG8_MMA(1, 1, At, B1); __builtin_amdgcn_s_setprio(0); PG8_BAR; PG8_SCHED;
            } else {
            PG8_LDB(B0, 0, 0); PG8_SCHED; PG8_LDA(At, 0, 0); PG8_STAGE(PG8_SA(1, 1), a1 + hstep, voffA);
            PG8_WAIT_L(8); PG8_BAR; PG8_WAIT_L(0); PG8_MMA(0, 0, At, B0); PG8_BAR; PG8_SCHED;
            PG8_LDB(B1, 0, 1); PG8_STAGE(PG8_SB(0, 0), b2, voffB);
            PG8_BAR; PG8_WAIT_L(0); PG8_MMA(0, 1, At, B1); PG8_BAR;
            PG8_LDA(At, 0, 1); PG8_STAGE(PG8_SA(0, 0), a2, voffA);
            PG8_BAR; PG8_WAIT_L(0); PG8_MMA(1, 0, At, B0); PG8_BAR; PG8_SCHED;
            PG8_STAGE(PG8_SB(0, 1), b2 + hstep, voffB);
            PG8_WAIT_V(6); PG8_BAR; PG8_MMA(1, 1, At, B1); PG8_BAR;
            PG8_LDB(B0, 1, 0); PG8_SCHED; PG8_LDA(At, 1, 0); PG8_STAGE(PG8_SA(0, 1), a2 + hstep, voffA);
            PG8_WAIT_L(8); PG8_BAR; PG8_WAIT_L(0); PG8_MMA(0, 0, At, B0); PG8_BAR; PG8_SCHED;
            PG8_LDB(B1, 1, 1); PG8_STAGE(PG8_SB(1, 0), b3, voffB);
            PG8_BAR; PG8_WAIT_L(0); PG8_MMA(0, 1, At, B1); PG8_BAR;
            PG8_LDA(At, 1, 1); PG8_STAGE(PG8_SA(1, 0), a3, voffA);
            PG8_BAR; PG8_WAIT_L(0); PG8_MMA(1, 0, At, B0); PG8_BAR; PG8_SCHED;
            PG8_STAGE(PG8_SB(1, 1), b3 + hstep, voffB);
            PG8_WAIT_V(6); PG8_BAR; PG8_MMA(1, 1, At, B1); PG8_BAR;
            }
        }
        if constexpr (ALIGN_EPI) { if (wr == 0) PG8_BAR; }
        if constexpr (!Epi::AFTER_DRAIN) { E(acc, cur, wr, wc, fr, fq); S.done(cur); }
        if (!has_next) break;
#pragma unroll
        for (int a = 0; a < 2; ++a)
#pragma unroll
            for (int b = 0; b < 2; ++b)
#pragma unroll
                for (int m = 0; m < 4; ++m)
#pragma unroll
                    for (int n = 0; n < 2; ++n) acc[a][b][m][n] = (f32x4){0.f, 0.f, 0.f, 0.f};
        cur = nxt; cA = nA; cB = nB; ++ui;
        if constexpr (ALIGN_EPI) { if (wr == 1) PG8_BAR; }
    }
    PG8_WAIT_V(0);
    if constexpr (!ALIGN_EPI) { if (wr == 0) PG8_BAR; }
    PG8_BAR;
    if constexpr (Epi::AFTER_DRAIN) { E.fused(acc, cur, wr, wc, fr, fq, lds, wid, lane); S.done(cur); }
#undef PG8_SA
#undef PG8_SB
#undef PG8_STAGE
#undef PG8_LDA
#undef PG8_LDB
#undef PG8_MMA
#undef PG8_WAIT_V
#undef PG8_WAIT_L
#undef PG8_BAR
#undef PG8_SCHED
}
}
namespace att {
using bf16 = unsigned short;
typedef short bf16x8 __attribute__((ext_vector_type(8)));
typedef short s16x4 __attribute__((ext_vector_type(4)));
typedef float f32x16 __attribute__((ext_vector_type(16)));
typedef float f32x4 __attribute__((ext_vector_type(4)));
typedef unsigned u32x4 __attribute__((ext_vector_type(4)));
constexpr int D = 128, NW = 8, QBLK = 32, KVBLK = 64, QB = NW * QBLK;
constexpr int SHM_V = KVBLK * D * 2, SHM_K = KVBLK * D * 2;
constexpr int LDS_BYTES = 2 * SHM_V + 2 * SHM_K + NW * 64 * 4;
#define KSWZ(row, colB) ((row) * 256 + ((colB) ^ (((row) & 7) << 4)))
#define SBAR() __builtin_amdgcn_sched_barrier(0)
__device__ __forceinline__ int v_st(int k, int c) { const int kk = (k & ~0xC) | ((k & 4) << 1) | ((k & 8) >> 1); return ((kk >> 3) * 4 + (c >> 5)) * 512 + ((kk & 7) * 32 + (c & 31)) * 2; }
__device__ __forceinline__ int v_rd_base(int lane) { return ((lane & 3) << 3) | (((lane >> 2) & 3) << 6) | (((lane >> 4) & 1) << 5) | (((lane >> 5) & 1) << 8); }
constexpr int v_rd_off(int d0, int ks, int half) { return d0 * 512 + ks * 4096 + half * 2048; }
__device__ __forceinline__ int crow(int r, int hi) { return (r & 3) + 8 * (r >> 2) + 4 * hi; }
__device__ __forceinline__ unsigned cvtpk(float lo, float hi) { unsigned r; asm volatile("v_cvt_pk_bf16_f32 %0, %1, %2" : "=v"(r) : "v"(lo), "v"(hi)); return r; }
__device__ __forceinline__ bf16x8 load8(const bf16* p) { return *reinterpret_cast<const bf16x8*>(p); }

#define PK4(P, B_, OUT) do { unsigned a0 = cvtpk(P[B_+0], P[B_+1]), a1 = cvtpk(P[B_+2], P[B_+3]);                          \
        unsigned b0 = cvtpk(P[B_+4], P[B_+5]), b1 = cvtpk(P[B_+6], P[B_+7]);                                             \
        auto r0 = __builtin_amdgcn_permlane32_swap(a0, b0, false, false); auto r1 = __builtin_amdgcn_permlane32_swap(a1, b1, false, false); \
        u32x4 w = {r0[0], r1[0], r0[1], r1[1]}; OUT = *reinterpret_cast<bf16x8*>(&w); } while (0)

__device__ __forceinline__ void qkt_rt(f32x16& p0, f32x16& p1, const char* Kt, int r32, int hi, const bf16x8* qr) {
    p0 = f32x16{}; p1 = f32x16{};
    const char* kb[4];
#pragma unroll
    for (int dd = 0; dd < 4; ++dd) kb[dd] = Kt + KSWZ(r32, (dd * 16 + hi * 8) * 2);
#pragma unroll
    for (int d0 = 0; d0 < 8; ++d0) { const char* a = kb[d0 & 3] + (d0 >> 2) * 128;
        bf16x8 b0 = *reinterpret_cast<const bf16x8*>(a);
        bf16x8 b1 = *reinterpret_cast<const bf16x8*>(a + 32 * 256);
        p0 = __builtin_amdgcn_mfma_f32_32x32x16_bf16(b0, qr[d0], p0, 0, 0, 0);
        p1 = __builtin_amdgcn_mfma_f32_32x32x16_bf16(b1, qr[d0], p1, 0, 0, 0); }
}
__device__ __forceinline__ void pv_rt(f32x16* o, int vb, bf16x8 pa0, bf16x8 pa1, bf16x8 pa2, bf16x8 pa3) {
#define TRRD(dst, off) asm volatile("ds_read_b64_tr_b16 %0, %1 offset:%2" : "=&v"(dst) : "v"(vb), "i"(off) : "memory")
#define PV_D0(d0) do { s16x4 l0, l1, l2, l3, h0, h1, h2, h3; constexpr int b_ = v_rd_off(d0, 0, 0); \
        TRRD(l0, b_); TRRD(h0, b_ + 2048); TRRD(l1, b_ + 4096); TRRD(h1, b_ + 6144); TRRD(l2, b_ + 8192); TRRD(h2, b_ + 10240); TRRD(l3, b_ + 12288); TRRD(h3, b_ + 14336); \
        asm volatile("s_waitcnt lgkmcnt(0)" ::: "memory"); SBAR();   \
        o[d0] = __builtin_amdgcn_mfma_f32_32x32x16_bf16(pa0, (bf16x8){l0[0], l0[1], l0[2], l0[3], h0[0], h0[1], h0[2], h0[3]}, o[d0], 0, 0, 0);   \
        o[d0] = __builtin_amdgcn_mfma_f32_32x32x16_bf16(pa1, (bf16x8){l1[0], l1[1], l1[2], l1[3], h1[0], h1[1], h1[2], h1[3]}, o[d0], 0, 0, 0);   \
        o[d0] = __builtin_amdgcn_mfma_f32_32x32x16_bf16(pa2, (bf16x8){l2[0], l2[1], l2[2], l2[3], h2[0], h2[1], h2[2], h2[3]}, o[d0], 0, 0, 0);   \
        o[d0] = __builtin_amdgcn_mfma_f32_32x32x16_bf16(pa3, (bf16x8){l3[0], l3[1], l3[2], l3[3], h3[0], h3[1], h3[2], h3[3]}, o[d0], 0, 0, 0); } while (0)
    PV_D0(0); PV_D0(1); PV_D0(2); PV_D0(3);
#undef PV_D0
#undef TRRD
}

constexpr float SB_DONE = 1e-30f;
__device__ __forceinline__ void sb_half(f32x16& p, float& carry, int dq, bool needmask, bool lane_hi) {
    float kp[16];
#pragma unroll
    for (int r = 0; r < 16; ++r) {
        const float zz = fminf(p[r], 100.f);
        const float e = __builtin_amdgcn_exp2f(zz);
        float k = __builtin_amdgcn_rcpf(1.f + e);
        float be = e * k;
        if (needmask) { const int c = 8 * (r >> 2) + (r & 3); const bool valid = (dq - c) > 0; k = valid ? k : 1.f; be = valid ? be : 0.f; }
        kp[r] = k; p[r] = be;
    }
    float L[4], H[4];
#pragma unroll
    for (int j = 0; j < 4; ++j) { const float g = (kp[4 * j] * kp[4 * j + 1]) * (kp[4 * j + 2] * kp[4 * j + 3]);
        auto rr = __builtin_amdgcn_permlane32_swap(__float_as_uint(g), __float_as_uint(g), false, false);
        L[j] = __uint_as_float(rr[0]); H[j] = __uint_as_float(rr[1]); }
    float U[4]; U[3] = 1.f; U[2] = L[3] * H[3]; U[1] = U[2] * (L[2] * H[2]); U[0] = U[1] * (L[1] * H[1]);
    const float tot = U[0] * (L[0] * H[0]);
#pragma unroll
    for (int j = 0; j < 4; ++j) {
        const float a3 = carry * U[j] * (lane_hi ? 1.f : H[j]);
        const float a2 = a3 * kp[4 * j + 3], a1 = a2 * kp[4 * j + 2], a0 = a1 * kp[4 * j + 1];
        p[4 * j + 3] *= a3; p[4 * j + 2] *= a2; p[4 * j + 1] *= a1; p[4 * j] *= a0;
    }
    carry *= tot;
}

template <int PQ, int PK, int PV, int PO>
__device__ __forceinline__ void sb_block(const bf16* Q, const bf16* K, const bf16* V, bf16* O, int P0, char* lds, volatile __attribute__((address_space(3))) unsigned* flags) {
    const int tid = pg8::tid_opaque(), wid = __builtin_amdgcn_readfirstlane(tid >> 6), lane = tid & 63, r32 = lane & 31, hi = lane >> 5;
    char* K_lds = lds; char* V_lds = lds + 2 * SHM_K;
    const int sr = tid >> 4, sc = (tid & 15) * 8, vst0 = v_st(sr, sc), vst1 = v_st(32 + sr, sc), kws = KSWZ(sr, sc * 2);
    const int vb0 = (int)(uintptr_t)V_lds + v_rd_base(lane);
    bf16x8 qr[8];
#pragma unroll
    for (int d0 = 0; d0 < 8; ++d0) qr[d0] = load8(Q + (size_t)(wid * QBLK + r32) * PQ + d0 * 16 + hi * 8);
    f32x16 o[4] = {};
    float carry = 1.f;
    const int qlo = P0 + wid * QBLK, qpos = qlo + r32;
    int j = P0 / KVBLK + 3;
    bf16x8 st_k0, st_k1, st_v0, st_v1;
#define SB_LOAD(jt) do { const size_t k0_ = (size_t)(jt) * KVBLK; st_k0 = load8(K + (k0_ + sr) * PK + sc); st_k1 = load8(K + (k0_ + 32 + sr) * PK + sc); \
                         st_v0 = load8(V + (k0_ + sr) * PV + sc); st_v1 = load8(V + (k0_ + 32 + sr) * PV + sc); } while (0)
#define SB_WRITE(bf) do { *(bf16x8*)(K_lds + (bf) * SHM_K + kws) = st_k0; *(bf16x8*)(K_lds + (bf) * SHM_K + kws + 32 * 256) = st_k1; \
                          *(bf16x8*)(V_lds + (bf) * SHM_V + vst0) = st_v0; *(bf16x8*)(V_lds + (bf) * SHM_V + vst1) = st_v1; } while (0)
    SB_LOAD(j); asm volatile("s_waitcnt vmcnt(0)" ::: "memory"); SB_WRITE(0);
    __syncthreads();
    int buf = 0, it = 0; bool wdone = false;
    for (;;) {
        const int kb = j * KVBLK; const bool more = j > 0;
        if (more) SB_LOAD(j - 1);
        const bool act = !wdone && (kb < qlo + QBLK - 1);
        if (act) {
            f32x16 p0, p1;
            qkt_rt(p0, p1, K_lds + buf * SHM_K, r32, hi, qr);
            const bool needmask = kb + KVBLK - 1 >= qlo;
            sb_half(p1, carry, qpos - (kb + 32) - 4 * hi, needmask, hi != 0);
            sb_half(p0, carry, qpos - kb - 4 * hi, needmask, hi != 0);
            bf16x8 pa0, pa1, pa2, pa3;
            PK4(p0, 0, pa0); PK4(p0, 8, pa1); PK4(p1, 0, pa2); PK4(p1, 8, pa3);
            SBAR();
            pv_rt(o, vb0 + buf * SHM_V, pa0, pa1, pa2, pa3);
            wdone = __all(carry < SB_DONE);
        }
        if (more) { asm volatile("s_waitcnt vmcnt(0)" ::: "memory"); SB_WRITE(buf ^ 1); }
        if (lane == 0) flags[(it & 1) * 8 + wid] = wdone ? 1u : 0u;
        __syncthreads();
        unsigned alld = 1u;
#pragma unroll
        for (int w = 0; w < NW; ++w) alld &= flags[(it & 1) * 8 + w];
        if (!more || alld) break;
        --j; buf ^= 1; ++it;
    }
#undef SB_LOAD
#undef SB_WRITE
    bf16* Ow = O + (size_t)(wid * QBLK) * PO;
#pragma unroll
    for (int r = 0; r < 16; ++r) { const int orow = crow(r, hi);
#pragma unroll
        for (int d0 = 0; d0 < 4; ++d0) { const float v = o[d0][r]; const float vn = __shfl_xor(v, 1);
            if ((r32 & 1) == 0) *(unsigned*)(Ow + (size_t)orow * PO + d0 * 32 + r32) = cvtpk(v, vn); } }
    __syncthreads();
}

constexpr float THR2 = 8.f * 1.4426950408889634f;
struct DiffRef { const bf16* Q; const bf16* K; const bf16* V; bf16* O; int P0; int mode; };
struct DiffConst { float lam; float omli; float eps; const float* gain; float* scr; };
template <int PQ, int PK, int PV, int PO>
__device__ __forceinline__ void sm_block(const DiffRef& cur, const DiffConst& C, char* lds) {
    const int tid = pg8::tid_opaque(), wid = __builtin_amdgcn_readfirstlane(tid >> 6), lane = tid & 63, r32 = lane & 31, hi = lane >> 5;
    char* K_lds = lds; char* V_lds = lds + 2 * SHM_K; float* al_l = (float*)(lds + 2 * SHM_K + 2 * SHM_V) + wid * 32;
    const int sr = tid >> 4, sc = (tid & 15) * 8, vst0 = v_st(sr, sc), vst1 = v_st(32 + sr, sc), kws = KSWZ(sr, sc * 2);
    const int vb0 = (int)(uintptr_t)V_lds + v_rd_base(lane);
    const bf16* Q = cur.Q; const bf16* K = cur.K; const bf16* V = cur.V; const int P0 = cur.P0;
    bf16x8 qr[8];
#pragma unroll
    for (int d0 = 0; d0 < 8; ++d0) qr[d0] = load8(Q + (size_t)(wid * QBLK + r32) * PQ + d0 * 16 + hi * 8);
    f32x16 o[4] = {};
    float m_reg = -1e30f, l_reg = 0.f;
    const int qlo = P0 + wid * QBLK, qm = qlo + r32 - 4 * hi;
    const int NT = P0 / KVBLK + 4;
    bf16x8 st_k0, st_k1, st_v0, st_v1;
#define SM_LOAD(jt) do { const size_t k0_ = (size_t)(jt) * KVBLK; st_k0 = load8(K + (k0_ + sr) * PK + sc); st_k1 = load8(K + (k0_ + 32 + sr) * PK + sc); \
                         st_v0 = load8(V + (k0_ + sr) * PV + sc); st_v1 = load8(V + (k0_ + 32 + sr) * PV + sc); } while (0)
#define SM_WRITE(bf) do { *(bf16x8*)(K_lds + (bf) * SHM_K + kws) = st_k0; *(bf16x8*)(K_lds + (bf) * SHM_K + kws + 32 * 256) = st_k1; \
                          *(bf16x8*)(V_lds + (bf) * SHM_V + vst0) = st_v0; *(bf16x8*)(V_lds + (bf) * SHM_V + vst1) = st_v1; } while (0)
    SM_LOAD(0); asm volatile("s_waitcnt vmcnt(0)" ::: "memory"); SM_WRITE(0);
    __syncthreads();
    int buf = 0;
    for (int t = 0; t < NT; ++t) {
        const int kb = t * KVBLK; const bool more = t + 1 < NT;
        if (more) SM_LOAD(t + 1);
        if (kb <= qlo + QBLK - 1) {
            f32x16 p0, p1;
            qkt_rt(p0, p1, K_lds + buf * SHM_K, r32, hi, qr);
            if (kb + KVBLK - 1 > qlo) {
                const int dq = qm - kb; const float NEG = -__builtin_inff();
#pragma unroll
                for (int r = 0; r < 16; ++r) { const int c = (r & 3) + 8 * (r >> 2); if ((dq - c) < 0) p0[r] = NEG; if ((dq - c - 32) < 0) p1[r] = NEG; }
            }
            float pmax = p0[0];
#pragma unroll
            for (int r = 1; r < 16; ++r) pmax = fmaxf(pmax, p0[r]);
#pragma unroll
            for (int r = 0; r < 16; ++r) pmax = fmaxf(pmax, p1[r]);
            { auto rr = __builtin_amdgcn_permlane32_swap(__float_as_uint(pmax), __float_as_uint(pmax), false, false); pmax = fmaxf(__uint_as_float(rr[0]), __uint_as_float(rr[1])); }
            float alpha = 1.f;
            if (!__all((pmax - m_reg) <= THR2)) {
                const float mn = fmaxf(m_reg, pmax); alpha = __builtin_amdgcn_exp2f(m_reg - mn); m_reg = mn;
                if (hi == 0) al_l[r32] = alpha; asm volatile("s_waitcnt lgkmcnt(0)" ::: "memory");
#pragma unroll
                for (int d_ = 0; d_ < 4; ++d_)
#pragma unroll
                    for (int r = 0; r < 16; ++r) o[d_][r] *= al_l[crow(r, hi)];
            }
            float ps = 0.f;
#pragma unroll
            for (int r = 0; r < 16; ++r) { p0[r] = __builtin_amdgcn_exp2f(p0[r] - m_reg); ps += p0[r]; }
#pragma unroll
            for (int r = 0; r < 16; ++r) { p1[r] = __builtin_amdgcn_exp2f(p1[r] - m_reg); ps += p1[r]; }
            { auto rr = __builtin_amdgcn_permlane32_swap(__float_as_uint(ps), __float_as_uint(ps), false, false); ps = __uint_as_float(rr[0]) + __uint_as_float(rr[1]); }
            l_reg = l_reg * alpha + ps;
            bf16x8 pa0, pa1, pa2, pa3;
            PK4(p0, 0, pa0); PK4(p0, 8, pa1); PK4(p1, 0, pa2); PK4(p1, 8, pa3);
            SBAR();
            pv_rt(o, vb0 + buf * SHM_V, pa0, pa1, pa2, pa3);
        }
        if (more) { asm volatile("s_waitcnt vmcnt(0)" ::: "memory"); SM_WRITE(buf ^ 1); }
        __syncthreads();
        buf ^= 1;
    }
#undef SM_LOAD
#undef SM_WRITE
    if (hi == 0) al_l[r32] = l_reg; asm volatile("s_waitcnt lgkmcnt(0)" ::: "memory");
    float rli[16];
#pragma unroll
    for (int r = 0; r < 16; ++r) rli[r] = __builtin_amdgcn_rcpf(al_l[crow(r, hi)]);
#define OPQ(v) asm volatile("" : "+v"(v))
    char* sA = (char*)C.scr; char* sB = sA + 16384;
    const unsigned lo16 = (unsigned)lane * 16u;
    const int mode = cur.mode;
    if (mode == 0 || mode == 1) { char* s = mode ? sB : sA;
#pragma unroll
        for (int r = 0; r < 16; ++r) { unsigned vo = lo16; OPQ(vo);
            const f32x4 v = {o[0][r] * rli[r], o[1][r] * rli[r], o[2][r] * rli[r], o[3][r] * rli[r]};
            *(f32x4*)(s + (size_t)(vo + r * 1024)) = v; }
    } else if (mode == 2) {
#pragma unroll
        for (int r = 0; r < 16; ++r) { unsigned vo = lo16; OPQ(vo);
            f32x4* ap = (f32x4*)(sA + (size_t)(vo + r * 1024)); const f32x4 a = *ap;
            const f32x4 v = {a[0] - C.lam * (o[0][r] * rli[r]), a[1] - C.lam * (o[1][r] * rli[r]), a[2] - C.lam * (o[2][r] * rli[r]), a[3] - C.lam * (o[3][r] * rli[r])};
            *ap = v;
            if ((r & 3) == 3) asm volatile("" ::: "memory"); }
    } else {
        float g0[4], g1[4];
#pragma unroll
        for (int d0 = 0; d0 < 4; ++d0) { g0[d0] = C.gain[d0 * 32 + r32]; g1[d0] = C.gain[128 + d0 * 32 + r32]; }
        char* Ow = (char*)(cur.O + (size_t)(wid * QBLK) * PO);
        const unsigned lo_o = (unsigned)((4 * hi) * PO + r32) * 2u;
#pragma unroll
        for (int r = 0; r < 16; ++r) { unsigned vo = lo16; OPQ(vo);
            const f32x4 a = *(const f32x4*)(sA + (size_t)(vo + r * 1024)); const f32x4 b = *(const f32x4*)(sB + (size_t)(vo + r * 1024));
            float d1[4], ss = 0.f;
#pragma unroll
            for (int d0 = 0; d0 < 4; ++d0) { d1[d0] = b[d0] - C.lam * (o[d0][r] * rli[r]); ss += d1[d0] * d1[d0] + a[d0] * a[d0]; }
            ss += __shfl_xor(ss, 1); ss += __shfl_xor(ss, 2); ss += __shfl_xor(ss, 4); ss += __shfl_xor(ss, 8); ss += __shfl_xor(ss, 16);
            const float scl = rsqrtf(ss * (1.f / 256.f) + C.eps) * C.omli;
            unsigned wo = lo_o; OPQ(wo);
            char* rowp = Ow + (size_t)(wo + (unsigned)(((r & 3) + 8 * (r >> 2)) * PO * 2));
#pragma unroll
            for (int d0 = 0; d0 < 4; ++d0) {
                const float v0 = a[d0] * scl * g0[d0], v1 = d1[d0] * scl * g1[d0];
                const float v0n = __shfl_xor(v0, 1), v1n = __shfl_xor(v1, 1);
                if ((r32 & 1) == 0) { *(unsigned*)(rowp + d0 * 64) = cvtpk(v0, v0n); *(unsigned*)(rowp + 256 + d0 * 64) = cvtpk(v1, v1n); }
            }
            if ((r & 1) == 1) asm volatile("" ::: "memory");
        }
    }
#undef OPQ
    __syncthreads();
}

constexpr int K2 = 32;
constexpr int ST2_K0 = 0, ST2_K1 = 8192, ST2_V = 16384, ST2_BYTES = 32768;
__device__ __forceinline__ int v_st2(int k, int c) { const int kk = (k & ~0xC) | ((k & 4) << 1) | ((k & 8) >> 1); return ((kk >> 3) * 8 + (c >> 5)) * 512 + ((kk & 7) * 32 + (c & 31)) * 2; }
struct Diff2Const { float lam; float omli; float eps; float mb; const float* gain; };
template <int PQ, int PK, int PV, int PO>
__device__ __forceinline__ void diff2_block(const bf16* Qb  , const bf16* Kb  , const bf16* Vb  ,
                                            bf16* Ob, int P0, const Diff2Const& C, char* lds) {
    const int tid = pg8::tid_opaque(), wid = __builtin_amdgcn_readfirstlane(tid >> 6), lane = tid & 63, r32 = lane & 31, hi = lane >> 5;
    const int rg = wid & 3, cc = wid >> 2;
    const int krow = tid >> 4, kcol = (tid & 15) * 8, kws = KSWZ(krow, kcol * 2);
    const int vrow0 = tid >> 5, vcol = (tid & 31) * 8, vst0 = v_st2(vrow0, vcol), vst1 = v_st2(16 + vrow0, vcol);
    const int vb0 = (int)(uintptr_t)lds + ST2_V + v_rd_base(lane);
    const char* Kmine = lds + (cc ? ST2_K1 : ST2_K0);
    bf16x8 qr[8];
    { unsigned qo = (unsigned)((rg * QBLK + r32) * PQ + cc * 128 + hi * 8) * 2u; asm volatile("" : "+v"(qo));
#pragma unroll
      for (int d0 = 0; d0 < 8; ++d0) qr[d0] = *(const bf16x8*)((const char*)Qb + (size_t)qo + d0 * 32); }
    f32x16 o[8];
#pragma unroll
    for (int d0 = 0; d0 < 8; ++d0) o[d0] = f32x16{};
    float l_reg = 0.f;
    const int qlo = P0 + rg * QBLK, qm = qlo + r32 - 4 * hi;
    const int NT = P0 / K2 + 4;
    bf16x8 st_k0, st_k1, st_v0, st_v1;
    const unsigned koff = (unsigned)(krow * PK + kcol) * 2u, voffa = (unsigned)(vrow0 * PV + vcol) * 2u, voffb = (unsigned)((16 + vrow0) * PV + vcol) * 2u;
#define D2_LOAD(jt) do { const char* kt_ = (const char*)Kb + (size_t)(jt) * (K2 * PK * 2); const char* vt_ = (const char*)Vb + (size_t)(jt) * (K2 * PV * 2); \
                         unsigned ko_ = koff, va_ = voffa, vb_ = voffb; asm volatile("" : "+v"(ko_), "+v"(va_), "+v"(vb_)); \
                         st_k0 = *(const bf16x8*)(kt_ + (size_t)ko_); st_k1 = *(const bf16x8*)(kt_ + (size_t)ko_ + 256); \
                         st_v0 = *(const bf16x8*)(vt_ + (size_t)va_); st_v1 = *(const bf16x8*)(vt_ + (size_t)vb_); } while (0)
#define D2_WRITE(bf) do { char* st_ = lds + (bf) * ST2_BYTES; *(bf16x8*)(st_ + ST2_K0 + kws) = st_k0; *(bf16x8*)(st_ + ST2_K1 + kws) = st_k1; \
                          *(bf16x8*)(st_ + ST2_V + vst0) = st_v0; *(bf16x8*)(st_ + ST2_V + vst1) = st_v1; } while (0)
    D2_LOAD(0); asm volatile("s_waitcnt vmcnt(0)" ::: "memory"); D2_WRITE(0);
    __syncthreads();
    int buf = 0;
    for (int t = 0; t < NT; ++t) {
        const int kb = t * K2; const bool more = t + 1 < NT;
        if (more) D2_LOAD(t + 1);
        if (kb <= qlo + QBLK - 1) {
            f32x16 p0 = f32x16{};
            { const char* Kt = Kmine + buf * ST2_BYTES; const char* kbp[4];
#pragma unroll
              for (int dd = 0; dd < 4; ++dd) kbp[dd] = Kt + KSWZ(r32, (dd * 16 + hi * 8) * 2);
#pragma unroll
              for (int d0 = 0; d0 < 8; ++d0) { const bf16x8 b0 = *reinterpret_cast<const bf16x8*>(kbp[d0 & 3] + (d0 >> 2) * 128); p0 = __builtin_amdgcn_mfma_f32_32x32x16_bf16(b0, qr[d0], p0, 0, 0, 0); } }
            const float mb = C.mb;
            if (kb + K2 - 1 > qlo) {
                const int dq = qm - kb;
#pragma unroll
                for (int r = 0; r < 16; ++r) { const int c = (r & 3) + 8 * (r >> 2); const float e = __builtin_amdgcn_exp2f(p0[r] - mb); p0[r] = (dq - c) >= 0 ? e : 0.f; }
            } else {
#pragma unroll
                for (int r = 0; r < 16; ++r) p0[r] = __builtin_amdgcn_exp2f(p0[r] - mb);
            }
            float ps = 0.f;
#pragma unroll
            for (int r = 0; r < 16; ++r) ps += p0[r];
            l_reg += ps;
            bf16x8 pa0, pa1;
            PK4(p0, 0, pa0); PK4(p0, 8, pa1);
            SBAR();
            const int vb = vb0 + buf * ST2_BYTES;
#define TRRD(dst, off) asm volatile("ds_read_b64_tr_b16 %0, %1 offset:%2" : "=&v"(dst) : "v"(vb), "i"(off) : "memory")
#define PV2_RD(d0, L0, H0, L1, H1) do { constexpr int b_ = (d0) * 512; TRRD(L0, b_); TRRD(H0, b_ + 4096); TRRD(L1, b_ + 8192); TRRD(H1, b_ + 12288); } while (0)
#define PV2_MM(d0, L0, H0, L1, H1) do { \
        o[d0] = __builtin_amdgcn_mfma_f32_32x32x16_bf16(pa0, (bf16x8){L0[0], L0[1], L0[2], L0[3], H0[0], H0[1], H0[2], H0[3]}, o[d0], 0, 0, 0); \
        o[d0] = __builtin_amdgcn_mfma_f32_32x32x16_bf16(pa1, (bf16x8){L1[0], L1[1], L1[2], L1[3], H1[0], H1[1], H1[2], H1[3]}, o[d0], 0, 0, 0); } while (0)
#define LGK(n) do { asm volatile("s_waitcnt lgkmcnt(" #n ")" ::: "memory"); SBAR(); } while (0)
            { s16x4 la0, ha0, la1, ha1, lb0, hb0, lb1, hb1;
              PV2_RD(0, la0, ha0, la1, ha1);
              PV2_RD(1, lb0, hb0, lb1, hb1); LGK(4); PV2_MM(0, la0, ha0, la1, ha1);
              PV2_RD(2, la0, ha0, la1, ha1); LGK(4); PV2_MM(1, lb0, hb0, lb1, hb1);
              PV2_RD(3, lb0, hb0, lb1, hb1); LGK(4); PV2_MM(2, la0, ha0, la1, ha1);
              PV2_RD(4, la0, ha0, la1, ha1); LGK(4); PV2_MM(3, lb0, hb0, lb1, hb1);
              PV2_RD(5, lb0, hb0, lb1, hb1); LGK(4); PV2_MM(4, la0, ha0, la1, ha1);
              PV2_RD(6, la0, ha0, la1, ha1); LGK(4); PV2_MM(5, lb0, hb0, lb1, hb1);
              PV2_RD(7, lb0, hb0, lb1, hb1); LGK(4); PV2_MM(6, la0, ha0, la1, ha1);
              LGK(0); PV2_MM(7, lb0, hb0, lb1, hb1); }
#undef PV2_RD
#undef PV2_MM
#undef LGK
#undef TRRD
        }
        if (more) { asm volatile("s_waitcnt vmcnt(0)" ::: "memory"); D2_WRITE(buf ^ 1); }
        __syncthreads();
        buf ^= 1;
    }
#undef D2_LOAD
#undef D2_WRITE
    { auto rr = __builtin_amdgcn_permlane32_swap(__float_as_uint(l_reg), __float_as_uint(l_reg), false, false); l_reg = __uint_as_float(rr[0]) + __uint_as_float(rr[1]); }
    float* lw = (float*)(lds + 132096) + wid * 32;
    if (hi == 0) lw[r32] = l_reg; asm volatile("s_waitcnt lgkmcnt(0)" ::: "memory");
    float rli[16];
#pragma unroll
    for (int r = 0; r < 16; ++r) rli[r] = __builtin_amdgcn_rcpf(lw[crow(r, hi)]);
    float* X = (float*)lds + rg * 8192;
#define OPQ(v) asm volatile("" : "+v"(v))
    if (cc == 1) {
#pragma unroll
        for (int r = 0; r < 16; ++r) { const float f = C.lam * rli[r]; unsigned vo = (unsigned)lane; OPQ(vo);
#pragma unroll
            for (int d0 = 0; d0 < 8; ++d0) X[(r * 8 + d0) * 64 + vo] = o[d0][r] * f; }
    }
    __syncthreads();
    if (cc == 0) {
        float g[8];
        { unsigned go = (unsigned)r32 * 4u; OPQ(go);
#pragma unroll
          for (int d0 = 0; d0 < 8; ++d0) g[d0] = *(const float*)((const char*)C.gain + (size_t)go + d0 * 128); }
        char* Ow = (char*)(Ob + (size_t)(rg * QBLK) * PO);
        const unsigned lo_o = (unsigned)((4 * hi) * PO + r32) * 2u;
#pragma unroll
        for (int r = 0; r < 16; ++r) { unsigned vo = (unsigned)lane; OPQ(vo);
            float d[8], ss = 0.f;
#pragma unroll
            for (int d0 = 0; d0 < 8; ++d0) { d[d0] = o[d0][r] * rli[r] - X[(r * 8 + d0) * 64 + vo]; ss += d[d0] * d[d0]; }
            ss += __shfl_xor(ss, 1); ss += __shfl_xor(ss, 2); ss += __shfl_xor(ss, 4); ss += __shfl_xor(ss, 8); ss += __shfl_xor(ss, 16);
            const float scl = rsqrtf(ss * (1.f / 256.f) + C.eps) * C.omli;
            unsigned wo = lo_o; OPQ(wo);
            char* rowp = Ow + (size_t)(wo + (unsigned)(((r & 3) + 8 * (r >> 2)) * PO * 2));
#pragma unroll
            for (int d0 = 0; d0 < 8; ++d0) { const float v = d[d0] * scl * g[d0]; const float vn = __shfl_xor(v, 1);
                if ((r32 & 1) == 0) *(unsigned*)(rowp + d0 * 64) = cvtpk(v, vn); }
        }
    }
#undef OPQ
    __syncthreads();
}
}
#ifndef PG8_SP2
#define PG8_SP2 true
#endif
#ifndef PG8_ALIGN
#define PG8_ALIGN true
#endif
#ifndef MK_SPLIT
#define MK_SPLIT 0
#endif
#ifndef MK_CHECK
#define MK_CHECK 0
#endif
constexpr int NWAVES = 8;
constexpr int BATCH = 2, SEQ = 4096, DM = 4096, MROWS = BATCH * SEQ, FF = 11008, FF2 = 2 * FF, NQKV = 3 * DM;
constexpr int SB_H = 32, DF_H = 16, HD = 128;
constexpr float RMS_EPS = 1e-6f;
constexpr float LOG2E = 1.4426950408889634f;
constexpr float QSCALE = 0.08838834764831845f * LOG2E;
constexpr int NPH = 14;
constexpr size_t MiB = 1u << 20;
constexpr size_t WS_CTL = 0, CTL_ZERO_BYTES = 1 * MiB;
constexpr size_t WS_WQKV0 = 2 * MiB;
constexpr size_t WS_WO0   = WS_WQKV0 + 96 * MiB;
constexpr size_t WS_WQKV1 = WS_WO0 + 32 * MiB;
constexpr size_t WS_WO1   = WS_WQKV1 + 96 * MiB;
constexpr size_t WS_WUP0  = WS_WO1 + 32 * MiB;
constexpr size_t WS_WUP1  = WS_WUP0 + 172 * MiB;
constexpr size_t WS_WDN0  = WS_WUP1 + 172 * MiB;
constexpr size_t WS_WDN1  = WS_WDN0 + 86 * MiB;
constexpr size_t WS_XN    = WS_WDN1 + 86 * MiB;
constexpr size_t WS_PART  = WS_XN + 64 * MiB;
constexpr size_t WS_QKV   = WS_PART + 2 * MiB;
constexpr size_t WS_QKN   = WS_QKV + 192 * MiB;
constexpr size_t WS_AO    = WS_QKN + 128 * MiB;
constexpr size_t WS_U     = WS_AO + 64 * MiB;
constexpr size_t WS_ACT   = WS_U + 344 * MiB;
constexpr size_t WS_SCR   = WS_ACT + 172 * MiB;
constexpr size_t WS_HALO  = WS_SCR + 64 * MiB;
constexpr size_t WS_X1    = WS_HALO + 44 * MiB;
constexpr size_t WS_END   = WS_X1 + (MK_CHECK ? 3 * 128 * MiB : 0);
constexpr int CW_TMO = 0, CW_CODE = 1, CW_FAIL = 2, CW_BAR = 4096;

constexpr int RING_OFF = 0, RING_BYTES = 131072;
constexpr int LDSCTL_OFF = RING_BYTES, MISC_OFF = LDSCTL_OFF + 320;
constexpr int LDS_BYTES = 147456;
constexpr int RS_OFF = MISC_OFF + 128;
static_assert(RS_OFF % 16 == 0 && RS_OFF + 1024 <= LDS_BYTES, "LDS map");

#define GAS __attribute__((address_space(1)))
#define LAS __attribute__((address_space(3)))
typedef unsigned short bf16;
typedef unsigned v4u __attribute__((ext_vector_type(4)));
typedef unsigned v2u __attribute__((ext_vector_type(2)));
typedef float f32x4 __attribute__((ext_vector_type(4)));
typedef short bf16x8 __attribute__((ext_vector_type(8)));
typedef GAS unsigned gu32;
#define RLX_AGENT __ATOMIC_RELAXED, __HIP_MEMORY_SCOPE_AGENT
#define LDS_WAIT() asm volatile("s_waitcnt lgkmcnt(0)" ::: "memory")
#define VM_WAIT() asm volatile("s_waitcnt vmcnt(0)" ::: "memory")
__device__ __forceinline__ unsigned f2bf(float f) { unsigned u = __builtin_bit_cast(unsigned, f); return (u + 0x7fffu + ((u >> 16) & 1u)) >> 16; }
__device__ __forceinline__ unsigned pk2(float lo, float hi) { return f2bf(lo) | (f2bf(hi) << 16); }
__device__ __forceinline__ float bf2f(unsigned short b) { return __builtin_bit_cast(float, (unsigned)b << 16); }

#define XB_TMO      128
#define XB_XCNT(j)  (256  + 64 * (j))
#define XB_XSUB(j)  (1280 + 64 * (j))
#define XB_XGEN(j)  (2304 + 64 * (j))
#define XB_TOP      3328
#define XB_TOPGEN   3392
#define XCD_BAR_WORDS 3456
#define XB_SPIN_CAP (1u << 18)
__device__ __forceinline__ unsigned xb_ld(unsigned* p)              { return __hip_atomic_load(p, __ATOMIC_RELAXED, __HIP_MEMORY_SCOPE_AGENT); }
__device__ __forceinline__ unsigned xb_add(unsigned* p, unsigned v) { return __hip_atomic_fetch_add(p, v, __ATOMIC_RELAXED, __HIP_MEMORY_SCOPE_AGENT); }
__device__ __forceinline__ unsigned xb_xcc_id() { return (unsigned)__builtin_amdgcn_s_getreg((3 << 11) | 20) & 0xFu; }
#define XB_SPIN(cond, bar) do { unsigned _sp = 0; while (cond) { __builtin_amdgcn_s_sleep(1); \
    if ((++_sp & 255u) == 0u) { if (xb_ld(&(bar)[XB_TMO])) break; if (_sp > XB_SPIN_CAP) { atomicAdd(&(bar)[XB_TMO], 1u); break; } } } } while (0)
struct XcdBarrier { unsigned* bar; unsigned x; volatile LAS unsigned* st; };
__device__ __forceinline__ XcdBarrier xcd_barrier_post(unsigned* bar, volatile LAS unsigned* st) {
    XcdBarrier b; b.bar = bar; b.x = xb_xcc_id(); b.st = st;
    if (threadIdx.x == 0) (void)xb_add(&bar[XB_XCNT(b.x)], 1u);
    return b;
}
__device__ __forceinline__ void xcd_barrier_complete(unsigned* bar, unsigned x, unsigned& nloc, unsigned& nx) {
    const unsigned G = gridDim.x * gridDim.y * gridDim.z;
    unsigned sum, cnt, mine, sp = 0u;
    for (;;) {
        sum = 0u; cnt = 0u; mine = 0u;
#pragma unroll
        for (unsigned j = 0; j < 16; ++j) { const unsigned c = xb_ld(&bar[XB_XCNT(j)]); sum += c; cnt += (c > 0u) ? 1u : 0u; mine = (j == x) ? c : mine; }
        if (sum == G) break;
        __builtin_amdgcn_s_sleep(1);
        if ((++sp & 255u) == 0u) { if (xb_ld(&bar[XB_TMO])) break; if (sp > XB_SPIN_CAP) { atomicAdd(&bar[XB_TMO], 1u); break; } }
    }
    nloc = mine > 0u ? mine : 1u; nx = cnt > 0u ? cnt : 1u;
}
__device__ __forceinline__ void xcd_barrier(const XcdBarrier& b) {
    asm volatile("s_waitcnt vmcnt(0)" ::: "memory");
    __syncthreads();
    if (threadIdx.x == 0) {
        unsigned* bar = b.bar; const unsigned myx = xb_xcc_id();
        __builtin_amdgcn_s_waitcnt(0);
        unsigned nloc = b.st[0], nx = b.st[1];
        if (nloc == 0u) { xcd_barrier_complete(bar, myx, nloc, nx); b.st[0] = nloc; b.st[1] = nx; }
        const unsigned old = xb_add(&bar[XB_XSUB(myx)], 1u);
        const unsigned gen = old / nloc;
        if (old + 1u == (gen + 1u) * nloc) {
            __builtin_amdgcn_fence(__ATOMIC_RELEASE, "agent");
            asm volatile("s_waitcnt vmcnt(0)" ::: "memory");
            const unsigned og = xb_add(&bar[XB_TOP], 1u);
            const unsigned tg = og / nx;
            if (og + 1u == (tg + 1u) * nx) xb_add(&bar[XB_TOPGEN], 1u);
            else XB_SPIN(xb_ld(&bar[XB_TOPGEN]) == tg, bar);
            __builtin_amdgcn_fence(__ATOMIC_ACQUIRE, "agent");
            xb_add(&bar[XB_XGEN(myx)], 1u);
            asm volatile("s_waitcnt vmcnt(0)" ::: "memory");
        } else {
            XB_SPIN(xb_ld(&bar[XB_XGEN(myx)]) == gen, bar);
            __builtin_amdgcn_fence(__ATOMIC_ACQUIRE, "agent");
            asm volatile("s_waitcnt vmcnt(0)" ::: "memory");
        }
    }
    __syncthreads();
}

__device__ __forceinline__ float wave_sum(float v) {
#pragma unroll
    for (int o = 1; o < 64; o <<= 1) v += __shfl_xor(v, o);
    return v;
}

constexpr int TR_STRIDE = 33;
__device__ __forceinline__ void transpose_item(const float* W, const float* gain, int K, int N, bf16* WT, LAS unsigned* scr, int item, int lane, bool gateperm) {
    const int nblk = N / 64, kb = item / nblk, nb = item % nblk, k0 = 64 * kb, n0 = 64 * nb;
    const int h_ = N / 2, nd0 = gateperm ? ((n0 % h_) / 128) * 256 + (n0 / h_) * 128 + (n0 % 128) : n0;
    const int kp = lane >> 4, c = lane & 15;
    f32x4 va[8], vb[8];
#pragma unroll
    for (int i = 0; i < 8; ++i) { const GAS float* src = (const GAS float*)W + (size_t)(k0 + 8 * i + 2 * kp) * N + n0 + 4 * c; va[i] = __builtin_nontemporal_load((const GAS f32x4*)src); vb[i] = __builtin_nontemporal_load((const GAS f32x4*)(src + N)); }
#pragma unroll
    for (int i = 0; i < 8; ++i) { float ga = 1.f, gb = 1.f; if (gain) { ga = gain[k0 + 8 * i + 2 * kp]; gb = gain[k0 + 8 * i + 2 * kp + 1]; }
        LAS unsigned* d = scr + (4 * c) * TR_STRIDE + 4 * i + kp;
        d[0 * TR_STRIDE] = pk2(va[i].x * ga, vb[i].x * gb); d[1 * TR_STRIDE] = pk2(va[i].y * ga, vb[i].y * gb);
        d[2 * TR_STRIDE] = pk2(va[i].z * ga, vb[i].z * gb); d[3 * TR_STRIDE] = pk2(va[i].w * ga, vb[i].w * gb); }
    LDS_WAIT(); asm volatile("" ::: "memory");
    const int c8 = lane & 7, nr = lane >> 3;
#pragma unroll
    for (int j = 0; j < 8; ++j) { const int n = nr + 8 * j; const LAS unsigned* s = scr + n * TR_STRIDE + 4 * c8;
        v4u o; o.x = s[0]; o.y = s[1]; o.z = s[2]; o.w = s[3];
        *(GAS v4u*)(WT + (size_t)(nd0 + n) * K + k0 + 8 * c8) = o; }
    LDS_WAIT(); asm volatile("" ::: "memory");
}
__device__ __forceinline__ void xrow_to_bf16(const float* xrow, bf16* orow, float* prow, int lane) {
    const GAS f32x4* xr = (const GAS f32x4*)xrow + lane;
    float s = 0.f; GAS unsigned long long* o8 = (GAS unsigned long long*)orow + lane;
#pragma unroll
    for (int j = 0; j < 16; ++j) { const f32x4 v = xr[64 * j]; s += (v.x * v.x + v.y * v.y) + (v.z * v.z + v.w * v.w);
        o8[64 * j] = (unsigned long long)pk2(v.x, v.y) | ((unsigned long long)pk2(v.z, v.w) << 32); }
    s = wave_sum(s);
    prow[lane] = lane == 0 ? s : 0.f;
}

__device__ __forceinline__ void cvt8(const v4u w, float (&f)[8]) {
    f[0] = __builtin_bit_cast(float, w.x << 16); f[1] = __builtin_bit_cast(float, w.x & 0xffff0000u); f[2] = __builtin_bit_cast(float, w.y << 16); f[3] = __builtin_bit_cast(float, w.y & 0xffff0000u);
    f[4] = __builtin_bit_cast(float, w.z << 16); f[5] = __builtin_bit_cast(float, w.z & 0xffff0000u); f[6] = __builtin_bit_cast(float, w.w << 16); f[7] = __builtin_bit_cast(float, w.w & 0xffff0000u);
}
constexpr int CG_ROWS = 32, CG_NCG = FF / 8, CG_ITEMS = (MROWS / CG_ROWS) * CG_NCG;
__device__ __forceinline__ void convgate_item(const bf16* U, const float* cw, const float* cb, bf16* ACT, int item) {
    const int chunk = item / CG_NCG, cg = item % CG_NCG, m0 = chunk * CG_ROWS, t0 = m0 % SEQ, j0 = cg * 8;
    float wg[3][8], wv[3][8], bg[8], bv[8];
#pragma unroll
    for (int i = 0; i < 3; ++i)
#pragma unroll
        for (int h = 0; h < 2; ++h) { const f32x4 a = *(const f32x4*)(cw + (size_t)i * FF2 + j0 + 4 * h), b = *(const f32x4*)(cw + (size_t)i * FF2 + FF + j0 + 4 * h);
            wg[i][4 * h] = a.x; wg[i][4 * h + 1] = a.y; wg[i][4 * h + 2] = a.z; wg[i][4 * h + 3] = a.w; wv[i][4 * h] = b.x; wv[i][4 * h + 1] = b.y; wv[i][4 * h + 2] = b.z; wv[i][4 * h + 3] = b.w; }
#pragma unroll
    for (int h = 0; h < 2; ++h) { const f32x4 a = *(const f32x4*)(cb + j0 + 4 * h), b = *(const f32x4*)(cb + FF + j0 + 4 * h);
        bg[4 * h] = a.x; bg[4 * h + 1] = a.y; bg[4 * h + 2] = a.z; bg[4 * h + 3] = a.w; bv[4 * h] = b.x; bv[4 * h + 1] = b.y; bv[4 * h + 2] = b.z; bv[4 * h + 3] = b.w; }
    float g2[8], g1[8], v2[8], v1[8];
    const v4u z4 = {0u, 0u, 0u, 0u};
    { const v4u a = t0 >= 2 ? *(const GAS v4u*)(U + (size_t)(m0 - 2) * FF2 + j0) : z4, b = t0 >= 2 ? *(const GAS v4u*)(U + (size_t)(m0 - 2) * FF2 + FF + j0) : z4; cvt8(a, g2); cvt8(b, v2); }
    { const v4u a = t0 >= 1 ? *(const GAS v4u*)(U + (size_t)(m0 - 1) * FF2 + j0) : z4, b = t0 >= 1 ? *(const GAS v4u*)(U + (size_t)(m0 - 1) * FF2 + FF + j0) : z4; cvt8(a, g1); cvt8(b, v1); }
#pragma unroll 4
    for (int r = 0; r < CG_ROWS; ++r) {
        float g0[8], v0[8]; cvt8(*(const GAS v4u*)(U + (size_t)(m0 + r) * FF2 + j0), g0); cvt8(*(const GAS v4u*)(U + (size_t)(m0 + r) * FF2 + FF + j0), v0);
        float o[8];
#pragma unroll
        for (int e = 0; e < 8; ++e) { const float cgv = bg[e] + wg[0][e] * g2[e] + wg[1][e] * g1[e] + wg[2][e] * g0[e]; const float cvv = bv[e] + wv[0][e] * v2[e] + wv[1][e] * v1[e] + wv[2][e] * v0[e];
            const float sg = cgv * __builtin_amdgcn_rcpf(1.f + __builtin_amdgcn_exp2f(-cgv * LOG2E)); o[e] = sg * cvv; g2[e] = g1[e]; g1[e] = g0[e]; v2[e] = v1[e]; v1[e] = v0[e]; }
        v4u w; w.x = pk2(o[0], o[1]); w.y = pk2(o[2], o[3]); w.z = pk2(o[4], o[5]); w.w = pk2(o[6], o[7]);
        *(GAS v4u*)(ACT + (size_t)(m0 + r) * FF + j0) = w;
    }
}

constexpr int FX_ITEMS = (MROWS / 64) * CG_NCG;
__device__ __forceinline__ void ld8(const float* p, float (&f)[8]) { const f32x4 a = *(const GAS f32x4*)p, b = *(const GAS f32x4*)(p + 4); f[0] = a.x; f[1] = a.y; f[2] = a.z; f[3] = a.w; f[4] = b.x; f[5] = b.y; f[6] = b.z; f[7] = b.w; }
__device__ __forceinline__ void fixup_item(const float* halo, const float* cw, const float* cb, bf16* ACT, int item) {
    const int grp = item / CG_NCG, cg = item % CG_NCG, j0 = cg * 8; const bool first = (grp % (SEQ / 64)) == 0;
    float wg[3][8], wv[3][8], bg[8], bv[8];
#pragma unroll
    for (int i = 0; i < 3; ++i) { ld8(cw + (size_t)i * FF2 + j0, wg[i]); ld8(cw + (size_t)i * FF2 + FF + j0, wv[i]); }
    ld8(cb + j0, bg); ld8(cb + FF + j0, bv);
    float h0g[8], h0v[8], h1g[8], h1v[8], t0g[8], t0v[8], t1g[8], t1v[8];
    const float* hb = halo + (size_t)grp * 4 * FF2 + j0;
    ld8(hb, h0g); ld8(hb + FF, h0v); ld8(hb + FF2, h1g); ld8(hb + FF2 + FF, h1v);
    if (!first) { const float* pb = hb - 4 * (size_t)FF2; ld8(pb + 2 * (size_t)FF2, t0g); ld8(pb + 2 * (size_t)FF2 + FF, t0v); ld8(pb + 3 * (size_t)FF2, t1g); ld8(pb + 3 * (size_t)FF2 + FF, t1v); }
    else {
#pragma unroll
        for (int e = 0; e < 8; ++e) { t0g[e] = 0.f; t0v[e] = 0.f; t1g[e] = 0.f; t1v[e] = 0.f; } }
    float o0[8], o1[8];
#pragma unroll
    for (int e = 0; e < 8; ++e) {
        const float cg0 = bg[e] + wg[0][e] * t0g[e] + wg[1][e] * t1g[e] + wg[2][e] * h0g[e], cv0 = bv[e] + wv[0][e] * t0v[e] + wv[1][e] * t1v[e] + wv[2][e] * h0v[e];
        const float cg1 = bg[e] + wg[0][e] * t1g[e] + wg[1][e] * h0g[e] + wg[2][e] * h1g[e], cv1 = bv[e] + wv[0][e] * t1v[e] + wv[1][e] * h0v[e] + wv[2][e] * h1v[e];
        o0[e] = cg0 * __builtin_amdgcn_rcpf(1.f + __builtin_amdgcn_exp2f(-cg0 * LOG2E)) * cv0; o1[e] = cg1 * __builtin_amdgcn_rcpf(1.f + __builtin_amdgcn_exp2f(-cg1 * LOG2E)) * cv1; }
    v4u w0, w1; w0.x = pk2(o0[0], o0[1]); w0.y = pk2(o0[2], o0[3]); w0.z = pk2(o0[4], o0[5]); w0.w = pk2(o0[6], o0[7]);
    w1.x = pk2(o1[0], o1[1]); w1.y = pk2(o1[2], o1[3]); w1.z = pk2(o1[4], o1[5]); w1.w = pk2(o1[6], o1[7]);
    *(GAS v4u*)(ACT + (size_t)(grp * 64) * FF + j0) = w0; *(GAS v4u*)(ACT + (size_t)(grp * 64 + 1) * FF + j0) = w1;
}

__device__ __forceinline__ void sincos_rev(float ang, float& s, float& c) {
    const float I1 = 0.15915493667125702f, I2 = 6.420638326565253e-09f;
    const float r1 = ang * I1; const float e1 = __builtin_fmaf(ang, I1, -r1); const float r2 = __builtin_fmaf(ang, I2, e1);
    const float fr = (r1 - __builtin_rintf(r1)) + r2;
    s = __builtin_amdgcn_sinf(fr); c = __builtin_amdgcn_cosf(fr);
}
__device__ __forceinline__ void qknorm_row(const bf16* qkv_row, bf16* qkn_row, const float* gq, const float* gk, int t, int lane) {
    const int c = lane & 7, gs = lane >> 3;
    float cs[8], sn[8];
#pragma unroll
    for (int e = 0; e < 8; ++e) { const int i = 8 * c + e; const float invf = __builtin_amdgcn_exp2f(-(float)i * (13.287712379549449f / 64.f));
        sincos_rev((float)t * invf, sn[e], cs[e]); }
    float gA[8], gB[8];
#pragma unroll 1
    for (int qk = 0; qk < 2; ++qk) {
        const float* gn = qk ? gk : gq; const float sc = qk ? 1.f : QSCALE;
#pragma unroll
        for (int e = 0; e < 8; ++e) { gA[e] = gn[8 * c + e]; gB[e] = gn[64 + 8 * c + e]; }
        v4u ra[4], rb[4];
#pragma unroll
        for (int it = 0; it < 4; ++it) { const int col = qk * 4096 + (it * 8 + gs) * 128 + 8 * c; ra[it] = *(const GAS v4u*)(qkv_row + col); rb[it] = *(const GAS v4u*)(qkv_row + col + 64); }
#pragma unroll
        for (int it = 0; it < 4; ++it) {
            const int col = qk * 4096 + (it * 8 + gs) * 128 + 8 * c;
            float xa[8], xb[8]; cvt8(ra[it], xa); cvt8(rb[it], xb);
            float ss = 0.f;
#pragma unroll
            for (int e = 0; e < 8; ++e) ss += xa[e] * xa[e] + xb[e] * xb[e];
            ss += __shfl_xor(ss, 1); ss += __shfl_xor(ss, 2); ss += __shfl_xor(ss, 4);
            const float inv = rsqrtf(ss * (1.f / 128.f) + RMS_EPS);
            float oa[8], ob[8];
#pragma unroll
            for (int e = 0; e < 8; ++e) { const float ya = xa[e] * inv * gA[e], yb = xb[e] * inv * gB[e]; oa[e] = (ya * cs[e] - yb * sn[e]) * sc; ob[e] = (yb * cs[e] + ya * sn[e]) * sc; }
            v4u wa, wb; wa.x = pk2(oa[0], oa[1]); wa.y = pk2(oa[2], oa[3]); wa.z = pk2(oa[4], oa[5]); wa.w = pk2(oa[6], oa[7]);
            wb.x = pk2(ob[0], ob[1]); wb.y = pk2(ob[2], ob[3]); wb.z = pk2(ob[4], ob[5]); wb.w = pk2(ob[6], ob[7]);
            *(GAS v4u*)(qkn_row + col) = wa; *(GAS v4u*)(qkn_row + col + 64) = wb;
        }
    }
}
struct Args { const float* in[18]; float* out; unsigned char* ws; int ph_lo, ph_hi; };
static_assert(sizeof(Args) == 18 * 8 + 8 + 8 + 8, "Args has no padding");

struct MatDesc { int in_idx; size_t in_off; int gain_idx; size_t gain_off; int K, N; size_t ws_off; int gateperm; };
__device__ __forceinline__ MatDesc mat_desc(int i) {
    switch (i) {
    case 0: return MatDesc{2, 0, 1, 0, DM, NQKV, WS_WQKV0, 0};
    case 1: return MatDesc{3, 0, -1, 0, DM, DM, WS_WO0, 0};
    case 2: return MatDesc{14, 0, 13, 0, DM, FF2, WS_WUP0, 1};
    case 3: return MatDesc{17, 0, -1, 0, FF, DM, WS_WDN0, 0};
    case 4: return MatDesc{4, 0, 1, (size_t)DM, DM, NQKV, WS_WQKV1, 0};
    case 5: return MatDesc{5, 0, -1, 0, DM, DM, WS_WO1, 0};
    case 6: return MatDesc{14, (size_t)DM * FF2, 13, (size_t)DM, DM, FF2, WS_WUP1, 1};
    default: return MatDesc{17, (size_t)FF * DM, -1, 0, FF, DM, WS_WDN1, 0};
    }
}

__global__ void __launch_bounds__(NWAVES * 64, 2) mk_fwd(Args args) {
    extern __shared__ __attribute__((aligned(16))) unsigned char lds[];
    LAS unsigned char* ldsl = (LAS unsigned char*)lds;
    volatile LAS unsigned* MISC = (volatile LAS unsigned*)(ldsl + MISC_OFF);
    const int tid = threadIdx.x, lane = tid & 63, wave = __builtin_amdgcn_readfirstlane(tid >> 6);
    const int G = gridDim.x, bx = blockIdx.x;
    const int gw = bx * NWAVES + wave, NGW = G * NWAVES;
    unsigned char* ws = args.ws;
    gu32* ctl = (gu32*)(ws + WS_CTL);
    for (int u = tid; u < (LDS_BYTES - LDSCTL_OFF) / 4; u += NWAVES * 64) ((LAS unsigned*)(ldsl + LDSCTL_OFF))[u] = 0u;
    __syncthreads();
    XcdBarrier bar; bar.bar = (unsigned*)(ctl + CW_BAR); bar.x = 0; bar.st = nullptr;
    const int lo = args.ph_lo, hi = args.ph_hi;
    if (hi - lo > 1) bar = xcd_barrier_post((unsigned*)(ctl + CW_BAR), MISC + 8);
#ifndef PH_MASK
#define PH_MASK 0x3fff
#endif
#define IN(k) (((PH_MASK >> (k)) & 1) && lo <= (k) && (k) < hi)
#define SEAM(k) do { if (IN(k) && IN((k) + 1)) xcd_barrier(bar); STAMP((k) + 1); } while (0)
#ifndef REPEAT_PHASE
#define REPEAT_PHASE -1
#endif
#ifndef REPEAT_N
#define REPEAT_N 1
#endif
#ifndef LEAK_A
#define LEAK_A -1
#endif
#ifndef LEAK_B
#define LEAK_B 14
#endif
#ifndef LEAK_OFF
#define LEAK_OFF 0
#endif
    unsigned long long tA = 0, tB = 0;
#define STAMP(k) do { if (LEAK_A >= 0 && bx == 0 && tid == 0) { if ((k) == LEAK_A) tA = __builtin_amdgcn_s_memrealtime(); if ((k) == LEAK_B) tB = __builtin_amdgcn_s_memrealtime(); } } while (0)
#define NREP(k) (REPEAT_PHASE == (k) ? 1 + REPEAT_N : 1)
    float* DUMMY = (float*)(ws + WS_END);

    bf16* XN = (bf16*)(ws + WS_XN); float* PART = (float*)(ws + WS_PART);
    bf16* QKV = (bf16*)(ws + WS_QKV); bf16* QKN = (bf16*)(ws + WS_QKN); bf16* AO = (bf16*)(ws + WS_AO);
    bf16* ACT = (bf16*)(ws + WS_ACT); float* HALO = (float*)(ws + WS_HALO);
    const float* x_in = args.in[0];

#ifndef JIT_CONV
#define JIT_CONV 1
#endif
#define CONVERT_MAT(MI) do { const MatDesc md = mat_desc(MI); LAS unsigned* scr_ = (LAS unsigned*)(ldsl + RING_OFF + wave * 16384); \
        const float* W_ = args.in[md.in_idx] + md.in_off; const float* gain_ = md.gain_idx >= 0 ? args.in[md.gain_idx] + md.gain_off : nullptr; \
        bf16* WT_ = (bf16*)(ws + md.ws_off); const int nitems_ = (md.K / 64) * (md.N / 64); \
        for (int it_ = gw; it_ < nitems_; it_ += NGW) transpose_item(W_, gain_, md.K, md.N, WT_, scr_, it_, lane, md.gateperm != 0); } while (0)
#define CONVERT_MAT_RANGE(MI, I0, I1, WG0) do { const MatDesc md = mat_desc(MI); LAS unsigned* scr_ = (LAS unsigned*)(ldsl + RING_OFF + wave * 16384); \
        const float* W_ = args.in[md.in_idx] + md.in_off; const float* gain_ = md.gain_idx >= 0 ? args.in[md.gain_idx] + md.gain_off : nullptr; \
        bf16* WT_ = (bf16*)(ws + md.ws_off); const int i1_ = (I1); \
        for (int it_ = (I0) + (bx - (WG0)) * NWAVES + wave; it_ < i1_; it_ += (G - (WG0)) * NWAVES) transpose_item(W_, gain_, md.K, md.N, WT_, scr_, it_, lane, md.gateperm != 0); } while (0)
#ifndef TAILFILL
#define TAILFILL 1
#endif
#ifndef DN_NUM
#define DN_NUM 52
#endif
constexpr int DN_ITEMS = (FF / 64) * (DM / 64), DN_SPLIT = TAILFILL ? (DN_ITEMS * DN_NUM) / 100 : 0;
#ifndef SPLIT_CONV
#define SPLIT_CONV 1
#endif
#ifdef PROBE_XCC
    if (tid == 0) __hip_atomic_store(ctl + 2048 + bx, 1u + xb_xcc_id(), RLX_AGENT);
#endif
    STAMP(0);
    if (IN(0)) _Pragma("unroll") for (int rep = 0; rep < NREP(0); ++rep) { if (rep) xcd_barrier(bar);
        LAS unsigned* scr = (LAS unsigned*)(ldsl + RING_OFF + wave * 16384);
#pragma unroll 1
#if JIT_CONV
        for (int m = gw; m < MROWS; m += NGW) xrow_to_bf16(x_in + (size_t)m * DM, XN + (size_t)m * DM, PART + (size_t)m * pg8::NPART, lane);
        CONVERT_MAT(0);
    }
#else
        for (int mo = 0; mo < (SPLIT_CONV ? 4 : 8); ++mo) { const int mi = SPLIT_CONV ? ((mo + 1) & 3) : ((mo + 1) & 7); const MatDesc md = mat_desc(mi);
            if (mi == 0) { for (int m = gw; m < MROWS; m += NGW) xrow_to_bf16(x_in + (size_t)m * DM, XN + (size_t)m * DM, PART + (size_t)m * pg8::NPART, lane); }
            const float* W = args.in[md.in_idx] + md.in_off; const float* gain = md.gain_idx >= 0 ? args.in[md.gain_idx] + md.gain_off : nullptr;
            bf16* WT = (bf16*)(ws + md.ws_off); const int nitems = (md.K / 64) * (md.N / 64);
            for (int it = gw; it < nitems; it += NGW) transpose_item(W, gain, md.K, md.N, WT, scr, it, lane, md.gateperm != 0); }
    }
#endif
    SEAM(0);
    if (IN(1)) _Pragma("unroll") for (int rep = 0; rep < NREP(1); ++rep) { if (rep) xcd_barrier(bar);
        pg8::Gemm g{XN, (const bf16*)(ws + WS_WQKV0), MROWS, NQKV, DM}; pg8::StaticOrder S; S.init(MROWS, NQKV, G, bx);
        pg8::EpiScale E{QKV, NQKV, PART, 1.f / DM, RMS_EPS, DM, QSCALE, (LAS float*)(ldsl + RS_OFF)};
        pg8::gemm_phase<pg8::EpiScale, pg8::StaticOrder, PG8_ALIGN, PG8_SP2>(ldsl + RING_OFF, g, S, E);
    }
    SEAM(1);
    if (IN(2)) _Pragma("unroll") for (int rep = 0; rep < NREP(2); ++rep) { if (rep) xcd_barrier(bar);
        constexpr int NBLK = BATCH * SB_H * (SEQ / 256);
        for (int L = bx; L < NBLK; L += G) { const int qb = L % 16, bh = L / 16, b = bh / SB_H, h = bh % SB_H;
            const bf16* kvbase = QKV + (size_t)(b * SEQ) * NQKV + h * HD;
            att::sb_block<NQKV, NQKV, NQKV, DM>(kvbase + (size_t)(qb * 256) * NQKV, kvbase + DM, kvbase + 2 * DM, AO + (size_t)(b * SEQ + qb * 256) * DM + h * HD, qb * 256, (char*)lds + RING_OFF, (volatile LAS unsigned*)(ldsl + RING_OFF + 65536)); }
        if (JIT_CONV) CONVERT_MAT(1);
    }
    SEAM(2);
    if (IN(3)) _Pragma("unroll") for (int rep = 0; rep < NREP(3); ++rep) { if (rep) xcd_barrier(bar);
        pg8::Gemm g{AO, (const bf16*)(ws + WS_WO0), MROWS, DM, DM}; pg8::StaticOrder S; S.init(MROWS, DM, G, bx);
        pg8::EpiResid<false, false> E{nullptr, nullptr, XN, PART, DM};
        pg8::gemm_phase<pg8::EpiResid<false, false>, pg8::StaticOrder, PG8_ALIGN, PG8_SP2>(ldsl + RING_OFF, g, S, E);
        if (JIT_CONV) CONVERT_MAT(2);
    }
    SEAM(3);
#define UP_PHASE(WOFF, LAYER) do { pg8::Gemm g{XN, (const bf16*)(ws + (WOFF)), MROWS, FF2, DM}; pg8::StaticOrder S; S.init(MROWS, FF2, G, bx); \
        pg8::EpiConvGate E{ACT, FF, PART, 1.f / DM, RMS_EPS, args.in[15] + (size_t)(LAYER) * 3 * FF2, args.in[16] + (size_t)(LAYER) * FF2, HALO, (LAS float*)(ldsl + RS_OFF)}; \
        pg8::gemm_phase<pg8::EpiConvGate, pg8::StaticOrder, PG8_ALIGN, PG8_SP2>(ldsl + RING_OFF, g, S, E); } while (0)
#define CG_PHASE(LAYER) do { const float* cw = args.in[15] + (size_t)(LAYER) * 3 * FF2; const float* cb = args.in[16] + (size_t)(LAYER) * FF2; \
        for (int it = bx * (NWAVES * 64) + tid; it < FX_ITEMS; it += G * NWAVES * 64) fixup_item(HALO, cw, cb, ACT, it); } while (0)
#ifndef DOWN_WGM
#define DOWN_WGM 8
#endif
#define DOWN_PHASE(WOFF, OUT, LAST) do { pg8::Gemm g{ACT, (const bf16*)(ws + (WOFF)), MROWS, DM, FF}; pg8::StaticOrder S; S.init(MROWS, DM, G, bx, DOWN_WGM); \
        pg8::EpiResid<false, LAST> E{nullptr, OUT, XN, PART, DM}; \
        pg8::gemm_phase<pg8::EpiResid<false, LAST>, pg8::StaticOrder, PG8_ALIGN, PG8_SP2>(ldsl + RING_OFF, g, S, E); } while (0)
    const int up_units = (MROWS / 256) * (FF2 / 256), up_full = up_units % G;
    if (IN(4)) _Pragma("unroll") for (int rep = 0; rep < NREP(4); ++rep) { if (rep) xcd_barrier(bar); UP_PHASE(WS_WUP0, 0); if (JIT_CONV && TAILFILL && up_full && bx >= up_full) CONVERT_MAT_RANGE(3, 0, DN_SPLIT, up_full); }
    SEAM(4);
    if (IN(5)) _Pragma("unroll") for (int rep = 0; rep < NREP(5); ++rep) { if (rep) xcd_barrier(bar); CG_PHASE(0); if (JIT_CONV) { if (TAILFILL && up_full) CONVERT_MAT_RANGE(3, DN_SPLIT, DN_ITEMS, 0); else CONVERT_MAT(3); } }
    SEAM(5);
    if (IN(6)) { DOWN_PHASE(WS_WDN0, nullptr, false); for (int rep = 1; rep < NREP(6); ++rep) { xcd_barrier(bar); DOWN_PHASE(WS_WDN0, DUMMY, true); } if (JIT_CONV) CONVERT_MAT(4); }
    SEAM(6);
#ifdef PROBE_LATE_QKV
    { pg8::Gemm g{XN, (const bf16*)(ws + WS_WQKV0), MROWS, NQKV, DM}; pg8::StaticOrder S; S.init(MROWS, NQKV, G, bx);
      pg8::EpiScale E{QKV, NQKV, PART, 1.f / DM, RMS_EPS, DM, QSCALE, (LAS float*)(ldsl + RS_OFF)};
      pg8::gemm_phase<pg8::EpiScale, pg8::StaticOrder, PG8_ALIGN, PG8_SP2>(ldsl + RING_OFF, g, S, E); xcd_barrier(bar); }
#if PROBE_LATE_QKV == 2
    { pg8::Gemm g{XN, (const bf16*)(ws + WS_WQKV0), MROWS, NQKV, DM}; pg8::StaticOrder S; S.init(MROWS, NQKV, G, bx);
      pg8::EpiScale E{QKV, NQKV, PART, 1.f / DM, RMS_EPS, DM, QSCALE, (LAS float*)(ldsl + RS_OFF)};
      pg8::gemm_phase<pg8::EpiScale, pg8::StaticOrder, PG8_ALIGN, PG8_SP2>(ldsl + RING_OFF, g, S, E); xcd_barrier(bar); }
#endif
#endif
    if (IN(7)) _Pragma("unroll") for (int rep = 0; rep < NREP(7); ++rep) { if (rep) xcd_barrier(bar);
        pg8::Gemm g{XN, (const bf16*)(ws + WS_WQKV1), MROWS, NQKV, DM}; pg8::StaticOrder S; S.init(MROWS, NQKV, G, bx);
        pg8::EpiScale E{QKV, NQKV, PART, 1.f / DM, RMS_EPS, 0, 1.f, (LAS float*)(ldsl + RS_OFF)};
        pg8::gemm_phase<pg8::EpiScale, pg8::StaticOrder, PG8_ALIGN, PG8_SP2>(ldsl + RING_OFF, g, S, E);
    }
    SEAM(7);
    if (IN(8)) _Pragma("unroll") for (int rep = 0; rep < NREP(8); ++rep) { if (rep) xcd_barrier(bar); for (int m = gw; m < MROWS; m += NGW) qknorm_row(QKV + (size_t)m * NQKV, QKN + (size_t)m * 8192, args.in[6], args.in[7], m % SEQ, lane); }
    SEAM(8);
    if (IN(9)) _Pragma("unroll") for (int rep = 0; rep < NREP(9); ++rep) { if (rep) xcd_barrier(bar);
        float lam, omli;
        { const float a1 = wave_sum(args.in[8][lane] * args.in[9][lane] + args.in[8][lane + 64] * args.in[9][lane + 64]);
          const float a2 = wave_sum(args.in[10][lane] * args.in[11][lane] + args.in[10][lane + 64] * args.in[11][lane + 64]);
          const float li = 0.8f - 0.6f * 0.7408182206817179f;
          lam = __expf(a1) - __expf(a2) + li; omli = 1.f - li; }
        float mq = fmaxf(fabsf(args.in[6][lane]), fabsf(args.in[6][lane + 64])), mk = fmaxf(fabsf(args.in[7][lane]), fabsf(args.in[7][lane + 64]));
#pragma unroll
        for (int o_ = 1; o_ < 64; o_ <<= 1) { mq = fmaxf(mq, __shfl_xor(mq, o_)); mk = fmaxf(mk, __shfl_xor(mk, o_)); }
        att::Diff2Const C{lam, omli, RMS_EPS, QSCALE * 128.f * mq * mk * 1.02f, args.in[12]};
        constexpr int NITEM = BATCH * DF_H * 16;
        for (int w = bx; w < NITEM; w += G) {
            const int bh = (w & 7) * 4 + ((w >> 3) >> 4), xq = (w >> 3) & 15, b = bh / DF_H, h = bh % DF_H;
            const bf16* qn = QKN + (size_t)(b * SEQ) * 8192 + h * 256; const bf16* vb = QKV + (size_t)(b * SEQ) * NQKV + 2 * DM + h * 256;
#pragma unroll 1
            for (int ps = 0; ps < 2; ++ps) { const int qb = ps ? 31 - xq : xq;
                att::diff2_block<8192, 8192, NQKV, DM>(qn + (size_t)(qb * 128) * 8192, qn + 4096, vb, AO + (size_t)(b * SEQ + qb * 128) * DM + h * 256, qb * 128, C, (char*)lds + RING_OFF); }
        }
        if (JIT_CONV) CONVERT_MAT(5);
    }
    SEAM(9);
    if (IN(10)) {
        pg8::Gemm g{AO, (const bf16*)(ws + WS_WO1), MROWS, DM, DM}; pg8::StaticOrder S; S.init(MROWS, DM, G, bx);
        pg8::EpiResid<false, false> E{nullptr, nullptr, XN, PART, DM};
        pg8::gemm_phase<pg8::EpiResid<false, false>, pg8::StaticOrder, PG8_ALIGN, PG8_SP2>(ldsl + RING_OFF, g, S, E);
        if (JIT_CONV) CONVERT_MAT(6);
    }
    SEAM(10);
    if (IN(11)) { UP_PHASE(WS_WUP1, 1); if (JIT_CONV && TAILFILL && up_full && bx >= up_full) CONVERT_MAT_RANGE(7, 0, DN_SPLIT, up_full); }
    SEAM(11);
    if (IN(12)) { CG_PHASE(1); if (JIT_CONV) { if (TAILFILL && up_full) CONVERT_MAT_RANGE(7, DN_SPLIT, DN_ITEMS, 0); else CONVERT_MAT(7); } }
    SEAM(12);
    if (IN(13)) DOWN_PHASE(WS_WDN1, args.out, true);
#ifdef PROBE_XCC
    { xcd_barrier(bar);
      if (bx == 0 && tid == 0) { unsigned bad = 0; for (int i = 0; i < G; ++i) { const unsigned xi = __hip_atomic_load(ctl + 2048 + i, RLX_AGENT), xr = __hip_atomic_load(ctl + 2048 + (i & 7), RLX_AGENT); if (xi != xr || xi == 0u) ++bad; }
          for (int r = 0; r < 8; ++r) for (int q = r + 1; q < 8; ++q) if (__hip_atomic_load(ctl + 2048 + r, RLX_AGENT) == __hip_atomic_load(ctl + 2048 + q, RLX_AGENT)) bad += 1000;
          if (bad) args.out[0] = 1000.f * (float)bad; } }
#endif
    if (LEAK_A >= 0) { xcd_barrier(bar); STAMP(14); if (bx == 0 && tid == 0) args.out[0] = 1000.f * ((float)(long long)(tB - tA) * 0.01f - (float)(LEAK_OFF)); }
#undef IN
#undef SEAM
}
#if MK_CHECK
#include "check.inc"
#endif
extern "C" void kernel_launch(void* const* d_in, const int* in_sizes, int n_in, void* d_out, int out_size, void* d_ws, size_t ws_size, hipStream_t stream) {
    static int grid = 0;
    if (grid == 0) {
        if (n_in != 18 || in_sizes[0] != MROWS * DM || out_size != MROWS * DM || ws_size < WS_END) {
            fprintf(stderr, "kernel_launch: built for 18 inputs, x/out of %d floats, >= %zu bytes of workspace; got n_in %d, in0 %d, out %d, ws %zu; nothing launched\n", MROWS * DM, (size_t)WS_END, n_in, n_in > 0 ? in_sizes[0] : -1, out_size, ws_size); grid = -1; return; }
        int dev = 0, cus = 0, per_cu = 0;
        if (hipGetDevice(&dev) != hipSuccess || hipDeviceGetAttribute(&cus, hipDeviceAttributeMultiprocessorCount, dev) != hipSuccess) { fprintf(stderr, "kernel_launch: device query failed\n"); grid = -1; return; }
        if (hipFuncSetAttribute((const void*)mk_fwd, hipFuncAttributeMaxDynamicSharedMemorySize, LDS_BYTES) != hipSuccess) { fprintf(stderr, "kernel_launch: hipFuncSetAttribute failed\n"); grid = -1; return; }
        if (hipOccupancyMaxActiveBlocksPerMultiprocessor(&per_cu, (const void*)mk_fwd, NWAVES * 64, LDS_BYTES) != hipSuccess || per_cu < 1)
            fprintf(stderr, "kernel_launch: note: occupancy query reports %d workgroups per CU\n", per_cu);
        (void)hipGetLastError();
        grid = cus;
    }
    if (grid < 0) return;
    if (hipMemsetAsync((char*)d_ws + WS_CTL, 0, CTL_ZERO_BYTES, stream) != hipSuccess) { fprintf(stderr, "kernel_launch: memset failed\n"); return; }
    Args a{};
    for (int i = 0; i < 18; ++i) a.in[i] = (const float*)d_in[i];
    a.out = (float*)d_out; a.ws = (unsigned char*)d_ws;
#if MK_CHECK
    for (int p = 0; p < NPH; ++p) { a.ph_lo = p; a.ph_hi = p + 1;
        hipLaunchKernelGGL(mk_fwd, dim3(grid), dim3(NWAVES * 64), LDS_BYTES, stream, a);
        hipLaunchKernelGGL(mk_check, dim3(256), dim3(256), 0, stream, a, p); }
    hipLaunchKernelGGL(mk_report, dim3(1), dim3(64), 0, stream, a);
#elif MK_SPLIT
    for (int p = 0; p < NPH; ++p) { a.ph_lo = p; a.ph_hi = p + 1; hipLaunchKernelGGL(mk_fwd, dim3(grid), dim3(NWAVES * 64), LDS_BYTES, stream, a); }
#else
    a.ph_lo = 0; a.ph_hi = NPH;
    hipLaunchKernelGGL(mk_fwd, dim3(grid), dim3(NWAVES * 64), LDS_BYTES, stream, a);
#ifdef PROBE_TWICE
    (void)hipMemsetAsync((char*)d_ws + WS_CTL, 0, CTL_ZERO_BYTES, stream);
    hipLaunchKernelGGL(mk_fwd, dim3(grid), dim3(NWAVES * 64), LDS_BYTES, stream, a);
#endif
#endif
    const hipError_t le = hipPeekAtLastError();
    if (le != hipSuccess) fprintf(stderr, "kernel_launch: launch failed: %s\n", hipGetErrorName(le));
}
```

```cpp
#define PRIO_BEFORE_BAR 1
#define RS_LDS 1
#define RESID_PERM 1
#define QKN_FAST 1
#include <hip/hip_runtime.h>
#include <cstdio>
#include <cstdint>
namespace pg8 {
__device__ __forceinline__ int tid_opaque() { int t = (int)threadIdx.x; asm volatile("" : "+v"(t)); return t; }
#define PG8_LAS __attribute__((address_space(3)))
typedef unsigned short bf16_t;
typedef short bf16x8 __attribute__((ext_vector_type(8)));
typedef float f32x4 __attribute__((ext_vector_type(4)));
typedef unsigned u32x4 __attribute__((ext_vector_type(4)));
constexpr int BM = 256, BK = 64, HALF = 128, HTB = HALF * BK * 2  , STAGE_BYTES = 8 * HTB, NXCD = 8, WGM = 8;

__host__ __device__ __forceinline__ int lds_byte(int r, int c) { const int st = (r >> 4) * 2 + (c >> 5), rr = r & 15, cc = c & 31, ob = rr * 64 + cc * 2; return st * 1024 + (ob ^ (((ob >> 9) & 1) << 5)); }
__host__ __device__ __forceinline__ void stage_rc(int b, int& R, int& C) { const int st = b / 1024, sb = b % 1024, swz = sb ^ (((sb >> 9) & 1) << 5); R = (st >> 1) * 16 + swz / 64; C = (st & 1) * 32 + (swz % 64) / 2; }
__host__ __device__ __forceinline__ int perm32(int rho) { const int n = rho >> 4, i = rho & 15; return 8 * (i >> 2) + 4 * n + (i & 3); }

struct Unit { int pm, pn; };
struct Gemm { const bf16_t* A; const bf16_t* Bt; int M, N, K; };

struct StaticOrder {
    int nM, nN, nwg, G, c, wgm;
    __host__ __device__ void init(int M, int N, int G_, int c_, int wgm_ = WGM) { nM = M / BM; nN = N / BM; nwg = nM * nN; G = G_; c = c_; wgm = wgm_; }
    __host__ __device__ bool next(int i, Unit& u) const {
        const long L = (long)i * G + c; if (L >= nwg) return false;
        int wgid = (int)L; { const int q = nwg / NXCD, r = nwg % NXCD, xcd = wgid % NXCD, off = wgid / NXCD; wgid = (xcd < r ? xcd * (q + 1) : r * (q + 1) + (xcd - r) * q) + off; }
        const int nig = wgm * nN, gid = wgid / nig, fm = gid * wgm, gsz = (nM - fm) < wgm ? (nM - fm) : wgm;
        u.pm = fm + ((wgid % nig) % gsz); u.pn = (wgid % nig) / gsz; return true;
    }
    __device__ __forceinline__ void a_ready(const Unit&) const {}
    __device__ __forceinline__ void done(const Unit&) const {}
};
struct RangeOrder : StaticOrder {
    int i0, i1;
    __host__ __device__ bool next(int i, Unit& u) const { return (i0 + i < i1) && StaticOrder::next(i0 + i, u); }
};


__device__ __forceinline__ unsigned cvt_pk_bf16(float lo, float hi) { unsigned r; asm volatile("v_cvt_pk_bf16_f32 %0, %1, %2" : "=v"(r) : "v"(lo), "v"(hi)); return r; }

constexpr int NPART = 64;

struct NoStage { __device__ __forceinline__ void operator()() const {} };
template <class Stage = NoStage>
__device__ __forceinline__ void row_scales_lds(float (&rs)[2][4], PG8_LAS float* rl, const float* part, int urow0  , float inv_k, float eps, int wr, int wc, int fr, int fq, const Stage& stage = Stage()) {
    stage();
#pragma unroll
    for (int ai = 0; ai < 2; ++ai) { const int lr = ai * HALF + wr * 64 + wc * 16 + fr;
        const f32x4* pp = (const f32x4*)(part + (size_t)(urow0 + lr) * NPART + fq * 16);
        const f32x4 a = pp[0], b = pp[1], c = pp[2], d = pp[3];
        float s = ((a[0] + a[1]) + (a[2] + a[3])) + ((b[0] + b[1]) + (b[2] + b[3])) + (((c[0] + c[1]) + (c[2] + c[3])) + ((d[0] + d[1]) + (d[2] + d[3])));
        s += __shfl_xor(s, 16); s += __shfl_xor(s, 32);
        if (fq == 0) rl[lr] = rsqrtf(s * inv_k + eps); }
    asm volatile("s_waitcnt lgkmcnt(0)" ::: "memory");
    __builtin_amdgcn_s_barrier();
#pragma unroll
    for (int ai = 0; ai < 2; ++ai)
#pragma unroll
        for (int m = 0; m < 4; ++m) rs[ai][m] = rl[ai * HALF + wr * 64 + m * 16 + fr];
}

struct EpiScale {
    static constexpr bool PERM = true, AFTER_DRAIN = false;
    bf16_t* O; int ldc; const float* part; float inv_k; float eps; int qcols; float qs; PG8_LAS float* rl;
    __device__ __forceinline__ void operator()(const f32x4 (&acc)[2][2][4][2], const Unit& u, int wr, int wc, int fr, int fq) const {
        const int row0 = u.pm * BM + wr * 64 + fr; const int col0 = u.pn * BM + wc * 32 + 8 * fq;
        const float sc = (u.pn * BM < qcols) ? qs : 1.f;
#ifdef RS_LDS
        float rsl[2][4]; row_scales_lds(rsl, rl, part, u.pm * BM, inv_k, eps, wr, wc, fr, fq);
#endif
#pragma unroll
        for (int ai = 0; ai < 2; ++ai)
#pragma unroll
            for (int m = 0; m < 4; ++m) {
                const int row = row0 + ai * HALF + m * 16;
#ifdef RS_LDS
                const float r = rsl[ai][m] * sc;
#else
                const f32x4* pp = (const f32x4*)(part + (size_t)row * NPART + fq * 16);
                const f32x4 a = pp[0], b = pp[1], c = pp[2], d = pp[3];
                float s = ((a[0] + a[1]) + (a[2] + a[3])) + ((b[0] + b[1]) + (b[2] + b[3])) + (((c[0] + c[1]) + (c[2] + c[3])) + ((d[0] + d[1]) + (d[2] + d[3])));
                s += __shfl_xor(s, 16); s += __shfl_xor(s, 32);
                const float r = rsqrtf(s * inv_k + eps) * sc;
#endif
                bf16_t* rowp = O + (size_t)row * ldc + col0;
#pragma unroll
                for (int bj = 0; bj < 2; ++bj) { const f32x4 v0 = acc[ai][bj][m][0] * r, v1 = acc[ai][bj][m][1] * r;
                    u32x4 w; w.x = cvt_pk_bf16(v0[0], v0[1]); w.y = cvt_pk_bf16(v0[2], v0[3]); w.z = cvt_pk_bf16(v1[0], v1[1]); w.w = cvt_pk_bf16(v1[2], v1[3]);
                    *(u32x4*)(rowp + bj * HALF) = w; }
            }
    }
};

#ifndef RESID_HOIST
#define RESID_HOIST 0
#endif
#ifndef RESID_PERM
#define RESID_PERM 0
#endif
template <bool BASE_F32, bool OUT_F32> struct EpiResid {
    static constexpr bool PERM = RESID_PERM != 0, AFTER_DRAIN = false;
    const float* basef; float* outf; bf16_t* xn; float* part; int ldc;
    __device__ __forceinline__ void operator()(const f32x4 (&acc)[2][2][4][2], const Unit& u, int wr, int wc, int fr, int fq) const {
        typedef unsigned u32x2v __attribute__((ext_vector_type(2)));
        const int row0 = u.pm * BM + wr * 64 + fr; const int col0 = u.pn * BM + wc * 32 + (PERM ? 8 : 4) * fq;
        u32x4 bpre[2][4][2];
        if constexpr (PERM && RESID_HOIST && !BASE_F32) {
#pragma unroll
            for (int ai = 0; ai < 2; ++ai)
#pragma unroll
                for (int m = 0; m < 4; ++m)
#pragma unroll
                    for (int bj = 0; bj < 2; ++bj) bpre[ai][m][bj] = *(const u32x4*)(xn + (size_t)(row0 + ai * HALF + m * 16) * ldc + col0 + bj * HALF);
        }
#pragma unroll
        for (int ai = 0; ai < 2; ++ai)
#pragma unroll
            for (int m = 0; m < 4; ++m) {
                const int row = row0 + ai * HALF + m * 16; const size_t off = (size_t)row * ldc + col0; float ss = 0.f;
                if constexpr (PERM) {
#pragma unroll
                    for (int bj = 0; bj < 2; ++bj) { const size_t o2 = off + bj * HALF;
                        f32x4 b0, b1;
                        if (BASE_F32) { b0 = *(const f32x4*)(basef + o2); b1 = *(const f32x4*)(basef + o2 + 4); }
                        else { const u32x4 b = RESID_HOIST ? bpre[ai][m][bj] : *(const u32x4*)(xn + o2);
                            b0[0] = __builtin_bit_cast(float, b.x << 16); b0[1] = __builtin_bit_cast(float, b.x & 0xffff0000u); b0[2] = __builtin_bit_cast(float, b.y << 16); b0[3] = __builtin_bit_cast(float, b.y & 0xffff0000u);
                            b1[0] = __builtin_bit_cast(float, b.z << 16); b1[1] = __builtin_bit_cast(float, b.z & 0xffff0000u); b1[2] = __builtin_bit_cast(float, b.w << 16); b1[3] = __builtin_bit_cast(float, b.w & 0xffff0000u); }
                        const f32x4 o0 = b0 + acc[ai][bj][m][0], o1 = b1 + acc[ai][bj][m][1];
                        if (OUT_F32) { *(f32x4*)(outf + o2) = o0; *(f32x4*)(outf + o2 + 4) = o1; }
                        else { u32x4 w; w.x = cvt_pk_bf16(o0[0], o0[1]); w.y = cvt_pk_bf16(o0[2], o0[3]); w.z = cvt_pk_bf16(o1[0], o1[1]); w.w = cvt_pk_bf16(o1[2], o1[3]); *(u32x4*)(xn + o2) = w;
                            ss += ((o0[0] * o0[0] + o0[1] * o0[1]) + (o0[2] * o0[2] + o0[3] * o0[3])) + ((o1[0] * o1[0] + o1[1] * o1[1]) + (o1[2] * o1[2] + o1[3] * o1[3])); } }
                } else {
#pragma unroll
                for (int bj = 0; bj < 2; ++bj)
#pragma unroll
                    for (int n = 0; n < 2; ++n) { const size_t o2 = off + bj * HALF + n * 16;
                        f32x4 bs;
                        if (BASE_F32) bs = *(const f32x4*)(basef + o2);
                        else { const u32x2v b = *(const u32x2v*)(xn + o2); bs[0] = __builtin_bit_cast(float, b.x << 16); bs[1] = __builtin_bit_cast(float, b.x & 0xffff0000u); bs[2] = __builtin_bit_cast(float, b.y << 16); bs[3] = __builtin_bit_cast(float, b.y & 0xffff0000u); }
                        const f32x4 o = bs + acc[ai][bj][m][n];
                        if (OUT_F32) *(f32x4*)(outf + o2) = o;
                        else { u32x2v w; w.x = cvt_pk_bf16(o[0], o[1]); w.y = cvt_pk_bf16(o[2], o[3]); *(u32x2v*)(xn + o2) = w;
                            ss += (o[0] * o[0] + o[1] * o[1]) + (o[2] * o[2] + o[3] * o[3]); } }
                }
                if (!OUT_F32) { ss += __shfl_xor(ss, 16); ss += __shfl_xor(ss, 32); if (fq == 0) part[(size_t)row * NPART + u.pn * 4 + wc] = ss; }
            }
    }
};

struct EpiResidRT {
    static constexpr bool PERM = false, AFTER_DRAIN = false;
    float* outf; bf16_t* xn; float* part; int ldc;
    __device__ __forceinline__ void operator()(const f32x4 (&acc)[2][2][4][2], const Unit& u, int wr, int wc, int fr, int fq) const {
        typedef unsigned u32x2v __attribute__((ext_vector_type(2)));
        const int row0 = u.pm * BM + wr * 64 + fr; const int col0 = u.pn * BM + wc * 32 + 4 * fq; const bool last = outf != nullptr;
#pragma unroll
        for (int ai = 0; ai < 2; ++ai)
#pragma unroll
            for (int m = 0; m < 4; ++m) {
                const int row = row0 + ai * HALF + m * 16; const size_t off = (size_t)row * ldc + col0; float ss = 0.f;
#pragma unroll
                for (int bj = 0; bj < 2; ++bj)
#pragma unroll
                    for (int n = 0; n < 2; ++n) { const size_t o2 = off + bj * HALF + n * 16;
                        const u32x2v b = *(const u32x2v*)(xn + o2); f32x4 bs; bs[0] = __builtin_bit_cast(float, b.x << 16); bs[1] = __builtin_bit_cast(float, b.x & 0xffff0000u); bs[2] = __builtin_bit_cast(float, b.y << 16); bs[3] = __builtin_bit_cast(float, b.y & 0xffff0000u);
                        const f32x4 o = bs + acc[ai][bj][m][n];
                        if (last) *(f32x4*)(outf + o2) = o;
                        else { u32x2v w; w.x = cvt_pk_bf16(o[0], o[1]); w.y = cvt_pk_bf16(o[2], o[3]); *(u32x2v*)(xn + o2) = w; }
                        ss += (o[0] * o[0] + o[1] * o[1]) + (o[2] * o[2] + o[3] * o[3]); }
                if (!last) { ss += __shfl_xor(ss, 16); ss += __shfl_xor(ss, 32); if (fq == 0) part[(size_t)row * NPART + u.pn * 4 + wc] = ss; }
            }
    }
};

__device__ __forceinline__ float dpp_ror1(float v) { return __builtin_bit_cast(float, __builtin_amdgcn_update_dpp(0, __builtin_bit_cast(int, v), 0x121, 0xf, 0xf, false)); }
__device__ __forceinline__ float dpp_ror2(float v) { return __builtin_bit_cast(float, __builtin_amdgcn_update_dpp(0, __builtin_bit_cast(int, v), 0x122, 0xf, 0xf, false)); }
__device__ __forceinline__ float dpp_shr1(float old, float v) { return __builtin_bit_cast(float, __builtin_amdgcn_update_dpp(__builtin_bit_cast(int, old), __builtin_bit_cast(int, v), 0x111, 0xf, 0xf, false)); }
__device__ __forceinline__ float dpp_shr2(float old, float v) { return __builtin_bit_cast(float, __builtin_amdgcn_update_dpp(__builtin_bit_cast(int, old), __builtin_bit_cast(int, v), 0x112, 0xf, 0xf, false)); }
__device__ __forceinline__ void conv_taps(float& acc, float cur, float prev, float w1, float w0) {
    asm("s_nop 1\n\t"
        "v_fmac_f32_dpp %0, %1, %3 row_shr:1 row_mask:0xf bank_mask:0xf\n\t"
        "v_fmac_f32_dpp %0, %1, %4 row_shr:2 row_mask:0xf bank_mask:0xf\n\t"
        "v_fmac_f32_dpp %0, %2, %3 row_shl:15 row_mask:0xf bank_mask:0xf\n\t"
        "v_fmac_f32_dpp %0, %2, %4 row_shl:14 row_mask:0xf bank_mask:0xf"
        : "+v"(acc) : "v"(cur), "v"(prev), "v"(w1), "v"(w0));
}
template <int CTRL> __device__ __forceinline__ float dppz(float v) { return __builtin_bit_cast(float, __builtin_amdgcn_update_dpp(0, __builtin_bit_cast(int, v), CTRL, 0xf, 0xf, true)); }
struct EpiConvGate {
    static constexpr bool PERM = true, AFTER_DRAIN = false;
    bf16_t* ACT; int ff; const float* part; float inv_k; float eps; const float* cw; const float* cb; float* halo; PG8_LAS float* rl;
    __device__ __forceinline__ void operator()(const f32x4 (&acc)[2][2][4][2], const Unit& u, int wr, int wc, int fr, int fq) const {
        typedef unsigned u32x2v __attribute__((ext_vector_type(2)));
        const int ff2 = 2 * ff;
        const int row0 = u.pm * BM + wr * 64 + fr; const int ch0 = u.pn * HALF + wc * 32 + 8 * fq;
        float rs[2][4];
#if defined(RS_LDS) && defined(CONVW_LDS)
        PG8_LAS float* wl = rl + 256;
        { const float* cwp = cw; const float* cbp = cb; const int chb = u.pn * HALF, ffv = ff;
          row_scales_lds(rs, rl, part, u.pm * BM, inv_k, eps, wr, wc, fr, fq, [=]() { const int t = wr * 256 + wc * 64 + fq * 16 + fr;
              if (t < 256) { const int arr = t >> 5, q = t & 31; const int half = arr >> 2, k = arr & 3;
                  const float* src = (k < 3 ? cwp + (size_t)k * 2 * ffv : cbp) + half * ffv + chb + 4 * q;
                  *(PG8_LAS f32x4*)(wl + arr * 128 + 4 * q) = *(const f32x4*)src; } }); }
#elif defined(RS_LDS)
        row_scales_lds(rs, rl, part, u.pm * BM, inv_k, eps, wr, wc, fr, fq);
#else
#pragma unroll
        for (int ai = 0; ai < 2; ++ai)
#pragma unroll
            for (int m = 0; m < 4; ++m) { const int row = row0 + ai * HALF + m * 16;
                const f32x4* pp = (const f32x4*)(part + (size_t)row * NPART + fq * 16);
                const f32x4 a = pp[0], b = pp[1], c = pp[2], d = pp[3];
                float s = ((a[0] + a[1]) + (a[2] + a[3])) + ((b[0] + b[1]) + (b[2] + b[3])) + (((c[0] + c[1]) + (c[2] + c[3])) + ((d[0] + d[1]) + (d[2] + d[3])));
                s += __shfl_xor(s, 16); s += __shfl_xor(s, 32);
                rs[ai][m] = rsqrtf(s * inv_k + eps); }
#endif
        u32x2v lo[2][4];
#pragma unroll
        for (int n = 0; n < 2; ++n) {
            const int ch = ch0 + 4 * n;
#if defined(RS_LDS) && defined(CONVW_LDS)
            const int cl = wc * 32 + 8 * fq + 4 * n;
            const f32x4 wg0 = *(const PG8_LAS f32x4*)(wl + cl), wg1 = *(const PG8_LAS f32x4*)(wl + 128 + cl), wg2 = *(const PG8_LAS f32x4*)(wl + 256 + cl), bg = *(const PG8_LAS f32x4*)(wl + 384 + cl);
            const f32x4 wv0 = *(const PG8_LAS f32x4*)(wl + 512 + cl), wv1 = *(const PG8_LAS f32x4*)(wl + 640 + cl), wv2 = *(const PG8_LAS f32x4*)(wl + 768 + cl), bv = *(const PG8_LAS f32x4*)(wl + 896 + cl);
#else
            const f32x4 wg0 = *(const f32x4*)(cw + ch), wg1 = *(const f32x4*)(cw + ff2 + ch), wg2 = *(const f32x4*)(cw + 2 * ff2 + ch), bg = *(const f32x4*)(cb + ch);
            const f32x4 wv0 = *(const f32x4*)(cw + ff + ch), wv1 = *(const f32x4*)(cw + ff2 + ff + ch), wv2 = *(const f32x4*)(cw + 2 * ff2 + ff + ch), bv = *(const f32x4*)(cb + ff + ch);
#endif
#pragma unroll
            for (int ai = 0; ai < 2; ++ai) {
                f32x4 gq = {0.f, 0.f, 0.f, 0.f}, vq = gq;
                const int grp = (u.pm * BM + ai * HALF + wr * 64) >> 6;
#pragma unroll
                for (int m = 0; m < 4; ++m) {
                    const f32x4 g = acc[ai][0][m][n] * rs[ai][m], v = acc[ai][1][m][n] * rs[ai][m];
                    f32x4 cg, cv;
#pragma unroll
                    for (int e = 0; e < 4; ++e) {
                        float a = __builtin_fmaf(wg2[e], g[e], bg[e]), b = __builtin_fmaf(wv2[e], v[e], bv[e]);
                        conv_taps(a, g[e], gq[e], wg1[e], wg0[e]); conv_taps(b, v[e], vq[e], wv1[e], wv0[e]);
                        cg[e] = a; cv[e] = b; }
                    gq = g; vq = v;
                    f32x4 o;
#pragma unroll
                    for (int e = 0; e < 4; ++e) o[e] = cg[e] * __builtin_amdgcn_rcpf(1.f + __builtin_amdgcn_exp2f(-1.4426950408889634f * cg[e])) * cv[e];
                    u32x2v w; w.x = cvt_pk_bf16(o[0], o[1]); w.y = cvt_pk_bf16(o[2], o[3]);
                    const int row = row0 + ai * HALF + m * 16;
                    if (n == 0) lo[ai][m] = w;
                    else if (!(m == 0 && fr < 2)) { u32x4 w4; w4.x = lo[ai][m].x; w4.y = lo[ai][m].y; w4.z = w.x; w4.w = w.y; *(u32x4*)(ACT + (size_t)row * ff + ch0) = w4; }
                    if ((m == 0 && fr < 2) || (m == 3 && fr >= 14)) { float* hp = halo + ((size_t)grp * 4 + (m == 0 ? fr : fr - 12)) * ff2 + ch; *(f32x4*)hp = g; *(f32x4*)(hp + ff) = v; }
                }
            }
        }
    }
};
template <class Epi, class Sched, bool ALIGN_EPI = false, bool SP2 = false>
__device__ __forceinline__ void gemm_phase(PG8_LAS unsigned char* lds, const Gemm g, const Sched& S, const Epi& E) {
    const int tid = tid_opaque(), wid = __builtin_amdgcn_readfirstlane(tid >> 6), lane = tid & 63, wr = wid >> 2, wc = wid & 3, fr = lane & 15, fq = lane >> 4;
    const int K = g.K, nt = K / BK;
    unsigned voffA[2], voffB[2];
#pragma unroll
    for (int i = 0; i < 2; ++i) { int R, C; stage_rc(tid * 16 + i * 8192, R, C); const int Rb = Epi::PERM ? ((R & ~31) + perm32(R & 31)) : R;
        voffA[i] = (unsigned)(R * K + C) * 2u; voffB[i] = (unsigned)(Rb * K + C) * 2u; }
    const size_t kstep = (size_t)(BK * 2);
    const size_t hstep = (size_t)HALF * K * 2;
    const size_t tstep = 2 * hstep;
    const unsigned ldsw = (unsigned)wid * 1024u;
    const int aoff = lds_byte(wr * 64 + fr, fq * 8), boff = lds_byte(wc * 32 + fr, fq * 8);
#define PG8_SA(b, h) (((b) * 2 + (h)) * HTB)
#define PG8_SB(b, h) ((4 + (b) * 2 + (h)) * HTB)
#define PG8_STAGE(bufoff, gbase, voff) do { _Pragma("unroll") for (int _i = 0; _i < 2; ++_i) \
        __builtin_amdgcn_global_load_lds((const unsigned*)((const char*)(gbase) + (voff)[_i]), (PG8_LAS unsigned*)(lds + (bufoff) + ldsw + _i * 8192), 16, 0, 0); } while (0)
#define PG8_LDA(dst, b, h) do { _Pragma("unroll") for (int m = 0; m < 4; ++m) _Pragma("unroll") for (int k = 0; k < 2; ++k) dst[m][k] = *(const PG8_LAS bf16x8*)(lds + PG8_SA(b, h) + aoff + m * 2048 + k * 1024); } while (0)
#define PG8_LDB(dst, b, h) do { _Pragma("unroll") for (int n = 0; n < 2; ++n) _Pragma("unroll") for (int k = 0; k < 2; ++k) dst[n][k] = *(const PG8_LAS bf16x8*)(lds + PG8_SB(b, h) + boff + n * 2048 + k * 1024); } while (0)
#define PG8_MMA(ai, bj, At, Bt) do { if (!SP2) __builtin_amdgcn_s_setprio(1); _Pragma("unroll") for (int m = 0; m < 4; ++m) _Pragma("unroll") for (int n = 0; n < 2; ++n) _Pragma("unroll") for (int k = 0; k < 2; ++k) \
        acc[ai][bj][m][n] = __builtin_amdgcn_mfma_f32_16x16x32_bf16(Bt[n][k], At[m][k], acc[ai][bj][m][n], 0, 0, 0); if (!SP2) __builtin_amdgcn_s_setprio(0); } while (0)
#ifdef PRIO_BEFORE_BAR
#define PG8_PRIO_UP_PRE __builtin_amdgcn_s_setprio(1)
#define PG8_PRIO_UP_POST do { } while (0)
#else
#define PG8_PRIO_UP_PRE do { } while (0)
#define PG8_PRIO_UP_POST __builtin_amdgcn_s_setprio(1)
#endif
#define PG8_WAIT_V(n) asm volatile("s_waitcnt vmcnt(" #n ")" ::: "memory")
#define PG8_WAIT_L(n) asm volatile("s_waitcnt lgkmcnt(" #n ")" ::: "memory")
#define PG8_BAR __builtin_amdgcn_s_barrier()
#define PG8_SCHED __builtin_amdgcn_sched_barrier(0)
    Unit cur, nxt; int ui = 0;
    if (!S.next(0, cur)) return;
    f32x4 acc[2][2][4][2];
#pragma unroll
    for (int a = 0; a < 2; ++a)
#pragma unroll
        for (int b = 0; b < 2; ++b)
#pragma unroll
            for (int m = 0; m < 4; ++m)
#pragma unroll
                for (int n = 0; n < 2; ++n) acc[a][b][m][n] = (f32x4){0.f, 0.f, 0.f, 0.f};
    bf16x8 At[4][2], B0[2][2], B1[2][2];
    const char* cA = (const char*)g.A + (size_t)cur.pm * tstep; const char* cB = (const char*)g.Bt + (size_t)cur.pn * tstep;
    S.a_ready(cur);
    if constexpr (SP2) {
        PG8_STAGE(PG8_SB(0, 0), cB, voffB); PG8_STAGE(PG8_SB(0, 1), cB + hstep, voffB); PG8_STAGE(PG8_SA(0, 0), cA, voffA); PG8_STAGE(PG8_SA(0, 1), cA + hstep, voffA);
        if (wr == 1) PG8_BAR;
        PG8_WAIT_V(2); PG8_BAR;
        PG8_STAGE(PG8_SB(1, 0), cB + kstep, voffB); PG8_STAGE(PG8_SA(1, 0), cA + kstep, voffA); PG8_STAGE(PG8_SB(1, 1), cB + hstep + kstep, voffB);
        PG8_WAIT_V(6); PG8_BAR;
    } else {
        PG8_STAGE(PG8_SB(0, 0), cB, voffB); PG8_STAGE(PG8_SA(0, 0), cA, voffA); PG8_STAGE(PG8_SB(0, 1), cB + hstep, voffB); PG8_STAGE(PG8_SA(0, 1), cA + hstep, voffA);
        if (wr == 1) PG8_BAR;
        PG8_WAIT_V(4); PG8_BAR;
        PG8_STAGE(PG8_SB(1, 0), cB + kstep, voffB); PG8_STAGE(PG8_SA(1, 0), cA + kstep, voffA); PG8_STAGE(PG8_SB(1, 1), cB + hstep + kstep, voffB);
        PG8_WAIT_V(6); PG8_BAR;
    }
    for (;;) {
        const bool has_next = S.next(ui + 1, nxt);
        const char* nA = has_next ? (const char*)g.A + (size_t)nxt.pm * tstep : cA; const char* nB = has_next ? (const char*)g.Bt + (size_t)nxt.pn * tstep : cB;
        for (int t = 0; t < nt; t += 2) {
            const bool last = (t == nt - 2);
            const char* a1 = cA + (size_t)(t + 1) * kstep;
            const char* a2 = last ? nA : cA + (size_t)(t + 2) * kstep; const char* b2 = last ? nB : cB + (size_t)(t + 2) * kstep;
            const char* a3 = a2 + kstep; const char* b3 = b2 + kstep;
            if (last && has_next) S.a_ready(nxt);
            if constexpr (SP2) {
            PG8_LDB(B0, 0, 0); PG8_LDB(B1, 0, 1); PG8_SCHED; PG8_LDA(At, 0, 0); PG8_STAGE(PG8_SA(1, 1), a1 + hstep, voffA);
            PG8_WAIT_V(8); PG8_WAIT_L(0); PG8_PRIO_UP_PRE; PG8_BAR; PG8_PRIO_UP_POST; PG8_MMA(0, 0, At, B0); PG8_MMA(0, 1, At, B1); __builtin_amdgcn_s_setprio(0); PG8_BAR; PG8_SCHED;
            PG8_LDA(At, 0, 1); PG8_STAGE(PG8_SB(0, 0), b2, voffB); PG8_STAGE(PG8_SB(0, 1), b2 + hstep, voffB); PG8_STAGE(PG8_SA(0, 0), a2, voffA);
            PG8_WAIT_V(8); PG8_WAIT_L(0); PG8_PRIO_UP_PRE; PG8_BAR; PG8_PRIO_UP_POST; PG8_MMA(1, 0, At, B0); PG8_MMA(1, 1, At, B1); __builtin_amdgcn_s_setprio(0); PG8_BAR; PG8_SCHED;
            PG8_LDB(B0, 1, 0); PG8_LDB(B1, 1, 1); PG8_SCHED; PG8_LDA(At, 1, 0); PG8_STAGE(PG8_SA(0, 1), a2 + hstep, voffA);
            PG8_WAIT_V(8); PG8_WAIT_L(0); PG8_PRIO_UP_PRE; PG8_BAR; PG8_PRIO_UP_POST; PG8_MMA(0, 0, At, B0); PG8_MMA(0, 1, At, B1); __builtin_amdgcn_s_setprio(0); PG8_BAR; PG8_SCHED;
            PG8_LDA(At, 1, 1); PG8_STAGE(PG8_SB(1, 0), b3, voffB); PG8_STAGE(PG8_SB(1, 1), b3 + hstep, voffB); PG8_STAGE(PG8_SA(1, 0), a3, voffA);
            PG8_WAIT_V(8); PG8_WAIT_L(0); PG8_PRIO_UP_PRE; PG8_BAR; PG8_PRIO_UP_POST; PG8_MMA(1, 0, At, B0); PG8_MMA(1, 1, At, B1); __builtin_amdgcn_s_setprio(0); PG8_BAR; PG8_SCHED;
            } else {
            PG8_LDB(B0, 0, 0); PG8_SCHED; PG8_LDA(At, 0, 0); PG8_STAGE(PG8_SA(1, 1), a1 + hstep, voffA);
            PG8_WAIT_L(8); PG8_BAR; PG8_WAIT_L(0); PG8_MMA(0, 0, At, B0); PG8_BAR; PG8_SCHED;
            PG8_LDB(B1, 0, 1); PG8_STAGE(PG8_SB(0, 0), b2, voffB);
            PG8_BAR; PG8_WAIT_L(0); PG8_MMA(0, 1, At, B1); PG8_BAR;
            PG8_LDA(At, 0, 1); PG8_STAGE(PG8_SA(0, 0), a2, voffA);
            PG8_BAR; PG8_WAIT_L(0); PG8_MMA(1, 0, At, B0); PG8_BAR; PG8_SCHED;
            PG8_STAGE(PG8_SB(0, 1), b2 + hstep, voffB);
            PG8_WAIT_V(6); PG8_BAR; PG8_MMA(1, 1, At, B1); PG8_BAR;
            PG8_LDB(B0, 1, 0); PG8_SCHED; PG8_LDA(At, 1, 0); PG8_STAGE(PG8_SA(0, 1), a2 + hstep, voffA);
            PG8_WAIT_L(8); PG8_BAR; PG8_WAIT_L(0); PG8_MMA(0, 0, At, B0); PG8_BAR; PG8_SCHED;
            PG8_LDB(B1, 1, 1); PG8_STAGE(PG8_SB(1, 0), b3, voffB);
            PG8_BAR; PG8_WAIT_L(0); PG8_MMA(0, 1, At, B1); PG8_BAR;
            PG8_LDA(At, 1, 1); PG8_STAGE(PG8_SA(1, 0), a3, voffA);
            PG8_BAR; PG8_WAIT_L(0); PG8_MMA(1, 0, At, B0); PG8_BAR; PG8_SCHED;
            PG8_STAGE(PG8_SB(1, 1), b3 + hstep, voffB);
            PG8_WAIT_V(6); PG8_BAR; PG8_MMA(1, 1, At, B1); PG8_BAR;
            }
        }
        if constexpr (ALIGN_EPI) { if (wr == 0) PG8_BAR; }
        if constexpr (!Epi::AFTER_DRAIN) { E(acc, cur, wr, wc, fr, fq); S.done(cur); }
        if (!has_next) break;
#pragma unroll
        for (int a = 0; a < 2; ++a)
#pragma unroll
            for (int b = 0; b < 2; ++b)
#pragma unroll
                for (int m = 0; m < 4; ++m)
#pragma unroll
                    for (int n = 0; n < 2; ++n) acc[a][b][m][n] = (f32x4){0.f, 0.f, 0.f, 0.f};
        cur = nxt; cA = nA; cB = nB; ++ui;
        if constexpr (ALIGN_EPI) { if (wr == 1) PG8_BAR; }
    }
    PG8_WAIT_V(0);
    if constexpr (!ALIGN_EPI) { if (wr == 0) PG8_BAR; }
    PG8_BAR;
    if constexpr (Epi::AFTER_DRAIN) { E.fused(acc, cur, wr, wc, fr, fq, lds, wid, lane); S.done(cur); }
#undef PG8_SA
#undef PG8_SB
#undef PG8_STAGE
#undef PG8_LDA
#undef PG8_LDB
#undef PG8_MMA
#undef PG8_WAIT_V
#undef PG8_WAIT_L
#undef PG8_BAR
#undef PG8_SCHED
}
}
namespace att {
using bf16 = unsigned short;
typedef short bf16x8 __attribute__((ext_vector_type(8)));
typedef short s16x4 __attribute__((ext_vector_type(4)));
typedef float f32x16 __attribute__((ext_vector_type(16)));
typedef float f32x4 __attribute__((ext_vector_type(4)));
typedef unsigned u32x4 __attribute__((ext_vector_type(4)));
constexpr int D = 128, NW = 8, QBLK = 32, KVBLK = 64, QB = NW * QBLK;
constexpr int SHM_V = KVBLK * D * 2, SHM_K = KVBLK * D * 2;
constexpr int LDS_BYTES = 2 * SHM_V + 2 * SHM_K + NW * 64 * 4;
#define KSWZ(row, colB) ((row) * 256 + ((colB) ^ (((row) & 7) << 4)))
#define SBAR() __builtin_amdgcn_sched_barrier(0)
__device__ __forceinline__ int v_st(int k, int c) { const int kk = (k & ~0xC) | ((k & 4) << 1) | ((k & 8) >> 1); return ((kk >> 3) * 4 + (c >> 5)) * 512 + ((kk & 7) * 32 + (c & 31)) * 2; }
__device__ __forceinline__ int v_rd_base(int lane) { return ((lane & 3) << 3) | (((lane >> 2) & 3) << 6) | (((lane >> 4) & 1) << 5) | (((lane >> 5) & 1) << 8); }
constexpr int v_rd_off(int d0, int ks, int half) { return d0 * 512 + ks * 4096 + half * 2048; }
__device__ __forceinline__ int crow(int r, int hi) { return (r & 3) + 8 * (r >> 2) + 4 * hi; }
__device__ __forceinline__ unsigned cvtpk(float lo, float hi) { unsigned r; asm volatile("v_cvt_pk_bf16_f32 %0, %1, %2" : "=v"(r) : "v"(lo), "v"(hi)); return r; }
__device__ __forceinline__ bf16x8 load8(const bf16* p) { return *reinterpret_cast<const bf16x8*>(p); }

#define PK4(P, B_, OUT) do { unsigned a0 = cvtpk(P[B_+0], P[B_+1]), a1 = cvtpk(P[B_+2], P[B_+3]);                          \
        unsigned b0 = cvtpk(P[B_+4], P[B_+5]), b1 = cvtpk(P[B_+6], P[B_+7]);                                             \
        auto r0 = __builtin_amdgcn_permlane32_swap(a0, b0, false, false); auto r1 = __builtin_amdgcn_permlane32_swap(a1, b1, false, false); \
        u32x4 w = {r0[0], r1[0], r0[1], r1[1]}; OUT = *reinterpret_cast<bf16x8*>(&w); } while (0)

__device__ __forceinline__ void qkt_rt(f32x16& p0, f32x16& p1, const char* Kt, int r32, int hi, const bf16x8* qr) {
    p0 = f32x16{}; p1 = f32x16{};
    const char* kb[4];
#pragma unroll
    for (int dd = 0; dd < 4; ++dd) kb[dd] = Kt + KSWZ(r32, (dd * 16 + hi * 8) * 2);
#pragma unroll
    for (int d0 = 0; d0 < 8; ++d0) { const char* a = kb[d0 & 3] + (d0 >> 2) * 128;
        bf16x8 b0 = *reinterpret_cast<const bf16x8*>(a);
        bf16x8 b1 = *reinterpret_cast<const bf16x8*>(a + 32 * 256);
        p0 = __builtin_amdgcn_mfma_f32_32x32x16_bf16(b0, qr[d0], p0, 0, 0, 0);
        p1 = __builtin_amdgcn_mfma_f32_32x32x16_bf16(b1, qr[d0], p1, 0, 0, 0); }
}
__device__ __forceinline__ void pv_rt(f32x16* o, int vb, bf16x8 pa0, bf16x8 pa1, bf16x8 pa2, bf16x8 pa3) {
#define TRRD(dst, off) asm volatile("ds_read_b64_tr_b16 %0, %1 offset:%2" : "=&v"(dst) : "v"(vb), "i"(off) : "memory")
#define PV_D0(d0) do { s16x4 l0, l1, l2, l3, h0, h1, h2, h3; constexpr int b_ = v_rd_off(d0, 0, 0); \
        TRRD(l0, b_); TRRD(h0, b_ + 2048); TRRD(l1, b_ + 4096); TRRD(h1, b_ + 6144); TRRD(l2, b_ + 8192); TRRD(h2, b_ + 10240); TRRD(l3, b_ + 12288); TRRD(h3, b_ + 14336); \
        asm volatile("s_waitcnt lgkmcnt(0)" ::: "memory"); SBAR();   \
        o[d0] = __builtin_amdgcn_mfma_f32_32x32x16_bf16(pa0, (bf16x8){l0[0], l0[1], l0[2], l0[3], h0[0], h0[1], h0[2], h0[3]}, o[d0], 0, 0, 0);   \
        o[d0] = __builtin_amdgcn_mfma_f32_32x32x16_bf16(pa1, (bf16x8){l1[0], l1[1], l1[2], l1[3], h1[0], h1[1], h1[2], h1[3]}, o[d0], 0, 0, 0);   \
        o[d0] = __builtin_amdgcn_mfma_f32_32x32x16_bf16(pa2, (bf16x8){l2[0], l2[1], l2[2], l2[3], h2[0], h2[1], h2[2], h2[3]}, o[d0], 0, 0, 0);   \
        o[d0] = __builtin_amdgcn_mfma_f32_32x32x16_bf16(pa3, (bf16x8){l3[0], l3[1], l3[2], l3[3], h3[0], h3[1], h3[2], h3[3]}, o[d0], 0, 0, 0); } while (0)
    PV_D0(0); PV_D0(1); PV_D0(2); PV_D0(3);
#undef PV_D0
#undef TRRD
}

constexpr float SB_DONE = 1e-30f;
__device__ __forceinline__ void sb_half(f32x16& p, float& carry, int dq, bool needmask, bool lane_hi) {
    float kp[16];
#pragma unroll
    for (int r = 0; r < 16; ++r) {
        const float zz = fminf(p[r], 100.f);
        const float e = __builtin_amdgcn_exp2f(zz);
        float k = __builtin_amdgcn_rcpf(1.f + e);
        float be = e * k;
        if (needmask) { const int c = 8 * (r >> 2) + (r & 3); const bool valid = (dq - c) > 0; k = valid ? k : 1.f; be = valid ? be : 0.f; }
        kp[r] = k; p[r] = be;
    }
    float L[4], H[4];
#pragma unroll
    for (int j = 0; j < 4; ++j) { const float g = (kp[4 * j] * kp[4 * j + 1]) * (kp[4 * j + 2] * kp[4 * j + 3]);
        auto rr = __builtin_amdgcn_permlane32_swap(__float_as_uint(g), __float_as_uint(g), false, false);
        L[j] = __uint_as_float(rr[0]); H[j] = __uint_as_float(rr[1]); }
    float U[4]; U[3] = 1.f; U[2] = L[3] * H[3]; U[1] = U[2] * (L[2] * H[2]); U[0] = U[1] * (L[1] * H[1]);
    const float tot = U[0] * (L[0] * H[0]);
#pragma unroll
    for (int j = 0; j < 4; ++j) {
        const float a3 = carry * U[j] * (lane_hi ? 1.f : H[j]);
        const float a2 = a3 * kp[4 * j + 3], a1 = a2 * kp[4 * j + 2], a0 = a1 * kp[4 * j + 1];
        p[4 * j + 3] *= a3; p[4 * j + 2] *= a2; p[4 * j + 1] *= a1; p[4 * j] *= a0;
    }
    carry *= tot;
}

template <int PQ, int PK, int PV, int PO>
__device__ __forceinline__ void sb_block(const bf16* Q, const bf16* K, const bf16* V, bf16* O, int P0, char* lds, volatile __attribute__((address_space(3))) unsigned* flags) {
    const int tid = pg8::tid_opaque(), wid = __builtin_amdgcn_readfirstlane(tid >> 6), lane = tid & 63, r32 = lane & 31, hi = lane >> 5;
    char* K_lds = lds; char* V_lds = lds + 2 * SHM_K;
    const int sr = tid >> 4, sc = (tid & 15) * 8, vst0 = v_st(sr, sc), vst1 = v_st(32 + sr, sc), kws = KSWZ(sr, sc * 2);
    const int vb0 = (int)(uintptr_t)V_lds + v_rd_base(lane);
    bf16x8 qr[8];
#pragma unroll
    for (int d0 = 0; d0 < 8; ++d0) qr[d0] = load8(Q + (size_t)(wid * QBLK + r32) * PQ + d0 * 16 + hi * 8);
    f32x16 o[4] = {};
    float carry = 1.f;
    const int qlo = P0 + wid * QBLK, qpos = qlo + r32;
    int j = P0 / KVBLK + 3;
    bf16x8 st_k0, st_k1, st_v0, st_v1;
#define SB_LOAD(jt) do { const size_t k0_ = (size_t)(jt) * KVBLK; st_k0 = load8(K + (k0_ + sr) * PK + sc); st_k1 = load8(K + (k0_ + 32 + sr) * PK + sc); \
                         st_v0 = load8(V + (k0_ + sr) * PV + sc); st_v1 = load8(V + (k0_ + 32 + sr) * PV + sc); } while (0)
#define SB_WRITE(bf) do { *(bf16x8*)(K_lds + (bf) * SHM_K + kws) = st_k0; *(bf16x8*)(K_lds + (bf) * SHM_K + kws + 32 * 256) = st_k1; \
                          *(bf16x8*)(V_lds + (bf) * SHM_V + vst0) = st_v0; *(bf16x8*)(V_lds + (bf) * SHM_V + vst1) = st_v1; } while (0)
    SB_LOAD(j); asm volatile("s_waitcnt vmcnt(0)" ::: "memory"); SB_WRITE(0);
    __syncthreads();
    int buf = 0, it = 0; bool wdone = false;
    for (;;) {
        const int kb = j * KVBLK; const bool more = j > 0;
        if (more) SB_LOAD(j - 1);
        const bool act = !wdone && (kb < qlo + QBLK - 1);
        if (act) {
            f32x16 p0, p1;
            qkt_rt(p0, p1, K_lds + buf * SHM_K, r32, hi, qr);
            const bool needmask = kb + KVBLK - 1 >= qlo;
            sb_half(p1, carry, qpos - (kb + 32) - 4 * hi, needmask, hi != 0);
            sb_half(p0, carry, qpos - kb - 4 * hi, needmask, hi != 0);
            bf16x8 pa0, pa1, pa2, pa3;
            PK4(p0, 0, pa0); PK4(p0, 8, pa1); PK4(p1, 0, pa2); PK4(p1, 8, pa3);
            SBAR();
            pv_rt(o, vb0 + buf * SHM_V, pa0, pa1, pa2, pa3);
            wdone = __all(carry < SB_DONE);
        }
        if (more) { asm volatile("s_waitcnt vmcnt(0)" ::: "memory"); SB_WRITE(buf ^ 1); }
        if (lane == 0) flags[(it & 1) * 8 + wid] = wdone ? 1u : 0u;
        __syncthreads();
        unsigned alld = 1u;
#pragma unroll
        for (int w = 0; w < NW; ++w) alld &= flags[(it & 1) * 8 + w];
        if (!more || alld) break;
        --j; buf ^= 1; ++it;
    }
#undef SB_LOAD
#undef SB_WRITE
    bf16* Ow = O + (size_t)(wid * QBLK) * PO;
#pragma unroll
    for (int r = 0; r < 16; ++r) { const int orow = crow(r, hi);
#pragma unroll
        for (int d0 = 0; d0 < 4; ++d0) { const float v = o[d0][r]; const float vn = __shfl_xor(v, 1);
            if ((r32 & 1) == 0) *(unsigned*)(Ow + (size_t)orow * PO + d0 * 32 + r32) = cvtpk(v, vn); } }
    __syncthreads();
}

constexpr float THR2 = 8.f * 1.4426950408889634f;
struct DiffRef { const bf16* Q; const bf16* K; const bf16* V; bf16* O; int P0; int mode; };
struct DiffConst { float lam; float omli; float eps; const float* gain; float* scr; };
template <int PQ, int PK, int PV, int PO>
__device__ __forceinline__ void sm_block(const DiffRef& cur, const DiffConst& C, char* lds) {
    const int tid = pg8::tid_opaque(), wid = __builtin_amdgcn_readfirstlane(tid >> 6), lane = tid & 63, r32 = lane & 31, hi = lane >> 5;
    char* K_lds = lds; char* V_lds = lds + 2 * SHM_K; float* al_l = (float*)(lds + 2 * SHM_K + 2 * SHM_V) + wid * 32;
    const int sr = tid >> 4, sc = (tid & 15) * 8, vst0 = v_st(sr, sc), vst1 = v_st(32 + sr, sc), kws = KSWZ(sr, sc * 2);
    const int vb0 = (int)(uintptr_t)V_lds + v_rd_base(lane);
    const bf16* Q = cur.Q; const bf16* K = cur.K; const bf16* V = cur.V; const int P0 = cur.P0;
    bf16x8 qr[8];
#pragma unroll
    for (int d0 = 0; d0 < 8; ++d0) qr[d0] = load8(Q + (size_t)(wid * QBLK + r32) * PQ + d0 * 16 + hi * 8);
    f32x16 o[4] = {};
    float m_reg = -1e30f, l_reg = 0.f;
    const int qlo = P0 + wid * QBLK, qm = qlo + r32 - 4 * hi;
    const int NT = P0 / KVBLK + 4;
    bf16x8 st_k0, st_k1, st_v0, st_v1;
#define SM_LOAD(jt) do { const size_t k0_ = (size_t)(jt) * KVBLK; st_k0 = load8(K + (k0_ + sr) * PK + sc); st_k1 = load8(K + (k0_ + 32 + sr) * PK + sc); \
                         st_v0 = load8(V + (k0_ + sr) * PV + sc); st_v1 = load8(V + (k0_ + 32 + sr) * PV + sc); } while (0)
#define SM_WRITE(bf) do { *(bf16x8*)(K_lds + (bf) * SHM_K + kws) = st_k0; *(bf16x8*)(K_lds + (bf) * SHM_K + kws + 32 * 256) = st_k1; \
                          *(bf16x8*)(V_lds + (bf) * SHM_V + vst0) = st_v0; *(bf16x8*)(V_lds + (bf) * SHM_V + vst1) = st_v1; } while (0)
    SM_LOAD(0); asm volatile("s_waitcnt vmcnt(0)" ::: "memory"); SM_WRITE(0);
    __syncthreads();
    int buf = 0;
    for (int t = 0; t < NT; ++t) {
        const int kb = t * KVBLK; const bool more = t + 1 < NT;
        if (more) SM_LOAD(t + 1);
        if (kb <= qlo + QBLK - 1) {
            f32x16 p0, p1;
            qkt_rt(p0, p1, K_lds + buf * SHM_K, r32, hi, qr);
            if (kb + KVBLK - 1 > qlo) {
                const int dq = qm - kb; const float NEG = -__builtin_inff();
#pragma unroll
                for (int r = 0; r < 16; ++r) { const int c = (r & 3) + 8 * (r >> 2); if ((dq - c) < 0) p0[r] = NEG; if ((dq - c - 32) < 0) p1[r] = NEG; }
            }
            float pmax = p0[0];
#pragma unroll
            for (int r = 1; r < 16; ++r) pmax = fmaxf(pmax, p0[r]);
#pragma unroll
            for (int r = 0; r < 16; ++r) pmax = fmaxf(pmax, p1[r]);
            { auto rr = __builtin_amdgcn_permlane32_swap(__float_as_uint(pmax), __float_as_uint(pmax), false, false); pmax = fmaxf(__uint_as_float(rr[0]), __uint_as_float(rr[1])); }
            float alpha = 1.f;
            if (!__all((pmax - m_reg) <= THR2)) {
                const float mn = fmaxf(m_reg, pmax); alpha = __builtin_amdgcn_exp2f(m_reg - mn); m_reg = mn;
                if (hi == 0) al_l[r32] = alpha; asm volatile("s_waitcnt lgkmcnt(0)" ::: "memory");
#pragma unroll
                for (int d_ = 0; d_ < 4; ++d_)
#pragma unroll
                    for (int r = 0; r < 16; ++r) o[d_][r] *= al_l[crow(r, hi)];
            }
            float ps = 0.f;
#pragma unroll
            for (int r = 0; r < 16; ++r) { p0[r] = __builtin_amdgcn_exp2f(p0[r] - m_reg); ps += p0[r]; }
#pragma unroll
            for (int r = 0; r < 16; ++r) { p1[r] = __builtin_amdgcn_exp2f(p1[r] - m_reg); ps += p1[r]; }
            { auto rr = __builtin_amdgcn_permlane32_swap(__float_as_uint(ps), __float_as_uint(ps), false, false); ps = __uint_as_float(rr[0]) + __uint_as_float(rr[1]); }
            l_reg = l_reg * alpha + ps;
            bf16x8 pa0, pa1, pa2, pa3;
            PK4(p0, 0, pa0); PK4(p0, 8, pa1); PK4(p1, 0, pa2); PK4(p1, 8, pa3);
            SBAR();
            pv_rt(o, vb0 + buf * SHM_V, pa0, pa1, pa2, pa3);
        }
        if (more) { asm volatile("s_waitcnt vmcnt(0)" ::: "memory"); SM_WRITE(buf ^ 1); }
        __syncthreads();
        buf ^= 1;
    }
#undef SM_LOAD
#undef SM_WRITE
    if (hi == 0) al_l[r32] = l_reg; asm volatile("s_waitcnt lgkmcnt(0)" ::: "memory");
    float rli[16];
#pragma unroll
    for (int r = 0; r < 16; ++r) rli[r] = __builtin_amdgcn_rcpf(al_l[crow(r, hi)]);
#define OPQ(v) asm volatile("" : "+v"(v))
    char* sA = (char*)C.scr; char* sB = sA + 16384;
    const unsigned lo16 = (unsigned)lane * 16u;
    const int mode = cur.mode;
    if (mode == 0 || mode == 1) { char* s = mode ? sB : sA;
#pragma unroll
        for (int r = 0; r < 16; ++r) { unsigned vo = lo16; OPQ(vo);
            const f32x4 v = {o[0][r] * rli[r], o[1][r] * rli[r], o[2][r] * rli[r], o[3][r] * rli[r]};
            *(f32x4*)(s + (size_t)(vo + r * 1024)) = v; }
    } else if (mode == 2) {
#pragma unroll
        for (int r = 0; r < 16; ++r) { unsigned vo = lo16; OPQ(vo);
            f32x4* ap = (f32x4*)(sA + (size_t)(vo + r * 1024)); const f32x4 a = *ap;
            const f32x4 v = {a[0] - C.lam * (o[0][r] * rli[r]), a[1] - C.lam * (o[1][r] * rli[r]), a[2] - C.lam * (o[2][r] * rli[r]), a[3] - C.lam * (o[3][r] * rli[r])};
            *ap = v;
            if ((r & 3) == 3) asm volatile("" ::: "memory"); }
    } else {
        float g0[4], g1[4];
#pragma unroll
        for (int d0 = 0; d0 < 4; ++d0) { g0[d0] = C.gain[d0 * 32 + r32]; g1[d0] = C.gain[128 + d0 * 32 + r32]; }
        char* Ow = (char*)(cur.O + (size_t)(wid * QBLK) * PO);
        const unsigned lo_o = (unsigned)((4 * hi) * PO + r32) * 2u;
#pragma unroll
        for (int r = 0; r < 16; ++r) { unsigned vo = lo16; OPQ(vo);
            const f32x4 a = *(const f32x4*)(sA + (size_t)(vo + r * 1024)); const f32x4 b = *(const f32x4*)(sB + (size_t)(vo + r * 1024));
            float d1[4], ss = 0.f;
#pragma unroll
            for (int d0 = 0; d0 < 4; ++d0) { d1[d0] = b[d0] - C.lam * (o[d0][r] * rli[r]); ss += d1[d0] * d1[d0] + a[d0] * a[d0]; }
            ss += __shfl_xor(ss, 1); ss += __shfl_xor(ss, 2); ss += __shfl_xor(ss, 4); ss += __shfl_xor(ss, 8); ss += __shfl_xor(ss, 16);
            const float scl = rsqrtf(ss * (1.f / 256.f) + C.eps) * C.omli;
            unsigned wo = lo_o; OPQ(wo);
            char* rowp = Ow + (size_t)(wo + (unsigned)(((r & 3) + 8 * (r >> 2)) * PO * 2));
#pragma unroll
            for (int d0 = 0; d0 < 4; ++d0) {
                const float v0 = a[d0] * scl * g0[d0], v1 = d1[d0] * scl * g1[d0];
                const float v0n = __shfl_xor(v0, 1), v1n = __shfl_xor(v1, 1);
                if ((r32 & 1) == 0) { *(unsigned*)(rowp + d0 * 64) = cvtpk(v0, v0n); *(unsigned*)(rowp + 256 + d0 * 64) = cvtpk(v1, v1n); }
            }
            if ((r & 1) == 1) asm volatile("" ::: "memory");
        }
    }
#undef OPQ
    __syncthreads();
}

constexpr int K2 = 32;
constexpr int ST2_K0 = 0, ST2_K1 = 8192, ST2_V = 16384, ST2_BYTES = 32768;
__device__ __forceinline__ int v_st2(int k, int c) { const int kk = (k & ~0xC) | ((k & 4) << 1) | ((k & 8) >> 1); return ((kk >> 3) * 8 + (c >> 5)) * 512 + ((kk & 7) * 32 + (c & 31)) * 2; }
struct Diff2Const { float lam; float omli; float eps; float mb; const float* gain; };
template <int PQ, int PK, int PV, int PO>
__device__ __forceinline__ void diff2_block(const bf16* Qb  , const bf16* Kb  , const bf16* Vb  ,
                                            bf16* Ob, int P0, const Diff2Const& C, char* lds) {
    const int tid = pg8::tid_opaque(), wid = __builtin_amdgcn_readfirstlane(tid >> 6), lane = tid & 63, r32 = lane & 31, hi = lane >> 5;
    const int rg = wid & 3, cc = wid >> 2;
    const int krow = tid >> 4, kcol = (tid & 15) * 8, kws = KSWZ(krow, kcol * 2);
    const int vrow0 = tid >> 5, vcol = (tid & 31) * 8, vst0 = v_st2(vrow0, vcol), vst1 = v_st2(16 + vrow0, vcol);
    const int vb0 = (int)(uintptr_t)lds + ST2_V + v_rd_base(lane);
    const char* Kmine = lds + (cc ? ST2_K1 : ST2_K0);
    bf16x8 qr[8];
    { unsigned qo = (unsigned)((rg * QBLK + r32) * PQ + cc * 128 + hi * 8) * 2u; asm volatile("" : "+v"(qo));
#pragma unroll
      for (int d0 = 0; d0 < 8; ++d0) qr[d0] = *(const bf16x8*)((const char*)Qb + (size_t)qo + d0 * 32); }
    f32x16 o[8];
#pragma unroll
    for (int d0 = 0; d0 < 8; ++d0) o[d0] = f32x16{};
    float l_reg = 0.f;
    const int qlo = P0 + rg * QBLK, qm = qlo + r32 - 4 * hi;
    const int NT = P0 / K2 + 4;
    bf16x8 st_k0, st_k1, st_v0, st_v1;
    const unsigned koff = (unsigned)(krow * PK + kcol) * 2u, voffa = (unsigned)(vrow0 * PV + vcol) * 2u, voffb = (unsigned)((16 + vrow0) * PV + vcol) * 2u;
#define D2_LOAD(jt) do { const char* kt_ = (const char*)Kb + (size_t)(jt) * (K2 * PK * 2); const char* vt_ = (const char*)Vb + (size_t)(jt) * (K2 * PV * 2); \
                         unsigned ko_ = koff, va_ = voffa, vb_ = voffb; asm volatile("" : "+v"(ko_), "+v"(va_), "+v"(vb_)); \
                         st_k0 = *(const bf16x8*)(kt_ + (size_t)ko_); st_k1 = *(const bf16x8*)(kt_ + (size_t)ko_ + 256); \
                         st_v0 = *(const bf16x8*)(vt_ + (size_t)va_); st_v1 = *(const bf16x8*)(vt_ + (size_t)vb_); } while (0)
#define D2_WRITE(bf) do { char* st_ = lds + (bf) * ST2_BYTES; *(bf16x8*)(st_ + ST2_K0 + kws) = st_k0; *(bf16x8*)(st_ + ST2_K1 + kws) = st_k1; \
                          *(bf16x8*)(st_ + ST2_V + vst0) = st_v0; *(bf16x8*)(st_ + ST2_V + vst1) = st_v1; } while (0)
    D2_LOAD(0); asm volatile("s_waitcnt vmcnt(0)" ::: "memory"); D2_WRITE(0);
    __syncthreads();
    int buf = 0;
    for (int t = 0; t < NT; ++t) {
        const int kb = t * K2; const bool more = t + 1 < NT;
        if (more) D2_LOAD(t + 1);
        if (kb <= qlo + QBLK - 1) {
            f32x16 p0 = f32x16{};
            { const char* Kt = Kmine + buf * ST2_BYTES; const char* kbp[4];
#pragma unroll
              for (int dd = 0; dd < 4; ++dd) kbp[dd] = Kt + KSWZ(r32, (dd * 16 + hi * 8) * 2);
#pragma unroll
              for (int d0 = 0; d0 < 8; ++d0) { const bf16x8 b0 = *reinterpret_cast<const bf16x8*>(kbp[d0 & 3] + (d0 >> 2) * 128); p0 = __builtin_amdgcn_mfma_f32_32x32x16_bf16(b0, qr[d0], p0, 0, 0, 0); } }
            const float mb = C.mb;
            if (kb + K2 - 1 > qlo) {
                const int dq = qm - kb;
#pragma unroll
                for (int r = 0; r < 16; ++r) { const int c = (r & 3) + 8 * (r >> 2); const float e = __builtin_amdgcn_exp2f(p0[r] - mb); p0[r] = (dq - c) >= 0 ? e : 0.f; }
            } else {
#pragma unroll
                for (int r = 0; r < 16; ++r) p0[r] = __builtin_amdgcn_exp2f(p0[r] - mb);
            }
            float ps = 0.f;
#pragma unroll
            for (int r = 0; r < 16; ++r) ps += p0[r];
            l_reg += ps;
            bf16x8 pa0, pa1;
            PK4(p0, 0, pa0); PK4(p0, 8, pa1);
            SBAR();
            const int vb = vb0 + buf * ST2_BYTES;
#define TRRD(dst, off) asm volatile("ds_read_b64_tr_b16 %0, %1 offset:%2" : "=&v"(dst) : "v"(vb), "i"(off) : "memory")
#define PV2_RD(d0, L0, H0, L1, H1) do { constexpr int b_ = (d0) * 512; TRRD(L0, b_); TRRD(H0, b_ + 4096); TRRD(L1, b_ + 8192); TRRD(H1, b_ + 12288); } while (0)
#define PV2_MM(d0, L0, H0, L1, H1) do { \
        o[d0] = __builtin_amdgcn_mfma_f32_32x32x16_bf16(pa0, (bf16x8){L0[0], L0[1], L0[2], L0[3], H0[0], H0[1], H0[2], H0[3]}, o[d0], 0, 0, 0); \
        o[d0] = __builtin_amdgcn_mfma_f32_32x32x16_bf16(pa1, (bf16x8){L1[0], L1[1], L1[2], L1[3], H1[0], H1[1], H1[2], H1[3]}, o[d0], 0, 0, 0); } while (0)
#define LGK(n) do { asm volatile("s_waitcnt lgkmcnt(" #n ")" ::: "memory"); SBAR(); } while (0)
            { s16x4 la0, ha0, la1, ha1, lb0, hb0, lb1, hb1;
              PV2_RD(0, la0, ha0, la1, ha1);
              PV2_RD(1, lb0, hb0, lb1, hb1); LGK(4); PV2_MM(0, la0, ha0, la1, ha1);
              PV2_RD(2, la0, ha0, la1, ha1); LGK(4); PV2_MM(1, lb0, hb0, lb1, hb1);
              PV2_RD(3, lb0, hb0, lb1, hb1); LGK(4); PV2_MM(2, la0, ha0, la1, ha1);
              PV2_RD(4, la0, ha0, la1, ha1); LGK(4); PV2_MM(3, lb0, hb0, lb1, hb1);
              PV2_RD(5, lb0, hb0, lb1, hb1); LGK(4); PV2_MM(4, la0, ha0, la1, ha1);
              PV2_RD(6, la0, ha0, la1, ha1); LGK(4); PV2_MM(5, lb0, hb0, lb1, hb1);
              PV2_RD(7, lb0, hb0, lb1, hb1); LGK(4); PV2_MM(6, la0, ha0, la1, ha1);
              LGK(0); PV2_MM(7, lb0, hb0, lb1, hb1); }
#undef PV2_RD
#undef PV2_MM
#undef LGK
#undef TRRD
        }
        if (more) { asm volatile("s_waitcnt vmcnt(0)" ::: "memory"); D2_WRITE(buf ^ 1); }
        __syncthreads();
        buf ^= 1;
    }
#undef D2_LOAD
#undef D2_WRITE
    { auto rr = __builtin_amdgcn_permlane32_swap(__float_as_uint(l_reg), __float_as_uint(l_reg), false, false); l_reg = __uint_as_float(rr[0]) + __uint_as_float(rr[1]); }
    float* lw = (float*)(lds + 132096) + wid * 32;
    if (hi == 0) lw[r32] = l_reg; asm volatile("s_waitcnt lgkmcnt(0)" ::: "memory");
    float rli[16];
#pragma unroll
    for (int r = 0; r < 16; ++r) rli[r] = __builtin_amdgcn_rcpf(lw[crow(r, hi)]);
    float* X = (float*)lds + rg * 8192;
#define OPQ(v) asm volatile("" : "+v"(v))
    if (cc == 1) {
#pragma unroll
        for (int r = 0; r < 16; ++r) { const float f = C.lam * rli[r]; unsigned vo = (unsigned)lane; OPQ(vo);
#pragma unroll
            for (int d0 = 0; d0 < 8; ++d0) X[(r * 8 + d0) * 64 + vo] = o[d0][r] * f; }
    }
    __syncthreads();
    if (cc == 0) {
        float g[8];
        { unsigned go = (unsigned)r32 * 4u; OPQ(go);
#pragma unroll
          for (int d0 = 0; d0 < 8; ++d0) g[d0] = *(const float*)((const char*)C.gain + (size_t)go + d0 * 128); }
        char* Ow = (char*)(Ob + (size_t)(rg * QBLK) * PO);
        const unsigned lo_o = (unsigned)((4 * hi) * PO + r32) * 2u;
#pragma unroll
        for (int r = 0; r < 16; ++r) { unsigned vo = (unsigned)lane; OPQ(vo);
            float d[8], ss = 0.f;
#pragma unroll
            for (int d0 = 0; d0 < 8; ++d0) { d[d0] = o[d0][r] * rli[r] - X[(r * 8 + d0) * 64 + vo]; ss += d[d0] * d[d0]; }
            ss += __shfl_xor(ss, 1); ss += __shfl_xor(ss, 2); ss += __shfl_xor(ss, 4); ss += __shfl_xor(ss, 8); ss += __shfl_xor(ss, 16);
            const float scl = rsqrtf(ss * (1.f / 256.f) + C.eps) * C.omli;
            unsigned wo = lo_o; OPQ(wo);
            char* rowp = Ow + (size_t)(wo + (unsigned)(((r & 3) + 8 * (r >> 2)) * PO * 2));
#pragma unroll
            for (int d0 = 0; d0 < 8; ++d0) { const float v = d[d0] * scl * g[d0]; const float vn = __shfl_xor(v, 1);
                if ((r32 & 1) == 0) *(unsigned*)(rowp + d0 * 64) = cvtpk(v, vn); }
        }
    }
#undef OPQ
    __syncthreads();
}
}
#ifndef PG8_SP2
#define PG8_SP2 true
#endif
#ifndef PG8_ALIGN
#define PG8_ALIGN true
#endif
#ifndef MK_SPLIT
#define MK_SPLIT 0
#endif
#ifndef MK_CHECK
#define MK_CHECK 0
#endif
constexpr int NWAVES = 8;
constexpr int BATCH = 2, SEQ = 4096, DM = 4096, MROWS = BATCH * SEQ, FF = 11008, FF2 = 2 * FF, NQKV = 3 * DM;
constexpr int SB_H = 32, DF_H = 16, HD = 128;
constexpr float RMS_EPS = 1e-6f;
constexpr float LOG2E = 1.4426950408889634f;
constexpr float QSCALE = 0.08838834764831845f * LOG2E;
constexpr int NPH = 14;
constexpr size_t MiB = 1u << 20;
constexpr size_t WS_CTL = 0, CTL_ZERO_BYTES = 1 * MiB;
constexpr size_t WS_WQKV0 = 2 * MiB;
constexpr size_t WS_WO0   = WS_WQKV0 + 96 * MiB;
constexpr size_t WS_WQKV1 = WS_WO0 + 32 * MiB;
constexpr size_t WS_WO1   = WS_WQKV1 + 96 * MiB;
constexpr size_t WS_WUP0  = WS_WO1 + 32 * MiB;
constexpr size_t WS_WUP1  = WS_WUP0 + 172 * MiB;
constexpr size_t WS_WDN0  = WS_WUP1 + 172 * MiB;
constexpr size_t WS_WDN1  = WS_WDN0 + 86 * MiB;
constexpr size_t WS_XN    = WS_WDN1 + 86 * MiB;
constexpr size_t WS_PART  = WS_XN + 64 * MiB;
constexpr size_t WS_QKV   = WS_PART + 2 * MiB;
constexpr size_t WS_QKN   = WS_QKV + 192 * MiB;
constexpr size_t WS_AO    = WS_QKN + 128 * MiB;
constexpr size_t WS_U     = WS_AO + 64 * MiB;
constexpr size_t WS_ACT   = WS_U + 344 * MiB;
constexpr size_t WS_SCR   = WS_ACT + 172 * MiB;
constexpr size_t WS_HALO  = WS_SCR + 64 * MiB;
constexpr size_t WS_X1    = WS_HALO + 44 * MiB;
constexpr size_t WS_END   = WS_X1 + (MK_CHECK ? 3 * 128 * MiB : 0);
constexpr int CW_TMO = 0, CW_CODE = 1, CW_FAIL = 2, CW_BAR = 4096;

constexpr int RING_OFF = 0, RING_BYTES = 131072;
constexpr int LDSCTL_OFF = RING_BYTES, MISC_OFF = LDSCTL_OFF + 320;
constexpr int LDS_BYTES = 147456;
constexpr int RS_OFF = MISC_OFF + 128;
static_assert(RS_OFF % 16 == 0 && RS_OFF + 1024 + 4096 <= LDS_BYTES, "LDS map");

#define GAS __attribute__((address_space(1)))
#define LAS __attribute__((address_space(3)))
typedef unsigned short bf16;
typedef unsigned v4u __attribute__((ext_vector_type(4)));
typedef unsigned v2u __attribute__((ext_vector_type(2)));
typedef float f32x4 __attribute__((ext_vector_type(4)));
typedef short bf16x8 __attribute__((ext_vector_type(8)));
typedef GAS unsigned gu32;
#define RLX_AGENT __ATOMIC_RELAXED, __HIP_MEMORY_SCOPE_AGENT
#define LDS_WAIT() asm volatile("s_waitcnt lgkmcnt(0)" ::: "memory")
#define VM_WAIT() asm volatile("s_waitcnt vmcnt(0)" ::: "memory")
__device__ __forceinline__ unsigned f2bf(float f) { unsigned u = __builtin_bit_cast(unsigned, f); return (u + 0x7fffu + ((u >> 16) & 1u)) >> 16; }
__device__ __forceinline__ unsigned pk2(float lo, float hi) { return f2bf(lo) | (f2bf(hi) << 16); }
__device__ __forceinline__ float bf2f(unsigned short b) { return __builtin_bit_cast(float, (unsigned)b << 16); }

#define XB_TMO      128
#define XB_XCNT(j)  (256  + 64 * (j))
#define XB_XSUB(j)  (1280 + 64 * (j))
#define XB_XGEN(j)  (2304 + 64 * (j))
#define XB_TOP      3328
#define XB_TOPGEN   3392
#define XCD_BAR_WORDS 3456
#define XB_SPIN_CAP (1u << 18)
__device__ __forceinline__ unsigned xb_ld(unsigned* p)              { return __hip_atomic_load(p, __ATOMIC_RELAXED, __HIP_MEMORY_SCOPE_AGENT); }
__device__ __forceinline__ unsigned xb_add(unsigned* p, unsigned v) { return __hip_atomic_fetch_add(p, v, __ATOMIC_RELAXED, __HIP_MEMORY_SCOPE_AGENT); }
__device__ __forceinline__ unsigned xb_xcc_id() { return (unsigned)__builtin_amdgcn_s_getreg((3 << 11) | 20) & 0xFu; }
#define XB_SPIN(cond, bar) do { unsigned _sp = 0; while (cond) { __builtin_amdgcn_s_sleep(1); \
    if ((++_sp & 255u) == 0u) { if (xb_ld(&(bar)[XB_TMO])) break; if (_sp > XB_SPIN_CAP) { atomicAdd(&(bar)[XB_TMO], 1u); break; } } } } while (0)
struct XcdBarrier { unsigned* bar; unsigned x; volatile LAS unsigned* st; };
__device__ __forceinline__ XcdBarrier xcd_barrier_post(unsigned* bar, volatile LAS unsigned* st) {
    XcdBarrier b; b.bar = bar; b.x = xb_xcc_id(); b.st = st;
    if (threadIdx.x == 0) (void)xb_add(&bar[XB_XCNT(b.x)], 1u);
    return b;
}
__device__ __forceinline__ void xcd_barrier_complete(unsigned* bar, unsigned x, unsigned& nloc, unsigned& nx) {
    const unsigned G = gridDim.x * gridDim.y * gridDim.z;
    unsigned sum, cnt, mine, sp = 0u;
    for (;;) {
        sum = 0u; cnt = 0u; mine = 0u;
#pragma unroll
        for (unsigned j = 0; j < 16; ++j) { const unsigned c = xb_ld(&bar[XB_XCNT(j)]); sum += c; cnt += (c > 0u) ? 1u : 0u; mine = (j == x) ? c : mine; }
        if (sum == G) break;
        __builtin_amdgcn_s_sleep(1);
        if ((++sp & 255u) == 0u) { if (xb_ld(&bar[XB_TMO])) break; if (sp > XB_SPIN_CAP) { atomicAdd(&bar[XB_TMO], 1u); break; } }
    }
    nloc = mine > 0u ? mine : 1u; nx = cnt > 0u ? cnt : 1u;
}
__device__ __forceinline__ void xcd_barrier(const XcdBarrier& b) {
    asm volatile("s_waitcnt vmcnt(0)" ::: "memory");
    __syncthreads();
    if (threadIdx.x == 0) {
        unsigned* bar = b.bar; const unsigned myx = xb_xcc_id();
        __builtin_amdgcn_s_waitcnt(0);
        unsigned nloc = b.st[0], nx = b.st[1];
        if (nloc == 0u) { xcd_barrier_complete(bar, myx, nloc, nx); b.st[0] = nloc; b.st[1] = nx; }
        const unsigned old = xb_add(&bar[XB_XSUB(myx)], 1u);
        const unsigned gen = old / nloc;
        if (old + 1u == (gen + 1u) * nloc) {
            __builtin_amdgcn_fence(__ATOMIC_RELEASE, "agent");
            asm volatile("s_waitcnt vmcnt(0)" ::: "memory");
            const unsigned og = xb_add(&bar[XB_TOP], 1u);
            const unsigned tg = og / nx;
            if (og + 1u == (tg + 1u) * nx) xb_add(&bar[XB_TOPGEN], 1u);
            else XB_SPIN(xb_ld(&bar[XB_TOPGEN]) == tg, bar);
            __builtin_amdgcn_fence(__ATOMIC_ACQUIRE, "agent");
            xb_add(&bar[XB_XGEN(myx)], 1u);
            asm volatile("s_waitcnt vmcnt(0)" ::: "memory");
        } else {
            XB_SPIN(xb_ld(&bar[XB_XGEN(myx)]) == gen, bar);
            __builtin_amdgcn_fence(__ATOMIC_ACQUIRE, "agent");
            asm volatile("s_waitcnt vmcnt(0)" ::: "memory");
        }
    }
    __syncthreads();
}

__device__ __forceinline__ float wave_sum(float v) {
#pragma unroll
    for (int o = 1; o < 64; o <<= 1) v += __shfl_xor(v, o);
    return v;
}

constexpr int TR_STRIDE = 33;
__device__ __forceinline__ void transpose_item(const float* W, const float* gain, int K, int N, bf16* WT, LAS unsigned* scr, int item, int lane, bool gateperm) {
    const int nblk = N / 64, kb = item / nblk, nb = item % nblk, k0 = 64 * kb, n0 = 64 * nb;
    const int h_ = N / 2, nd0 = gateperm ? ((n0 % h_) / 128) * 256 + (n0 / h_) * 128 + (n0 % 128) : n0;
    const int kp = lane >> 4, c = lane & 15;
    f32x4 va[8], vb[8];
#pragma unroll
    for (int i = 0; i < 8; ++i) { const GAS float* src = (const GAS float*)W + (size_t)(k0 + 8 * i + 2 * kp) * N + n0 + 4 * c; va[i] = __builtin_nontemporal_load((const GAS f32x4*)src); vb[i] = __builtin_nontemporal_load((const GAS f32x4*)(src + N)); }
#pragma unroll
    for (int i = 0; i < 8; ++i) { float ga = 1.f, gb = 1.f; if (gain) { ga = gain[k0 + 8 * i + 2 * kp]; gb = gain[k0 + 8 * i + 2 * kp + 1]; }
        LAS unsigned* d = scr + (4 * c) * TR_STRIDE + 4 * i + kp;
        d[0 * TR_STRIDE] = pk2(va[i].x * ga, vb[i].x * gb); d[1 * TR_STRIDE] = pk2(va[i].y * ga, vb[i].y * gb);
        d[2 * TR_STRIDE] = pk2(va[i].z * ga, vb[i].z * gb); d[3 * TR_STRIDE] = pk2(va[i].w * ga, vb[i].w * gb); }
    LDS_WAIT(); asm volatile("" ::: "memory");
    const int c8 = lane & 7, nr = lane >> 3;
#pragma unroll
    for (int j = 0; j < 8; ++j) { const int n = nr + 8 * j; const LAS unsigned* s = scr + n * TR_STRIDE + 4 * c8;
        v4u o; o.x = s[0]; o.y = s[1]; o.z = s[2]; o.w = s[3];
        *(GAS v4u*)(WT + (size_t)(nd0 + n) * K + k0 + 8 * c8) = o; }
    LDS_WAIT(); asm volatile("" ::: "memory");
}
__device__ __forceinline__ void xrow_to_bf16(const float* xrow, bf16* orow, float* prow, int lane) {
    const GAS f32x4* xr = (const GAS f32x4*)xrow + lane;
    float s = 0.f; GAS unsigned long long* o8 = (GAS unsigned long long*)orow + lane;
#pragma unroll
    for (int j = 0; j < 16; ++j) { const f32x4 v = xr[64 * j]; s += (v.x * v.x + v.y * v.y) + (v.z * v.z + v.w * v.w);
        o8[64 * j] = (unsigned long long)pk2(v.x, v.y) | ((unsigned long long)pk2(v.z, v.w) << 32); }
    s = wave_sum(s);
    prow[lane] = lane == 0 ? s : 0.f;
}

__device__ __forceinline__ void cvt8(const v4u w, float (&f)[8]) {
    f[0] = __builtin_bit_cast(float, w.x << 16); f[1] = __builtin_bit_cast(float, w.x & 0xffff0000u); f[2] = __builtin_bit_cast(float, w.y << 16); f[3] = __builtin_bit_cast(float, w.y & 0xffff0000u);
    f[4] = __builtin_bit_cast(float, w.z << 16); f[5] = __builtin_bit_cast(float, w.z & 0xffff0000u); f[6] = __builtin_bit_cast(float, w.w << 16); f[7] = __builtin_bit_cast(float, w.w & 0xffff0000u);
}
constexpr int CG_ROWS = 32, CG_NCG = FF / 8, CG_ITEMS = (MROWS / CG_ROWS) * CG_NCG;
__device__ __forceinline__ void convgate_item(const bf16* U, const float* cw, const float* cb, bf16* ACT, int item) {
    const int chunk = item / CG_NCG, cg = item % CG_NCG, m0 = chunk * CG_ROWS, t0 = m0 % SEQ, j0 = cg * 8;
    float wg[3][8], wv[3][8], bg[8], bv[8];
#pragma unroll
    for (int i = 0; i < 3; ++i)
#pragma unroll
        for (int h = 0; h < 2; ++h) { const f32x4 a = *(const f32x4*)(cw + (size_t)i * FF2 + j0 + 4 * h), b = *(const f32x4*)(cw + (size_t)i * FF2 + FF + j0 + 4 * h);
            wg[i][4 * h] = a.x; wg[i][4 * h + 1] = a.y; wg[i][4 * h + 2] = a.z; wg[i][4 * h + 3] = a.w; wv[i][4 * h] = b.x; wv[i][4 * h + 1] = b.y; wv[i][4 * h + 2] = b.z; wv[i][4 * h + 3] = b.w; }
#pragma unroll
    for (int h = 0; h < 2; ++h) { const f32x4 a = *(const f32x4*)(cb + j0 + 4 * h), b = *(const f32x4*)(cb + FF + j0 + 4 * h);
        bg[4 * h] = a.x; bg[4 * h + 1] = a.y; bg[4 * h + 2] = a.z; bg[4 * h + 3] = a.w; bv[4 * h] = b.x; bv[4 * h + 1] = b.y; bv[4 * h + 2] = b.z; bv[4 * h + 3] = b.w; }
    float g2[8], g1[8], v2[8], v1[8];
    const v4u z4 = {0u, 0u, 0u, 0u};
    { const v4u a = t0 >= 2 ? *(const GAS v4u*)(U + (size_t)(m0 - 2) * FF2 + j0) : z4, b = t0 >= 2 ? *(const GAS v4u*)(U + (size_t)(m0 - 2) * FF2 + FF + j0) : z4; cvt8(a, g2); cvt8(b, v2); }
    { const v4u a = t0 >= 1 ? *(const GAS v4u*)(U + (size_t)(m0 - 1) * FF2 + j0) : z4, b = t0 >= 1 ? *(const GAS v4u*)(U + (size_t)(m0 - 1) * FF2 + FF + j0) : z4; cvt8(a, g1); cvt8(b, v1); }
#pragma unroll 4
    for (int r = 0; r < CG_ROWS; ++r) {
        float g0[8], v0[8]; cvt8(*(const GAS v4u*)(U + (size_t)(m0 + r) * FF2 + j0), g0); cvt8(*(const GAS v4u*)(U + (size_t)(m0 + r) * FF2 + FF + j0), v0);
        float o[8];
#pragma unroll
        for (int e = 0; e < 8; ++e) { const float cgv = bg[e] + wg[0][e] * g2[e] + wg[1][e] * g1[e] + wg[2][e] * g0[e]; const float cvv = bv[e] + wv[0][e] * v2[e] + wv[1][e] * v1[e] + wv[2][e] * v0[e];
            const float sg = cgv * __builtin_amdgcn_rcpf(1.f + __builtin_amdgcn_exp2f(-cgv * LOG2E)); o[e] = sg * cvv; g2[e] = g1[e]; g1[e] = g0[e]; v2[e] = v1[e]; v1[e] = v0[e]; }
        v4u w; w.x = pk2(o[0], o[1]); w.y = pk2(o[2], o[3]); w.z = pk2(o[4], o[5]); w.w = pk2(o[6], o[7]);
        *(GAS v4u*)(ACT + (size_t)(m0 + r) * FF + j0) = w;
    }
}

constexpr int FX_ITEMS = (MROWS / 64) * CG_NCG;
__device__ __forceinline__ void ld8(const float* p, float (&f)[8]) { const f32x4 a = *(const GAS f32x4*)p, b = *(const GAS f32x4*)(p + 4); f[0] = a.x; f[1] = a.y; f[2] = a.z; f[3] = a.w; f[4] = b.x; f[5] = b.y; f[6] = b.z; f[7] = b.w; }
__device__ __forceinline__ void fixup_item(const float* halo, const float* cw, const float* cb, bf16* ACT, int item) {
    const int grp = item / CG_NCG, cg = item % CG_NCG, j0 = cg * 8; const bool first = (grp % (SEQ / 64)) == 0;
    float wg[3][8], wv[3][8], bg[8], bv[8];
#pragma unroll
    for (int i = 0; i < 3; ++i) { ld8(cw + (size_t)i * FF2 + j0, wg[i]); ld8(cw + (size_t)i * FF2 + FF + j0, wv[i]); }
    ld8(cb + j0, bg); ld8(cb + FF + j0, bv);
    float h0g[8], h0v[8], h1g[8], h1v[8], t0g[8], t0v[8], t1g[8], t1v[8];
    const float* hb = halo + (size_t)grp * 4 * FF2 + j0;
    ld8(hb, h0g); ld8(hb + FF, h0v); ld8(hb + FF2, h1g); ld8(hb + FF2 + FF, h1v);
    if (!first) { const float* pb = hb - 4 * (size_t)FF2; ld8(pb + 2 * (size_t)FF2, t0g); ld8(pb + 2 * (size_t)FF2 + FF, t0v); ld8(pb + 3 * (size_t)FF2, t1g); ld8(pb + 3 * (size_t)FF2 + FF, t1v); }
    else {
#pragma unroll
        for (int e = 0; e < 8; ++e) { t0g[e] = 0.f; t0v[e] = 0.f; t1g[e] = 0.f; t1v[e] = 0.f; } }
    float o0[8], o1[8];
#pragma unroll
    for (int e = 0; e < 8; ++e) {
        const float cg0 = bg[e] + wg[0][e] * t0g[e] + wg[1][e] * t1g[e] + wg[2][e] * h0g[e], cv0 = bv[e] + wv[0][e] * t0v[e] + wv[1][e] * t1v[e] + wv[2][e] * h0v[e];
        const float cg1 = bg[e] + wg[0][e] * t1g[e] + wg[1][e] * h0g[e] + wg[2][e] * h1g[e], cv1 = bv[e] + wv[0][e] * t1v[e] + wv[1][e] * h0v[e] + wv[2][e] * h1v[e];
        o0[e] = cg0 * __builtin_amdgcn_rcpf(1.f + __builtin_amdgcn_exp2f(-cg0 * LOG2E)) * cv0; o1[e] = cg1 * __builtin_amdgcn_rcpf(1.f + __builtin_amdgcn_exp2f(-cg1 * LOG2E)) * cv1; }
    v4u w0, w1; w0.x = pk2(o0[0], o0[1]); w0.y = pk2(o0[2], o0[3]); w0.z = pk2(o0[4], o0[5]); w0.w = pk2(o0[6], o0[7]);
    w1.x = pk2(o1[0], o1[1]); w1.y = pk2(o1[2], o1[3]); w1.z = pk2(o1[4], o1[5]); w1.w = pk2(o1[6], o1[7]);
    *(GAS v4u*)(ACT + (size_t)(grp * 64) * FF + j0) = w0; *(GAS v4u*)(ACT + (size_t)(grp * 64 + 1) * FF + j0) = w1;
}

__device__ __forceinline__ void sincos_rev(float ang, float& s, float& c) {
    const float I1 = 0.15915493667125702f, I2 = 6.420638326565253e-09f;
    const float r1 = ang * I1; const float e1 = __builtin_fmaf(ang, I1, -r1); const float r2 = __builtin_fmaf(ang, I2, e1);
    const float fr = (r1 - __builtin_rintf(r1)) + r2;
    s = __builtin_amdgcn_sinf(fr); c = __builtin_amdgcn_cosf(fr);
}
__device__ __forceinline__ void qknorm_row(const bf16* qkv_row, bf16* qkn_row, const float* gq, const float* gk, int t, int lane) {
    const int c = lane & 7, gs = lane >> 3;
    float cs[8], sn[8];
#pragma unroll
    for (int e = 0; e < 8; ++e) { const int i = 8 * c + e; const float invf = __builtin_amdgcn_exp2f(-(float)i * (13.287712379549449f / 64.f));
        sincos_rev((float)t * invf, sn[e], cs[e]); }
    float gA[8], gB[8];
#pragma unroll 1
    for (int qk = 0; qk < 2; ++qk) {
        const float* gn = qk ? gk : gq; const float sc = qk ? 1.f : QSCALE;
#pragma unroll
        for (int e = 0; e < 8; ++e) { gA[e] = gn[8 * c + e]; gB[e] = gn[64 + 8 * c + e]; }
        v4u ra[4], rb[4];
#pragma unroll
        for (int it = 0; it < 4; ++it) { const int col = qk * 4096 + (it * 8 + gs) * 128 + 8 * c; ra[it] = *(const GAS v4u*)(qkv_row + col); rb[it] = *(const GAS v4u*)(qkv_row + col + 64); }
#pragma unroll
        for (int it = 0; it < 4; ++it) {
            const int col = qk * 4096 + (it * 8 + gs) * 128 + 8 * c;
            float xa[8], xb[8]; cvt8(ra[it], xa); cvt8(rb[it], xb);
            float ss = 0.f;
#pragma unroll
            for (int e = 0; e < 8; ++e) ss += xa[e] * xa[e] + xb[e] * xb[e];
            ss += __shfl_xor(ss, 1); ss += __shfl_xor(ss, 2); ss += __shfl_xor(ss, 4);
            const float inv = rsqrtf(ss * (1.f / 128.f) + RMS_EPS);
            float oa[8], ob[8];
#pragma unroll
            for (int e = 0; e < 8; ++e) { const float ya = xa[e] * inv * gA[e], yb = xb[e] * inv * gB[e]; oa[e] = (ya * cs[e] - yb * sn[e]) * sc; ob[e] = (yb * cs[e] + ya * sn[e]) * sc; }
            v4u wa, wb; wa.x = pk2(oa[0], oa[1]); wa.y = pk2(oa[2], oa[3]); wa.z = pk2(oa[4], oa[5]); wa.w = pk2(oa[6], oa[7]);
            wb.x = pk2(ob[0], ob[1]); wb.y = pk2(ob[2], ob[3]); wb.z = pk2(ob[4], ob[5]); wb.w = pk2(ob[6], ob[7]);
            *(GAS v4u*)(qkn_row + col) = wa; *(GAS v4u*)(qkn_row + col + 64) = wb;
        }
    }
}
#ifdef QKN_FAST
__device__ __forceinline__ unsigned qkn_pk(float lo, float hi) { unsigned r; asm volatile("v_cvt_pk_bf16_f32 %0, %1, %2" : "=v"(r) : "v"(lo), "v"(hi)); return r; }
__device__ __forceinline__ void qknorm_rows(const bf16* qkv, bf16* qkn, const float* gq, const float* gk, int gw, int ngw, int lane) {
    const int c = lane & 7, gs = lane >> 3;
    float gA[2][8], gB[2][8];
#pragma unroll
    for (int e = 0; e < 8; ++e) { gA[0][e] = gq[8 * c + e]; gB[0][e] = gq[64 + 8 * c + e]; gA[1][e] = gk[8 * c + e]; gB[1][e] = gk[64 + 8 * c + e]; }
#pragma unroll 1
    for (int m = gw; m < MROWS; m += ngw) {
        const bf16* qkv_row = qkv + (size_t)m * NQKV; bf16* qkn_row = qkn + (size_t)m * 8192; const int t = m % SEQ;
        v4u ra[2][4], rb[2][4];
#pragma unroll
        for (int qk = 0; qk < 2; ++qk)
#pragma unroll
            for (int it = 0; it < 4; ++it) { const int col = qk * 4096 + (it * 8 + gs) * 128 + 8 * c; ra[qk][it] = *(const GAS v4u*)(qkv_row + col); rb[qk][it] = *(const GAS v4u*)(qkv_row + col + 64); }
        float cs[8], sn[8];
#pragma unroll
        for (int e = 0; e < 8; ++e) { const int i = 8 * c + e; const float invf = __builtin_amdgcn_exp2f(-(float)i * (13.287712379549449f / 64.f));
            sincos_rev((float)t * invf, sn[e], cs[e]); }
#pragma unroll
        for (int qk = 0; qk < 2; ++qk) { const float sc = qk ? 1.f : QSCALE;
#pragma unroll
            for (int it = 0; it < 4; ++it) {
                const int col = qk * 4096 + (it * 8 + gs) * 128 + 8 * c;
                float xa[8], xb[8]; cvt8(ra[qk][it], xa); cvt8(rb[qk][it], xb);
                float ss = 0.f;
#pragma unroll
                for (int e = 0; e < 8; ++e) ss += xa[e] * xa[e] + xb[e] * xb[e];
                ss += __shfl_xor(ss, 1); ss += __shfl_xor(ss, 2); ss += __shfl_xor(ss, 4);
                const float inv = rsqrtf(ss * (1.f / 128.f) + RMS_EPS);
                float oa[8], ob[8];
#pragma unroll
                for (int e = 0; e < 8; ++e) { const float ya = xa[e] * inv * gA[qk][e], yb = xb[e] * inv * gB[qk][e]; oa[e] = (ya * cs[e] - yb * sn[e]) * sc; ob[e] = (yb * cs[e] + ya * sn[e]) * sc; }
                v4u wa, wb; wa.x = qkn_pk(oa[0], oa[1]); wa.y = qkn_pk(oa[2], oa[3]); wa.z = qkn_pk(oa[4], oa[5]); wa.w = qkn_pk(oa[6], oa[7]);
                wb.x = qkn_pk(ob[0], ob[1]); wb.y = qkn_pk(ob[2], ob[3]); wb.z = qkn_pk(ob[4], ob[5]); wb.w = qkn_pk(ob[6], ob[7]);
                *(GAS v4u*)(qkn_row + col) = wa; *(GAS v4u*)(qkn_row + col + 64) = wb;
            }
        }
    }
}
#endif
struct Args { const float* in[18]; float* out; unsigned char* ws; int ph_lo, ph_hi; };
static_assert(sizeof(Args) == 18 * 8 + 8 + 8 + 8, "Args has no padding");

struct MatDesc { int in_idx; size_t in_off; int gain_idx; size_t gain_off; int K, N; size_t ws_off; int gateperm; };
__device__ __forceinline__ MatDesc mat_desc(int i) {
    switch (i) {
    case 0: return MatDesc{2, 0, 1, 0, DM, NQKV, WS_WQKV0, 0};
    case 1: return MatDesc{3, 0, -1, 0, DM, DM, WS_WO0, 0};
    case 2: return MatDesc{14, 0, 13, 0, DM, FF2, WS_WUP0, 1};
    case 3: return MatDesc{17, 0, -1, 0, FF, DM, WS_WDN0, 0};
    case 4: return MatDesc{4, 0, 1, (size_t)DM, DM, NQKV, WS_WQKV1, 0};
    case 5: return MatDesc{5, 0, -1, 0, DM, DM, WS_WO1, 0};
    case 6: return MatDesc{14, (size_t)DM * FF2, 13, (size_t)DM, DM, FF2, WS_WUP1, 1};
    default: return MatDesc{17, (size_t)FF * DM, -1, 0, FF, DM, WS_WDN1, 0};
    }
}

__global__ void __launch_bounds__(NWAVES * 64, 2) mk_fwd(Args args) {
    extern __shared__ __attribute__((aligned(16))) unsigned char lds[];
    LAS unsigned char* ldsl = (LAS unsigned char*)lds;
    volatile LAS unsigned* MISC = (volatile LAS unsigned*)(ldsl + MISC_OFF);
    const int tid = threadIdx.x, lane = tid & 63, wave = __builtin_amdgcn_readfirstlane(tid >> 6);
    const int G = gridDim.x, bx = blockIdx.x;
    const int gw = bx * NWAVES + wave, NGW = G * NWAVES;
    unsigned char* ws = args.ws;
    gu32* ctl = (gu32*)(ws + WS_CTL);
    for (int u = tid; u < (LDS_BYTES - LDSCTL_OFF) / 4; u += NWAVES * 64) ((LAS unsigned*)(ldsl + LDSCTL_OFF))[u] = 0u;
    __syncthreads();
    XcdBarrier bar; bar.bar = (unsigned*)(ctl + CW_BAR); bar.x = 0; bar.st = nullptr;
    const int lo = args.ph_lo, hi = args.ph_hi;
    if (hi - lo > 1) bar = xcd_barrier_post((unsigned*)(ctl + CW_BAR), MISC + 8);
#ifndef PH_MASK
#define PH_MASK 0x3fff
#endif
#define IN(k) (((PH_MASK >> (k)) & 1) && lo <= (k) && (k) < hi)
#define SEAM(k) do { if (IN(k) && IN((k) + 1)) xcd_barrier(bar); STAMP((k) + 1); } while (0)
#ifndef REPEAT_PHASE
#define REPEAT_PHASE -1
#endif
#ifndef REPEAT_N
#define REPEAT_N 1
#endif
#ifndef LEAK_A
#define LEAK_A -1
#endif
#ifndef LEAK_B
#define LEAK_B 14
#endif
#ifndef LEAK_OFF
#define LEAK_OFF 0
#endif
    unsigned long long tA = 0, tB = 0;
#define STAMP(k) do { if (LEAK_A >= 0 && bx == 0 && tid == 0) { if ((k) == LEAK_A) tA = __builtin_amdgcn_s_memrealtime(); if ((k) == LEAK_B) tB = __builtin_amdgcn_s_memrealtime(); } } while (0)
#define NREP(k) (REPEAT_PHASE == (k) ? 1 + REPEAT_N : 1)
    float* DUMMY = (float*)(ws + WS_END);

    bf16* XN = (bf16*)(ws + WS_XN); float* PART = (float*)(ws + WS_PART);
    bf16* QKV = (bf16*)(ws + WS_QKV); bf16* QKN = (bf16*)(ws + WS_QKN); bf16* AO = (bf16*)(ws + WS_AO);
    bf16* ACT = (bf16*)(ws + WS_ACT); float* HALO = (float*)(ws + WS_HALO);
    const float* x_in = args.in[0];

#ifndef JIT_CONV
#define JIT_CONV 1
#endif
#define CONVERT_MAT(MI) do { const MatDesc md = mat_desc(MI); LAS unsigned* scr_ = (LAS unsigned*)(ldsl + RING_OFF + wave * 16384); \
        const float* W_ = args.in[md.in_idx] + md.in_off; const float* gain_ = md.gain_idx >= 0 ? args.in[md.gain_idx] + md.gain_off : nullptr; \
        bf16* WT_ = (bf16*)(ws + md.ws_off); const int nitems_ = (md.K / 64) * (md.N / 64); \
        for (int it_ = gw; it_ < nitems_; it_ += NGW) transpose_item(W_, gain_, md.K, md.N, WT_, scr_, it_, lane, md.gateperm != 0); } while (0)
#define CONVERT_MAT_RANGE(MI, I0, I1, WG0) do { const MatDesc md = mat_desc(MI); LAS unsigned* scr_ = (LAS unsigned*)(ldsl + RING_OFF + wave * 16384); \
        const float* W_ = args.in[md.in_idx] + md.in_off; const float* gain_ = md.gain_idx >= 0 ? args.in[md.gain_idx] + md.gain_off : nullptr; \
        bf16* WT_ = (bf16*)(ws + md.ws_off); const int i1_ = (I1); \
        for (int it_ = (I0) + (bx - (WG0)) * NWAVES + wave; it_ < i1_; it_ += (G - (WG0)) * NWAVES) transpose_item(W_, gain_, md.K, md.N, WT_, scr_, it_, lane, md.gateperm != 0); } while (0)
#ifndef TAILFILL
#define TAILFILL 1
#endif
#ifndef DN_NUM
#define DN_NUM 52
#endif
constexpr int DN_ITEMS = (FF / 64) * (DM / 64), DN_SPLIT = TAILFILL ? (DN_ITEMS * DN_NUM) / 100 : 0;
#ifndef SPLIT_CONV
#define SPLIT_CONV 1
#endif
#ifdef PROBE_XCC
    if (tid == 0) __hip_atomic_store(ctl + 2048 + bx, 1u + xb_xcc_id(), RLX_AGENT);
#endif
    STAMP(0);
    if (IN(0)) _Pragma("unroll") for (int rep = 0; rep < NREP(0); ++rep) { if (rep) xcd_barrier(bar);
        LAS unsigned* scr = (LAS unsigned*)(ldsl + RING_OFF + wave * 16384);
#pragma unroll 1
#if JIT_CONV
        for (int m = gw; m < MROWS; m += NGW) xrow_to_bf16(x_in + (size_t)m * DM, XN + (size_t)m * DM, PART + (size_t)m * pg8::NPART, lane);
        CONVERT_MAT(0);
    }
#else
        for (int mo = 0; mo < (SPLIT_CONV ? 4 : 8); ++mo) { const int mi = SPLIT_CONV ? ((mo + 1) & 3) : ((mo + 1) & 7); const MatDesc md = mat_desc(mi);
            if (mi == 0) { for (int m = gw; m < MROWS; m += NGW) xrow_to_bf16(x_in + (size_t)m * DM, XN + (size_t)m * DM, PART + (size_t)m * pg8::NPART, lane); }
            const float* W = args.in[md.in_idx] + md.in_off; const float* gain = md.gain_idx >= 0 ? args.in[md.gain_idx] + md.gain_off : nullptr;
            bf16* WT = (bf16*)(ws + md.ws_off); const int nitems = (md.K / 64) * (md.N / 64);
            for (int it = gw; it < nitems; it += NGW) transpose_item(W, gain, md.K, md.N, WT, scr, it, lane, md.gateperm != 0); }
    }
#endif
    SEAM(0);
    if (IN(1)) _Pragma("unroll") for (int rep = 0; rep < NREP(1); ++rep) { if (rep) xcd_barrier(bar);
        pg8::Gemm g{XN, (const bf16*)(ws + WS_WQKV0), MROWS, NQKV, DM}; pg8::StaticOrder S; S.init(MROWS, NQKV, G, bx);
        pg8::EpiScale E{QKV, NQKV, PART, 1.f / DM, RMS_EPS, DM, QSCALE, (LAS float*)(ldsl + RS_OFF)};
        pg8::gemm_phase<pg8::EpiScale, pg8::StaticOrder, PG8_ALIGN, PG8_SP2>(ldsl + RING_OFF, g, S, E);
    }
    SEAM(1);
    if (IN(2)) _Pragma("unroll") for (int rep = 0; rep < NREP(2); ++rep) { if (rep) xcd_barrier(bar);
        constexpr int NBLK = BATCH * SB_H * (SEQ / 256);
        for (int L = bx; L < NBLK; L += G) { const int qb = L % 16, bh = L / 16, b = bh / SB_H, h = bh % SB_H;
            const bf16* kvbase = QKV + (size_t)(b * SEQ) * NQKV + h * HD;
            att::sb_block<NQKV, NQKV, NQKV, DM>(kvbase + (size_t)(qb * 256) * NQKV, kvbase + DM, kvbase + 2 * DM, AO + (size_t)(b * SEQ + qb * 256) * DM + h * HD, qb * 256, (char*)lds + RING_OFF, (volatile LAS unsigned*)(ldsl + RING_OFF + 65536)); }
        if (JIT_CONV) CONVERT_MAT(1);
    }
    SEAM(2);
    if (IN(3)) _Pragma("unroll") for (int rep = 0; rep < NREP(3); ++rep) { if (rep) xcd_barrier(bar);
        pg8::Gemm g{AO, (const bf16*)(ws + WS_WO0), MROWS, DM, DM}; pg8::StaticOrder S; S.init(MROWS, DM, G, bx);
        pg8::EpiResid<false, false> E{nullptr, nullptr, XN, PART, DM};
        pg8::gemm_phase<pg8::EpiResid<false, false>, pg8::StaticOrder, PG8_ALIGN, PG8_SP2>(ldsl + RING_OFF, g, S, E);
        if (JIT_CONV) CONVERT_MAT(2);
    }
    SEAM(3);
#define UP_PHASE(WOFF, LAYER) do { pg8::Gemm g{XN, (const bf16*)(ws + (WOFF)), MROWS, FF2, DM}; pg8::StaticOrder S; S.init(MROWS, FF2, G, bx); \
        pg8::EpiConvGate E{ACT, FF, PART, 1.f / DM, RMS_EPS, args.in[15] + (size_t)(LAYER) * 3 * FF2, args.in[16] + (size_t)(LAYER) * FF2, HALO, (LAS float*)(ldsl + RS_OFF)}; \
        pg8::gemm_phase<pg8::EpiConvGate, pg8::StaticOrder, PG8_ALIGN, PG8_SP2>(ldsl + RING_OFF, g, S, E); } while (0)
#define CG_PHASE(LAYER) do { const float* cw = args.in[15] + (size_t)(LAYER) * 3 * FF2; const float* cb = args.in[16] + (size_t)(LAYER) * FF2; \
        for (int it = bx * (NWAVES * 64) + tid; it < FX_ITEMS; it += G * NWAVES * 64) fixup_item(HALO, cw, cb, ACT, it); } while (0)
#ifndef DOWN_WGM
#define DOWN_WGM 8
#endif
#define DOWN_PHASE(WOFF, OUT, LAST) do { pg8::Gemm g{ACT, (const bf16*)(ws + (WOFF)), MROWS, DM, FF}; pg8::StaticOrder S; S.init(MROWS, DM, G, bx, DOWN_WGM); \
        pg8::EpiResid<false, LAST> E{nullptr, OUT, XN, PART, DM}; \
        pg8::gemm_phase<pg8::EpiResid<false, LAST>, pg8::StaticOrder, PG8_ALIGN, PG8_SP2>(ldsl + RING_OFF, g, S, E); } while (0)
    const int up_units = (MROWS / 256) * (FF2 / 256), up_full = up_units % G;
    if (IN(4)) _Pragma("unroll") for (int rep = 0; rep < NREP(4); ++rep) { if (rep) xcd_barrier(bar); UP_PHASE(WS_WUP0, 0); if (JIT_CONV && TAILFILL && up_full && bx >= up_full) CONVERT_MAT_RANGE(3, 0, DN_SPLIT, up_full); }
    SEAM(4);
    if (IN(5)) _Pragma("unroll") for (int rep = 0; rep < NREP(5); ++rep) { if (rep) xcd_barrier(bar); CG_PHASE(0); if (JIT_CONV) { if (TAILFILL && up_full) CONVERT_MAT_RANGE(3, DN_SPLIT, DN_ITEMS, 0); else CONVERT_MAT(3); } }
    SEAM(5);
    if (IN(6)) { DOWN_PHASE(WS_WDN0, nullptr, false); for (int rep = 1; rep < NREP(6); ++rep) { xcd_barrier(bar); DOWN_PHASE(WS_WDN0, DUMMY, true); } if (JIT_CONV) CONVERT_MAT(4); }
    SEAM(6);
#ifdef PROBE_LATE_QKV
    { pg8::Gemm g{XN, (const bf16*)(ws + WS_WQKV0), MROWS, NQKV, DM}; pg8::StaticOrder S; S.init(MROWS, NQKV, G, bx);
      pg8::EpiScale E{QKV, NQKV, PART, 1.f / DM, RMS_EPS, DM, QSCALE, (LAS float*)(ldsl + RS_OFF)};
      pg8::gemm_phase<pg8::EpiScale, pg8::StaticOrder, PG8_ALIGN, PG8_SP2>(ldsl + RING_OFF, g, S, E); xcd_barrier(bar); }
#if PROBE_LATE_QKV == 2
    { pg8::Gemm g{XN, (const bf16*)(ws + WS_WQKV0), MROWS, NQKV, DM}; pg8::StaticOrder S; S.init(MROWS, NQKV, G, bx);
      pg8::EpiScale E{QKV, NQKV, PART, 1.f / DM, RMS_EPS, DM, QSCALE, (LAS float*)(ldsl + RS_OFF)};
      pg8::gemm_phase<pg8::EpiScale, pg8::StaticOrder, PG8_ALIGN, PG8_SP2>(ldsl + RING_OFF, g, S, E); xcd_barrier(bar); }
#endif
#endif
    if (IN(7)) _Pragma("unroll") for (int rep = 0; rep < NREP(7); ++rep) { if (rep) xcd_barrier(bar);
        pg8::Gemm g{XN, (const bf16*)(ws + WS_WQKV1), MROWS, NQKV, DM}; pg8::StaticOrder S; S.init(MROWS, NQKV, G, bx);
        pg8::EpiScale E{QKV, NQKV, PART, 1.f / DM, RMS_EPS, 0, 1.f, (LAS float*)(ldsl + RS_OFF)};
        pg8::gemm_phase<pg8::EpiScale, pg8::StaticOrder, PG8_ALIGN, PG8_SP2>(ldsl + RING_OFF, g, S, E);
    }
    SEAM(7);
    if (IN(8)) _Pragma("unroll") for (int rep = 0; rep < NREP(8); ++rep) { if (rep) xcd_barrier(bar);
#ifdef QKN_FAST
        qknorm_rows(QKV, QKN, args.in[6], args.in[7], gw, NGW, lane); }
#else
        for (int m = gw; m < MROWS; m += NGW) qknorm_row(QKV + (size_t)m * NQKV, QKN + (size_t)m * 8192, args.in[6], args.in[7], m % SEQ, lane); }
#endif
    SEAM(8);
    if (IN(9)) _Pragma("unroll") for (int rep = 0; rep < NREP(9); ++rep) { if (rep) xcd_barrier(bar);
        float lam, omli;
        { const float a1 = wave_sum(args.in[8][lane] * args.in[9][lane] + args.in[8][lane + 64] * args.in[9][lane + 64]);
          const float a2 = wave_sum(args.in[10][lane] * args.in[11][lane] + args.in[10][lane + 64] * args.in[11][lane + 64]);
          const float li = 0.8f - 0.6f * 0.7408182206817179f;
          lam = __expf(a1) - __expf(a2) + li; omli = 1.f - li; }
        float mq = fmaxf(fabsf(args.in[6][lane]), fabsf(args.in[6][lane + 64])), mk = fmaxf(fabsf(args.in[7][lane]), fabsf(args.in[7][lane + 64]));
#pragma unroll
        for (int o_ = 1; o_ < 64; o_ <<= 1) { mq = fmaxf(mq, __shfl_xor(mq, o_)); mk = fmaxf(mk, __shfl_xor(mk, o_)); }
        att::Diff2Const C{lam, omli, RMS_EPS, QSCALE * 128.f * mq * mk * 1.02f, args.in[12]};
        constexpr int NITEM = BATCH * DF_H * 16;
        for (int w = bx; w < NITEM; w += G) {
            const int bh = (w & 7) * 4 + ((w >> 3) >> 4), xq = (w >> 3) & 15, b = bh / DF_H, h = bh % DF_H;
            const bf16* qn = QKN + (size_t)(b * SEQ) * 8192 + h * 256; const bf16* vb = QKV + (size_t)(b * SEQ) * NQKV + 2 * DM + h * 256;
#pragma unroll 1
            for (int ps = 0; ps < 2; ++ps) { const int qb = ps ? 31 - xq : xq;
                att::diff2_block<8192, 8192, NQKV, DM>(qn + (size_t)(qb * 128) * 8192, qn + 4096, vb, AO + (size_t)(b * SEQ + qb * 128) * DM + h * 256, qb * 128, C, (char*)lds + RING_OFF); }
        }
        if (JIT_CONV) CONVERT_MAT(5);
    }
    SEAM(9);
    if (IN(10)) {
        pg8::Gemm g{AO, (const bf16*)(ws + WS_WO1), MROWS, DM, DM}; pg8::StaticOrder S; S.init(MROWS, DM, G, bx);
        pg8::EpiResid<false, false> E{nullptr, nullptr, XN, PART, DM};
        pg8::gemm_phase<pg8::EpiResid<false, false>, pg8::StaticOrder, PG8_ALIGN, PG8_SP2>(ldsl + RING_OFF, g, S, E);
        if (JIT_CONV) CONVERT_MAT(6);
    }
    SEAM(10);
    if (IN(11)) { UP_PHASE(WS_WUP1, 1); if (JIT_CONV && TAILFILL && up_full && bx >= up_full) CONVERT_MAT_RANGE(7, 0, DN_SPLIT, up_full); }
    SEAM(11);
    if (IN(12)) { CG_PHASE(1); if (JIT_CONV) { if (TAILFILL && up_full) CONVERT_MAT_RANGE(7, DN_SPLIT, DN_ITEMS, 0); else CONVERT_MAT(7); } }
    SEAM(12);
    if (IN(13)) DOWN_PHASE(WS_WDN1, args.out, true);
#ifdef PROBE_XCC
    { xcd_barrier(bar);
      if (bx == 0 && tid == 0) { unsigned bad = 0; for (int i = 0; i < G; ++i) { const unsigned xi = __hip_atomic_load(ctl + 2048 + i, RLX_AGENT), xr = __hip_atomic_load(ctl + 2048 + (i & 7), RLX_AGENT); if (xi != xr || xi == 0u) ++bad; }
          for (int r = 0; r < 8; ++r) for (int q = r + 1; q < 8; ++q) if (__hip_atomic_load(ctl + 2048 + r, RLX_AGENT) == __hip_atomic_load(ctl + 2048 + q, RLX_AGENT)) bad += 1000;
          if (bad) args.out[0] = 1000.f * (float)bad; } }
#endif
    if (LEAK_A >= 0) { xcd_barrier(bar); STAMP(14); if (bx == 0 && tid == 0) args.out[0] = 1000.f * ((float)(long long)(tB - tA) * 0.01f - (float)(LEAK_OFF)); }
#undef IN
#undef SEAM
}
#if MK_CHECK
#include "check.inc"
#endif
extern "C" void kernel_launch(void* const* d_in, const int* in_sizes, int n_in, void* d_out, int out_size, void* d_ws, size_t ws_size, hipStream_t stream) {
    static int grid = 0;
    if (grid == 0) {
        if (n_in != 18 || in_sizes[0] != MROWS * DM || out_size != MROWS * DM || ws_size < WS_END) {
            fprintf(stderr, "kernel_launch: built for 18 inputs, x/out of %d floats, >= %zu bytes of workspace; got n_in %d, in0 %d, out %d, ws %zu; nothing launched\n", MROWS * DM, (size_t)WS_END, n_in, n_in > 0 ? in_sizes[0] : -1, out_size, ws_size); grid = -1; return; }
        int dev = 0, cus = 0, per_cu = 0;
        if (hipGetDevice(&dev) != hipSuccess || hipDeviceGetAttribute(&cus, hipDeviceAttributeMultiprocessorCount, dev) != hipSuccess) { fprintf(stderr, "kernel_launch: device query failed\n"); grid = -1; return; }
        if (hipFuncSetAttribute((const void*)mk_fwd, hipFuncAttributeMaxDynamicSharedMemorySize, LDS_BYTES) != hipSuccess) { fprintf(stderr, "kernel_launch: hipFuncSetAttribute failed\n"); grid = -1; return; }
        if (hipOccupancyMaxActiveBlocksPerMultiprocessor(&per_cu, (const void*)mk_fwd, NWAVES * 64, LDS_BYTES) != hipSuccess || per_cu < 1)
            fprintf(stderr, "kernel_launch: note: occupancy query reports %d workgroups per CU\n", per_cu);
        (void)hipGetLastError();
        grid = cus;
    }
    if (grid < 0) return;
    if (hipMemsetAsync((char*)d_ws + WS_CTL, 0, CTL_ZERO_BYTES, stream) != hipSuccess) { fprintf(stderr, "kernel_launch: memset failed\n"); return; }
    Args a{};
    for (int i = 0; i < 18; ++i) a.in[i] = (const float*)d_in[i];
    a.out = (float*)d_out; a.ws = (unsigned char*)d_ws;
#if MK_CHECK
    for (int p = 0; p < NPH; ++p) { a.ph_lo = p; a.ph_hi = p + 1;
        hipLaunchKernelGGL(mk_fwd, dim3(grid), dim3(NWAVES * 64), LDS_BYTES, stream, a);
        hipLaunchKernelGGL(mk_check, dim3(256), dim3(256), 0, stream, a, p); }
    hipLaunchKernelGGL(mk_report, dim3(1), dim3(64), 0, stream, a);
#elif MK_SPLIT
    for (int p = 0; p < NPH; ++p) { a.ph_lo = p; a.ph_hi = p + 1; hipLaunchKernelGGL(mk_fwd, dim3(grid), dim3(NWAVES * 64), LDS_BYTES, stream, a); }
#else
    a.ph_lo = 0; a.ph_hi = NPH;
    hipLaunchKernelGGL(mk_fwd, dim3(grid), dim3(NWAVES * 64), LDS_BYTES, stream, a);
#ifdef PROBE_TWICE
    (void)hipMemsetAsync((char*)d_ws + WS_CTL, 0, CTL_ZERO_BYTES, stream);
    hipLaunchKernelGGL(mk_fwd, dim3(grid), dim3(NWAVES * 64), LDS_BYTES, stream, a);
#endif
#endif
    const hipError_t le = hipPeekAtLastError();
    if (le != hipSuccess) fprintf(stderr, "kernel_launch: launch failed: %s\n", hipGetErrorName(le));
}
```

```cpp
#define PRIO_BEFORE_BAR 1
#define RS_LDS 1
#define RESID_PERM 1
#define QKN_FAST 1
#define RS_REUSE 1
#include <hip/hip_runtime.h>
#include <cstdio>
#include <cstdint>
namespace pg8 {
__device__ __forceinline__ int tid_opaque() { int t = (int)threadIdx.x; asm volatile("" : "+v"(t)); return t; }
#define PG8_LAS __attribute__((address_space(3)))
typedef unsigned short bf16_t;
typedef short bf16x8 __attribute__((ext_vector_type(8)));
typedef float f32x4 __attribute__((ext_vector_type(4)));
typedef unsigned u32x4 __attribute__((ext_vector_type(4)));
constexpr int BM = 256, BK = 64, HALF = 128, HTB = HALF * BK * 2  , STAGE_BYTES = 8 * HTB, NXCD = 8, WGM = 8;

__host__ __device__ __forceinline__ int lds_byte(int r, int c) { const int st = (r >> 4) * 2 + (c >> 5), rr = r & 15, cc = c & 31, ob = rr * 64 + cc * 2; return st * 1024 + (ob ^ (((ob >> 9) & 1) << 5)); }
__host__ __device__ __forceinline__ void stage_rc(int b, int& R, int& C) { const int st = b / 1024, sb = b % 1024, swz = sb ^ (((sb >> 9) & 1) << 5); R = (st >> 1) * 16 + swz / 64; C = (st & 1) * 32 + (swz % 64) / 2; }
__host__ __device__ __forceinline__ int perm32(int rho) { const int n = rho >> 4, i = rho & 15; return 8 * (i >> 2) + 4 * n + (i & 3); }

struct Unit { int pm, pn; };
struct Gemm { const bf16_t* A; const bf16_t* Bt; int M, N, K; };

struct StaticOrder {
    int nM, nN, nwg, G, c, wgm;
    __host__ __device__ void init(int M, int N, int G_, int c_, int wgm_ = WGM) { nM = M / BM; nN = N / BM; nwg = nM * nN; G = G_; c = c_; wgm = wgm_; }
    __host__ __device__ bool next(int i, Unit& u) const {
        const long L = (long)i * G + c; if (L >= nwg) return false;
        int wgid = (int)L; { const int q = nwg / NXCD, r = nwg % NXCD, xcd = wgid % NXCD, off = wgid / NXCD; wgid = (xcd < r ? xcd * (q + 1) : r * (q + 1) + (xcd - r) * q) + off; }
        const int nig = wgm * nN, gid = wgid / nig, fm = gid * wgm, gsz = (nM - fm) < wgm ? (nM - fm) : wgm;
        u.pm = fm + ((wgid % nig) % gsz); u.pn = (wgid % nig) / gsz; return true;
    }
    __device__ __forceinline__ void a_ready(const Unit&) const {}
    __device__ __forceinline__ void done(const Unit&) const {}
};
struct RangeOrder : StaticOrder {
    int i0, i1;
    __host__ __device__ bool next(int i, Unit& u) const { return (i0 + i < i1) && StaticOrder::next(i0 + i, u); }
};


__device__ __forceinline__ unsigned cvt_pk_bf16(float lo, float hi) { unsigned r; asm volatile("v_cvt_pk_bf16_f32 %0, %1, %2" : "=v"(r) : "v"(lo), "v"(hi)); return r; }

constexpr int NPART = 64;

struct NoStage { __device__ __forceinline__ void operator()() const {} };
template <class Stage = NoStage>
__device__ __forceinline__ void row_scales_lds(float (&rs)[2][4], PG8_LAS float* rl, const float* part, int urow0  , float inv_k, float eps, int wr, int wc, int fr, int fq, const Stage& stage = Stage()) {
    stage();
#ifdef RS_REUSE
    const int tag = __builtin_amdgcn_readfirstlane(((const PG8_LAS int*)rl)[256]);
    if (tag != urow0) {
#endif
#pragma unroll
    for (int ai = 0; ai < 2; ++ai) { const int lr = ai * HALF + wr * 64 + wc * 16 + fr;
        const f32x4* pp = (const f32x4*)(part + (size_t)(urow0 + lr) * NPART + fq * 16);
        const f32x4 a = pp[0], b = pp[1], c = pp[2], d = pp[3];
        float s = ((a[0] + a[1]) + (a[2] + a[3])) + ((b[0] + b[1]) + (b[2] + b[3])) + (((c[0] + c[1]) + (c[2] + c[3])) + ((d[0] + d[1]) + (d[2] + d[3])));
        s += __shfl_xor(s, 16); s += __shfl_xor(s, 32);
        if (fq == 0) rl[lr] = rsqrtf(s * inv_k + eps); }
    asm volatile("s_waitcnt lgkmcnt(0)" ::: "memory");
    __builtin_amdgcn_s_barrier();
#ifdef RS_REUSE
        if (wr == 0 && wc == 0 && fr == 0 && fq == 0) ((PG8_LAS int*)rl)[256] = urow0;
    }
#endif
#pragma unroll
    for (int ai = 0; ai < 2; ++ai)
#pragma unroll
        for (int m = 0; m < 4; ++m) rs[ai][m] = rl[ai * HALF + wr * 64 + m * 16 + fr];
}

struct EpiScale {
    static constexpr int TWICE_OK = 1, NSTORE = 16;
    static constexpr bool PERM = true, AFTER_DRAIN = false;
    bf16_t* O; int ldc; const float* part; float inv_k; float eps; int qcols; float qs; PG8_LAS float* rl;
    __device__ __forceinline__ void operator()(const f32x4 (&acc)[2][2][4][2], const Unit& u, int wr, int wc, int fr, int fq) const {
        const int row0 = u.pm * BM + wr * 64 + fr; const int col0 = u.pn * BM + wc * 32 + 8 * fq;
        const float sc = (u.pn * BM < qcols) ? qs : 1.f;
#ifdef RS_LDS
        float rsl[2][4]; row_scales_lds(rsl, rl, part, u.pm * BM, inv_k, eps, wr, wc, fr, fq);
#endif
#pragma unroll
        for (int ai = 0; ai < 2; ++ai)
#pragma unroll
            for (int m = 0; m < 4; ++m) {
                const int row = row0 + ai * HALF + m * 16;
#ifdef RS_LDS
                const float r = rsl[ai][m] * sc;
#else
                const f32x4* pp = (const f32x4*)(part + (size_t)row * NPART + fq * 16);
                const f32x4 a = pp[0], b = pp[1], c = pp[2], d = pp[3];
                float s = ((a[0] + a[1]) + (a[2] + a[3])) + ((b[0] + b[1]) + (b[2] + b[3])) + (((c[0] + c[1]) + (c[2] + c[3])) + ((d[0] + d[1]) + (d[2] + d[3])));
                s += __shfl_xor(s, 16); s += __shfl_xor(s, 32);
                const float r = rsqrtf(s * inv_k + eps) * sc;
#endif
                bf16_t* rowp = O + (size_t)row * ldc + col0;
#pragma unroll
                for (int bj = 0; bj < 2; ++bj) { const f32x4 v0 = acc[ai][bj][m][0] * r, v1 = acc[ai][bj][m][1] * r;
                    u32x4 w; w.x = cvt_pk_bf16(v0[0], v0[1]); w.y = cvt_pk_bf16(v0[2], v0[3]); w.z = cvt_pk_bf16(v1[0], v1[1]); w.w = cvt_pk_bf16(v1[2], v1[3]);
                    *(u32x4*)(rowp + bj * HALF) = w; }
            }
    }
};

#ifndef RESID_HOIST
#define RESID_HOIST 0
#endif
#ifndef RESID_PERM
#define RESID_PERM 0
#endif
template <bool BASE_F32, bool OUT_F32> struct EpiResid {
    static constexpr int TWICE_OK = 0, NSTORE = 16;
    static constexpr bool PERM = RESID_PERM != 0, AFTER_DRAIN = false;
    const float* basef; float* outf; bf16_t* xn; float* part; int ldc;
    __device__ __forceinline__ void operator()(const f32x4 (&acc)[2][2][4][2], const Unit& u, int wr, int wc, int fr, int fq) const {
        typedef unsigned u32x2v __attribute__((ext_vector_type(2)));
        const int row0 = u.pm * BM + wr * 64 + fr; const int col0 = u.pn * BM + wc * 32 + (PERM ? 8 : 4) * fq;
        u32x4 bpre[2][4][2];
        if constexpr (PERM && RESID_HOIST && !BASE_F32) {
#pragma unroll
            for (int ai = 0; ai < 2; ++ai)
#pragma unroll
                for (int m = 0; m < 4; ++m)
#pragma unroll
                    for (int bj = 0; bj < 2; ++bj) bpre[ai][m][bj] = *(const u32x4*)(xn + (size_t)(row0 + ai * HALF + m * 16) * ldc + col0 + bj * HALF);
        }
#pragma unroll
        for (int ai = 0; ai < 2; ++ai)
#pragma unroll
            for (int m = 0; m < 4; ++m) {
                const int row = row0 + ai * HALF + m * 16; const size_t off = (size_t)row * ldc + col0; float ss = 0.f;
                if constexpr (PERM) {
#pragma unroll
                    for (int bj = 0; bj < 2; ++bj) { const size_t o2 = off + bj * HALF;
                        f32x4 b0, b1;
                        if (BASE_F32) { b0 = *(const f32x4*)(basef + o2); b1 = *(const f32x4*)(basef + o2 + 4); }
                        else { const u32x4 b = RESID_HOIST ? bpre[ai][m][bj] : *(const u32x4*)(xn + o2);
                            b0[0] = __builtin_bit_cast(float, b.x << 16); b0[1] = __builtin_bit_cast(float, b.x & 0xffff0000u); b0[2] = __builtin_bit_cast(float, b.y << 16); b0[3] = __builtin_bit_cast(float, b.y & 0xffff0000u);
                            b1[0] = __builtin_bit_cast(float, b.z << 16); b1[1] = __builtin_bit_cast(float, b.z & 0xffff0000u); b1[2] = __builtin_bit_cast(float, b.w << 16); b1[3] = __builtin_bit_cast(float, b.w & 0xffff0000u); }
                        const f32x4 o0 = b0 + acc[ai][bj][m][0], o1 = b1 + acc[ai][bj][m][1];
                        if (OUT_F32) { *(f32x4*)(outf + o2) = o0; *(f32x4*)(outf + o2 + 4) = o1; }
                        else { u32x4 w; w.x = cvt_pk_bf16(o0[0], o0[1]); w.y = cvt_pk_bf16(o0[2], o0[3]); w.z = cvt_pk_bf16(o1[0], o1[1]); w.w = cvt_pk_bf16(o1[2], o1[3]); *(u32x4*)(xn + o2) = w;
                            ss += ((o0[0] * o0[0] + o0[1] * o0[1]) + (o0[2] * o0[2] + o0[3] * o0[3])) + ((o1[0] * o1[0] + o1[1] * o1[1]) + (o1[2] * o1[2] + o1[3] * o1[3])); } }
                } else {
#pragma unroll
                for (int bj = 0; bj < 2; ++bj)
#pragma unroll
                    for (int n = 0; n < 2; ++n) { const size_t o2 = off + bj * HALF + n * 16;
                        f32x4 bs;
                        if (BASE_F32) bs = *(const f32x4*)(basef + o2);
                        else { const u32x2v b = *(const u32x2v*)(xn + o2); bs[0] = __builtin_bit_cast(float, b.x << 16); bs[1] = __builtin_bit_cast(float, b.x & 0xffff0000u); bs[2] = __builtin_bit_cast(float, b.y << 16); bs[3] = __builtin_bit_cast(float, b.y & 0xffff0000u); }
                        const f32x4 o = bs + acc[ai][bj][m][n];
                        if (OUT_F32) *(f32x4*)(outf + o2) = o;
                        else { u32x2v w; w.x = cvt_pk_bf16(o[0], o[1]); w.y = cvt_pk_bf16(o[2], o[3]); *(u32x2v*)(xn + o2) = w;
                            ss += (o[0] * o[0] + o[1] * o[1]) + (o[2] * o[2] + o[3] * o[3]); } }
                }
                if (!OUT_F32) { ss += __shfl_xor(ss, 16); ss += __shfl_xor(ss, 32); if (fq == 0) part[(size_t)row * NPART + u.pn * 4 + wc] = ss; }
            }
    }
};

struct EpiResidRT {
    static constexpr int TWICE_OK = 0, NSTORE = 16;
    static constexpr bool PERM = false, AFTER_DRAIN = false;
    float* outf; bf16_t* xn; float* part; int ldc;
    __device__ __forceinline__ void operator()(const f32x4 (&acc)[2][2][4][2], const Unit& u, int wr, int wc, int fr, int fq) const {
        typedef unsigned u32x2v __attribute__((ext_vector_type(2)));
        const int row0 = u.pm * BM + wr * 64 + fr; const int col0 = u.pn * BM + wc * 32 + 4 * fq; const bool last = outf != nullptr;
#pragma unroll
        for (int ai = 0; ai < 2; ++ai)
#pragma unroll
            for (int m = 0; m < 4; ++m) {
                const int row = row0 + ai * HALF + m * 16; const size_t off = (size_t)row * ldc + col0; float ss = 0.f;
#pragma unroll
                for (int bj = 0; bj < 2; ++bj)
#pragma unroll
                    for (int n = 0; n < 2; ++n) { const size_t o2 = off + bj * HALF + n * 16;
                        const u32x2v b = *(const u32x2v*)(xn + o2); f32x4 bs; bs[0] = __builtin_bit_cast(float, b.x << 16); bs[1] = __builtin_bit_cast(float, b.x & 0xffff0000u); bs[2] = __builtin_bit_cast(float, b.y << 16); bs[3] = __builtin_bit_cast(float, b.y & 0xffff0000u);
                        const f32x4 o = bs + acc[ai][bj][m][n];
                        if (last) *(f32x4*)(outf + o2) = o;
                        else { u32x2v w; w.x = cvt_pk_bf16(o[0], o[1]); w.y = cvt_pk_bf16(o[2], o[3]); *(u32x2v*)(xn + o2) = w; }
                        ss += (o[0] * o[0] + o[1] * o[1]) + (o[2] * o[2] + o[3] * o[3]); }
                if (!last) { ss += __shfl_xor(ss, 16); ss += __shfl_xor(ss, 32); if (fq == 0) part[(size_t)row * NPART + u.pn * 4 + wc] = ss; }
            }
    }
};

__device__ __forceinline__ float dpp_ror1(float v) { return __builtin_bit_cast(float, __builtin_amdgcn_update_dpp(0, __builtin_bit_cast(int, v), 0x121, 0xf, 0xf, false)); }
__device__ __forceinline__ float dpp_ror2(float v) { return __builtin_bit_cast(float, __builtin_amdgcn_update_dpp(0, __builtin_bit_cast(int, v), 0x122, 0xf, 0xf, false)); }
__device__ __forceinline__ float dpp_shr1(float old, float v) { return __builtin_bit_cast(float, __builtin_amdgcn_update_dpp(__builtin_bit_cast(int, old), __builtin_bit_cast(int, v), 0x111, 0xf, 0xf, false)); }
__device__ __forceinline__ float dpp_shr2(float old, float v) { return __builtin_bit_cast(float, __builtin_amdgcn_update_dpp(__builtin_bit_cast(int, old), __builtin_bit_cast(int, v), 0x112, 0xf, 0xf, false)); }
__device__ __forceinline__ void conv_taps(float& acc, float cur, float prev, float w1, float w0) {
    asm("s_nop 1\n\t"
        "v_fmac_f32_dpp %0, %1, %3 row_shr:1 row_mask:0xf bank_mask:0xf\n\t"
        "v_fmac_f32_dpp %0, %1, %4 row_shr:2 row_mask:0xf bank_mask:0xf\n\t"
        "v_fmac_f32_dpp %0, %2, %3 row_shl:15 row_mask:0xf bank_mask:0xf\n\t"
        "v_fmac_f32_dpp %0, %2, %4 row_shl:14 row_mask:0xf bank_mask:0xf"
        : "+v"(acc) : "v"(cur), "v"(prev), "v"(w1), "v"(w0));
}
template <int CTRL> __device__ __forceinline__ float dppz(float v) { return __builtin_bit_cast(float, __builtin_amdgcn_update_dpp(0, __builtin_bit_cast(int, v), CTRL, 0xf, 0xf, true)); }
struct EpiConvGate {
    static constexpr int TWICE_OK = 2, NSTORE = 8;
    static constexpr bool PERM = true, AFTER_DRAIN = false;
    bf16_t* ACT; int ff; const float* part; float inv_k; float eps; const float* cw; const float* cb; float* halo; PG8_LAS float* rl;
    __device__ __forceinline__ void operator()(const f32x4 (&acc)[2][2][4][2], const Unit& u, int wr, int wc, int fr, int fq) const {
        typedef unsigned u32x2v __attribute__((ext_vector_type(2)));
        const int ff2 = 2 * ff;
        const int row0 = u.pm * BM + wr * 64 + fr; const int ch0 = u.pn * HALF + wc * 32 + 8 * fq;
        float rs[2][4];
#if defined(RS_LDS) && defined(CONVW_LDS)
        PG8_LAS float* wl = rl + 256;
        { const float* cwp = cw; const float* cbp = cb; const int chb = u.pn * HALF, ffv = ff;
          row_scales_lds(rs, rl, part, u.pm * BM, inv_k, eps, wr, wc, fr, fq, [=]() { const int t = wr * 256 + wc * 64 + fq * 16 + fr;
              if (t < 256) { const int arr = t >> 5, q = t & 31; const int half = arr >> 2, k = arr & 3;
                  const float* src = (k < 3 ? cwp + (size_t)k * 2 * ffv : cbp) + half * ffv + chb + 4 * q;
                  *(PG8_LAS f32x4*)(wl + arr * 128 + 4 * q) = *(const f32x4*)src; } }); }
#elif defined(RS_LDS)
        row_scales_lds(rs, rl, part, u.pm * BM, inv_k, eps, wr, wc, fr, fq);
#else
#pragma unroll
        for (int ai = 0; ai < 2; ++ai)
#pragma unroll
            for (int m = 0; m < 4; ++m) { const int row = row0 + ai * HALF + m * 16;
                const f32x4* pp = (const f32x4*)(part + (size_t)row * NPART + fq * 16);
                const f32x4 a = pp[0], b = pp[1], c = pp[2], d = pp[3];
                float s = ((a[0] + a[1]) + (a[2] + a[3])) + ((b[0] + b[1]) + (b[2] + b[3])) + (((c[0] + c[1]) + (c[2] + c[3])) + ((d[0] + d[1]) + (d[2] + d[3])));
                s += __shfl_xor(s, 16); s += __shfl_xor(s, 32);
                rs[ai][m] = rsqrtf(s * inv_k + eps); }
#endif
        u32x2v lo[2][4];
#pragma unroll
        for (int n = 0; n < 2; ++n) {
            const int ch = ch0 + 4 * n;
#if defined(RS_LDS) && defined(CONVW_LDS)
            const int cl = wc * 32 + 8 * fq + 4 * n;
            const f32x4 wg0 = *(const PG8_LAS f32x4*)(wl + cl), wg1 = *(const PG8_LAS f32x4*)(wl + 128 + cl), wg2 = *(const PG8_LAS f32x4*)(wl + 256 + cl), bg = *(const PG8_LAS f32x4*)(wl + 384 + cl);
            const f32x4 wv0 = *(const PG8_LAS f32x4*)(wl + 512 + cl), wv1 = *(const PG8_LAS f32x4*)(wl + 640 + cl), wv2 = *(const PG8_LAS f32x4*)(wl + 768 + cl), bv = *(const PG8_LAS f32x4*)(wl + 896 + cl);
#else
            const f32x4 wg0 = *(const f32x4*)(cw + ch), wg1 = *(const f32x4*)(cw + ff2 + ch), wg2 = *(const f32x4*)(cw + 2 * ff2 + ch), bg = *(const f32x4*)(cb + ch);
            const f32x4 wv0 = *(const f32x4*)(cw + ff + ch), wv1 = *(const f32x4*)(cw + ff2 + ff + ch), wv2 = *(const f32x4*)(cw + 2 * ff2 + ff + ch), bv = *(const f32x4*)(cb + ff + ch);
#endif
#pragma unroll
            for (int ai = 0; ai < 2; ++ai) {
                f32x4 gq = {0.f, 0.f, 0.f, 0.f}, vq = gq;
                const int grp = (u.pm * BM + ai * HALF + wr * 64) >> 6;
#pragma unroll
                for (int m = 0; m < 4; ++m) {
                    const f32x4 g = acc[ai][0][m][n] * rs[ai][m], v = acc[ai][1][m][n] * rs[ai][m];
                    f32x4 cg, cv;
#pragma unroll
                    for (int e = 0; e < 4; ++e) {
                        float a = __builtin_fmaf(wg2[e], g[e], bg[e]), b = __builtin_fmaf(wv2[e], v[e], bv[e]);
                        conv_taps(a, g[e], gq[e], wg1[e], wg0[e]); conv_taps(b, v[e], vq[e], wv1[e], wv0[e]);
                        cg[e] = a; cv[e] = b; }
                    gq = g; vq = v;
                    f32x4 o;
#pragma unroll
                    for (int e = 0; e < 4; ++e) o[e] = cg[e] * __builtin_amdgcn_rcpf(1.f + __builtin_amdgcn_exp2f(-1.4426950408889634f * cg[e])) * cv[e];
                    u32x2v w; w.x = cvt_pk_bf16(o[0], o[1]); w.y = cvt_pk_bf16(o[2], o[3]);
                    const int row = row0 + ai * HALF + m * 16;
                    if (n == 0) lo[ai][m] = w;
                    else if (!(m == 0 && fr < 2)) { u32x4 w4; w4.x = lo[ai][m].x; w4.y = lo[ai][m].y; w4.z = w.x; w4.w = w.y; *(u32x4*)(ACT + (size_t)row * ff + ch0) = w4; }
                    if ((m == 0 && fr < 2) || (m == 3 && fr >= 14)) { float* hp = halo + ((size_t)grp * 4 + (m == 0 ? fr : fr - 12)) * ff2 + ch; *(f32x4*)hp = g; *(f32x4*)(hp + ff) = v; }
                }
            }
        }
    }
};
template <class Epi, class Sched, bool ALIGN_EPI = false, bool SP2 = false>
__device__ __forceinline__ void gemm_phase(PG8_LAS unsigned char* lds, const Gemm g, const Sched& S, const Epi& E) {
    const int tid = tid_opaque(), wid = __builtin_amdgcn_readfirstlane(tid >> 6), lane = tid & 63, wr = wid >> 2, wc = wid & 3, fr = lane & 15, fq = lane >> 4;
    const int K = g.K, nt = K / BK;
    unsigned voffA[2], voffB[2];
#pragma unroll
    for (int i = 0; i < 2; ++i) { int R, C; stage_rc(tid * 16 + i * 8192, R, C); const int Rb = Epi::PERM ? ((R & ~31) + perm32(R & 31)) : R;
        voffA[i] = (unsigned)(R * K + C) * 2u; voffB[i] = (unsigned)(Rb * K + C) * 2u; }
    const size_t kstep = (size_t)(BK * 2);
    const size_t hstep = (size_t)HALF * K * 2;
    const size_t tstep = 2 * hstep;
    const unsigned ldsw = (unsigned)wid * 1024u;
    const int aoff = lds_byte(wr * 64 + fr, fq * 8), boff = lds_byte(wc * 32 + fr, fq * 8);
#define PG8_SA(b, h) (((b) * 2 + (h)) * HTB)
#define PG8_SB(b, h) ((4 + (b) * 2 + (h)) * HTB)
#define PG8_STAGE(bufoff, gbase, voff) do { _Pragma("unroll") for (int _i = 0; _i < 2; ++_i) \
        __builtin_amdgcn_global_load_lds((const unsigned*)((const char*)(gbase) + (voff)[_i]), (PG8_LAS unsigned*)(lds + (bufoff) + ldsw + _i * 8192), 16, 0, 0); } while (0)
#define PG8_LDA(dst, b, h) do { _Pragma("unroll") for (int m = 0; m < 4; ++m) _Pragma("unroll") for (int k = 0; k < 2; ++k) dst[m][k] = *(const PG8_LAS bf16x8*)(lds + PG8_SA(b, h) + aoff + m * 2048 + k * 1024); } while (0)
#define PG8_LDB(dst, b, h) do { _Pragma("unroll") for (int n = 0; n < 2; ++n) _Pragma("unroll") for (int k = 0; k < 2; ++k) dst[n][k] = *(const PG8_LAS bf16x8*)(lds + PG8_SB(b, h) + boff + n * 2048 + k * 1024); } while (0)
#define PG8_MMA(ai, bj, At, Bt) do { if (!SP2) __builtin_amdgcn_s_setprio(1); _Pragma("unroll") for (int m = 0; m < 4; ++m) _Pragma("unroll") for (int n = 0; n < 2; ++n) _Pragma("unroll") for (int k = 0; k < 2; ++k) \
        acc[ai][bj][m][n] = __builtin_amdgcn_mfma_f32_16x16x32_bf16(Bt[n][k], At[m][k], acc[ai][bj][m][n], 0, 0, 0); if (!SP2) __builtin_amdgcn_s_setprio(0); } while (0)
#ifdef PRIO_BEFORE_BAR
#define PG8_PRIO_UP_PRE __builtin_amdgcn_s_setprio(1)
#define PG8_PRIO_UP_POST do { } while (0)
#else
#define PG8_PRIO_UP_PRE do { } while (0)
#define PG8_PRIO_UP_POST __builtin_amdgcn_s_setprio(1)
#endif
#define PG8_WAIT_V(n) asm volatile("s_waitcnt vmcnt(" #n ")" ::: "memory")
#define PG8_WAIT_L(n) asm volatile("s_waitcnt lgkmcnt(" #n ")" ::: "memory")
#define PG8_BAR __builtin_amdgcn_s_barrier()
#define PG8_SCHED __builtin_amdgcn_sched_barrier(0)
    Unit cur, nxt; int ui = 0;
    if (!S.next(0, cur)) return;
    f32x4 acc[2][2][4][2];
#pragma unroll
    for (int a = 0; a < 2; ++a)
#pragma unroll
        for (int b = 0; b < 2; ++b)
#pragma unroll
            for (int m = 0; m < 4; ++m)
#pragma unroll
                for (int n = 0; n < 2; ++n) acc[a][b][m][n] = (f32x4){0.f, 0.f, 0.f, 0.f};
    bf16x8 At[4][2], B0[2][2], B1[2][2];
    const char* cA = (const char*)g.A + (size_t)cur.pm * tstep; const char* cB = (const char*)g.Bt + (size_t)cur.pn * tstep;
    S.a_ready(cur);
    if constexpr (SP2) {
        PG8_STAGE(PG8_SB(0, 0), cB, voffB); PG8_STAGE(PG8_SB(0, 1), cB + hstep, voffB); PG8_STAGE(PG8_SA(0, 0), cA, voffA); PG8_STAGE(PG8_SA(0, 1), cA + hstep, voffA);
        if (wr == 1) PG8_BAR;
        PG8_WAIT_V(2); PG8_BAR;
        PG8_STAGE(PG8_SB(1, 0), cB + kstep, voffB); PG8_STAGE(PG8_SA(1, 0), cA + kstep, voffA); PG8_STAGE(PG8_SB(1, 1), cB + hstep + kstep, voffB);
        PG8_WAIT_V(6); PG8_BAR;
    } else {
        PG8_STAGE(PG8_SB(0, 0), cB, voffB); PG8_STAGE(PG8_SA(0, 0), cA, voffA); PG8_STAGE(PG8_SB(0, 1), cB + hstep, voffB); PG8_STAGE(PG8_SA(0, 1), cA + hstep, voffA);
        if (wr == 1) PG8_BAR;
        PG8_WAIT_V(4); PG8_BAR;
        PG8_STAGE(PG8_SB(1, 0), cB + kstep, voffB); PG8_STAGE(PG8_SA(1, 0), cA + kstep, voffA); PG8_STAGE(PG8_SB(1, 1), cB + hstep + kstep, voffB);
        PG8_WAIT_V(6); PG8_BAR;
    }
    for (;;) {
        const bool has_next = S.next(ui + 1, nxt);
        const char* nA = has_next ? (const char*)g.A + (size_t)nxt.pm * tstep : cA; const char* nB = has_next ? (const char*)g.Bt + (size_t)nxt.pn * tstep : cB;
        for (int t = 0; t < nt; t += 2) {
            const bool last = (t == nt - 2);
            const char* a1 = cA + (size_t)(t + 1) * kstep;
            const char* a2 = last ? nA : cA + (size_t)(t + 2) * kstep; const char* b2 = last ? nB : cB + (size_t)(t + 2) * kstep;
            const char* a3 = a2 + kstep; const char* b3 = b2 + kstep;
            if (last && has_next) S.a_ready(nxt);
            if constexpr (SP2) {
            PG8_LDB(B0, 0, 0); PG8_LDB(B1, 0, 1); PG8_SCHED; PG8_LDA(At, 0, 0); PG8_STAGE(PG8_SA(1, 1), a1 + hstep, voffA);
            PG8_WAIT_V(8); PG8_WAIT_L(0); PG8_PRIO_UP_PRE; PG8_BAR; PG8_PRIO_UP_POST; PG8_MMA(0, 0, At, B0); PG8_MMA(0, 1, At, B1); __builtin_amdgcn_s_setprio(0); PG8_BAR; PG8_SCHED;
            PG8_LDA(At, 0, 1); PG8_STAGE(PG8_SB(0, 0), b2, voffB); PG8_STAGE(PG8_SB(0, 1), b2 + hstep, voffB); PG8_STAGE(PG8_SA(0, 0), a2, voffA);
            PG8_WAIT_V(8); PG8_WAIT_L(0); PG8_PRIO_UP_PRE; PG8_BAR; PG8_PRIO_UP_POST; PG8_MMA(1, 0, At, B0); PG8_MMA(1, 1, At, B1); __builtin_amdgcn_s_setprio(0); PG8_BAR; PG8_SCHED;
            PG8_LDB(B0, 1, 0); PG8_LDB(B1, 1, 1); PG8_SCHED; PG8_LDA(At, 1, 0); PG8_STAGE(PG8_SA(0, 1), a2 + hstep, voffA);
            PG8_WAIT_V(8); PG8_WAIT_L(0); PG8_PRIO_UP_PRE; PG8_BAR; PG8_PRIO_UP_POST; PG8_MMA(0, 0, At, B0); PG8_MMA(0, 1, At, B1); __builtin_amdgcn_s_setprio(0); PG8_BAR; PG8_SCHED;
            PG8_LDA(At, 1, 1); PG8_STAGE(PG8_SB(1, 0), b3, voffB); PG8_STAGE(PG8_SB(1, 1), b3 + hstep, voffB); PG8_STAGE(PG8_SA(1, 0), a3, voffA);
            PG8_WAIT_V(8); PG8_WAIT_L(0); PG8_PRIO_UP_PRE; PG8_BAR; PG8_PRIO_UP_POST; PG8_MMA(1, 0, At, B0); PG8_MMA(1, 1, At, B1); __builtin_amdgcn_s_setprio(0); PG8_BAR; PG8_SCHED;
            } else {
            PG8_LDB(B0, 0, 0); PG8_SCHED; PG8_LDA(At, 0, 0); PG8_STAGE(PG8_SA(1, 1), a1 + hstep, voffA);
            PG8_WAIT_L(8); PG8_BAR; PG8_WAIT_L(0); PG8_MMA(0, 0, At, B0); PG8_BAR; PG8_SCHED;
            PG8_LDB(B1, 0, 1); PG8_STAGE(PG8_SB(0, 0), b2, voffB);
            PG8_BAR; PG8_WAIT_L(0); PG8_MMA(0, 1, At, B1); PG8_BAR;
            PG8_LDA(At, 0, 1); PG8_STAGE(PG8_SA(0, 0), a2, voffA);
            PG8_BAR; PG8_WAIT_L(0); PG8_MMA(1, 0, At, B0); PG8_BAR; PG8_SCHED;
            PG8_STAGE(PG8_SB(0, 1), b2 + hstep, voffB);
            PG8_WAIT_V(6); PG8_BAR; PG8_MMA(1, 1, At, B1); PG8_BAR;
            PG8_LDB(B0, 1, 0); PG8_SCHED; PG8_LDA(At, 1, 0); PG8_STAGE(PG8_SA(0, 1), a2 + hstep, voffA);
            PG8_WAIT_L(8); PG8_BAR; PG8_WAIT_L(0); PG8_MMA(0, 0, At, B0); PG8_BAR; PG8_SCHED;
            PG8_LDB(B1, 1, 1); PG8_STAGE(PG8_SB(1, 0), b3, voffB);
            PG8_BAR; PG8_WAIT_L(0); PG8_MMA(0, 1, At, B1); PG8_BAR;
            PG8_LDA(At, 1, 1); PG8_STAGE(PG8_SA(1, 0), a3, voffA);
            PG8_BAR; PG8_WAIT_L(0); PG8_MMA(1, 0, At, B0); PG8_BAR; PG8_SCHED;
            PG8_STAGE(PG8_SB(1, 1), b3 + hstep, voffB);
            PG8_WAIT_V(6); PG8_BAR; PG8_MMA(1, 1, At, B1); PG8_BAR;
            }
        }
        if constexpr (ALIGN_EPI) { if (wr == 0) PG8_BAR; }
        if constexpr (!Epi::AFTER_DRAIN) { E(acc, cur, wr, wc, fr, fq); S.done(cur); }
        if (!has_next) break;
#pragma unroll
        for (int a = 0; a < 2; ++a)
#pragma unroll
            for (int b = 0; b < 2; ++b)
#pragma unroll
                for (int m = 0; m < 4; ++m)
#pragma unroll
                    for (int n = 0; n < 2; ++n) acc[a][b][m][n] = (f32x4){0.f, 0.f, 0.f, 0.f};
        cur = nxt; cA = nA; cB = nB; ++ui;
        if constexpr (ALIGN_EPI) { if (wr == 1) PG8_BAR; }
    }
    PG8_WAIT_V(0);
    if constexpr (!ALIGN_EPI) { if (wr == 0) PG8_BAR; }
    PG8_BAR;
    if constexpr (Epi::AFTER_DRAIN) { E.fused(acc, cur, wr, wc, fr, fq, lds, wid, lane); S.done(cur); }
#undef PG8_SA
#undef PG8_SB
#undef PG8_STAGE
#undef PG8_LDA
#undef PG8_LDB
#undef PG8_MMA
#undef PG8_WAIT_V
#undef PG8_WAIT_L
#undef PG8_BAR
#undef PG8_SCHED
}
}
namespace att {
using bf16 = unsigned short;
typedef short bf16x8 __attribute__((ext_vector_type(8)));
typedef short s16x4 __attribute__((ext_vector_type(4)));
typedef float f32x16 __attribute__((ext_vector_type(16)));
typedef float f32x4 __attribute__((ext_vector_type(4)));
typedef unsigned u32x4 __attribute__((ext_vector_type(4)));
constexpr int D = 128, NW = 8, QBLK = 32, KVBLK = 64, QB = NW * QBLK;
constexpr int SHM_V = KVBLK * D * 2, SHM_K = KVBLK * D * 2;
constexpr int LDS_BYTES = 2 * SHM_V + 2 * SHM_K + NW * 64 * 4;
#define KSWZ(row, colB) ((row) * 256 + ((colB) ^ (((row) & 7) << 4)))
#define SBAR() __builtin_amdgcn_sched_barrier(0)
__device__ __forceinline__ int v_st(int k, int c) { const int kk = (k & ~0xC) | ((k & 4) << 1) | ((k & 8) >> 1); return ((kk >> 3) * 4 + (c >> 5)) * 512 + ((kk & 7) * 32 + (c & 31)) * 2; }
__device__ __forceinline__ int v_rd_base(int lane) { return ((lane & 3) << 3) | (((lane >> 2) & 3) << 6) | (((lane >> 4) & 1) << 5) | (((lane >> 5) & 1) << 8); }
constexpr int v_rd_off(int d0, int ks, int half) { return d0 * 512 + ks * 4096 + half * 2048; }
__device__ __forceinline__ int crow(int r, int hi) { return (r & 3) + 8 * (r >> 2) + 4 * hi; }
__device__ __forceinline__ unsigned cvtpk(float lo, float hi) { unsigned r; asm volatile("v_cvt_pk_bf16_f32 %0, %1, %2" : "=v"(r) : "v"(lo), "v"(hi)); return r; }
__device__ __forceinline__ bf16x8 load8(const bf16* p) { return *reinterpret_cast<const bf16x8*>(p); }

#define PK4(P, B_, OUT) do { unsigned a0 = cvtpk(P[B_+0], P[B_+1]), a1 = cvtpk(P[B_+2], P[B_+3]);                          \
        unsigned b0 = cvtpk(P[B_+4], P[B_+5]), b1 = cvtpk(P[B_+6], P[B_+7]);                                             \
        auto r0 = __builtin_amdgcn_permlane32_swap(a0, b0, false, false); auto r1 = __builtin_amdgcn_permlane32_swap(a1, b1, false, false); \
        u32x4 w = {r0[0], r1[0], r0[1], r1[1]}; OUT = *reinterpret_cast<bf16x8*>(&w); } while (0)

__device__ __forceinline__ void qkt_rt(f32x16& p0, f32x16& p1, const char* Kt, int r32, int hi, const bf16x8* qr) {
    p0 = f32x16{}; p1 = f32x16{};
    const char* kb[4];
#pragma unroll
    for (int dd = 0; dd < 4; ++dd) kb[dd] = Kt + KSWZ(r32, (dd * 16 + hi * 8) * 2);
#pragma unroll
    for (int d0 = 0; d0 < 8; ++d0) { const char* a = kb[d0 & 3] + (d0 >> 2) * 128;
        bf16x8 b0 = *reinterpret_cast<const bf16x8*>(a);
        bf16x8 b1 = *reinterpret_cast<const bf16x8*>(a + 32 * 256);
        p0 = __builtin_amdgcn_mfma_f32_32x32x16_bf16(b0, qr[d0], p0, 0, 0, 0);
        p1 = __builtin_amdgcn_mfma_f32_32x32x16_bf16(b1, qr[d0], p1, 0, 0, 0); }
}
__device__ __forceinline__ void pv_rt(f32x16* o, int vb, bf16x8 pa0, bf16x8 pa1, bf16x8 pa2, bf16x8 pa3) {
#define TRRD(dst, off) asm volatile("ds_read_b64_tr_b16 %0, %1 offset:%2" : "=&v"(dst) : "v"(vb), "i"(off) : "memory")
#define PV_D0(d0) do { s16x4 l0, l1, l2, l3, h0, h1, h2, h3; constexpr int b_ = v_rd_off(d0, 0, 0); \
        TRRD(l0, b_); TRRD(h0, b_ + 2048); TRRD(l1, b_ + 4096); TRRD(h1, b_ + 6144); TRRD(l2, b_ + 8192); TRRD(h2, b_ + 10240); TRRD(l3, b_ + 12288); TRRD(h3, b_ + 14336); \
        asm volatile("s_waitcnt lgkmcnt(0)" ::: "memory"); SBAR();   \
        o[d0] = __builtin_amdgcn_mfma_f32_32x32x16_bf16(pa0, (bf16x8){l0[0], l0[1], l0[2], l0[3], h0[0], h0[1], h0[2], h0[3]}, o[d0], 0, 0, 0);   \
        o[d0] = __builtin_amdgcn_mfma_f32_32x32x16_bf16(pa1, (bf16x8){l1[0], l1[1], l1[2], l1[3], h1[0], h1[1], h1[2], h1[3]}, o[d0], 0, 0, 0);   \
        o[d0] = __builtin_amdgcn_mfma_f32_32x32x16_bf16(pa2, (bf16x8){l2[0], l2[1], l2[2], l2[3], h2[0], h2[1], h2[2], h2[3]}, o[d0], 0, 0, 0);   \
        o[d0] = __builtin_amdgcn_mfma_f32_32x32x16_bf16(pa3, (bf16x8){l3[0], l3[1], l3[2], l3[3], h3[0], h3[1], h3[2], h3[3]}, o[d0], 0, 0, 0); } while (0)
    PV_D0(0); PV_D0(1); PV_D0(2); PV_D0(3);
#undef PV_D0
#undef TRRD
}

constexpr float SB_DONE = 1e-30f;
__device__ __forceinline__ void sb_half(f32x16& p, float& carry, int dq, bool needmask, bool lane_hi) {
    float kp[16];
#pragma unroll
    for (int r = 0; r < 16; ++r) {
        const float zz = fminf(p[r], 100.f);
        const float e = __builtin_amdgcn_exp2f(zz);
        float k = __builtin_amdgcn_rcpf(1.f + e);
        float be = e * k;
        if (needmask) { const int c = 8 * (r >> 2) + (r & 3); const bool valid = (dq - c) > 0; k = valid ? k : 1.f; be = valid ? be : 0.f; }
        kp[r] = k; p[r] = be;
    }
    float L[4], H[4];
#pragma unroll
    for (int j = 0; j < 4; ++j) { const float g = (kp[4 * j] * kp[4 * j + 1]) * (kp[4 * j + 2] * kp[4 * j + 3]);
        auto rr = __builtin_amdgcn_permlane32_swap(__float_as_uint(g), __float_as_uint(g), false, false);
        L[j] = __uint_as_float(rr[0]); H[j] = __uint_as_float(rr[1]); }
    float U[4]; U[3] = 1.f; U[2] = L[3] * H[3]; U[1] = U[2] * (L[2] * H[2]); U[0] = U[1] * (L[1] * H[1]);
    const float tot = U[0] * (L[0] * H[0]);
#pragma unroll
    for (int j = 0; j < 4; ++j) {
        const float a3 = carry * U[j] * (lane_hi ? 1.f : H[j]);
        const float a2 = a3 * kp[4 * j + 3], a1 = a2 * kp[4 * j + 2], a0 = a1 * kp[4 * j + 1];
        p[4 * j + 3] *= a3; p[4 * j + 2] *= a2; p[4 * j + 1] *= a1; p[4 * j] *= a0;
    }
    carry *= tot;
}

template <int PQ, int PK, int PV, int PO>
__device__ __forceinline__ void sb_block(const bf16* Q, const bf16* K, const bf16* V, bf16* O, int P0, char* lds, volatile __attribute__((address_space(3))) unsigned* flags) {
    const int tid = pg8::tid_opaque(), wid = __builtin_amdgcn_readfirstlane(tid >> 6), lane = tid & 63, r32 = lane & 31, hi = lane >> 5;
    char* K_lds = lds; char* V_lds = lds + 2 * SHM_K;
    const int sr = tid >> 4, sc = (tid & 15) * 8, vst0 = v_st(sr, sc), vst1 = v_st(32 + sr, sc), kws = KSWZ(sr, sc * 2);
    const int vb0 = (int)(uintptr_t)V_lds + v_rd_base(lane);
    bf16x8 qr[8];
#pragma unroll
    for (int d0 = 0; d0 < 8; ++d0) qr[d0] = load8(Q + (size_t)(wid * QBLK + r32) * PQ + d0 * 16 + hi * 8);
    f32x16 o[4] = {};
    float carry = 1.f;
    const int qlo = P0 + wid * QBLK, qpos = qlo + r32;
    int j = P0 / KVBLK + 3;
    bf16x8 st_k0, st_k1, st_v0, st_v1;
#define SB_LOAD(jt) do { const size_t k0_ = (size_t)(jt) * KVBLK; st_k0 = load8(K + (k0_ + sr) * PK + sc); st_k1 = load8(K + (k0_ + 32 + sr) * PK + sc); \
                         st_v0 = load8(V + (k0_ + sr) * PV + sc); st_v1 = load8(V + (k0_ + 32 + sr) * PV + sc); } while (0)
#define SB_WRITE(bf) do { *(bf16x8*)(K_lds + (bf) * SHM_K + kws) = st_k0; *(bf16x8*)(K_lds + (bf) * SHM_K + kws + 32 * 256) = st_k1; \
                          *(bf16x8*)(V_lds + (bf) * SHM_V + vst0) = st_v0; *(bf16x8*)(V_lds + (bf) * SHM_V + vst1) = st_v1; } while (0)
    SB_LOAD(j); asm volatile("s_waitcnt vmcnt(0)" ::: "memory"); SB_WRITE(0);
    __syncthreads();
    int buf = 0, it = 0; bool wdone = false;
    for (;;) {
        const int kb = j * KVBLK; const bool more = j > 0;
        if (more) SB_LOAD(j - 1);
        const bool act = !wdone && (kb < qlo + QBLK - 1);
        if (act) {
            f32x16 p0, p1;
            qkt_rt(p0, p1, K_lds + buf * SHM_K, r32, hi, qr);
            const bool needmask = kb + KVBLK - 1 >= qlo;
            sb_half(p1, carry, qpos - (kb + 32) - 4 * hi, needmask, hi != 0);
            sb_half(p0, carry, qpos - kb - 4 * hi, needmask, hi != 0);
            bf16x8 pa0, pa1, pa2, pa3;
            PK4(p0, 0, pa0); PK4(p0, 8, pa1); PK4(p1, 0, pa2); PK4(p1, 8, pa3);
            SBAR();
            pv_rt(o, vb0 + buf * SHM_V, pa0, pa1, pa2, pa3);
            wdone = __all(carry < SB_DONE);
        }
        if (more) { asm volatile("s_waitcnt vmcnt(0)" ::: "memory"); SB_WRITE(buf ^ 1); }
        if (lane == 0) flags[(it & 1) * 8 + wid] = wdone ? 1u : 0u;
        __syncthreads();
        unsigned alld = 1u;
#pragma unroll
        for (int w = 0; w < NW; ++w) alld &= flags[(it & 1) * 8 + w];
        if (!more || alld) break;
        --j; buf ^= 1; ++it;
    }
#undef SB_LOAD
#undef SB_WRITE
    bf16* Ow = O + (size_t)(wid * QBLK) * PO;
#pragma unroll
    for (int r = 0; r < 16; ++r) { const int orow = crow(r, hi);
#pragma unroll
        for (int d0 = 0; d0 < 4; ++d0) { const float v = o[d0][r]; const float vn = __shfl_xor(v, 1);
            if ((r32 & 1) == 0) *(unsigned*)(Ow + (size_t)orow * PO + d0 * 32 + r32) = cvtpk(v, vn); } }
    __syncthreads();
}

constexpr float THR2 = 8.f * 1.4426950408889634f;
struct DiffRef { const bf16* Q; const bf16* K; const bf16* V; bf16* O; int P0; int mode; };
struct DiffConst { float lam; float omli; float eps; const float* gain; float* scr; };
template <int PQ, int PK, int PV, int PO>
__device__ __forceinline__ void sm_block(const DiffRef& cur, const DiffConst& C, char* lds) {
    const int tid = pg8::tid_opaque(), wid = __builtin_amdgcn_readfirstlane(tid >> 6), lane = tid & 63, r32 = lane & 31, hi = lane >> 5;
    char* K_lds = lds; char* V_lds = lds + 2 * SHM_K; float* al_l = (float*)(lds + 2 * SHM_K + 2 * SHM_V) + wid * 32;
    const int sr = tid >> 4, sc = (tid & 15) * 8, vst0 = v_st(sr, sc), vst1 = v_st(32 + sr, sc), kws = KSWZ(sr, sc * 2);
    const int vb0 = (int)(uintptr_t)V_lds + v_rd_base(lane);
    const bf16* Q = cur.Q; const bf16* K = cur.K; const bf16* V = cur.V; const int P0 = cur.P0;
    bf16x8 qr[8];
#pragma unroll
    for (int d0 = 0; d0 < 8; ++d0) qr[d0] = load8(Q + (size_t)(wid * QBLK + r32) * PQ + d0 * 16 + hi * 8);
    f32x16 o[4] = {};
    float m_reg = -1e30f, l_reg = 0.f;
    const int qlo = P0 + wid * QBLK, qm = qlo + r32 - 4 * hi;
    const int NT = P0 / KVBLK + 4;
    bf16x8 st_k0, st_k1, st_v0, st_v1;
#define SM_LOAD(jt) do { const size_t k0_ = (size_t)(jt) * KVBLK; st_k0 = load8(K + (k0_ + sr) * PK + sc); st_k1 = load8(K + (k0_ + 32 + sr) * PK + sc); \
                         st_v0 = load8(V + (k0_ + sr) * PV + sc); st_v1 = load8(V + (k0_ + 32 + sr) * PV + sc); } while (0)
#define SM_WRITE(bf) do { *(bf16x8*)(K_lds + (bf) * SHM_K + kws) = st_k0; *(bf16x8*)(K_lds + (bf) * SHM_K + kws + 32 * 256) = st_k1; \
                          *(bf16x8*)(V_lds + (bf) * SHM_V + vst0) = st_v0; *(bf16x8*)(V_lds + (bf) * SHM_V + vst1) = st_v1; } while (0)
    SM_LOAD(0); asm volatile("s_waitcnt vmcnt(0)" ::: "memory"); SM_WRITE(0);
    __syncthreads();
    int buf = 0;
    for (int t = 0; t < NT; ++t) {
        const int kb = t * KVBLK; const bool more = t + 1 < NT;
        if (more) SM_LOAD(t + 1);
        if (kb <= qlo + QBLK - 1) {
            f32x16 p0, p1;
            qkt_rt(p0, p1, K_lds + buf * SHM_K, r32, hi, qr);
            if (kb + KVBLK - 1 > qlo) {
                const int dq = qm - kb; const float NEG = -__builtin_inff();
#pragma unroll
                for (int r = 0; r < 16; ++r) { const int c = (r & 3) + 8 * (r >> 2); if ((dq - c) < 0) p0[r] = NEG; if ((dq - c - 32) < 0) p1[r] = NEG; }
            }
            float pmax = p0[0];
#pragma unroll
            for (int r = 1; r < 16; ++r) pmax = fmaxf(pmax, p0[r]);
#pragma unroll
            for (int r = 0; r < 16; ++r) pmax = fmaxf(pmax, p1[r]);
            { auto rr = __builtin_amdgcn_permlane32_swap(__float_as_uint(pmax), __float_as_uint(pmax), false, false); pmax = fmaxf(__uint_as_float(rr[0]), __uint_as_float(rr[1])); }
            float alpha = 1.f;
            if (!__all((pmax - m_reg) <= THR2)) {
                const float mn = fmaxf(m_reg, pmax); alpha = __builtin_amdgcn_exp2f(m_reg - mn); m_reg = mn;
                if (hi == 0) al_l[r32] = alpha; asm volatile("s_waitcnt lgkmcnt(0)" ::: "memory");
#pragma unroll
                for (int d_ = 0; d_ < 4; ++d_)
#pragma unroll
                    for (int r = 0; r < 16; ++r) o[d_][r] *= al_l[crow(r, hi)];
            }
            float ps = 0.f;
#pragma unroll
            for (int r = 0; r < 16; ++r) { p0[r] = __builtin_amdgcn_exp2f(p0[r] - m_reg); ps += p0[r]; }
#pragma unroll
            for (int r = 0; r < 16; ++r) { p1[r] = __builtin_amdgcn_exp2f(p1[r] - m_reg); ps += p1[r]; }
            { auto rr = __builtin_amdgcn_permlane32_swap(__float_as_uint(ps), __float_as_uint(ps), false, false); ps = __uint_as_float(rr[0]) + __uint_as_float(rr[1]); }
            l_reg = l_reg * alpha + ps;
            bf16x8 pa0, pa1, pa2, pa3;
            PK4(p0, 0, pa0); PK4(p0, 8, pa1); PK4(p1, 0, pa2); PK4(p1, 8, pa3);
            SBAR();
            pv_rt(o, vb0 + buf * SHM_V, pa0, pa1, pa2, pa3);
        }
        if (more) { asm volatile("s_waitcnt vmcnt(0)" ::: "memory"); SM_WRITE(buf ^ 1); }
        __syncthreads();
        buf ^= 1;
    }
#undef SM_LOAD
#undef SM_WRITE
    if (hi == 0) al_l[r32] = l_reg; asm volatile("s_waitcnt lgkmcnt(0)" ::: "memory");
    float rli[16];
#pragma unroll
    for (int r = 0; r < 16; ++r) rli[r] = __builtin_amdgcn_rcpf(al_l[crow(r, hi)]);
#define OPQ(v) asm volatile("" : "+v"(v))
    char* sA = (char*)C.scr; char* sB = sA + 16384;
    const unsigned lo16 = (unsigned)lane * 16u;
    const int mode = cur.mode;
    if (mode == 0 || mode == 1) { char* s = mode ? sB : sA;
#pragma unroll
        for (int r = 0; r < 16; ++r) { unsigned vo = lo16; OPQ(vo);
            const f32x4 v = {o[0][r] * rli[r], o[1][r] * rli[r], o[2][r] * rli[r], o[3][r] * rli[r]};
            *(f32x4*)(s + (size_t)(vo + r * 1024)) = v; }
    } else if (mode == 2) {
#pragma unroll
        for (int r = 0; r < 16; ++r) { unsigned vo = lo16; OPQ(vo);
            f32x4* ap = (f32x4*)(sA + (size_t)(vo + r * 1024)); const f32x4 a = *ap;
            const f32x4 v = {a[0] - C.lam * (o[0][r] * rli[r]), a[1] - C.lam * (o[1][r] * rli[r]), a[2] - C.lam * (o[2][r] * rli[r]), a[3] - C.lam * (o[3][r] * rli[r])};
            *ap = v;
            if ((r & 3) == 3) asm volatile("" ::: "memory"); }
    } else {
        float g0[4], g1[4];
#pragma unroll
        for (int d0 = 0; d0 < 4; ++d0) { g0[d0] = C.gain[d0 * 32 + r32]; g1[d0] = C.gain[128 + d0 * 32 + r32]; }
        char* Ow = (char*)(cur.O + (size_t)(wid * QBLK) * PO);
        const unsigned lo_o = (unsigned)((4 * hi) * PO + r32) * 2u;
#pragma unroll
        for (int r = 0; r < 16; ++r) { unsigned vo = lo16; OPQ(vo);
            const f32x4 a = *(const f32x4*)(sA + (size_t)(vo + r * 1024)); const f32x4 b = *(const f32x4*)(sB + (size_t)(vo + r * 1024));
            float d1[4], ss = 0.f;
#pragma unroll
            for (int d0 = 0; d0 < 4; ++d0) { d1[d0] = b[d0] - C.lam * (o[d0][r] * rli[r]); ss += d1[d0] * d1[d0] + a[d0] * a[d0]; }
            ss += __shfl_xor(ss, 1); ss += __shfl_xor(ss, 2); ss += __shfl_xor(ss, 4); ss += __shfl_xor(ss, 8); ss += __shfl_xor(ss, 16);
            const float scl = rsqrtf(ss * (1.f / 256.f) + C.eps) * C.omli;
            unsigned wo = lo_o; OPQ(wo);
            char* rowp = Ow + (size_t)(wo + (unsigned)(((r & 3) + 8 * (r >> 2)) * PO * 2));
#pragma unroll
            for (int d0 = 0; d0 < 4; ++d0) {
                const float v0 = a[d0] * scl * g0[d0], v1 = d1[d0] * scl * g1[d0];
                const float v0n = __shfl_xor(v0, 1), v1n = __shfl_xor(v1, 1);
                if ((r32 & 1) == 0) { *(unsigned*)(rowp + d0 * 64) = cvtpk(v0, v0n); *(unsigned*)(rowp + 256 + d0 * 64) = cvtpk(v1, v1n); }
            }
            if ((r & 1) == 1) asm volatile("" ::: "memory");
        }
    }
#undef OPQ
    __syncthreads();
}

constexpr int K2 = 32;
constexpr int ST2_K0 = 0, ST2_K1 = 8192, ST2_V = 16384, ST2_BYTES = 32768;
__device__ __forceinline__ int v_st2(int k, int c) { const int kk = (k & ~0xC) | ((k & 4) << 1) | ((k & 8) >> 1); return ((kk >> 3) * 8 + (c >> 5)) * 512 + ((kk & 7) * 32 + (c & 31)) * 2; }
struct Diff2Const { float lam; float omli; float eps; float mb; const float* gain; };
template <int PQ, int PK, int PV, int PO>
__device__ __forceinline__ void diff2_block(const bf16* Qb  , const bf16* Kb  , const bf16* Vb  ,
                                            bf16* Ob, int P0, const Diff2Const& C, char* lds) {
    const int tid = pg8::tid_opaque(), wid = __builtin_amdgcn_readfirstlane(tid >> 6), lane = tid & 63, r32 = lane & 31, hi = lane >> 5;
    const int rg = wid & 3, cc = wid >> 2;
    const int krow = tid >> 4, kcol = (tid & 15) * 8, kws = KSWZ(krow, kcol * 2);
    const int vrow0 = tid >> 5, vcol = (tid & 31) * 8, vst0 = v_st2(vrow0, vcol), vst1 = v_st2(16 + vrow0, vcol);
    const int vb0 = (int)(uintptr_t)lds + ST2_V + v_rd_base(lane);
    const char* Kmine = lds + (cc ? ST2_K1 : ST2_K0);
    bf16x8 qr[8];
    { unsigned qo = (unsigned)((rg * QBLK + r32) * PQ + cc * 128 + hi * 8) * 2u; asm volatile("" : "+v"(qo));
#pragma unroll
      for (int d0 = 0; d0 < 8; ++d0) qr[d0] = *(const bf16x8*)((const char*)Qb + (size_t)qo + d0 * 32); }
    f32x16 o[8];
#pragma unroll
    for (int d0 = 0; d0 < 8; ++d0) o[d0] = f32x16{};
    float l_reg = 0.f;
    const int qlo = P0 + rg * QBLK, qm = qlo + r32 - 4 * hi;
    const int NT = P0 / K2 + 4;
    bf16x8 st_k0, st_k1, st_v0, st_v1;
    const unsigned koff = (unsigned)(krow * PK + kcol) * 2u, voffa = (unsigned)(vrow0 * PV + vcol) * 2u, voffb = (unsigned)((16 + vrow0) * PV + vcol) * 2u;
#define D2_LOAD(jt) do { const char* kt_ = (const char*)Kb + (size_t)(jt) * (K2 * PK * 2); const char* vt_ = (const char*)Vb + (size_t)(jt) * (K2 * PV * 2); \
                         unsigned ko_ = koff, va_ = voffa, vb_ = voffb; asm volatile("" : "+v"(ko_), "+v"(va_), "+v"(vb_)); \
                         st_k0 = *(const bf16x8*)(kt_ + (size_t)ko_); st_k1 = *(const bf16x8*)(kt_ + (size_t)ko_ + 256); \
                         st_v0 = *(const bf16x8*)(vt_ + (size_t)va_); st_v1 = *(const bf16x8*)(vt_ + (size_t)vb_); } while (0)
#define D2_WRITE(bf) do { char* st_ = lds + (bf) * ST2_BYTES; *(bf16x8*)(st_ + ST2_K0 + kws) = st_k0; *(bf16x8*)(st_ + ST2_K1 + kws) = st_k1; \
                          *(bf16x8*)(st_ + ST2_V + vst0) = st_v0; *(bf16x8*)(st_ + ST2_V + vst1) = st_v1; } while (0)
    D2_LOAD(0); asm volatile("s_waitcnt vmcnt(0)" ::: "memory"); D2_WRITE(0);
    __syncthreads();
    int buf = 0;
    for (int t = 0; t < NT; ++t) {
        const int kb = t * K2; const bool more = t + 1 < NT;
        if (more) D2_LOAD(t + 1);
        if (kb <= qlo + QBLK - 1) {
            f32x16 p0 = f32x16{};
            { const char* Kt = Kmine + buf * ST2_BYTES; const char* kbp[4];
#pragma unroll
              for (int dd = 0; dd < 4; ++dd) kbp[dd] = Kt + KSWZ(r32, (dd * 16 + hi * 8) * 2);
#pragma unroll
              for (int d0 = 0; d0 < 8; ++d0) { const bf16x8 b0 = *reinterpret_cast<const bf16x8*>(kbp[d0 & 3] + (d0 >> 2) * 128); p0 = __builtin_amdgcn_mfma_f32_32x32x16_bf16(b0, qr[d0], p0, 0, 0, 0); } }
            const float mb = C.mb;
            if (kb + K2 - 1 > qlo) {
                const int dq = qm - kb;
#pragma unroll
                for (int r = 0; r < 16; ++r) { const int c = (r & 3) + 8 * (r >> 2); const float e = __builtin_amdgcn_exp2f(p0[r] - mb); p0[r] = (dq - c) >= 0 ? e : 0.f; }
            } else {
#pragma unroll
                for (int r = 0; r < 16; ++r) p0[r] = __builtin_amdgcn_exp2f(p0[r] - mb);
            }
            float ps = 0.f;
#pragma unroll
            for (int r = 0; r < 16; ++r) ps += p0[r];
            l_reg += ps;
            bf16x8 pa0, pa1;
            PK4(p0, 0, pa0); PK4(p0, 8, pa1);
            SBAR();
            const int vb = vb0 + buf * ST2_BYTES;
#define TRRD(dst, off) asm volatile("ds_read_b64_tr_b16 %0, %1 offset:%2" : "=&v"(dst) : "v"(vb), "i"(off) : "memory")
#define PV2_RD(d0, L0, H0, L1, H1) do { constexpr int b_ = (d0) * 512; TRRD(L0, b_); TRRD(H0, b_ + 4096); TRRD(L1, b_ + 8192); TRRD(H1, b_ + 12288); } while (0)
#define PV2_MM(d0, L0, H0, L1, H1) do { \
        o[d0] = __builtin_amdgcn_mfma_f32_32x32x16_bf16(pa0, (bf16x8){L0[0], L0[1], L0[2], L0[3], H0[0], H0[1], H0[2], H0[3]}, o[d0], 0, 0, 0); \
        o[d0] = __builtin_amdgcn_mfma_f32_32x32x16_bf16(pa1, (bf16x8){L1[0], L1[1], L1[2], L1[3], H1[0], H1[1], H1[2], H1[3]}, o[d0], 0, 0, 0); } while (0)
#define LGK(n) do { asm volatile("s_waitcnt lgkmcnt(" #n ")" ::: "memory"); SBAR(); } while (0)
#ifdef D2_PV3
            { s16x4 la0, ha0, la1, ha1, lb0, hb0, lb1, hb1, lc0, hc0, lc1, hc1;
              PV2_RD(0, la0, ha0, la1, ha1); PV2_RD(1, lb0, hb0, lb1, hb1);
              PV2_RD(2, lc0, hc0, lc1, hc1); LGK(8); PV2_MM(0, la0, ha0, la1, ha1);
              PV2_RD(3, la0, ha0, la1, ha1); LGK(8); PV2_MM(1, lb0, hb0, lb1, hb1);
              PV2_RD(4, lb0, hb0, lb1, hb1); LGK(8); PV2_MM(2, lc0, hc0, lc1, hc1);
              PV2_RD(5, lc0, hc0, lc1, hc1); LGK(8); PV2_MM(3, la0, ha0, la1, ha1);
              PV2_RD(6, la0, ha0, la1, ha1); LGK(8); PV2_MM(4, lb0, hb0, lb1, hb1);
              PV2_RD(7, lb0, hb0, lb1, hb1); LGK(8); PV2_MM(5, lc0, hc0, lc1, hc1);
              LGK(4); PV2_MM(6, la0, ha0, la1, ha1);
              LGK(0); PV2_MM(7, lb0, hb0, lb1, hb1); }
#else
            { s16x4 la0, ha0, la1, ha1, lb0, hb0, lb1, hb1;
              PV2_RD(0, la0, ha0, la1, ha1);
              PV2_RD(1, lb0, hb0, lb1, hb1); LGK(4); PV2_MM(0, la0, ha0, la1, ha1);
              PV2_RD(2, la0, ha0, la1, ha1); LGK(4); PV2_MM(1, lb0, hb0, lb1, hb1);
              PV2_RD(3, lb0, hb0, lb1, hb1); LGK(4); PV2_MM(2, la0, ha0, la1, ha1);
              PV2_RD(4, la0, ha0, la1, ha1); LGK(4); PV2_MM(3, lb0, hb0, lb1, hb1);
              PV2_RD(5, lb0, hb0, lb1, hb1); LGK(4); PV2_MM(4, la0, ha0, la1, ha1);
              PV2_RD(6, la0, ha0, la1, ha1); LGK(4); PV2_MM(5, lb0, hb0, lb1, hb1);
              PV2_RD(7, lb0, hb0, lb1, hb1); LGK(4); PV2_MM(6, la0, ha0, la1, ha1);
              LGK(0); PV2_MM(7, lb0, hb0, lb1, hb1); }
#endif
#undef PV2_RD
#undef PV2_MM
#undef LGK
#undef TRRD
        }
        if (more) { asm volatile("s_waitcnt vmcnt(0)" ::: "memory"); D2_WRITE(buf ^ 1); }
        __syncthreads();
        buf ^= 1;
    }
#undef D2_LOAD
#undef D2_WRITE
    { auto rr = __builtin_amdgcn_permlane32_swap(__float_as_uint(l_reg), __float_as_uint(l_reg), false, false); l_reg = __uint_as_float(rr[0]) + __uint_as_float(rr[1]); }
    float* lw = (float*)(lds + 132096) + wid * 32;
    if (hi == 0) lw[r32] = l_reg; asm volatile("s_waitcnt lgkmcnt(0)" ::: "memory");
    float rli[16];
#pragma unroll
    for (int r = 0; r < 16; ++r) rli[r] = __builtin_amdgcn_rcpf(lw[crow(r, hi)]);
    float* X = (float*)lds + rg * 8192;
#define OPQ(v) asm volatile("" : "+v"(v))
    if (cc == 1) {
#pragma unroll
        for (int r = 0; r < 16; ++r) { const float f = C.lam * rli[r]; unsigned vo = (unsigned)lane; OPQ(vo);
#pragma unroll
            for (int d0 = 0; d0 < 8; ++d0) X[(r * 8 + d0) * 64 + vo] = o[d0][r] * f; }
    }
    __syncthreads();
    if (cc == 0) {
        float g[8];
        { unsigned go = (unsigned)r32 * 4u; OPQ(go);
#pragma unroll
          for (int d0 = 0; d0 < 8; ++d0) g[d0] = *(const float*)((const char*)C.gain + (size_t)go + d0 * 128); }
        char* Ow = (char*)(Ob + (size_t)(rg * QBLK) * PO);
        const unsigned lo_o = (unsigned)((4 * hi) * PO + r32) * 2u;
#pragma unroll
        for (int r = 0; r < 16; ++r) { unsigned vo = (unsigned)lane; OPQ(vo);
            float d[8], ss = 0.f;
#pragma unroll
            for (int d0 = 0; d0 < 8; ++d0) { d[d0] = o[d0][r] * rli[r] - X[(r * 8 + d0) * 64 + vo]; ss += d[d0] * d[d0]; }
            ss += __shfl_xor(ss, 1); ss += __shfl_xor(ss, 2); ss += __shfl_xor(ss, 4); ss += __shfl_xor(ss, 8); ss += __shfl_xor(ss, 16);
            const float scl = rsqrtf(ss * (1.f / 256.f) + C.eps) * C.omli;
#ifdef D2_OSTAGE
            unsigned xo = (unsigned)(r * 2048 + hi * 512 + r32 * 2); OPQ(xo);
#pragma unroll
            for (int d0 = 0; d0 < 8; ++d0) { const float v = d[d0] * scl * g[d0]; const float vn = __shfl_xor(v, 1);
                if ((r32 & 1) == 0) *(unsigned*)((char*)X + xo + d0 * 64) = cvtpk(v, vn); }
#else
            unsigned wo = lo_o; OPQ(wo);
            char* rowp = Ow + (size_t)(wo + (unsigned)(((r & 3) + 8 * (r >> 2)) * PO * 2));
#pragma unroll
            for (int d0 = 0; d0 < 8; ++d0) { const float v = d[d0] * scl * g[d0]; const float vn = __shfl_xor(v, 1);
                if ((r32 & 1) == 0) *(unsigned*)(rowp + d0 * 64) = cvtpk(v, vn); }
#endif
        }
#ifdef D2_OSTAGE
        asm volatile("s_waitcnt lgkmcnt(0)" ::: "memory");
#pragma unroll
        for (int r = 0; r < 16; ++r) { unsigned xo = (unsigned)(r * 2048 + hi * 512 + r32 * 16); OPQ(xo);
            const bf16x8 w = *(const bf16x8*)((const char*)X + xo);
            unsigned wo = (unsigned)((4 * hi) * PO * 2 + r32 * 16); OPQ(wo);
            *(bf16x8*)(Ow + (size_t)(wo + (unsigned)(((r & 3) + 8 * (r >> 2)) * PO * 2))) = w; }
#endif
    }
#undef OPQ
    __syncthreads();
}
}
#ifndef PG8_SP2
#define PG8_SP2 true
#endif
#ifndef PG8_ALIGN
#define PG8_ALIGN true
#endif
#ifndef MK_SPLIT
#define MK_SPLIT 0
#endif
#ifndef MK_CHECK
#define MK_CHECK 0
#endif
constexpr int NWAVES = 8;
constexpr int BATCH = 2, SEQ = 4096, DM = 4096, MROWS = BATCH * SEQ, FF = 11008, FF2 = 2 * FF, NQKV = 3 * DM;
constexpr int SB_H = 32, DF_H = 16, HD = 128;
constexpr float RMS_EPS = 1e-6f;
constexpr float LOG2E = 1.4426950408889634f;
constexpr float QSCALE = 0.08838834764831845f * LOG2E;
constexpr int NPH = 14;
constexpr size_t MiB = 1u << 20;
constexpr size_t WS_CTL = 0, CTL_ZERO_BYTES = 1 * MiB;
constexpr size_t WS_WQKV0 = 2 * MiB;
constexpr size_t WS_WO0   = WS_WQKV0 + 96 * MiB;
constexpr size_t WS_WQKV1 = WS_WO0 + 32 * MiB;
constexpr size_t WS_WO1   = WS_WQKV1 + 96 * MiB;
constexpr size_t WS_WUP0  = WS_WO1 + 32 * MiB;
constexpr size_t WS_WUP1  = WS_WUP0 + 172 * MiB;
constexpr size_t WS_WDN0  = WS_WUP1 + 172 * MiB;
constexpr size_t WS_WDN1  = WS_WDN0 + 86 * MiB;
constexpr size_t WS_XN    = WS_WDN1 + 86 * MiB;
constexpr size_t WS_PART  = WS_XN + 64 * MiB;
constexpr size_t WS_QKV   = WS_PART + 2 * MiB;
constexpr size_t WS_QKN   = WS_QKV + 192 * MiB;
constexpr size_t WS_AO    = WS_QKN + 128 * MiB;
constexpr size_t WS_U     = WS_AO + 64 * MiB;
constexpr size_t WS_ACT   = WS_U + 344 * MiB;
constexpr size_t WS_SCR   = WS_ACT + 172 * MiB;
constexpr size_t WS_HALO  = WS_SCR + 64 * MiB;
constexpr size_t WS_X1    = WS_HALO + 44 * MiB;
constexpr size_t WS_END   = WS_X1 + (MK_CHECK ? 3 * 128 * MiB : 0);
constexpr int CW_TMO = 0, CW_CODE = 1, CW_FAIL = 2, CW_BAR = 4096;

constexpr int RING_OFF = 0, RING_BYTES = 131072;
constexpr int LDSCTL_OFF = RING_BYTES, MISC_OFF = LDSCTL_OFF + 320;
constexpr int LDS_BYTES = 147456;
constexpr int RS_OFF = MISC_OFF + 128;
static_assert(RS_OFF % 16 == 0 && RS_OFF + 1024 + 16 + 4096 <= LDS_BYTES, "LDS map");

#define GAS __attribute__((address_space(1)))
#define LAS __attribute__((address_space(3)))
typedef unsigned short bf16;
typedef unsigned v4u __attribute__((ext_vector_type(4)));
typedef unsigned v2u __attribute__((ext_vector_type(2)));
typedef float f32x4 __attribute__((ext_vector_type(4)));
typedef short bf16x8 __attribute__((ext_vector_type(8)));
typedef GAS unsigned gu32;
#define RLX_AGENT __ATOMIC_RELAXED, __HIP_MEMORY_SCOPE_AGENT
#define LDS_WAIT() asm volatile("s_waitcnt lgkmcnt(0)" ::: "memory")
#define VM_WAIT() asm volatile("s_waitcnt vmcnt(0)" ::: "memory")
__device__ __forceinline__ unsigned f2bf(float f) { unsigned u = __builtin_bit_cast(unsigned, f); return (u + 0x7fffu + ((u >> 16) & 1u)) >> 16; }
__device__ __forceinline__ unsigned pk2(float lo, float hi) { return f2bf(lo) | (f2bf(hi) << 16); }
__device__ __forceinline__ float bf2f(unsigned short b) { return __builtin_bit_cast(float, (unsigned)b << 16); }

#define XB_TMO      128
#define XB_XCNT(j)  (256  + 64 * (j))
#define XB_XSUB(j)  (1280 + 64 * (j))
#define XB_XGEN(j)  (2304 + 64 * (j))
#define XB_TOP      3328
#define XB_TOPGEN   3392
#define XCD_BAR_WORDS 3456
#define XB_SPIN_CAP (1u << 18)
__device__ __forceinline__ unsigned xb_ld(unsigned* p)              { return __hip_atomic_load(p, __ATOMIC_RELAXED, __HIP_MEMORY_SCOPE_AGENT); }
__device__ __forceinline__ unsigned xb_add(unsigned* p, unsigned v) { return __hip_atomic_fetch_add(p, v, __ATOMIC_RELAXED, __HIP_MEMORY_SCOPE_AGENT); }
__device__ __forceinline__ unsigned xb_xcc_id() { return (unsigned)__builtin_amdgcn_s_getreg((3 << 11) | 20) & 0xFu; }
#define XB_SPIN(cond, bar) do { unsigned _sp = 0; while (cond) { __builtin_amdgcn_s_sleep(1); \
    if ((++_sp & 255u) == 0u) { if (xb_ld(&(bar)[XB_TMO])) break; if (_sp > XB_SPIN_CAP) { atomicAdd(&(bar)[XB_TMO], 1u); break; } } } } while (0)
struct XcdBarrier { unsigned* bar; unsigned x; volatile LAS unsigned* st; };
__device__ __forceinline__ XcdBarrier xcd_barrier_post(unsigned* bar, volatile LAS unsigned* st) {
    XcdBarrier b; b.bar = bar; b.x = xb_xcc_id(); b.st = st;
    if (threadIdx.x == 0) (void)xb_add(&bar[XB_XCNT(b.x)], 1u);
    return b;
}
__device__ __forceinline__ void xcd_barrier_complete(unsigned* bar, unsigned x, unsigned& nloc, unsigned& nx) {
    const unsigned G = gridDim.x * gridDim.y * gridDim.z;
    unsigned sum, cnt, mine, sp = 0u;
    for (;;) {
        sum = 0u; cnt = 0u; mine = 0u;
#pragma unroll
        for (unsigned j = 0; j < 16; ++j) { const unsigned c = xb_ld(&bar[XB_XCNT(j)]); sum += c; cnt += (c > 0u) ? 1u : 0u; mine = (j == x) ? c : mine; }
        if (sum == G) break;
        __builtin_amdgcn_s_sleep(1);
        if ((++sp & 255u) == 0u) { if (xb_ld(&bar[XB_TMO])) break; if (sp > XB_SPIN_CAP) { atomicAdd(&bar[XB_TMO], 1u); break; } }
    }
    nloc = mine > 0u ? mine : 1u; nx = cnt > 0u ? cnt : 1u;
}
__device__ __forceinline__ void xcd_barrier(const XcdBarrier& b) {
    asm volatile("s_waitcnt vmcnt(0)" ::: "memory");
    __syncthreads();
    if (threadIdx.x == 0) {
        unsigned* bar = b.bar; const unsigned myx = xb_xcc_id();
        __builtin_amdgcn_s_waitcnt(0);
        unsigned nloc = b.st[0], nx = b.st[1];
        if (nloc == 0u) { xcd_barrier_complete(bar, myx, nloc, nx); b.st[0] = nloc; b.st[1] = nx; }
        const unsigned old = xb_add(&bar[XB_XSUB(myx)], 1u);
        const unsigned gen = old / nloc;
        if (old + 1u == (gen + 1u) * nloc) {
            __builtin_amdgcn_fence(__ATOMIC_RELEASE, "agent");
            asm volatile("s_waitcnt vmcnt(0)" ::: "memory");
            const unsigned og = xb_add(&bar[XB_TOP], 1u);
            const unsigned tg = og / nx;
            if (og + 1u == (tg + 1u) * nx) xb_add(&bar[XB_TOPGEN], 1u);
            else XB_SPIN(xb_ld(&bar[XB_TOPGEN]) == tg, bar);
            __builtin_amdgcn_fence(__ATOMIC_ACQUIRE, "agent");
            xb_add(&bar[XB_XGEN(myx)], 1u);
            asm volatile("s_waitcnt vmcnt(0)" ::: "memory");
        } else {
            XB_SPIN(xb_ld(&bar[XB_XGEN(myx)]) == gen, bar);
            __builtin_amdgcn_fence(__ATOMIC_ACQUIRE, "agent");
            asm volatile("s_waitcnt vmcnt(0)" ::: "memory");
        }
    }
    __syncthreads();
}

__device__ __forceinline__ float wave_sum(float v) {
#pragma unroll
    for (int o = 1; o < 64; o <<= 1) v += __shfl_xor(v, o);
    return v;
}

constexpr int TR_STRIDE = 33;
__device__ __forceinline__ void transpose_item(const float* W, const float* gain, int K, int N, bf16* WT, LAS unsigned* scr, int item, int lane, bool gateperm) {
    const int nblk = N / 64, kb = item / nblk, nb = item % nblk, k0 = 64 * kb, n0 = 64 * nb;
    const int h_ = N / 2, nd0 = gateperm ? ((n0 % h_) / 128) * 256 + (n0 / h_) * 128 + (n0 % 128) : n0;
    const int kp = lane >> 4, c = lane & 15;
    f32x4 va[8], vb[8];
#pragma unroll
    for (int i = 0; i < 8; ++i) { const GAS float* src = (const GAS float*)W + (size_t)(k0 + 8 * i + 2 * kp) * N + n0 + 4 * c; va[i] = __builtin_nontemporal_load((const GAS f32x4*)src); vb[i] = __builtin_nontemporal_load((const GAS f32x4*)(src + N)); }
#pragma unroll
    for (int i = 0; i < 8; ++i) { float ga = 1.f, gb = 1.f; if (gain) { ga = gain[k0 + 8 * i + 2 * kp]; gb = gain[k0 + 8 * i + 2 * kp + 1]; }
        LAS unsigned* d = scr + (4 * c) * TR_STRIDE + 4 * i + kp;
        d[0 * TR_STRIDE] = pk2(va[i].x * ga, vb[i].x * gb); d[1 * TR_STRIDE] = pk2(va[i].y * ga, vb[i].y * gb);
        d[2 * TR_STRIDE] = pk2(va[i].z * ga, vb[i].z * gb); d[3 * TR_STRIDE] = pk2(va[i].w * ga, vb[i].w * gb); }
    LDS_WAIT(); asm volatile("" ::: "memory");
    const int c8 = lane & 7, nr = lane >> 3;
#pragma unroll
    for (int j = 0; j < 8; ++j) { const int n = nr + 8 * j; const LAS unsigned* s = scr + n * TR_STRIDE + 4 * c8;
        v4u o; o.x = s[0]; o.y = s[1]; o.z = s[2]; o.w = s[3];
        *(GAS v4u*)(WT + (size_t)(nd0 + n) * K + k0 + 8 * c8) = o; }
    LDS_WAIT(); asm volatile("" ::: "memory");
}
__device__ __forceinline__ void xrow_to_bf16(const float* xrow, bf16* orow, float* prow, int lane) {
    const GAS f32x4* xr = (const GAS f32x4*)xrow + lane;
    float s = 0.f; GAS unsigned long long* o8 = (GAS unsigned long long*)orow + lane;
#pragma unroll
    for (int j = 0; j < 16; ++j) { const f32x4 v = xr[64 * j]; s += (v.x * v.x + v.y * v.y) + (v.z * v.z + v.w * v.w);
        o8[64 * j] = (unsigned long long)pk2(v.x, v.y) | ((unsigned long long)pk2(v.z, v.w) << 32); }
    s = wave_sum(s);
    prow[lane] = lane == 0 ? s : 0.f;
}

__device__ __forceinline__ void cvt8(const v4u w, float (&f)[8]) {
    f[0] = __builtin_bit_cast(float, w.x << 16); f[1] = __builtin_bit_cast(float, w.x & 0xffff0000u); f[2] = __builtin_bit_cast(float, w.y << 16); f[3] = __builtin_bit_cast(float, w.y & 0xffff0000u);
    f[4] = __builtin_bit_cast(float, w.z << 16); f[5] = __builtin_bit_cast(float, w.z & 0xffff0000u); f[6] = __builtin_bit_cast(float, w.w << 16); f[7] = __builtin_bit_cast(float, w.w & 0xffff0000u);
}
constexpr int CG_ROWS = 32, CG_NCG = FF / 8, CG_ITEMS = (MROWS / CG_ROWS) * CG_NCG;
__device__ __forceinline__ void convgate_item(const bf16* U, const float* cw, const float* cb, bf16* ACT, int item) {
    const int chunk = item / CG_NCG, cg = item % CG_NCG, m0 = chunk * CG_ROWS, t0 = m0 % SEQ, j0 = cg * 8;
    float wg[3][8], wv[3][8], bg[8], bv[8];
#pragma unroll
    for (int i = 0; i < 3; ++i)
#pragma unroll
        for (int h = 0; h < 2; ++h) { const f32x4 a = *(const f32x4*)(cw + (size_t)i * FF2 + j0 + 4 * h), b = *(const f32x4*)(cw + (size_t)i * FF2 + FF + j0 + 4 * h);
            wg[i][4 * h] = a.x; wg[i][4 * h + 1] = a.y; wg[i][4 * h + 2] = a.z; wg[i][4 * h + 3] = a.w; wv[i][4 * h] = b.x; wv[i][4 * h + 1] = b.y; wv[i][4 * h + 2] = b.z; wv[i][4 * h + 3] = b.w; }
#pragma unroll
    for (int h = 0; h < 2; ++h) { const f32x4 a = *(const f32x4*)(cb + j0 + 4 * h), b = *(const f32x4*)(cb + FF + j0 + 4 * h);
        bg[4 * h] = a.x; bg[4 * h + 1] = a.y; bg[4 * h + 2] = a.z; bg[4 * h + 3] = a.w; bv[4 * h] = b.x; bv[4 * h + 1] = b.y; bv[4 * h + 2] = b.z; bv[4 * h + 3] = b.w; }
    float g2[8], g1[8], v2[8], v1[8];
    const v4u z4 = {0u, 0u, 0u, 0u};
    { const v4u a = t0 >= 2 ? *(const GAS v4u*)(U + (size_t)(m0 - 2) * FF2 + j0) : z4, b = t0 >= 2 ? *(const GAS v4u*)(U + (size_t)(m0 - 2) * FF2 + FF + j0) : z4; cvt8(a, g2); cvt8(b, v2); }
    { const v4u a = t0 >= 1 ? *(const GAS v4u*)(U + (size_t)(m0 - 1) * FF2 + j0) : z4, b = t0 >= 1 ? *(const GAS v4u*)(U + (size_t)(m0 - 1) * FF2 + FF + j0) : z4; cvt8(a, g1); cvt8(b, v1); }
#pragma unroll 4
    for (int r = 0; r < CG_ROWS; ++r) {
        float g0[8], v0[8]; cvt8(*(const GAS v4u*)(U + (size_t)(m0 + r) * FF2 + j0), g0); cvt8(*(const GAS v4u*)(U + (size_t)(m0 + r) * FF2 + FF + j0), v0);
        float o[8];
#pragma unroll
        for (int e = 0; e < 8; ++e) { const float cgv = bg[e] + wg[0][e] * g2[e] + wg[1][e] * g1[e] + wg[2][e] * g0[e]; const float cvv = bv[e] + wv[0][e] * v2[e] + wv[1][e] * v1[e] + wv[2][e] * v0[e];
            const float sg = cgv * __builtin_amdgcn_rcpf(1.f + __builtin_amdgcn_exp2f(-cgv * LOG2E)); o[e] = sg * cvv; g2[e] = g1[e]; g1[e] = g0[e]; v2[e] = v1[e]; v1[e] = v0[e]; }
        v4u w; w.x = pk2(o[0], o[1]); w.y = pk2(o[2], o[3]); w.z = pk2(o[4], o[5]); w.w = pk2(o[6], o[7]);
        *(GAS v4u*)(ACT + (size_t)(m0 + r) * FF + j0) = w;
    }
}

constexpr int FX_ITEMS = (MROWS / 64) * CG_NCG;
__device__ __forceinline__ void ld8(const float* p, float (&f)[8]) { const f32x4 a = *(const GAS f32x4*)p, b = *(const GAS f32x4*)(p + 4); f[0] = a.x; f[1] = a.y; f[2] = a.z; f[3] = a.w; f[4] = b.x; f[5] = b.y; f[6] = b.z; f[7] = b.w; }
__device__ __forceinline__ void fixup_item(const float* halo, const float* cw, const float* cb, bf16* ACT, int item) {
    const int grp = item / CG_NCG, cg = item % CG_NCG, j0 = cg * 8; const bool first = (grp % (SEQ / 64)) == 0;
    float wg[3][8], wv[3][8], bg[8], bv[8];
#pragma unroll
    for (int i = 0; i < 3; ++i) { ld8(cw + (size_t)i * FF2 + j0, wg[i]); ld8(cw + (size_t)i * FF2 + FF + j0, wv[i]); }
    ld8(cb + j0, bg); ld8(cb + FF + j0, bv);
    float h0g[8], h0v[8], h1g[8], h1v[8], t0g[8], t0v[8], t1g[8], t1v[8];
    const float* hb = halo + (size_t)grp * 4 * FF2 + j0;
    ld8(hb, h0g); ld8(hb + FF, h0v); ld8(hb + FF2, h1g); ld8(hb + FF2 + FF, h1v);
    if (!first) { const float* pb = hb - 4 * (size_t)FF2; ld8(pb + 2 * (size_t)FF2, t0g); ld8(pb + 2 * (size_t)FF2 + FF, t0v); ld8(pb + 3 * (size_t)FF2, t1g); ld8(pb + 3 * (size_t)FF2 + FF, t1v); }
    else {
#pragma unroll
        for (int e = 0; e < 8; ++e) { t0g[e] = 0.f; t0v[e] = 0.f; t1g[e] = 0.f; t1v[e] = 0.f; } }
    float o0[8], o1[8];
#pragma unroll
    for (int e = 0; e < 8; ++e) {
        const float cg0 = bg[e] + wg[0][e] * t0g[e] + wg[1][e] * t1g[e] + wg[2][e] * h0g[e], cv0 = bv[e] + wv[0][e] * t0v[e] + wv[1][e] * t1v[e] + wv[2][e] * h0v[e];
        const float cg1 = bg[e] + wg[0][e] * t1g[e] + wg[1][e] * h0g[e] + wg[2][e] * h1g[e], cv1 = bv[e] + wv[0][e] * t1v[e] + wv[1][e] * h0v[e] + wv[2][e] * h1v[e];
        o0[e] = cg0 * __builtin_amdgcn_rcpf(1.f + __builtin_amdgcn_exp2f(-cg0 * LOG2E)) * cv0; o1[e] = cg1 * __builtin_amdgcn_rcpf(1.f + __builtin_amdgcn_exp2f(-cg1 * LOG2E)) * cv1; }
    v4u w0, w1; w0.x = pk2(o0[0], o0[1]); w0.y = pk2(o0[2], o0[3]); w0.z = pk2(o0[4], o0[5]); w0.w = pk2(o0[6], o0[7]);
    w1.x = pk2(o1[0], o1[1]); w1.y = pk2(o1[2], o1[3]); w1.z = pk2(o1[4], o1[5]); w1.w = pk2(o1[6], o1[7]);
    *(GAS v4u*)(ACT + (size_t)(grp * 64) * FF + j0) = w0; *(GAS v4u*)(ACT + (size_t)(grp * 64 + 1) * FF + j0) = w1;
}

__device__ __forceinline__ void sincos_rev(float ang, float& s, float& c) {
    const float I1 = 0.15915493667125702f, I2 = 6.420638326565253e-09f;
    const float r1 = ang * I1; const float e1 = __builtin_fmaf(ang, I1, -r1); const float r2 = __builtin_fmaf(ang, I2, e1);
    const float fr = (r1 - __builtin_rintf(r1)) + r2;
    s = __builtin_amdgcn_sinf(fr); c = __builtin_amdgcn_cosf(fr);
}
__device__ __forceinline__ void qknorm_row(const bf16* qkv_row, bf16* qkn_row, const float* gq, const float* gk, int t, int lane) {
    const int c = lane & 7, gs = lane >> 3;
    float cs[8], sn[8];
#pragma unroll
    for (int e = 0; e < 8; ++e) { const int i = 8 * c + e; const float invf = __builtin_amdgcn_exp2f(-(float)i * (13.287712379549449f / 64.f));
        sincos_rev((float)t * invf, sn[e], cs[e]); }
    float gA[8], gB[8];
#pragma unroll 1
    for (int qk = 0; qk < 2; ++qk) {
        const float* gn = qk ? gk : gq; const float sc = qk ? 1.f : QSCALE;
#pragma unroll
        for (int e = 0; e < 8; ++e) { gA[e] = gn[8 * c + e]; gB[e] = gn[64 + 8 * c + e]; }
        v4u ra[4], rb[4];
#pragma unroll
        for (int it = 0; it < 4; ++it) { const int col = qk * 4096 + (it * 8 + gs) * 128 + 8 * c; ra[it] = *(const GAS v4u*)(qkv_row + col); rb[it] = *(const GAS v4u*)(qkv_row + col + 64); }
#pragma unroll
        for (int it = 0; it < 4; ++it) {
            const int col = qk * 4096 + (it * 8 + gs) * 128 + 8 * c;
            float xa[8], xb[8]; cvt8(ra[it], xa); cvt8(rb[it], xb);
            float ss = 0.f;
#pragma unroll
            for (int e = 0; e < 8; ++e) ss += xa[e] * xa[e] + xb[e] * xb[e];
            ss += __shfl_xor(ss, 1); ss += __shfl_xor(ss, 2); ss += __shfl_xor(ss, 4);
            const float inv = rsqrtf(ss * (1.f / 128.f) + RMS_EPS);
            float oa[8], ob[8];
#pragma unroll
            for (int e = 0; e < 8; ++e) { const float ya = xa[e] * inv * gA[e], yb = xb[e] * inv * gB[e]; oa[e] = (ya * cs[e] - yb * sn[e]) * sc; ob[e] = (yb * cs[e] + ya * sn[e]) * sc; }
            v4u wa, wb; wa.x = pk2(oa[0], oa[1]); wa.y = pk2(oa[2], oa[3]); wa.z = pk2(oa[4], oa[5]); wa.w = pk2(oa[6], oa[7]);
            wb.x = pk2(ob[0], ob[1]); wb.y = pk2(ob[2], ob[3]); wb.z = pk2(ob[4], ob[5]); wb.w = pk2(ob[6], ob[7]);
            *(GAS v4u*)(qkn_row + col) = wa; *(GAS v4u*)(qkn_row + col + 64) = wb;
        }
    }
}
#ifdef QKN_FAST
__device__ __forceinline__ unsigned qkn_pk(float lo, float hi) { unsigned r; asm volatile("v_cvt_pk_bf16_f32 %0, %1, %2" : "=v"(r) : "v"(lo), "v"(hi)); return r; }
__device__ __forceinline__ void qknorm_rows(const bf16* qkv, bf16* qkn, const float* gq, const float* gk, int gw, int ngw, int lane) {
    const int c = lane & 7, gs = lane >> 3;
    float gA[2][8], gB[2][8];
#pragma unroll
    for (int e = 0; e < 8; ++e) { gA[0][e] = gq[8 * c + e]; gB[0][e] = gq[64 + 8 * c + e]; gA[1][e] = gk[8 * c + e]; gB[1][e] = gk[64 + 8 * c + e]; }
#pragma unroll 1
    for (int m = gw; m < MROWS; m += ngw) {
        const bf16* qkv_row = qkv + (size_t)m * NQKV; bf16* qkn_row = qkn + (size_t)m * 8192; const int t = m % SEQ;
        v4u ra[2][4], rb[2][4];
#pragma unroll
        for (int qk = 0; qk < 2; ++qk)
#pragma unroll
            for (int it = 0; it < 4; ++it) { const int col = qk * 4096 + (it * 8 + gs) * 128 + 8 * c; ra[qk][it] = *(const GAS v4u*)(qkv_row + col); rb[qk][it] = *(const GAS v4u*)(qkv_row + col + 64); }
        float cs[8], sn[8];
#pragma unroll
        for (int e = 0; e < 8; ++e) { const int i = 8 * c + e; const float invf = __builtin_amdgcn_exp2f(-(float)i * (13.287712379549449f / 64.f));
            sincos_rev((float)t * invf, sn[e], cs[e]); }
#pragma unroll
        for (int qk = 0; qk < 2; ++qk) { const float sc = qk ? 1.f : QSCALE;
#pragma unroll
            for (int it = 0; it < 4; ++it) {
                const int col = qk * 4096 + (it * 8 + gs) * 128 + 8 * c;
                float xa[8], xb[8]; cvt8(ra[qk][it], xa); cvt8(rb[qk][it], xb);
                float ss = 0.f;
#pragma unroll
                for (int e = 0; e < 8; ++e) ss += xa[e] * xa[e] + xb[e] * xb[e];
                ss += __shfl_xor(ss, 1); ss += __shfl_xor(ss, 2); ss += __shfl_xor(ss, 4);
                const float inv = rsqrtf(ss * (1.f / 128.f) + RMS_EPS);
                float oa[8], ob[8];
#pragma unroll
                for (int e = 0; e < 8; ++e) { const float ya = xa[e] * inv * gA[qk][e], yb = xb[e] * inv * gB[qk][e]; oa[e] = (ya * cs[e] - yb * sn[e]) * sc; ob[e] = (yb * cs[e] + ya * sn[e]) * sc; }
                v4u wa, wb; wa.x = qkn_pk(oa[0], oa[1]); wa.y = qkn_pk(oa[2], oa[3]); wa.z = qkn_pk(oa[4], oa[5]); wa.w = qkn_pk(oa[6], oa[7]);
                wb.x = qkn_pk(ob[0], ob[1]); wb.y = qkn_pk(ob[2], ob[3]); wb.z = qkn_pk(ob[4], ob[5]); wb.w = qkn_pk(ob[6], ob[7]);
                *(GAS v4u*)(qkn_row + col) = wa; *(GAS v4u*)(qkn_row + col + 64) = wb;
            }
        }
    }
}
#endif
struct Args { const float* in[18]; float* out; unsigned char* ws; int ph_lo, ph_hi; };
static_assert(sizeof(Args) == 18 * 8 + 8 + 8 + 8, "Args has no padding");

struct MatDesc { int in_idx; size_t in_off; int gain_idx; size_t gain_off; int K, N; size_t ws_off; int gateperm; };
__device__ __forceinline__ MatDesc mat_desc(int i) {
    switch (i) {
    case 0: return MatDesc{2, 0, 1, 0, DM, NQKV, WS_WQKV0, 0};
    case 1: return MatDesc{3, 0, -1, 0, DM, DM, WS_WO0, 0};
    case 2: return MatDesc{14, 0, 13, 0, DM, FF2, WS_WUP0, 1};
    case 3: return MatDesc{17, 0, -1, 0, FF, DM, WS_WDN0, 0};
    case 4: return MatDesc{4, 0, 1, (size_t)DM, DM, NQKV, WS_WQKV1, 0};
    case 5: return MatDesc{5, 0, -1, 0, DM, DM, WS_WO1, 0};
    case 6: return MatDesc{14, (size_t)DM * FF2, 13, (size_t)DM, DM, FF2, WS_WUP1, 1};
    default: return MatDesc{17, (size_t)FF * DM, -1, 0, FF, DM, WS_WDN1, 0};
    }
}

__global__ void __launch_bounds__(NWAVES * 64, 2) mk_fwd(Args args) {
    extern __shared__ __attribute__((aligned(16))) unsigned char lds[];
    LAS unsigned char* ldsl = (LAS unsigned char*)lds;
    volatile LAS unsigned* MISC = (volatile LAS unsigned*)(ldsl + MISC_OFF);
    const int tid = threadIdx.x, lane = tid & 63, wave = __builtin_amdgcn_readfirstlane(tid >> 6);
    const int G = gridDim.x, bx = blockIdx.x;
    const int gw = bx * NWAVES + wave, NGW = G * NWAVES;
    unsigned char* ws = args.ws;
    gu32* ctl = (gu32*)(ws + WS_CTL);
    for (int u = tid; u < (LDS_BYTES - LDSCTL_OFF) / 4; u += NWAVES * 64) ((LAS unsigned*)(ldsl + LDSCTL_OFF))[u] = 0u;
    __syncthreads();
    XcdBarrier bar; bar.bar = (unsigned*)(ctl + CW_BAR); bar.x = 0; bar.st = nullptr;
    const int lo = args.ph_lo, hi = args.ph_hi;
    if (hi - lo > 1) bar = xcd_barrier_post((unsigned*)(ctl + CW_BAR), MISC + 8);
#ifndef PH_MASK
#define PH_MASK 0x3fff
#endif
#define IN(k) (((PH_MASK >> (k)) & 1) && lo <= (k) && (k) < hi)
#define RS_TAG_RESET() do { if (tid == 0) ((LAS int*)(ldsl + RS_OFF))[256] = -1; __syncthreads(); } while (0)
#define SEAM(k) do { if (IN(k) && IN((k) + 1)) xcd_barrier(bar); STAMP((k) + 1); } while (0)
#ifndef REPEAT_PHASE
#define REPEAT_PHASE -1
#endif
#ifndef REPEAT_N
#define REPEAT_N 1
#endif
#ifndef LEAK_A
#define LEAK_A -1
#endif
#ifndef LEAK_B
#define LEAK_B 14
#endif
#ifndef LEAK_OFF
#define LEAK_OFF 0
#endif
    unsigned long long tA = 0, tB = 0;
#define STAMP(k) do { if (LEAK_A >= 0 && bx == 0 && tid == 0) { if ((k) == LEAK_A) tA = __builtin_amdgcn_s_memrealtime(); if ((k) == LEAK_B) tB = __builtin_amdgcn_s_memrealtime(); } } while (0)
#define NREP(k) (REPEAT_PHASE == (k) ? 1 + REPEAT_N : 1)
    float* DUMMY = (float*)(ws + WS_END);

    bf16* XN = (bf16*)(ws + WS_XN); float* PART = (float*)(ws + WS_PART);
    bf16* QKV = (bf16*)(ws + WS_QKV); bf16* QKN = (bf16*)(ws + WS_QKN); bf16* AO = (bf16*)(ws + WS_AO);
    bf16* ACT = (bf16*)(ws + WS_ACT); float* HALO = (float*)(ws + WS_HALO);
    const float* x_in = args.in[0];

#ifndef JIT_CONV
#define JIT_CONV 1
#endif
#define CONVERT_MAT(MI) do { const MatDesc md = mat_desc(MI); LAS unsigned* scr_ = (LAS unsigned*)(ldsl + RING_OFF + wave * 16384); \
        const float* W_ = args.in[md.in_idx] + md.in_off; const float* gain_ = md.gain_idx >= 0 ? args.in[md.gain_idx] + md.gain_off : nullptr; \
        bf16* WT_ = (bf16*)(ws + md.ws_off); const int nitems_ = (md.K / 64) * (md.N / 64); \
        for (int it_ = gw; it_ < nitems_; it_ += NGW) transpose_item(W_, gain_, md.K, md.N, WT_, scr_, it_, lane, md.gateperm != 0); } while (0)
#define CONVERT_MAT_RANGE(MI, I0, I1, WG0) do { const MatDesc md = mat_desc(MI); LAS unsigned* scr_ = (LAS unsigned*)(ldsl + RING_OFF + wave * 16384); \
        const float* W_ = args.in[md.in_idx] + md.in_off; const float* gain_ = md.gain_idx >= 0 ? args.in[md.gain_idx] + md.gain_off : nullptr; \
        bf16* WT_ = (bf16*)(ws + md.ws_off); const int i1_ = (I1); \
        for (int it_ = (I0) + (bx - (WG0)) * NWAVES + wave; it_ < i1_; it_ += (G - (WG0)) * NWAVES) transpose_item(W_, gain_, md.K, md.N, WT_, scr_, it_, lane, md.gateperm != 0); } while (0)
#ifndef TAILFILL
#define TAILFILL 1
#endif
#ifndef DN_NUM
#define DN_NUM 52
#endif
constexpr int DN_ITEMS = (FF / 64) * (DM / 64), DN_SPLIT = TAILFILL ? (DN_ITEMS * DN_NUM) / 100 : 0;
#ifndef SPLIT_CONV
#define SPLIT_CONV 1
#endif
#ifdef PROBE_XCC
    if (tid == 0) __hip_atomic_store(ctl + 2048 + bx, 1u + xb_xcc_id(), RLX_AGENT);
#endif
    STAMP(0);
    if (IN(0)) _Pragma("unroll") for (int rep = 0; rep < NREP(0); ++rep) { if (rep) xcd_barrier(bar);
        LAS unsigned* scr = (LAS unsigned*)(ldsl + RING_OFF + wave * 16384);
#pragma unroll 1
#if JIT_CONV
        for (int m = gw; m < MROWS; m += NGW) xrow_to_bf16(x_in + (size_t)m * DM, XN + (size_t)m * DM, PART + (size_t)m * pg8::NPART, lane);
        CONVERT_MAT(0);
    }
#else
        for (int mo = 0; mo < (SPLIT_CONV ? 4 : 8); ++mo) { const int mi = SPLIT_CONV ? ((mo + 1) & 3) : ((mo + 1) & 7); const MatDesc md = mat_desc(mi);
            if (mi == 0) { for (int m = gw; m < MROWS; m += NGW) xrow_to_bf16(x_in + (size_t)m * DM, XN + (size_t)m * DM, PART + (size_t)m * pg8::NPART, lane); }
            const float* W = args.in[md.in_idx] + md.in_off; const float* gain = md.gain_idx >= 0 ? args.in[md.gain_idx] + md.gain_off : nullptr;
            bf16* WT = (bf16*)(ws + md.ws_off); const int nitems = (md.K / 64) * (md.N / 64);
            for (int it = gw; it < nitems; it += NGW) transpose_item(W, gain, md.K, md.N, WT, scr, it, lane, md.gateperm != 0); }
    }
#endif
    SEAM(0);
    if (IN(1)) _Pragma("unroll") for (int rep = 0; rep < NREP(1); ++rep) { if (rep) xcd_barrier(bar);
        pg8::Gemm g{XN, (const bf16*)(ws + WS_WQKV0), MROWS, NQKV, DM}; pg8::StaticOrder S; S.init(MROWS, NQKV, G, bx);
        pg8::EpiScale E{QKV, NQKV, PART, 1.f / DM, RMS_EPS, DM, QSCALE, (LAS float*)(ldsl + RS_OFF)};
        RS_TAG_RESET();
        pg8::gemm_phase<pg8::EpiScale, pg8::StaticOrder, PG8_ALIGN, PG8_SP2>(ldsl + RING_OFF, g, S, E);
    }
    SEAM(1);
    if (IN(2)) _Pragma("unroll") for (int rep = 0; rep < NREP(2); ++rep) { if (rep) xcd_barrier(bar);
        constexpr int NBLK = BATCH * SB_H * (SEQ / 256);
        for (int L = bx; L < NBLK; L += G) { const int qb = L % 16, bh = L / 16, b = bh / SB_H, h = bh % SB_H;
            const bf16* kvbase = QKV + (size_t)(b * SEQ) * NQKV + h * HD;
            att::sb_block<NQKV, NQKV, NQKV, DM>(kvbase + (size_t)(qb * 256) * NQKV, kvbase + DM, kvbase + 2 * DM, AO + (size_t)(b * SEQ + qb * 256) * DM + h * HD, qb * 256, (char*)lds + RING_OFF, (volatile LAS unsigned*)(ldsl + RING_OFF + 65536)); }
        if (JIT_CONV) CONVERT_MAT(1);
    }
    SEAM(2);
    if (IN(3)) _Pragma("unroll") for (int rep = 0; rep < NREP(3); ++rep) { if (rep) xcd_barrier(bar);
        pg8::Gemm g{AO, (const bf16*)(ws + WS_WO0), MROWS, DM, DM}; pg8::StaticOrder S; S.init(MROWS, DM, G, bx);
        pg8::EpiResid<false, false> E{nullptr, nullptr, XN, PART, DM};
        pg8::gemm_phase<pg8::EpiResid<false, false>, pg8::StaticOrder, PG8_ALIGN, PG8_SP2>(ldsl + RING_OFF, g, S, E);
        if (JIT_CONV) CONVERT_MAT(2);
    }
    SEAM(3);
#define UP_PHASE(WOFF, LAYER) do { pg8::Gemm g{XN, (const bf16*)(ws + (WOFF)), MROWS, FF2, DM}; pg8::StaticOrder S; S.init(MROWS, FF2, G, bx); \
        pg8::EpiConvGate E{ACT, FF, PART, 1.f / DM, RMS_EPS, args.in[15] + (size_t)(LAYER) * 3 * FF2, args.in[16] + (size_t)(LAYER) * FF2, HALO, (LAS float*)(ldsl + RS_OFF)}; RS_TAG_RESET(); \
        pg8::gemm_phase<pg8::EpiConvGate, pg8::StaticOrder, PG8_ALIGN, PG8_SP2>(ldsl + RING_OFF, g, S, E); } while (0)
#define CG_PHASE(LAYER) do { const float* cw = args.in[15] + (size_t)(LAYER) * 3 * FF2; const float* cb = args.in[16] + (size_t)(LAYER) * FF2; \
        for (int it = bx * (NWAVES * 64) + tid; it < FX_ITEMS; it += G * NWAVES * 64) fixup_item(HALO, cw, cb, ACT, it); } while (0)
#ifndef DOWN_WGM
#define DOWN_WGM 8
#endif
#define DOWN_PHASE(WOFF, OUT, LAST) do { pg8::Gemm g{ACT, (const bf16*)(ws + (WOFF)), MROWS, DM, FF}; pg8::StaticOrder S; S.init(MROWS, DM, G, bx, DOWN_WGM); \
        pg8::EpiResid<false, LAST> E{nullptr, OUT, XN, PART, DM}; \
        pg8::gemm_phase<pg8::EpiResid<false, LAST>, pg8::StaticOrder, PG8_ALIGN, PG8_SP2>(ldsl + RING_OFF, g, S, E); } while (0)
    const int up_units = (MROWS / 256) * (FF2 / 256), up_full = up_units % G;
    if (IN(4)) _Pragma("unroll") for (int rep = 0; rep < NREP(4); ++rep) { if (rep) xcd_barrier(bar); UP_PHASE(WS_WUP0, 0); if (JIT_CONV && TAILFILL && up_full && bx >= up_full) CONVERT_MAT_RANGE(3, 0, DN_SPLIT, up_full); }
    SEAM(4);
    if (IN(5)) _Pragma("unroll") for (int rep = 0; rep < NREP(5); ++rep) { if (rep) xcd_barrier(bar); CG_PHASE(0); if (JIT_CONV) { if (TAILFILL && up_full) CONVERT_MAT_RANGE(3, DN_SPLIT, DN_ITEMS, 0); else CONVERT_MAT(3); } }
    SEAM(5);
    if (IN(6)) { DOWN_PHASE(WS_WDN0, nullptr, false); for (int rep = 1; rep < NREP(6); ++rep) { xcd_barrier(bar); DOWN_PHASE(WS_WDN0, DUMMY, true); } if (JIT_CONV) CONVERT_MAT(4); }
    SEAM(6);
#ifdef PROBE_LATE_QKV
    { pg8::Gemm g{XN, (const bf16*)(ws + WS_WQKV0), MROWS, NQKV, DM}; pg8::StaticOrder S; S.init(MROWS, NQKV, G, bx);
      pg8::EpiScale E{QKV, NQKV, PART, 1.f / DM, RMS_EPS, DM, QSCALE, (LAS float*)(ldsl + RS_OFF)};
      pg8::gemm_phase<pg8::EpiScale, pg8::StaticOrder, PG8_ALIGN, PG8_SP2>(ldsl + RING_OFF, g, S, E); xcd_barrier(bar); }
#if PROBE_LATE_QKV == 2
    { pg8::Gemm g{XN, (const bf16*)(ws + WS_WQKV0), MROWS, NQKV, DM}; pg8::StaticOrder S; S.init(MROWS, NQKV, G, bx);
      pg8::EpiScale E{QKV, NQKV, PART, 1.f / DM, RMS_EPS, DM, QSCALE, (LAS float*)(ldsl + RS_OFF)};
      pg8::gemm_phase<pg8::EpiScale, pg8::StaticOrder, PG8_ALIGN, PG8_SP2>(ldsl + RING_OFF, g, S, E); xcd_barrier(bar); }
#endif
#endif
    if (IN(7)) _Pragma("unroll") for (int rep = 0; rep < NREP(7); ++rep) { if (rep) xcd_barrier(bar);
        pg8::Gemm g{XN, (const bf16*)(ws + WS_WQKV1), MROWS, NQKV, DM}; pg8::StaticOrder S; S.init(MROWS, NQKV, G, bx);
        pg8::EpiScale E{QKV, NQKV, PART, 1.f / DM, RMS_EPS, 0, 1.f, (LAS float*)(ldsl + RS_OFF)};
        RS_TAG_RESET();
        pg8::gemm_phase<pg8::EpiScale, pg8::StaticOrder, PG8_ALIGN, PG8_SP2>(ldsl + RING_OFF, g, S, E);
    }
    SEAM(7);
    if (IN(8)) _Pragma("unroll") for (int rep = 0; rep < NREP(8); ++rep) { if (rep) xcd_barrier(bar);
#ifdef QKN_FAST
        qknorm_rows(QKV, QKN, args.in[6], args.in[7], gw, NGW, lane); }
#else
        for (int m = gw; m < MROWS; m += NGW) qknorm_row(QKV + (size_t)m * NQKV, QKN + (size_t)m * 8192, args.in[6], args.in[7], m % SEQ, lane); }
#endif
    SEAM(8);
    if (IN(9)) _Pragma("unroll") for (int rep = 0; rep < NREP(9); ++rep) { if (rep) xcd_barrier(bar);
        float lam, omli;
        { const float a1 = wave_sum(args.in[8][lane] * args.in[9][lane] + args.in[8][lane + 64] * args.in[9][lane + 64]);
          const float a2 = wave_sum(args.in[10][lane] * args.in[11][lane] + args.in[10][lane + 64] * args.in[11][lane + 64]);
          const float li = 0.8f - 0.6f * 0.7408182206817179f;
          lam = __expf(a1) - __expf(a2) + li; omli = 1.f - li; }
        float mq = fmaxf(fabsf(args.in[6][lane]), fabsf(args.in[6][lane + 64])), mk = fmaxf(fabsf(args.in[7][lane]), fabsf(args.in[7][lane + 64]));
#pragma unroll
        for (int o_ = 1; o_ < 64; o_ <<= 1) { mq = fmaxf(mq, __shfl_xor(mq, o_)); mk = fmaxf(mk, __shfl_xor(mk, o_)); }
        att::Diff2Const C{lam, omli, RMS_EPS, QSCALE * 128.f * mq * mk * 1.02f, args.in[12]};
        constexpr int NITEM = BATCH * DF_H * 16;
        for (int w = bx; w < NITEM; w += G) {
            const int bh = (w & 7) * 4 + ((w >> 3) >> 4), xq = (w >> 3) & 15, b = bh / DF_H, h = bh % DF_H;
            const bf16* qn = QKN + (size_t)(b * SEQ) * 8192 + h * 256; const bf16* vb = QKV + (size_t)(b * SEQ) * NQKV + 2 * DM + h * 256;
#pragma unroll 1
            for (int ps = 0; ps < 2; ++ps) { const int qb = ps ? 31 - xq : xq;
                att::diff2_block<8192, 8192, NQKV, DM>(qn + (size_t)(qb * 128) * 8192, qn + 4096, vb, AO + (size_t)(b * SEQ + qb * 128) * DM + h * 256, qb * 128, C, (char*)lds + RING_OFF); }
        }
        if (JIT_CONV) CONVERT_MAT(5);
    }
    SEAM(9);
    if (IN(10)) {
        pg8::Gemm g{AO, (const bf16*)(ws + WS_WO1), MROWS, DM, DM}; pg8::StaticOrder S; S.init(MROWS, DM, G, bx);
        pg8::EpiResid<false, false> E{nullptr, nullptr, XN, PART, DM};
        pg8::gemm_phase<pg8::EpiResid<false, false>, pg8::StaticOrder, PG8_ALIGN, PG8_SP2>(ldsl + RING_OFF, g, S, E);
        if (JIT_CONV) CONVERT_MAT(6);
    }
    SEAM(10);
    if (IN(11)) { UP_PHASE(WS_WUP1, 1); if (JIT_CONV && TAILFILL && up_full && bx >= up_full) CONVERT_MAT_RANGE(7, 0, DN_SPLIT, up_full); }
    SEAM(11);
    if (IN(12)) { CG_PHASE(1); if (JIT_CONV) { if (TAILFILL && up_full) CONVERT_MAT_RANGE(7, DN_SPLIT, DN_ITEMS, 0); else CONVERT_MAT(7); } }
    SEAM(12);
    if (IN(13)) DOWN_PHASE(WS_WDN1, args.out, true);
#ifdef PROBE_XCC
    { xcd_barrier(bar);
      if (bx == 0 && tid == 0) { unsigned bad = 0; for (int i = 0; i < G; ++i) { const unsigned xi = __hip_atomic_load(ctl + 2048 + i, RLX_AGENT), xr = __hip_atomic_load(ctl + 2048 + (i & 7), RLX_AGENT); if (xi != xr || xi == 0u) ++bad; }
          for (int r = 0; r < 8; ++r) for (int q = r + 1; q < 8; ++q) if (__hip_atomic_load(ctl + 2048 + r, RLX_AGENT) == __hip_atomic_load(ctl + 2048 + q, RLX_AGENT)) bad += 1000;
          if (bad) args.out[0] = 1000.f * (float)bad; } }
#endif
    if (LEAK_A >= 0) { xcd_barrier(bar); STAMP(14); if (bx == 0 && tid == 0) args.out[0] = 1000.f * ((float)(long long)(tB - tA) * 0.01f - (float)(LEAK_OFF)); }
#undef IN
#undef SEAM
}
#if MK_CHECK
#include "check.inc"
#endif
extern "C" void kernel_launch(void* const* d_in, const int* in_sizes, int n_in, void* d_out, int out_size, void* d_ws, size_t ws_size, hipStream_t stream) {
    static int grid = 0;
    if (grid == 0) {
        if (n_in != 18 || in_sizes[0] != MROWS * DM || out_size != MROWS * DM || ws_size < WS_END) {
            fprintf(stderr, "kernel_launch: built for 18 inputs, x/out of %d floats, >= %zu bytes of workspace; got n_in %d, in0 %d, out %d, ws %zu; nothing launched\n", MROWS * DM, (size_t)WS_END, n_in, n_in > 0 ? in_sizes[0] : -1, out_size, ws_size); grid = -1; return; }
        int dev = 0, cus = 0, per_cu = 0;
        if (hipGetDevice(&dev) != hipSuccess || hipDeviceGetAttribute(&cus, hipDeviceAttributeMultiprocessorCount, dev) != hipSuccess) { fprintf(stderr, "kernel_launch: device query failed\n"); grid = -1; return; }
        if (hipFuncSetAttribute((const void*)mk_fwd, hipFuncAttributeMaxDynamicSharedMemorySize, LDS_BYTES) != hipSuccess) { fprintf(stderr, "kernel_launch: hipFuncSetAttribute failed\n"); grid = -1; return; }
        if (hipOccupancyMaxActiveBlocksPerMultiprocessor(&per_cu, (const void*)mk_fwd, NWAVES * 64, LDS_BYTES) != hipSuccess || per_cu < 1)
            fprintf(stderr, "kernel_launch: note: occupancy query reports %d workgroups per CU\n", per_cu);
        (void)hipGetLastError();
        grid = cus;
    }
    if (grid < 0) return;
    if (hipMemsetAsync((char*)d_ws + WS_CTL, 0, CTL_ZERO_BYTES, stream) != hipSuccess) { fprintf(stderr, "kernel_launch: memset failed\n"); return; }
    Args a{};
    for (int i = 0; i < 18; ++i) a.in[i] = (const float*)d_in[i];
    a.out = (float*)d_out; a.ws = (unsigned char*)d_ws;
#if MK_CHECK
    for (int p = 0; p < NPH; ++p) { a.ph_lo = p; a.ph_hi = p + 1;
        hipLaunchKernelGGL(mk_fwd, dim3(grid), dim3(NWAVES * 64), LDS_BYTES, stream, a);
        hipLaunchKernelGGL(mk_check, dim3(256), dim3(256), 0, stream, a, p); }
    hipLaunchKernelGGL(mk_report, dim3(1), dim3(64), 0, stream, a);
#elif MK_SPLIT
    for (int p = 0; p < NPH; ++p) { a.ph_lo = p; a.ph_hi = p + 1; hipLaunchKernelGGL(mk_fwd, dim3(grid), dim3(NWAVES * 64), LDS_BYTES, stream, a); }
#else
    a.ph_lo = 0; a.ph_hi = NPH;
    hipLaunchKernelGGL(mk_fwd, dim3(grid), dim3(NWAVES * 64), LDS_BYTES, stream, a);
#ifdef PROBE_TWICE
    (void)hipMemsetAsync((char*)d_ws + WS_CTL, 0, CTL_ZERO_BYTES, stream);
    hipLaunchKernelGGL(mk_fwd, dim3(grid), dim3(NWAVES * 64), LDS_BYTES, stream, a);
#endif
#endif
    const hipError_t le = hipPeekAtLastError();
    if (le != hipSuccess) fprintf(stderr, "kernel_launch: launch failed: %s\n", hipGetErrorName(le));
}
```

```cpp
#define PRIO_BEFORE_BAR 1
#define RS_LDS 1
#define RESID_PERM 1
#define QKN_FAST 1
#define RS_REUSE 1
#define CONVW_PF 1
#include <hip/hip_runtime.h>
#include <cstdio>
#include <cstdint>
namespace pg8 {
__device__ __forceinline__ int tid_opaque() { int t = (int)threadIdx.x; asm volatile("" : "+v"(t)); return t; }
#define PG8_LAS __attribute__((address_space(3)))
typedef unsigned short bf16_t;
typedef short bf16x8 __attribute__((ext_vector_type(8)));
typedef float f32x4 __attribute__((ext_vector_type(4)));
typedef unsigned u32x4 __attribute__((ext_vector_type(4)));
constexpr int BM = 256, BK = 64, HALF = 128, HTB = HALF * BK * 2  , STAGE_BYTES = 8 * HTB, NXCD = 8, WGM = 8;

__host__ __device__ __forceinline__ int lds_byte(int r, int c) { const int st = (r >> 4) * 2 + (c >> 5), rr = r & 15, cc = c & 31, ob = rr * 64 + cc * 2; return st * 1024 + (ob ^ (((ob >> 9) & 1) << 5)); }
__host__ __device__ __forceinline__ void stage_rc(int b, int& R, int& C) { const int st = b / 1024, sb = b % 1024, swz = sb ^ (((sb >> 9) & 1) << 5); R = (st >> 1) * 16 + swz / 64; C = (st & 1) * 32 + (swz % 64) / 2; }
__host__ __device__ __forceinline__ int perm32(int rho) { const int n = rho >> 4, i = rho & 15; return 8 * (i >> 2) + 4 * n + (i & 3); }

struct Unit { int pm, pn, seq; };
struct Gemm { const bf16_t* A; const bf16_t* Bt; int M, N, K; };

struct StaticOrder {
    int nM, nN, nwg, G, c, wgm;
    __host__ __device__ void init(int M, int N, int G_, int c_, int wgm_ = WGM) { nM = M / BM; nN = N / BM; nwg = nM * nN; G = G_; c = c_; wgm = wgm_; }
    __host__ __device__ bool next(int i, Unit& u) const {
        const long L = (long)i * G + c; if (L >= nwg) return false;
        int wgid = (int)L; { const int q = nwg / NXCD, r = nwg % NXCD, xcd = wgid % NXCD, off = wgid / NXCD; wgid = (xcd < r ? xcd * (q + 1) : r * (q + 1) + (xcd - r) * q) + off; }
        const int nig = wgm * nN, gid = wgid / nig, fm = gid * wgm, gsz = (nM - fm) < wgm ? (nM - fm) : wgm;
        u.pm = fm + ((wgid % nig) % gsz); u.pn = (wgid % nig) / gsz; return true;
    }
    __device__ __forceinline__ void a_ready(const Unit&) const {}
    __device__ __forceinline__ void done(const Unit&) const {}
};
struct RangeOrder : StaticOrder {
    int i0, i1;
    __host__ __device__ bool next(int i, Unit& u) const { return (i0 + i < i1) && StaticOrder::next(i0 + i, u); }
};


__device__ __forceinline__ unsigned cvt_pk_bf16(float lo, float hi) { unsigned r; asm volatile("v_cvt_pk_bf16_f32 %0, %1, %2" : "=v"(r) : "v"(lo), "v"(hi)); return r; }

constexpr int NPART = 64;

struct NoStage { __device__ __forceinline__ void operator()() const {} };
template <class Stage = NoStage>
__device__ __forceinline__ void row_scales_lds(float (&rs)[2][4], PG8_LAS float* rl, const float* part, int urow0  , float inv_k, float eps, int wr, int wc, int fr, int fq, const Stage& stage = Stage()) {
    stage();
#ifdef RS_REUSE
    const int tag = __builtin_amdgcn_readfirstlane(((const PG8_LAS int*)rl)[256]);
    if (tag != urow0) {
#endif
#pragma unroll
    for (int ai = 0; ai < 2; ++ai) { const int lr = ai * HALF + wr * 64 + wc * 16 + fr;
        const f32x4* pp = (const f32x4*)(part + (size_t)(urow0 + lr) * NPART + fq * 16);
        const f32x4 a = pp[0], b = pp[1], c = pp[2], d = pp[3];
        float s = ((a[0] + a[1]) + (a[2] + a[3])) + ((b[0] + b[1]) + (b[2] + b[3])) + (((c[0] + c[1]) + (c[2] + c[3])) + ((d[0] + d[1]) + (d[2] + d[3])));
        s += __shfl_xor(s, 16); s += __shfl_xor(s, 32);
        if (fq == 0) rl[lr] = rsqrtf(s * inv_k + eps); }
    asm volatile("s_waitcnt lgkmcnt(0)" ::: "memory");
    __builtin_amdgcn_s_barrier();
#ifdef RS_REUSE
        if (wr == 0 && wc == 0 && fr == 0 && fq == 0) ((PG8_LAS int*)rl)[256] = urow0;
    }
#endif
#pragma unroll
    for (int ai = 0; ai < 2; ++ai)
#pragma unroll
        for (int m = 0; m < 4; ++m) rs[ai][m] = rl[ai * HALF + wr * 64 + m * 16 + fr];
}

struct EpiScale {
    static constexpr int TWICE_OK = 1, NSTORE = 16;
    __device__ __forceinline__ void prefetch(const Unit&) const {}
    static constexpr bool PERM = true, AFTER_DRAIN = false;
    bf16_t* O; int ldc; const float* part; float inv_k; float eps; int qcols; float qs; PG8_LAS float* rl;
    __device__ __forceinline__ void operator()(const f32x4 (&acc)[2][2][4][2], const Unit& u, int wr, int wc, int fr, int fq) const {
        const int row0 = u.pm * BM + wr * 64 + fr; const int col0 = u.pn * BM + wc * 32 + 8 * fq;
        const float sc = (u.pn * BM < qcols) ? qs : 1.f;
#ifdef RS_LDS
        float rsl[2][4]; row_scales_lds(rsl, rl, part, u.pm * BM, inv_k, eps, wr, wc, fr, fq);
#endif
#pragma unroll
        for (int ai = 0; ai < 2; ++ai)
#pragma unroll
            for (int m = 0; m < 4; ++m) {
                const int row = row0 + ai * HALF + m * 16;
#ifdef RS_LDS
                const float r = rsl[ai][m] * sc;
#else
                const f32x4* pp = (const f32x4*)(part + (size_t)row * NPART + fq * 16);
                const f32x4 a = pp[0], b = pp[1], c = pp[2], d = pp[3];
                float s = ((a[0] + a[1]) + (a[2] + a[3])) + ((b[0] + b[1]) + (b[2] + b[3])) + (((c[0] + c[1]) + (c[2] + c[3])) + ((d[0] + d[1]) + (d[2] + d[3])));
                s += __shfl_xor(s, 16); s += __shfl_xor(s, 32);
                const float r = rsqrtf(s * inv_k + eps) * sc;
#endif
                bf16_t* rowp = O + (size_t)row * ldc + col0;
#pragma unroll
                for (int bj = 0; bj < 2; ++bj) { const f32x4 v0 = acc[ai][bj][m][0] * r, v1 = acc[ai][bj][m][1] * r;
                    u32x4 w; w.x = cvt_pk_bf16(v0[0], v0[1]); w.y = cvt_pk_bf16(v0[2], v0[3]); w.z = cvt_pk_bf16(v1[0], v1[1]); w.w = cvt_pk_bf16(v1[2], v1[3]);
                    *(u32x4*)(rowp + bj * HALF) = w; }
            }
    }
};

#ifndef RESID_HOIST
#define RESID_HOIST 0
#endif
#ifndef RESID_PERM
#define RESID_PERM 0
#endif
template <bool BASE_F32, bool OUT_F32> struct EpiResid {
    static constexpr int TWICE_OK = 0, NSTORE = 16;
    __device__ __forceinline__ void prefetch(const Unit&) const {}
    static constexpr bool PERM = RESID_PERM != 0, AFTER_DRAIN = false;
    const float* basef; float* outf; bf16_t* xn; float* part; int ldc;
    __device__ __forceinline__ void operator()(const f32x4 (&acc)[2][2][4][2], const Unit& u, int wr, int wc, int fr, int fq) const {
        typedef unsigned u32x2v __attribute__((ext_vector_type(2)));
        const int row0 = u.pm * BM + wr * 64 + fr; const int col0 = u.pn * BM + wc * 32 + (PERM ? 8 : 4) * fq;
        u32x4 bpre[2][4][2];
        if constexpr (PERM && RESID_HOIST && !BASE_F32) {
#pragma unroll
            for (int ai = 0; ai < 2; ++ai)
#pragma unroll
                for (int m = 0; m < 4; ++m)
#pragma unroll
                    for (int bj = 0; bj < 2; ++bj) bpre[ai][m][bj] = *(const u32x4*)(xn + (size_t)(row0 + ai * HALF + m * 16) * ldc + col0 + bj * HALF);
        }
#pragma unroll
        for (int ai = 0; ai < 2; ++ai)
#pragma unroll
            for (int m = 0; m < 4; ++m) {
                const int row = row0 + ai * HALF + m * 16; const size_t off = (size_t)row * ldc + col0; float ss = 0.f;
                if constexpr (PERM) {
#pragma unroll
                    for (int bj = 0; bj < 2; ++bj) { const size_t o2 = off + bj * HALF;
                        f32x4 b0, b1;
                        if (BASE_F32) { b0 = *(const f32x4*)(basef + o2); b1 = *(const f32x4*)(basef + o2 + 4); }
                        else { const u32x4 b = RESID_HOIST ? bpre[ai][m][bj] : *(const u32x4*)(xn + o2);
                            b0[0] = __builtin_bit_cast(float, b.x << 16); b0[1] = __builtin_bit_cast(float, b.x & 0xffff0000u); b0[2] = __builtin_bit_cast(float, b.y << 16); b0[3] = __builtin_bit_cast(float, b.y & 0xffff0000u);
                            b1[0] = __builtin_bit_cast(float, b.z << 16); b1[1] = __builtin_bit_cast(float, b.z & 0xffff0000u); b1[2] = __builtin_bit_cast(float, b.w << 16); b1[3] = __builtin_bit_cast(float, b.w & 0xffff0000u); }
                        const f32x4 o0 = b0 + acc[ai][bj][m][0], o1 = b1 + acc[ai][bj][m][1];
                        if (OUT_F32) { *(f32x4*)(outf + o2) = o0; *(f32x4*)(outf + o2 + 4) = o1; }
                        else { u32x4 w; w.x = cvt_pk_bf16(o0[0], o0[1]); w.y = cvt_pk_bf16(o0[2], o0[3]); w.z = cvt_pk_bf16(o1[0], o1[1]); w.w = cvt_pk_bf16(o1[2], o1[3]); *(u32x4*)(xn + o2) = w;
                            ss += ((o0[0] * o0[0] + o0[1] * o0[1]) + (o0[2] * o0[2] + o0[3] * o0[3])) + ((o1[0] * o1[0] + o1[1] * o1[1]) + (o1[2] * o1[2] + o1[3] * o1[3])); } }
                } else {
#pragma unroll
                for (int bj = 0; bj < 2; ++bj)
#pragma unroll
                    for (int n = 0; n < 2; ++n) { const size_t o2 = off + bj * HALF + n * 16;
                        f32x4 bs;
                        if (BASE_F32) bs = *(const f32x4*)(basef + o2);
                        else { const u32x2v b = *(const u32x2v*)(xn + o2); bs[0] = __builtin_bit_cast(float, b.x << 16); bs[1] = __builtin_bit_cast(float, b.x & 0xffff0000u); bs[2] = __builtin_bit_cast(float, b.y << 16); bs[3] = __builtin_bit_cast(float, b.y & 0xffff0000u); }
                        const f32x4 o = bs + acc[ai][bj][m][n];
                        if (OUT_F32) *(f32x4*)(outf + o2) = o;
                        else { u32x2v w; w.x = cvt_pk_bf16(o[0], o[1]); w.y = cvt_pk_bf16(o[2], o[3]); *(u32x2v*)(xn + o2) = w;
                            ss += (o[0] * o[0] + o[1] * o[1]) + (o[2] * o[2] + o[3] * o[3]); } }
                }
                if (!OUT_F32) { ss += __shfl_xor(ss, 16); ss += __shfl_xor(ss, 32); if (fq == 0) part[(size_t)row * NPART + u.pn * 4 + wc] = ss; }
            }
    }
};

struct EpiResidRT {
    static constexpr int TWICE_OK = 0, NSTORE = 16;
    __device__ __forceinline__ void prefetch(const Unit&) const {}
    static constexpr bool PERM = false, AFTER_DRAIN = false;
    float* outf; bf16_t* xn; float* part; int ldc;
    __device__ __forceinline__ void operator()(const f32x4 (&acc)[2][2][4][2], const Unit& u, int wr, int wc, int fr, int fq) const {
        typedef unsigned u32x2v __attribute__((ext_vector_type(2)));
        const int row0 = u.pm * BM + wr * 64 + fr; const int col0 = u.pn * BM + wc * 32 + 4 * fq; const bool last = outf != nullptr;
#pragma unroll
        for (int ai = 0; ai < 2; ++ai)
#pragma unroll
            for (int m = 0; m < 4; ++m) {
                const int row = row0 + ai * HALF + m * 16; const size_t off = (size_t)row * ldc + col0; float ss = 0.f;
#pragma unroll
                for (int bj = 0; bj < 2; ++bj)
#pragma unroll
                    for (int n = 0; n < 2; ++n) { const size_t o2 = off + bj * HALF + n * 16;
                        const u32x2v b = *(const u32x2v*)(xn + o2); f32x4 bs; bs[0] = __builtin_bit_cast(float, b.x << 16); bs[1] = __builtin_bit_cast(float, b.x & 0xffff0000u); bs[2] = __builtin_bit_cast(float, b.y << 16); bs[3] = __builtin_bit_cast(float, b.y & 0xffff0000u);
                        const f32x4 o = bs + acc[ai][bj][m][n];
                        if (last) *(f32x4*)(outf + o2) = o;
                        else { u32x2v w; w.x = cvt_pk_bf16(o[0], o[1]); w.y = cvt_pk_bf16(o[2], o[3]); *(u32x2v*)(xn + o2) = w; }
                        ss += (o[0] * o[0] + o[1] * o[1]) + (o[2] * o[2] + o[3] * o[3]); }
                if (!last) { ss += __shfl_xor(ss, 16); ss += __shfl_xor(ss, 32); if (fq == 0) part[(size_t)row * NPART + u.pn * 4 + wc] = ss; }
            }
    }
};

__device__ __forceinline__ float dpp_ror1(float v) { return __builtin_bit_cast(float, __builtin_amdgcn_update_dpp(0, __builtin_bit_cast(int, v), 0x121, 0xf, 0xf, false)); }
__device__ __forceinline__ float dpp_ror2(float v) { return __builtin_bit_cast(float, __builtin_amdgcn_update_dpp(0, __builtin_bit_cast(int, v), 0x122, 0xf, 0xf, false)); }
__device__ __forceinline__ float dpp_shr1(float old, float v) { return __builtin_bit_cast(float, __builtin_amdgcn_update_dpp(__builtin_bit_cast(int, old), __builtin_bit_cast(int, v), 0x111, 0xf, 0xf, false)); }
__device__ __forceinline__ float dpp_shr2(float old, float v) { return __builtin_bit_cast(float, __builtin_amdgcn_update_dpp(__builtin_bit_cast(int, old), __builtin_bit_cast(int, v), 0x112, 0xf, 0xf, false)); }
__device__ __forceinline__ void conv_taps(float& acc, float cur, float prev, float w1, float w0) {
    asm("s_nop 1\n\t"
        "v_fmac_f32_dpp %0, %1, %3 row_shr:1 row_mask:0xf bank_mask:0xf\n\t"
        "v_fmac_f32_dpp %0, %1, %4 row_shr:2 row_mask:0xf bank_mask:0xf\n\t"
        "v_fmac_f32_dpp %0, %2, %3 row_shl:15 row_mask:0xf bank_mask:0xf\n\t"
        "v_fmac_f32_dpp %0, %2, %4 row_shl:14 row_mask:0xf bank_mask:0xf"
        : "+v"(acc) : "v"(cur), "v"(prev), "v"(w1), "v"(w0));
}
template <int CTRL> __device__ __forceinline__ float dppz(float v) { return __builtin_bit_cast(float, __builtin_amdgcn_update_dpp(0, __builtin_bit_cast(int, v), CTRL, 0xf, 0xf, true)); }
struct EpiConvGate {
    static constexpr int TWICE_OK = 2, NSTORE = 8;
    __device__ __forceinline__ void prefetch(const Unit& u) const {
#ifdef CONVW_PF
        const int t = tid_opaque();
        if (t < 256) { const int arr = t >> 5, q = t & 31, half = arr >> 2, k = arr & 3;
            const float* src = (k < 3 ? cw + (size_t)k * 2 * ff : cb) + half * ff + u.pn * HALF + 4 * q;
            __builtin_amdgcn_global_load_lds((const unsigned*)src, (PG8_LAS unsigned*)(rl + 272 + (u.seq & 1) * 1024 + (t >> 6) * 256), 16, 0, 0); }
#endif
    }
    static constexpr bool PERM = true, AFTER_DRAIN = false;
    bf16_t* ACT; int ff; const float* part; float inv_k; float eps; const float* cw; const float* cb; float* halo; PG8_LAS float* rl;
    __device__ __forceinline__ void operator()(const f32x4 (&acc)[2][2][4][2], const Unit& u, int wr, int wc, int fr, int fq) const {
        typedef unsigned u32x2v __attribute__((ext_vector_type(2)));
        const int ff2 = 2 * ff;
        const int row0 = u.pm * BM + wr * 64 + fr; const int ch0 = u.pn * HALF + wc * 32 + 8 * fq;
        float rs[2][4];
#if defined(RS_LDS) && defined(CONVW_LDS)
        PG8_LAS float* wl = rl + 256;
        { const float* cwp = cw; const float* cbp = cb; const int chb = u.pn * HALF, ffv = ff;
          row_scales_lds(rs, rl, part, u.pm * BM, inv_k, eps, wr, wc, fr, fq, [=]() { const int t = wr * 256 + wc * 64 + fq * 16 + fr;
              if (t < 256) { const int arr = t >> 5, q = t & 31; const int half = arr >> 2, k = arr & 3;
                  const float* src = (k < 3 ? cwp + (size_t)k * 2 * ffv : cbp) + half * ffv + chb + 4 * q;
                  *(PG8_LAS f32x4*)(wl + arr * 128 + 4 * q) = *(const f32x4*)src; } }); }
#elif defined(RS_LDS)
        row_scales_lds(rs, rl, part, u.pm * BM, inv_k, eps, wr, wc, fr, fq);
#else
#pragma unroll
        for (int ai = 0; ai < 2; ++ai)
#pragma unroll
            for (int m = 0; m < 4; ++m) { const int row = row0 + ai * HALF + m * 16;
                const f32x4* pp = (const f32x4*)(part + (size_t)row * NPART + fq * 16);
                const f32x4 a = pp[0], b = pp[1], c = pp[2], d = pp[3];
                float s = ((a[0] + a[1]) + (a[2] + a[3])) + ((b[0] + b[1]) + (b[2] + b[3])) + (((c[0] + c[1]) + (c[2] + c[3])) + ((d[0] + d[1]) + (d[2] + d[3])));
                s += __shfl_xor(s, 16); s += __shfl_xor(s, 32);
                rs[ai][m] = rsqrtf(s * inv_k + eps); }
#endif
        u32x2v lo[2][4];
#pragma unroll
        for (int n = 0; n < 2; ++n) {
            const int ch = ch0 + 4 * n;
#if defined(RS_LDS) && defined(CONVW_PF)
            const PG8_LAS float* wl = rl + 272 + (u.seq & 1) * 1024; const int cl = wc * 32 + 8 * fq + 4 * n;
            const f32x4 wg0 = *(const PG8_LAS f32x4*)(wl + cl), wg1 = *(const PG8_LAS f32x4*)(wl + 128 + cl), wg2 = *(const PG8_LAS f32x4*)(wl + 256 + cl), bg = *(const PG8_LAS f32x4*)(wl + 384 + cl);
            const f32x4 wv0 = *(const PG8_LAS f32x4*)(wl + 512 + cl), wv1 = *(const PG8_LAS f32x4*)(wl + 640 + cl), wv2 = *(const PG8_LAS f32x4*)(wl + 768 + cl), bv = *(const PG8_LAS f32x4*)(wl + 896 + cl);
#elif defined(RS_LDS) && defined(CONVW_LDS)
            const int cl = wc * 32 + 8 * fq + 4 * n;
            const f32x4 wg0 = *(const PG8_LAS f32x4*)(wl + cl), wg1 = *(const PG8_LAS f32x4*)(wl + 128 + cl), wg2 = *(const PG8_LAS f32x4*)(wl + 256 + cl), bg = *(const PG8_LAS f32x4*)(wl + 384 + cl);
            const f32x4 wv0 = *(const PG8_LAS f32x4*)(wl + 512 + cl), wv1 = *(const PG8_LAS f32x4*)(wl + 640 + cl), wv2 = *(const PG8_LAS f32x4*)(wl + 768 + cl), bv = *(const PG8_LAS f32x4*)(wl + 896 + cl);
#else
            const f32x4 wg0 = *(const f32x4*)(cw + ch), wg1 = *(const f32x4*)(cw + ff2 + ch), wg2 = *(const f32x4*)(cw + 2 * ff2 + ch), bg = *(const f32x4*)(cb + ch);
            const f32x4 wv0 = *(const f32x4*)(cw + ff + ch), wv1 = *(const f32x4*)(cw + ff2 + ff + ch), wv2 = *(const f32x4*)(cw + 2 * ff2 + ff + ch), bv = *(const f32x4*)(cb + ff + ch);
#endif
#pragma unroll
            for (int ai = 0; ai < 2; ++ai) {
                f32x4 gq = {0.f, 0.f, 0.f, 0.f}, vq = gq;
                const int grp = (u.pm * BM + ai * HALF + wr * 64) >> 6;
#pragma unroll
                for (int m = 0; m < 4; ++m) {
                    const f32x4 g = acc[ai][0][m][n] * rs[ai][m], v = acc[ai][1][m][n] * rs[ai][m];
                    f32x4 cg, cv;
#pragma unroll
                    for (int e = 0; e < 4; ++e) {
                        float a = __builtin_fmaf(wg2[e], g[e], bg[e]), b = __builtin_fmaf(wv2[e], v[e], bv[e]);
                        conv_taps(a, g[e], gq[e], wg1[e], wg0[e]); conv_taps(b, v[e], vq[e], wv1[e], wv0[e]);
                        cg[e] = a; cv[e] = b; }
                    gq = g; vq = v;
                    f32x4 o;
#pragma unroll
                    for (int e = 0; e < 4; ++e) o[e] = cg[e] * __builtin_amdgcn_rcpf(1.f + __builtin_amdgcn_exp2f(-1.4426950408889634f * cg[e])) * cv[e];
                    u32x2v w; w.x = cvt_pk_bf16(o[0], o[1]); w.y = cvt_pk_bf16(o[2], o[3]);
                    const int row = row0 + ai * HALF + m * 16;
                    if (n == 0) lo[ai][m] = w;
                    else if (!(m == 0 && fr < 2)) { u32x4 w4; w4.x = lo[ai][m].x; w4.y = lo[ai][m].y; w4.z = w.x; w4.w = w.y; *(u32x4*)(ACT + (size_t)row * ff + ch0) = w4; }
                    if ((m == 0 && fr < 2) || (m == 3 && fr >= 14)) { float* hp = halo + ((size_t)grp * 4 + (m == 0 ? fr : fr - 12)) * ff2 + ch; *(f32x4*)hp = g; *(f32x4*)(hp + ff) = v; }
                }
            }
        }
    }
};
template <class Epi, class Sched, bool ALIGN_EPI = false, bool SP2 = false>
__device__ __forceinline__ void gemm_phase(PG8_LAS unsigned char* lds, const Gemm g, const Sched& S, const Epi& E) {
    const int tid = tid_opaque(), wid = __builtin_amdgcn_readfirstlane(tid >> 6), lane = tid & 63, wr = wid >> 2, wc = wid & 3, fr = lane & 15, fq = lane >> 4;
    const int K = g.K, nt = K / BK;
    unsigned voffA[2], voffB[2];
#pragma unroll
    for (int i = 0; i < 2; ++i) { int R, C; stage_rc(tid * 16 + i * 8192, R, C); const int Rb = Epi::PERM ? ((R & ~31) + perm32(R & 31)) : R;
        voffA[i] = (unsigned)(R * K + C) * 2u; voffB[i] = (unsigned)(Rb * K + C) * 2u; }
    const size_t kstep = (size_t)(BK * 2);
    const size_t hstep = (size_t)HALF * K * 2;
    const size_t tstep = 2 * hstep;
    const unsigned ldsw = (unsigned)wid * 1024u;
    const int aoff = lds_byte(wr * 64 + fr, fq * 8), boff = lds_byte(wc * 32 + fr, fq * 8);
#define PG8_SA(b, h) (((b) * 2 + (h)) * HTB)
#define PG8_SB(b, h) ((4 + (b) * 2 + (h)) * HTB)
#define PG8_STAGE(bufoff, gbase, voff) do { _Pragma("unroll") for (int _i = 0; _i < 2; ++_i) \
        __builtin_amdgcn_global_load_lds((const unsigned*)((const char*)(gbase) + (voff)[_i]), (PG8_LAS unsigned*)(lds + (bufoff) + ldsw + _i * 8192), 16, 0, 0); } while (0)
#define PG8_LDA(dst, b, h) do { _Pragma("unroll") for (int m = 0; m < 4; ++m) _Pragma("unroll") for (int k = 0; k < 2; ++k) dst[m][k] = *(const PG8_LAS bf16x8*)(lds + PG8_SA(b, h) + aoff + m * 2048 + k * 1024); } while (0)
#define PG8_LDB(dst, b, h) do { _Pragma("unroll") for (int n = 0; n < 2; ++n) _Pragma("unroll") for (int k = 0; k < 2; ++k) dst[n][k] = *(const PG8_LAS bf16x8*)(lds + PG8_SB(b, h) + boff + n * 2048 + k * 1024); } while (0)
#define PG8_MMA(ai, bj, At, Bt) do { if (!SP2) __builtin_amdgcn_s_setprio(1); _Pragma("unroll") for (int m = 0; m < 4; ++m) _Pragma("unroll") for (int n = 0; n < 2; ++n) _Pragma("unroll") for (int k = 0; k < 2; ++k) \
        acc[ai][bj][m][n] = __builtin_amdgcn_mfma_f32_16x16x32_bf16(Bt[n][k], At[m][k], acc[ai][bj][m][n], 0, 0, 0); if (!SP2) __builtin_amdgcn_s_setprio(0); } while (0)
#ifdef PRIO_BEFORE_BAR
#define PG8_PRIO_UP_PRE __builtin_amdgcn_s_setprio(1)
#define PG8_PRIO_UP_POST do { } while (0)
#else
#define PG8_PRIO_UP_PRE do { } while (0)
#define PG8_PRIO_UP_POST __builtin_amdgcn_s_setprio(1)
#endif
#define PG8_WAIT_V(n) asm volatile("s_waitcnt vmcnt(" #n ")" ::: "memory")
#define PG8_WAIT_L(n) asm volatile("s_waitcnt lgkmcnt(" #n ")" ::: "memory")
#define PG8_BAR __builtin_amdgcn_s_barrier()
#define PG8_SCHED __builtin_amdgcn_sched_barrier(0)
    Unit cur, nxt; int ui = 0;
    if (!S.next(0, cur)) return;
    cur.seq = 0; E.prefetch(cur);
    f32x4 acc[2][2][4][2];
#pragma unroll
    for (int a = 0; a < 2; ++a)
#pragma unroll
        for (int b = 0; b < 2; ++b)
#pragma unroll
            for (int m = 0; m < 4; ++m)
#pragma unroll
                for (int n = 0; n < 2; ++n) acc[a][b][m][n] = (f32x4){0.f, 0.f, 0.f, 0.f};
    bf16x8 At[4][2], B0[2][2], B1[2][2];
    const char* cA = (const char*)g.A + (size_t)cur.pm * tstep; const char* cB = (const char*)g.Bt + (size_t)cur.pn * tstep;
    S.a_ready(cur);
    if constexpr (SP2) {
        PG8_STAGE(PG8_SB(0, 0), cB, voffB); PG8_STAGE(PG8_SB(0, 1), cB + hstep, voffB); PG8_STAGE(PG8_SA(0, 0), cA, voffA); PG8_STAGE(PG8_SA(0, 1), cA + hstep, voffA);
        if (wr == 1) PG8_BAR;
        PG8_WAIT_V(2); PG8_BAR;
        PG8_STAGE(PG8_SB(1, 0), cB + kstep, voffB); PG8_STAGE(PG8_SA(1, 0), cA + kstep, voffA); PG8_STAGE(PG8_SB(1, 1), cB + hstep + kstep, voffB);
        PG8_WAIT_V(6); PG8_BAR;
    } else {
        PG8_STAGE(PG8_SB(0, 0), cB, voffB); PG8_STAGE(PG8_SA(0, 0), cA, voffA); PG8_STAGE(PG8_SB(0, 1), cB + hstep, voffB); PG8_STAGE(PG8_SA(0, 1), cA + hstep, voffA);
        if (wr == 1) PG8_BAR;
        PG8_WAIT_V(4); PG8_BAR;
        PG8_STAGE(PG8_SB(1, 0), cB + kstep, voffB); PG8_STAGE(PG8_SA(1, 0), cA + kstep, voffA); PG8_STAGE(PG8_SB(1, 1), cB + hstep + kstep, voffB);
        PG8_WAIT_V(6); PG8_BAR;
    }
    for (;;) {
        const bool has_next = S.next(ui + 1, nxt);
        const char* nA = has_next ? (const char*)g.A + (size_t)nxt.pm * tstep : cA; const char* nB = has_next ? (const char*)g.Bt + (size_t)nxt.pn * tstep : cB;
        for (int t = 0; t < nt; t += 2) {
            const bool last = (t == nt - 2);
            const char* a1 = cA + (size_t)(t + 1) * kstep;
            const char* a2 = last ? nA : cA + (size_t)(t + 2) * kstep; const char* b2 = last ? nB : cB + (size_t)(t + 2) * kstep;
            const char* a3 = a2 + kstep; const char* b3 = b2 + kstep;
            if (last && has_next) S.a_ready(nxt);
            if constexpr (SP2) {
            PG8_LDB(B0, 0, 0); PG8_LDB(B1, 0, 1); PG8_SCHED; PG8_LDA(At, 0, 0); PG8_STAGE(PG8_SA(1, 1), a1 + hstep, voffA);
            PG8_WAIT_V(8); PG8_WAIT_L(0); PG8_PRIO_UP_PRE; PG8_BAR; PG8_PRIO_UP_POST; PG8_MMA(0, 0, At, B0); PG8_MMA(0, 1, At, B1); __builtin_amdgcn_s_setprio(0); PG8_BAR; PG8_SCHED;
            PG8_LDA(At, 0, 1); PG8_STAGE(PG8_SB(0, 0), b2, voffB); PG8_STAGE(PG8_SB(0, 1), b2 + hstep, voffB); PG8_STAGE(PG8_SA(0, 0), a2, voffA);
            PG8_WAIT_V(8); PG8_WAIT_L(0); PG8_PRIO_UP_PRE; PG8_BAR; PG8_PRIO_UP_POST; PG8_MMA(1, 0, At, B0); PG8_MMA(1, 1, At, B1); __builtin_amdgcn_s_setprio(0); PG8_BAR; PG8_SCHED;
            PG8_LDB(B0, 1, 0); PG8_LDB(B1, 1, 1); PG8_SCHED; PG8_LDA(At, 1, 0); PG8_STAGE(PG8_SA(0, 1), a2 + hstep, voffA);
            PG8_WAIT_V(8); PG8_WAIT_L(0); PG8_PRIO_UP_PRE; PG8_BAR; PG8_PRIO_UP_POST; PG8_MMA(0, 0, At, B0); PG8_MMA(0, 1, At, B1); __builtin_amdgcn_s_setprio(0); PG8_BAR; PG8_SCHED;
            PG8_LDA(At, 1, 1); PG8_STAGE(PG8_SB(1, 0), b3, voffB); PG8_STAGE(PG8_SB(1, 1), b3 + hstep, voffB); PG8_STAGE(PG8_SA(1, 0), a3, voffA);
            PG8_WAIT_V(8); PG8_WAIT_L(0); PG8_PRIO_UP_PRE; PG8_BAR; PG8_PRIO_UP_POST; PG8_MMA(1, 0, At, B0); PG8_MMA(1, 1, At, B1); __builtin_amdgcn_s_setprio(0); PG8_BAR; PG8_SCHED;
            } else {
            PG8_LDB(B0, 0, 0); PG8_SCHED; PG8_LDA(At, 0, 0); PG8_STAGE(PG8_SA(1, 1), a1 + hstep, voffA);
            PG8_WAIT_L(8); PG8_BAR; PG8_WAIT_L(0); PG8_MMA(0, 0, At, B0); PG8_BAR; PG8_SCHED;
            PG8_LDB(B1, 0, 1); PG8_STAGE(PG8_SB(0, 0), b2, voffB);
            PG8_BAR; PG8_WAIT_L(0); PG8_MMA(0, 1, At, B1); PG8_BAR;
            PG8_LDA(At, 0, 1); PG8_STAGE(PG8_SA(0, 0), a2, voffA);
            PG8_BAR; PG8_WAIT_L(0); PG8_MMA(1, 0, At, B0); PG8_BAR; PG8_SCHED;
            PG8_STAGE(PG8_SB(0, 1), b2 + hstep, voffB);
            PG8_WAIT_V(6); PG8_BAR; PG8_MMA(1, 1, At, B1); PG8_BAR;
            PG8_LDB(B0, 1, 0); PG8_SCHED; PG8_LDA(At, 1, 0); PG8_STAGE(PG8_SA(0, 1), a2 + hstep, voffA);
            PG8_WAIT_L(8); PG8_BAR; PG8_WAIT_L(0); PG8_MMA(0, 0, At, B0); PG8_BAR; PG8_SCHED;
            PG8_LDB(B1, 1, 1); PG8_STAGE(PG8_SB(1, 0), b3, voffB);
            PG8_BAR; PG8_WAIT_L(0); PG8_MMA(0, 1, At, B1); PG8_BAR;
            PG8_LDA(At, 1, 1); PG8_STAGE(PG8_SA(1, 0), a3, voffA);
            PG8_BAR; PG8_WAIT_L(0); PG8_MMA(1, 0, At, B0); PG8_BAR; PG8_SCHED;
            PG8_STAGE(PG8_SB(1, 1), b3 + hstep, voffB);
            PG8_WAIT_V(6); PG8_BAR; PG8_MMA(1, 1, At, B1); PG8_BAR;
            }
        }
        if constexpr (ALIGN_EPI) { if (wr == 0) PG8_BAR; }
        if constexpr (!Epi::AFTER_DRAIN) { E(acc, cur, wr, wc, fr, fq); S.done(cur); }
        if (!has_next) break;
#pragma unroll
        for (int a = 0; a < 2; ++a)
#pragma unroll
            for (int b = 0; b < 2; ++b)
#pragma unroll
                for (int m = 0; m < 4; ++m)
#pragma unroll
                    for (int n = 0; n < 2; ++n) acc[a][b][m][n] = (f32x4){0.f, 0.f, 0.f, 0.f};
        cur = nxt; cA = nA; cB = nB; ++ui; cur.seq = ui; E.prefetch(cur);
        if constexpr (ALIGN_EPI) { if (wr == 1) PG8_BAR; }
    }
    PG8_WAIT_V(0);
    if constexpr (!ALIGN_EPI) { if (wr == 0) PG8_BAR; }
    PG8_BAR;
    if constexpr (Epi::AFTER_DRAIN) { E.fused(acc, cur, wr, wc, fr, fq, lds, wid, lane); S.done(cur); }
#undef PG8_SA
#undef PG8_SB
#undef PG8_STAGE
#undef PG8_LDA
#undef PG8_LDB
#undef PG8_MMA
#undef PG8_WAIT_V
#undef PG8_WAIT_L
#undef PG8_BAR
#undef PG8_SCHED
}
}
namespace att {
using bf16 = unsigned short;
typedef short bf16x8 __attribute__((ext_vector_type(8)));
typedef short s16x4 __attribute__((ext_vector_type(4)));
typedef float f32x16 __attribute__((ext_vector_type(16)));
typedef float f32x4 __attribute__((ext_vector_type(4)));
typedef unsigned u32x4 __attribute__((ext_vector_type(4)));
constexpr int D = 128, NW = 8, QBLK = 32, KVBLK = 64, QB = NW * QBLK;
constexpr int SHM_V = KVBLK * D * 2, SHM_K = KVBLK * D * 2;
constexpr int LDS_BYTES = 2 * SHM_V + 2 * SHM_K + NW * 64 * 4;
#define KSWZ(row, colB) ((row) * 256 + ((colB) ^ (((row) & 7) << 4)))
#define SBAR() __builtin_amdgcn_sched_barrier(0)
__device__ __forceinline__ int v_st(int k, int c) { const int kk = (k & ~0xC) | ((k & 4) << 1) | ((k & 8) >> 1); return ((kk >> 3) * 4 + (c >> 5)) * 512 + ((kk & 7) * 32 + (c & 31)) * 2; }
__device__ __forceinline__ int v_rd_base(int lane) { return ((lane & 3) << 3) | (((lane >> 2) & 3) << 6) | (((lane >> 4) & 1) << 5) | (((lane >> 5) & 1) << 8); }
constexpr int v_rd_off(int d0, int ks, int half) { return d0 * 512 + ks * 4096 + half * 2048; }
__device__ __forceinline__ int crow(int r, int hi) { return (r & 3) + 8 * (r >> 2) + 4 * hi; }
__device__ __forceinline__ unsigned cvtpk(float lo, float hi) { unsigned r; asm volatile("v_cvt_pk_bf16_f32 %0, %1, %2" : "=v"(r) : "v"(lo), "v"(hi)); return r; }
__device__ __forceinline__ bf16x8 load8(const bf16* p) { return *reinterpret_cast<const bf16x8*>(p); }

#define PK4(P, B_, OUT) do { unsigned a0 = cvtpk(P[B_+0], P[B_+1]), a1 = cvtpk(P[B_+2], P[B_+3]);                          \
        unsigned b0 = cvtpk(P[B_+4], P[B_+5]), b1 = cvtpk(P[B_+6], P[B_+7]);                                             \
        auto r0 = __builtin_amdgcn_permlane32_swap(a0, b0, false, false); auto r1 = __builtin_amdgcn_permlane32_swap(a1, b1, false, false); \
        u32x4 w = {r0[0], r1[0], r0[1], r1[1]}; OUT = *reinterpret_cast<bf16x8*>(&w); } while (0)

__device__ __forceinline__ void qkt_rt(f32x16& p0, f32x16& p1, const char* Kt, int r32, int hi, const bf16x8* qr) {
    p0 = f32x16{}; p1 = f32x16{};
    const char* kb[4];
#pragma unroll
    for (int dd = 0; dd < 4; ++dd) kb[dd] = Kt + KSWZ(r32, (dd * 16 + hi * 8) * 2);
#pragma unroll
    for (int d0 = 0; d0 < 8; ++d0) { const char* a = kb[d0 & 3] + (d0 >> 2) * 128;
        bf16x8 b0 = *reinterpret_cast<const bf16x8*>(a);
        bf16x8 b1 = *reinterpret_cast<const bf16x8*>(a + 32 * 256);
        p0 = __builtin_amdgcn_mfma_f32_32x32x16_bf16(b0, qr[d0], p0, 0, 0, 0);
        p1 = __builtin_amdgcn_mfma_f32_32x32x16_bf16(b1, qr[d0], p1, 0, 0, 0); }
}
__device__ __forceinline__ void pv_rt(f32x16* o, int vb, bf16x8 pa0, bf16x8 pa1, bf16x8 pa2, bf16x8 pa3) {
#define TRRD(dst, off) asm volatile("ds_read_b64_tr_b16 %0, %1 offset:%2" : "=&v"(dst) : "v"(vb), "i"(off) : "memory")
#define PV_D0(d0) do { s16x4 l0, l1, l2, l3, h0, h1, h2, h3; constexpr int b_ = v_rd_off(d0, 0, 0); \
        TRRD(l0, b_); TRRD(h0, b_ + 2048); TRRD(l1, b_ + 4096); TRRD(h1, b_ + 6144); TRRD(l2, b_ + 8192); TRRD(h2, b_ + 10240); TRRD(l3, b_ + 12288); TRRD(h3, b_ + 14336); \
        asm volatile("s_waitcnt lgkmcnt(0)" ::: "memory"); SBAR();   \
        o[d0] = __builtin_amdgcn_mfma_f32_32x32x16_bf16(pa0, (bf16x8){l0[0], l0[1], l0[2], l0[3], h0[0], h0[1], h0[2], h0[3]}, o[d0], 0, 0, 0);   \
        o[d0] = __builtin_amdgcn_mfma_f32_32x32x16_bf16(pa1, (bf16x8){l1[0], l1[1], l1[2], l1[3], h1[0], h1[1], h1[2], h1[3]}, o[d0], 0, 0, 0);   \
        o[d0] = __builtin_amdgcn_mfma_f32_32x32x16_bf16(pa2, (bf16x8){l2[0], l2[1], l2[2], l2[3], h2[0], h2[1], h2[2], h2[3]}, o[d0], 0, 0, 0);   \
        o[d0] = __builtin_amdgcn_mfma_f32_32x32x16_bf16(pa3, (bf16x8){l3[0], l3[1], l3[2], l3[3], h3[0], h3[1], h3[2], h3[3]}, o[d0], 0, 0, 0); } while (0)
    PV_D0(0); PV_D0(1); PV_D0(2); PV_D0(3);
#undef PV_D0
#undef TRRD
}

constexpr float SB_DONE = 1e-30f;
__device__ __forceinline__ void sb_half(f32x16& p, float& carry, int dq, bool needmask, bool lane_hi) {
    float kp[16];
#pragma unroll
    for (int r = 0; r < 16; ++r) {
        const float zz = fminf(p[r], 100.f);
        const float e = __builtin_amdgcn_exp2f(zz);
        float k = __builtin_amdgcn_rcpf(1.f + e);
        float be = e * k;
        if (needmask) { const int c = 8 * (r >> 2) + (r & 3); const bool valid = (dq - c) > 0; k = valid ? k : 1.f; be = valid ? be : 0.f; }
        kp[r] = k; p[r] = be;
    }
    float L[4], H[4];
#pragma unroll
    for (int j = 0; j < 4; ++j) { const float g = (kp[4 * j] * kp[4 * j + 1]) * (kp[4 * j + 2] * kp[4 * j + 3]);
        auto rr = __builtin_amdgcn_permlane32_swap(__float_as_uint(g), __float_as_uint(g), false, false);
        L[j] = __uint_as_float(rr[0]); H[j] = __uint_as_float(rr[1]); }
    float U[4]; U[3] = 1.f; U[2] = L[3] * H[3]; U[1] = U[2] * (L[2] * H[2]); U[0] = U[1] * (L[1] * H[1]);
    const float tot = U[0] * (L[0] * H[0]);
#pragma unroll
    for (int j = 0; j < 4; ++j) {
        const float a3 = carry * U[j] * (lane_hi ? 1.f : H[j]);
        const float a2 = a3 * kp[4 * j + 3], a1 = a2 * kp[4 * j + 2], a0 = a1 * kp[4 * j + 1];
        p[4 * j + 3] *= a3; p[4 * j + 2] *= a2; p[4 * j + 1] *= a1; p[4 * j] *= a0;
    }
    carry *= tot;
}

template <int PQ, int PK, int PV, int PO>
__device__ __forceinline__ void sb_block(const bf16* Q, const bf16* K, const bf16* V, bf16* O, int P0, char* lds, volatile __attribute__((address_space(3))) unsigned* flags) {
    const int tid = pg8::tid_opaque(), wid = __builtin_amdgcn_readfirstlane(tid >> 6), lane = tid & 63, r32 = lane & 31, hi = lane >> 5;
    char* K_lds = lds; char* V_lds = lds + 2 * SHM_K;
    const int sr = tid >> 4, sc = (tid & 15) * 8, vst0 = v_st(sr, sc), vst1 = v_st(32 + sr, sc), kws = KSWZ(sr, sc * 2);
    const int vb0 = (int)(uintptr_t)V_lds + v_rd_base(lane);
    bf16x8 qr[8];
#pragma unroll
    for (int d0 = 0; d0 < 8; ++d0) qr[d0] = load8(Q + (size_t)(wid * QBLK + r32) * PQ + d0 * 16 + hi * 8);
    f32x16 o[4] = {};
    float carry = 1.f;
    const int qlo = P0 + wid * QBLK, qpos = qlo + r32;
    int j = P0 / KVBLK + 3;
    bf16x8 st_k0, st_k1, st_v0, st_v1;
#define SB_LOAD(jt) do { const size_t k0_ = (size_t)(jt) * KVBLK; st_k0 = load8(K + (k0_ + sr) * PK + sc); st_k1 = load8(K + (k0_ + 32 + sr) * PK + sc); \
                         st_v0 = load8(V + (k0_ + sr) * PV + sc); st_v1 = load8(V + (k0_ + 32 + sr) * PV + sc); } while (0)
#define SB_WRITE(bf) do { *(bf16x8*)(K_lds + (bf) * SHM_K + kws) = st_k0; *(bf16x8*)(K_lds + (bf) * SHM_K + kws + 32 * 256) = st_k1; \
                          *(bf16x8*)(V_lds + (bf) * SHM_V + vst0) = st_v0; *(bf16x8*)(V_lds + (bf) * SHM_V + vst1) = st_v1; } while (0)
    SB_LOAD(j); asm volatile("s_waitcnt vmcnt(0)" ::: "memory"); SB_WRITE(0);
    __syncthreads();
    int buf = 0, it = 0; bool wdone = false;
    for (;;) {
        const int kb = j * KVBLK; const bool more = j > 0;
        if (more) SB_LOAD(j - 1);
        const bool act = !wdone && (kb < qlo + QBLK - 1);
        if (act) {
            f32x16 p0, p1;
            qkt_rt(p0, p1, K_lds + buf * SHM_K, r32, hi, qr);
            const bool needmask = kb + KVBLK - 1 >= qlo;
            sb_half(p1, carry, qpos - (kb + 32) - 4 * hi, needmask, hi != 0);
            sb_half(p0, carry, qpos - kb - 4 * hi, needmask, hi != 0);
            bf16x8 pa0, pa1, pa2, pa3;
            PK4(p0, 0, pa0); PK4(p0, 8, pa1); PK4(p1, 0, pa2); PK4(p1, 8, pa3);
            SBAR();
            pv_rt(o, vb0 + buf * SHM_V, pa0, pa1, pa2, pa3);
            wdone = __all(carry < SB_DONE);
        }
        if (more) { asm volatile("s_waitcnt vmcnt(0)" ::: "memory"); SB_WRITE(buf ^ 1); }
        if (lane == 0) flags[(it & 1) * 8 + wid] = wdone ? 1u : 0u;
        __syncthreads();
        unsigned alld = 1u;
#pragma unroll
        for (int w = 0; w < NW; ++w) alld &= flags[(it & 1) * 8 + w];
        if (!more || alld) break;
        --j; buf ^= 1; ++it;
    }
#undef SB_LOAD
#undef SB_WRITE
    bf16* Ow = O + (size_t)(wid * QBLK) * PO;
#pragma unroll
    for (int r = 0; r < 16; ++r) { const int orow = crow(r, hi);
#pragma unroll
        for (int d0 = 0; d0 < 4; ++d0) { const float v = o[d0][r]; const float vn = __shfl_xor(v, 1);
            if ((r32 & 1) == 0) *(unsigned*)(Ow + (size_t)orow * PO + d0 * 32 + r32) = cvtpk(v, vn); } }
    __syncthreads();
}

constexpr float THR2 = 8.f * 1.4426950408889634f;
struct DiffRef { const bf16* Q; const bf16* K; const bf16* V; bf16* O; int P0; int mode; };
struct DiffConst { float lam; float omli; float eps; const float* gain; float* scr; };
template <int PQ, int PK, int PV, int PO>
__device__ __forceinline__ void sm_block(const DiffRef& cur, const DiffConst& C, char* lds) {
    const int tid = pg8::tid_opaque(), wid = __builtin_amdgcn_readfirstlane(tid >> 6), lane = tid & 63, r32 = lane & 31, hi = lane >> 5;
    char* K_lds = lds; char* V_lds = lds + 2 * SHM_K; float* al_l = (float*)(lds + 2 * SHM_K + 2 * SHM_V) + wid * 32;
    const int sr = tid >> 4, sc = (tid & 15) * 8, vst0 = v_st(sr, sc), vst1 = v_st(32 + sr, sc), kws = KSWZ(sr, sc * 2);
    const int vb0 = (int)(uintptr_t)V_lds + v_rd_base(lane);
    const bf16* Q = cur.Q; const bf16* K = cur.K; const bf16* V = cur.V; const int P0 = cur.P0;
    bf16x8 qr[8];
#pragma unroll
    for (int d0 = 0; d0 < 8; ++d0) qr[d0] = load8(Q + (size_t)(wid * QBLK + r32) * PQ + d0 * 16 + hi * 8);
    f32x16 o[4] = {};
    float m_reg = -1e30f, l_reg = 0.f;
    const int qlo = P0 + wid * QBLK, qm = qlo + r32 - 4 * hi;
    const int NT = P0 / KVBLK + 4;
    bf16x8 st_k0, st_k1, st_v0, st_v1;
#define SM_LOAD(jt) do { const size_t k0_ = (size_t)(jt) * KVBLK; st_k0 = load8(K + (k0_ + sr) * PK + sc); st_k1 = load8(K + (k0_ + 32 + sr) * PK + sc); \
                         st_v0 = load8(V + (k0_ + sr) * PV + sc); st_v1 = load8(V + (k0_ + 32 + sr) * PV + sc); } while (0)
#define SM_WRITE(bf) do { *(bf16x8*)(K_lds + (bf) * SHM_K + kws) = st_k0; *(bf16x8*)(K_lds + (bf) * SHM_K + kws + 32 * 256) = st_k1; \
                          *(bf16x8*)(V_lds + (bf) * SHM_V + vst0) = st_v0; *(bf16x8*)(V_lds + (bf) * SHM_V + vst1) = st_v1; } while (0)
    SM_LOAD(0); asm volatile("s_waitcnt vmcnt(0)" ::: "memory"); SM_WRITE(0);
    __syncthreads();
    int buf = 0;
    for (int t = 0; t < NT; ++t) {
        const int kb = t * KVBLK; const bool more = t + 1 < NT;
        if (more) SM_LOAD(t + 1);
        if (kb <= qlo + QBLK - 1) {
            f32x16 p0, p1;
            qkt_rt(p0, p1, K_lds + buf * SHM_K, r32, hi, qr);
            if (kb + KVBLK - 1 > qlo) {
                const int dq = qm - kb; const float NEG = -__builtin_inff();
#pragma unroll
                for (int r = 0; r < 16; ++r) { const int c = (r & 3) + 8 * (r >> 2); if ((dq - c) < 0) p0[r] = NEG; if ((dq - c - 32) < 0) p1[r] = NEG; }
            }
            float pmax = p0[0];
#pragma unroll
            for (int r = 1; r < 16; ++r) pmax = fmaxf(pmax, p0[r]);
#pragma unroll
            for (int r = 0; r < 16; ++r) pmax = fmaxf(pmax, p1[r]);
            { auto rr = __builtin_amdgcn_permlane32_swap(__float_as_uint(pmax), __float_as_uint(pmax), false, false); pmax = fmaxf(__uint_as_float(rr[0]), __uint_as_float(rr[1])); }
            float alpha = 1.f;
            if (!__all((pmax - m_reg) <= THR2)) {
                const float mn = fmaxf(m_reg, pmax); alpha = __builtin_amdgcn_exp2f(m_reg - mn); m_reg = mn;
                if (hi == 0) al_l[r32] = alpha; asm volatile("s_waitcnt lgkmcnt(0)" ::: "memory");
#pragma unroll
                for (int d_ = 0; d_ < 4; ++d_)
#pragma unroll
                    for (int r = 0; r < 16; ++r) o[d_][r] *= al_l[crow(r, hi)];
            }
            float ps = 0.f;
#pragma unroll
            for (int r = 0; r < 16; ++r) { p0[r] = __builtin_amdgcn_exp2f(p0[r] - m_reg); ps += p0[r]; }
#pragma unroll
            for (int r = 0; r < 16; ++r) { p1[r] = __builtin_amdgcn_exp2f(p1[r] - m_reg); ps += p1[r]; }
            { auto rr = __builtin_amdgcn_permlane32_swap(__float_as_uint(ps), __float_as_uint(ps), false, false); ps = __uint_as_float(rr[0]) + __uint_as_float(rr[1]); }
            l_reg = l_reg * alpha + ps;
            bf16x8 pa0, pa1, pa2, pa3;
            PK4(p0, 0, pa0); PK4(p0, 8, pa1); PK4(p1, 0, pa2); PK4(p1, 8, pa3);
            SBAR();
            pv_rt(o, vb0 + buf * SHM_V, pa0, pa1, pa2, pa3);
        }
        if (more) { asm volatile("s_waitcnt vmcnt(0)" ::: "memory"); SM_WRITE(buf ^ 1); }
        __syncthreads();
        buf ^= 1;
    }
#undef SM_LOAD
#undef SM_WRITE
    if (hi == 0) al_l[r32] = l_reg; asm volatile("s_waitcnt lgkmcnt(0)" ::: "memory");
    float rli[16];
#pragma unroll
    for (int r = 0; r < 16; ++r) rli[r] = __builtin_amdgcn_rcpf(al_l[crow(r, hi)]);
#define OPQ(v) asm volatile("" : "+v"(v))
    char* sA = (char*)C.scr; char* sB = sA + 16384;
    const unsigned lo16 = (unsigned)lane * 16u;
    const int mode = cur.mode;
    if (mode == 0 || mode == 1) { char* s = mode ? sB : sA;
#pragma unroll
        for (int r = 0; r < 16; ++r) { unsigned vo = lo16; OPQ(vo);
            const f32x4 v = {o[0][r] * rli[r], o[1][r] * rli[r], o[2][r] * rli[r], o[3][r] * rli[r]};
            *(f32x4*)(s + (size_t)(vo + r * 1024)) = v; }
    } else if (mode == 2) {
#pragma unroll
        for (int r = 0; r < 16; ++r) { unsigned vo = lo16; OPQ(vo);
            f32x4* ap = (f32x4*)(sA + (size_t)(vo + r * 1024)); const f32x4 a = *ap;
            const f32x4 v = {a[0] - C.lam * (o[0][r] * rli[r]), a[1] - C.lam * (o[1][r] * rli[r]), a[2] - C.lam * (o[2][r] * rli[r]), a[3] - C.lam * (o[3][r] * rli[r])};
            *ap = v;
            if ((r & 3) == 3) asm volatile("" ::: "memory"); }
    } else {
        float g0[4], g1[4];
#pragma unroll
        for (int d0 = 0; d0 < 4; ++d0) { g0[d0] = C.gain[d0 * 32 + r32]; g1[d0] = C.gain[128 + d0 * 32 + r32]; }
        char* Ow = (char*)(cur.O + (size_t)(wid * QBLK) * PO);
        const unsigned lo_o = (unsigned)((4 * hi) * PO + r32) * 2u;
#pragma unroll
        for (int r = 0; r < 16; ++r) { unsigned vo = lo16; OPQ(vo);
            const f32x4 a = *(const f32x4*)(sA + (size_t)(vo + r * 1024)); const f32x4 b = *(const f32x4*)(sB + (size_t)(vo + r * 1024));
            float d1[4], ss = 0.f;
#pragma unroll
            for (int d0 = 0; d0 < 4; ++d0) { d1[d0] = b[d0] - C.lam * (o[d0][r] * rli[r]); ss += d1[d0] * d1[d0] + a[d0] * a[d0]; }
            ss += __shfl_xor(ss, 1); ss += __shfl_xor(ss, 2); ss += __shfl_xor(ss, 4); ss += __shfl_xor(ss, 8); ss += __shfl_xor(ss, 16);
            const float scl = rsqrtf(ss * (1.f / 256.f) + C.eps) * C.omli;
            unsigned wo = lo_o; OPQ(wo);
            char* rowp = Ow + (size_t)(wo + (unsigned)(((r & 3) + 8 * (r >> 2)) * PO * 2));
#pragma unroll
            for (int d0 = 0; d0 < 4; ++d0) {
                const float v0 = a[d0] * scl * g0[d0], v1 = d1[d0] * scl * g1[d0];
                const float v0n = __shfl_xor(v0, 1), v1n = __shfl_xor(v1, 1);
                if ((r32 & 1) == 0) { *(unsigned*)(rowp + d0 * 64) = cvtpk(v0, v0n); *(unsigned*)(rowp + 256 + d0 * 64) = cvtpk(v1, v1n); }
            }
            if ((r & 1) == 1) asm volatile("" ::: "memory");
        }
    }
#undef OPQ
    __syncthreads();
}

constexpr int K2 = 32;
constexpr int ST2_K0 = 0, ST2_K1 = 8192, ST2_V = 16384, ST2_BYTES = 32768;
__device__ __forceinline__ int v_st2(int k, int c) { const int kk = (k & ~0xC) | ((k & 4) << 1) | ((k & 8) >> 1); return ((kk >> 3) * 8 + (c >> 5)) * 512 + ((kk & 7) * 32 + (c & 31)) * 2; }
struct Diff2Const { float lam; float omli; float eps; float mb; const float* gain; };
template <int PQ, int PK, int PV, int PO>
__device__ __forceinline__ void diff2_block(const bf16* Qb  , const bf16* Kb  , const bf16* Vb  ,
                                            bf16* Ob, int P0, const Diff2Const& C, char* lds) {
    const int tid = pg8::tid_opaque(), wid = __builtin_amdgcn_readfirstlane(tid >> 6), lane = tid & 63, r32 = lane & 31, hi = lane >> 5;
    const int rg = wid & 3, cc = wid >> 2;
    const int krow = tid >> 4, kcol = (tid & 15) * 8, kws = KSWZ(krow, kcol * 2);
    const int vrow0 = tid >> 5, vcol = (tid & 31) * 8, vst0 = v_st2(vrow0, vcol), vst1 = v_st2(16 + vrow0, vcol);
    const int vb0 = (int)(uintptr_t)lds + ST2_V + v_rd_base(lane);
    const char* Kmine = lds + (cc ? ST2_K1 : ST2_K0);
    bf16x8 qr[8];
    { unsigned qo = (unsigned)((rg * QBLK + r32) * PQ + cc * 128 + hi * 8) * 2u; asm volatile("" : "+v"(qo));
#pragma unroll
      for (int d0 = 0; d0 < 8; ++d0) qr[d0] = *(const bf16x8*)((const char*)Qb + (size_t)qo + d0 * 32); }
    f32x16 o[8];
#pragma unroll
    for (int d0 = 0; d0 < 8; ++d0) o[d0] = f32x16{};
    float l_reg = 0.f;
    const int qlo = P0 + rg * QBLK, qm = qlo + r32 - 4 * hi;
    const int NT = P0 / K2 + 4;
    bf16x8 st_k0, st_k1, st_v0, st_v1;
    const unsigned koff = (unsigned)(krow * PK + kcol) * 2u, voffa = (unsigned)(vrow0 * PV + vcol) * 2u, voffb = (unsigned)((16 + vrow0) * PV + vcol) * 2u;
#define D2_LOAD(jt) do { const char* kt_ = (const char*)Kb + (size_t)(jt) * (K2 * PK * 2); const char* vt_ = (const char*)Vb + (size_t)(jt) * (K2 * PV * 2); \
                         unsigned ko_ = koff, va_ = voffa, vb_ = voffb; asm volatile("" : "+v"(ko_), "+v"(va_), "+v"(vb_)); \
                         st_k0 = *(const bf16x8*)(kt_ + (size_t)ko_); st_k1 = *(const bf16x8*)(kt_ + (size_t)ko_ + 256); \
                         st_v0 = *(const bf16x8*)(vt_ + (size_t)va_); st_v1 = *(const bf16x8*)(vt_ + (size_t)vb_); } while (0)
#define D2_WRITE(bf) do { char* st_ = lds + (bf) * ST2_BYTES; *(bf16x8*)(st_ + ST2_K0 + kws) = st_k0; *(bf16x8*)(st_ + ST2_K1 + kws) = st_k1; \
                          *(bf16x8*)(st_ + ST2_V + vst0) = st_v0; *(bf16x8*)(st_ + ST2_V + vst1) = st_v1; } while (0)
    D2_LOAD(0); asm volatile("s_waitcnt vmcnt(0)" ::: "memory"); D2_WRITE(0);
    __syncthreads();
    int buf = 0;
    for (int t = 0; t < NT; ++t) {
        const int kb = t * K2; const bool more = t + 1 < NT;
        if (more) D2_LOAD(t + 1);
        if (kb <= qlo + QBLK - 1) {
            f32x16 p0 = f32x16{};
            { const char* Kt = Kmine + buf * ST2_BYTES; const char* kbp[4];
#pragma unroll
              for (int dd = 0; dd < 4; ++dd) kbp[dd] = Kt + KSWZ(r32, (dd * 16 + hi * 8) * 2);
#pragma unroll
              for (int d0 = 0; d0 < 8; ++d0) { const bf16x8 b0 = *reinterpret_cast<const bf16x8*>(kbp[d0 & 3] + (d0 >> 2) * 128); p0 = __builtin_amdgcn_mfma_f32_32x32x16_bf16(b0, qr[d0], p0, 0, 0, 0); } }
            const float mb = C.mb;
            if (kb + K2 - 1 > qlo) {
                const int dq = qm - kb;
#pragma unroll
                for (int r = 0; r < 16; ++r) { const int c = (r & 3) + 8 * (r >> 2); const float e = __builtin_amdgcn_exp2f(p0[r] - mb); p0[r] = (dq - c) >= 0 ? e : 0.f; }
            } else {
#pragma unroll
                for (int r = 0; r < 16; ++r) p0[r] = __builtin_amdgcn_exp2f(p0[r] - mb);
            }
            float ps = 0.f;
#pragma unroll
            for (int r = 0; r < 16; ++r) ps += p0[r];
            l_reg += ps;
            bf16x8 pa0, pa1;
            PK4(p0, 0, pa0); PK4(p0, 8, pa1);
            SBAR();
            const int vb = vb0 + buf * ST2_BYTES;
#define TRRD(dst, off) asm volatile("ds_read_b64_tr_b16 %0, %1 offset:%2" : "=&v"(dst) : "v"(vb), "i"(off) : "memory")
#define PV2_RD(d0, L0, H0, L1, H1) do { constexpr int b_ = (d0) * 512; TRRD(L0, b_); TRRD(H0, b_ + 4096); TRRD(L1, b_ + 8192); TRRD(H1, b_ + 12288); } while (0)
#define PV2_MM(d0, L0, H0, L1, H1) do { \
        o[d0] = __builtin_amdgcn_mfma_f32_32x32x16_bf16(pa0, (bf16x8){L0[0], L0[1], L0[2], L0[3], H0[0], H0[1], H0[2], H0[3]}, o[d0], 0, 0, 0); \
        o[d0] = __builtin_amdgcn_mfma_f32_32x32x16_bf16(pa1, (bf16x8){L1[0], L1[1], L1[2], L1[3], H1[0], H1[1], H1[2], H1[3]}, o[d0], 0, 0, 0); } while (0)
#define LGK(n) do { asm volatile("s_waitcnt lgkmcnt(" #n ")" ::: "memory"); SBAR(); } while (0)
#ifdef D2_PV3
            { s16x4 la0, ha0, la1, ha1, lb0, hb0, lb1, hb1, lc0, hc0, lc1, hc1;
              PV2_RD(0, la0, ha0, la1, ha1); PV2_RD(1, lb0, hb0, lb1, hb1);
              PV2_RD(2, lc0, hc0, lc1, hc1); LGK(8); PV2_MM(0, la0, ha0, la1, ha1);
              PV2_RD(3, la0, ha0, la1, ha1); LGK(8); PV2_MM(1, lb0, hb0, lb1, hb1);
              PV2_RD(4, lb0, hb0, lb1, hb1); LGK(8); PV2_MM(2, lc0, hc0, lc1, hc1);
              PV2_RD(5, lc0, hc0, lc1, hc1); LGK(8); PV2_MM(3, la0, ha0, la1, ha1);
              PV2_RD(6, la0, ha0, la1, ha1); LGK(8); PV2_MM(4, lb0, hb0, lb1, hb1);
              PV2_RD(7, lb0, hb0, lb1, hb1); LGK(8); PV2_MM(5, lc0, hc0, lc1, hc1);
              LGK(4); PV2_MM(6, la0, ha0, la1, ha1);
              LGK(0); PV2_MM(7, lb0, hb0, lb1, hb1); }
#else
            { s16x4 la0, ha0, la1, ha1, lb0, hb0, lb1, hb1;
              PV2_RD(0, la0, ha0, la1, ha1);
              PV2_RD(1, lb0, hb0, lb1, hb1); LGK(4); PV2_MM(0, la0, ha0, la1, ha1);
              PV2_RD(2, la0, ha0, la1, ha1); LGK(4); PV2_MM(1, lb0, hb0, lb1, hb1);
              PV2_RD(3, lb0, hb0, lb1, hb1); LGK(4); PV2_MM(2, la0, ha0, la1, ha1);
              PV2_RD(4, la0, ha0, la1, ha1); LGK(4); PV2_MM(3, lb0, hb0, lb1, hb1);
              PV2_RD(5, lb0, hb0, lb1, hb1); LGK(4); PV2_MM(4, la0, ha0, la1, ha1);
              PV2_RD(6, la0, ha0, la1, ha1); LGK(4); PV2_MM(5, lb0, hb0, lb1, hb1);
              PV2_RD(7, lb0, hb0, lb1, hb1); LGK(4); PV2_MM(6, la0, ha0, la1, ha1);
              LGK(0); PV2_MM(7, lb0, hb0, lb1, hb1); }
#endif
#undef PV2_RD
#undef PV2_MM
#undef LGK
#undef TRRD
        }
        if (more) { asm volatile("s_waitcnt vmcnt(0)" ::: "memory"); D2_WRITE(buf ^ 1); }
        __syncthreads();
        buf ^= 1;
    }
#undef D2_LOAD
#undef D2_WRITE
    { auto rr = __builtin_amdgcn_permlane32_swap(__float_as_uint(l_reg), __float_as_uint(l_reg), false, false); l_reg = __uint_as_float(rr[0]) + __uint_as_float(rr[1]); }
    float* lw = (float*)(lds + 132096) + wid * 32;
    if (hi == 0) lw[r32] = l_reg; asm volatile("s_waitcnt lgkmcnt(0)" ::: "memory");
    float rli[16];
#pragma unroll
    for (int r = 0; r < 16; ++r) rli[r] = __builtin_amdgcn_rcpf(lw[crow(r, hi)]);
    float* X = (float*)lds + rg * 8192;
#define OPQ(v) asm volatile("" : "+v"(v))
    if (cc == 1) {
#pragma unroll
        for (int r = 0; r < 16; ++r) { const float f = C.lam * rli[r]; unsigned vo = (unsigned)lane; OPQ(vo);
#pragma unroll
            for (int d0 = 0; d0 < 8; ++d0) X[(r * 8 + d0) * 64 + vo] = o[d0][r] * f; }
    }
    __syncthreads();
    if (cc == 0) {
        float g[8];
        { unsigned go = (unsigned)r32 * 4u; OPQ(go);
#pragma unroll
          for (int d0 = 0; d0 < 8; ++d0) g[d0] = *(const float*)((const char*)C.gain + (size_t)go + d0 * 128); }
        char* Ow = (char*)(Ob + (size_t)(rg * QBLK) * PO);
        const unsigned lo_o = (unsigned)((4 * hi) * PO + r32) * 2u;
#pragma unroll
        for (int r = 0; r < 16; ++r) { unsigned vo = (unsigned)lane; OPQ(vo);
            float d[8], ss = 0.f;
#pragma unroll
            for (int d0 = 0; d0 < 8; ++d0) { d[d0] = o[d0][r] * rli[r] - X[(r * 8 + d0) * 64 + vo]; ss += d[d0] * d[d0]; }
            ss += __shfl_xor(ss, 1); ss += __shfl_xor(ss, 2); ss += __shfl_xor(ss, 4); ss += __shfl_xor(ss, 8); ss += __shfl_xor(ss, 16);
            const float scl = rsqrtf(ss * (1.f / 256.f) + C.eps) * C.omli;
#ifdef D2_OSTAGE
            unsigned xo = (unsigned)(r * 2048 + hi * 512 + r32 * 2); OPQ(xo);
#pragma unroll
            for (int d0 = 0; d0 < 8; ++d0) { const float v = d[d0] * scl * g[d0]; const float vn = __shfl_xor(v, 1);
                if ((r32 & 1) == 0) *(unsigned*)((char*)X + xo + d0 * 64) = cvtpk(v, vn); }
#else
            unsigned wo = lo_o; OPQ(wo);
            char* rowp = Ow + (size_t)(wo + (unsigned)(((r & 3) + 8 * (r >> 2)) * PO * 2));
#pragma unroll
            for (int d0 = 0; d0 < 8; ++d0) { const float v = d[d0] * scl * g[d0]; const float vn = __shfl_xor(v, 1);
                if ((r32 & 1) == 0) *(unsigned*)(rowp + d0 * 64) = cvtpk(v, vn); }
#endif
        }
#ifdef D2_OSTAGE
        asm volatile("s_waitcnt lgkmcnt(0)" ::: "memory");
#pragma unroll
        for (int r = 0; r < 16; ++r) { unsigned xo = (unsigned)(r * 2048 + hi * 512 + r32 * 16); OPQ(xo);
            const bf16x8 w = *(const bf16x8*)((const char*)X + xo);
            unsigned wo = (unsigned)((4 * hi) * PO * 2 + r32 * 16); OPQ(wo);
            *(bf16x8*)(Ow + (size_t)(wo + (unsigned)(((r & 3) + 8 * (r >> 2)) * PO * 2))) = w; }
#endif
    }
#undef OPQ
    __syncthreads();
}
}
#ifndef PG8_SP2
#define PG8_SP2 true
#endif
#ifndef PG8_ALIGN
#define PG8_ALIGN true
#endif
#ifndef MK_SPLIT
#define MK_SPLIT 0
#endif
#ifndef MK_CHECK
#define MK_CHECK 0
#endif
constexpr int NWAVES = 8;
constexpr int BATCH = 2, SEQ = 4096, DM = 4096, MROWS = BATCH * SEQ, FF = 11008, FF2 = 2 * FF, NQKV = 3 * DM;
constexpr int SB_H = 32, DF_H = 16, HD = 128;
constexpr float RMS_EPS = 1e-6f;
constexpr float LOG2E = 1.4426950408889634f;
constexpr float QSCALE = 0.08838834764831845f * LOG2E;
constexpr int NPH = 14;
constexpr size_t MiB = 1u << 20;
constexpr size_t WS_CTL = 0, CTL_ZERO_BYTES = 1 * MiB;
constexpr size_t WS_WQKV0 = 2 * MiB;
constexpr size_t WS_WO0   = WS_WQKV0 + 96 * MiB;
constexpr size_t WS_WQKV1 = WS_WO0 + 32 * MiB;
constexpr size_t WS_WO1   = WS_WQKV1 + 96 * MiB;
constexpr size_t WS_WUP0  = WS_WO1 + 32 * MiB;
constexpr size_t WS_WUP1  = WS_WUP0 + 172 * MiB;
constexpr size_t WS_WDN0  = WS_WUP1 + 172 * MiB;
constexpr size_t WS_WDN1  = WS_WDN0 + 86 * MiB;
constexpr size_t WS_XN    = WS_WDN1 + 86 * MiB;
constexpr size_t WS_PART  = WS_XN + 64 * MiB;
constexpr size_t WS_QKV   = WS_PART + 2 * MiB;
constexpr size_t WS_QKN   = WS_QKV + 192 * MiB;
constexpr size_t WS_AO    = WS_QKN + 128 * MiB;
constexpr size_t WS_U     = WS_AO + 64 * MiB;
constexpr size_t WS_ACT   = WS_U + 344 * MiB;
constexpr size_t WS_SCR   = WS_ACT + 172 * MiB;
constexpr size_t WS_HALO  = WS_SCR + 64 * MiB;
constexpr size_t WS_X1    = WS_HALO + 44 * MiB;
constexpr size_t WS_END   = WS_X1 + (MK_CHECK ? 3 * 128 * MiB : 0);
constexpr int CW_TMO = 0, CW_CODE = 1, CW_FAIL = 2, CW_BAR = 4096;

constexpr int RING_OFF = 0, RING_BYTES = 131072;
constexpr int LDSCTL_OFF = RING_BYTES, MISC_OFF = LDSCTL_OFF + 320;
constexpr int LDS_BYTES = 147456;
constexpr int RS_OFF = MISC_OFF + 128;
static_assert(RS_OFF % 16 == 0 && RS_OFF + 1088 + 2 * 4096 <= LDS_BYTES, "LDS map");

#define GAS __attribute__((address_space(1)))
#define LAS __attribute__((address_space(3)))
typedef unsigned short bf16;
typedef unsigned v4u __attribute__((ext_vector_type(4)));
typedef unsigned v2u __attribute__((ext_vector_type(2)));
typedef float f32x4 __attribute__((ext_vector_type(4)));
typedef short bf16x8 __attribute__((ext_vector_type(8)));
typedef GAS unsigned gu32;
#define RLX_AGENT __ATOMIC_RELAXED, __HIP_MEMORY_SCOPE_AGENT
#define LDS_WAIT() asm volatile("s_waitcnt lgkmcnt(0)" ::: "memory")
#define VM_WAIT() asm volatile("s_waitcnt vmcnt(0)" ::: "memory")
__device__ __forceinline__ unsigned f2bf(float f) { unsigned u = __builtin_bit_cast(unsigned, f); return (u + 0x7fffu + ((u >> 16) & 1u)) >> 16; }
__device__ __forceinline__ unsigned pk2(float lo, float hi) { return f2bf(lo) | (f2bf(hi) << 16); }
__device__ __forceinline__ float bf2f(unsigned short b) { return __builtin_bit_cast(float, (unsigned)b << 16); }

#define XB_TMO      128
#define XB_XCNT(j)  (256  + 64 * (j))
#define XB_XSUB(j)  (1280 + 64 * (j))
#define XB_XGEN(j)  (2304 + 64 * (j))
#define XB_TOP      3328
#define XB_TOPGEN   3392
#define XCD_BAR_WORDS 3456
#define XB_SPIN_CAP (1u << 18)
__device__ __forceinline__ unsigned xb_ld(unsigned* p)              { return __hip_atomic_load(p, __ATOMIC_RELAXED, __HIP_MEMORY_SCOPE_AGENT); }
__device__ __forceinline__ unsigned xb_add(unsigned* p, unsigned v) { return __hip_atomic_fetch_add(p, v, __ATOMIC_RELAXED, __HIP_MEMORY_SCOPE_AGENT); }
__device__ __forceinline__ unsigned xb_xcc_id() { return (unsigned)__builtin_amdgcn_s_getreg((3 << 11) | 20) & 0xFu; }
#define XB_SPIN(cond, bar) do { unsigned _sp = 0; while (cond) { __builtin_amdgcn_s_sleep(1); \
    if ((++_sp & 255u) == 0u) { if (xb_ld(&(bar)[XB_TMO])) break; if (_sp > XB_SPIN_CAP) { atomicAdd(&(bar)[XB_TMO], 1u); break; } } } } while (0)
struct XcdBarrier { unsigned* bar; unsigned x; volatile LAS unsigned* st; };
__device__ __forceinline__ XcdBarrier xcd_barrier_post(unsigned* bar, volatile LAS unsigned* st) {
    XcdBarrier b; b.bar = bar; b.x = xb_xcc_id(); b.st = st;
    if (threadIdx.x == 0) (void)xb_add(&bar[XB_XCNT(b.x)], 1u);
    return b;
}
__device__ __forceinline__ void xcd_barrier_complete(unsigned* bar, unsigned x, unsigned& nloc, unsigned& nx) {
    const unsigned G = gridDim.x * gridDim.y * gridDim.z;
    unsigned sum, cnt, mine, sp = 0u;
    for (;;) {
        sum = 0u; cnt = 0u; mine = 0u;
#pragma unroll
        for (unsigned j = 0; j < 16; ++j) { const unsigned c = xb_ld(&bar[XB_XCNT(j)]); sum += c; cnt += (c > 0u) ? 1u : 0u; mine = (j == x) ? c : mine; }
        if (sum == G) break;
        __builtin_amdgcn_s_sleep(1);
        if ((++sp & 255u) == 0u) { if (xb_ld(&bar[XB_TMO])) break; if (sp > XB_SPIN_CAP) { atomicAdd(&bar[XB_TMO], 1u); break; } }
    }
    nloc = mine > 0u ? mine : 1u; nx = cnt > 0u ? cnt : 1u;
}
__device__ __forceinline__ void xcd_barrier(const XcdBarrier& b) {
    asm volatile("s_waitcnt vmcnt(0)" ::: "memory");
    __syncthreads();
    if (threadIdx.x == 0) {
        unsigned* bar = b.bar; const unsigned myx = xb_xcc_id();
        __builtin_amdgcn_s_waitcnt(0);
        unsigned nloc = b.st[0], nx = b.st[1];
        if (nloc == 0u) { xcd_barrier_complete(bar, myx, nloc, nx); b.st[0] = nloc; b.st[1] = nx; }
        const unsigned old = xb_add(&bar[XB_XSUB(myx)], 1u);
        const unsigned gen = old / nloc;
        if (old + 1u == (gen + 1u) * nloc) {
            __builtin_amdgcn_fence(__ATOMIC_RELEASE, "agent");
            asm volatile("s_waitcnt vmcnt(0)" ::: "memory");
            const unsigned og = xb_add(&bar[XB_TOP], 1u);
            const unsigned tg = og / nx;
            if (og + 1u == (tg + 1u) * nx) xb_add(&bar[XB_TOPGEN], 1u);
            else XB_SPIN(xb_ld(&bar[XB_TOPGEN]) == tg, bar);
            __builtin_amdgcn_fence(__ATOMIC_ACQUIRE, "agent");
            xb_add(&bar[XB_XGEN(myx)], 1u);
            asm volatile("s_waitcnt vmcnt(0)" ::: "memory");
        } else {
            XB_SPIN(xb_ld(&bar[XB_XGEN(myx)]) == gen, bar);
            __builtin_amdgcn_fence(__ATOMIC_ACQUIRE, "agent");
            asm volatile("s_waitcnt vmcnt(0)" ::: "memory");
        }
    }
    __syncthreads();
}

__device__ __forceinline__ float wave_sum(float v) {
#pragma unroll
    for (int o = 1; o < 64; o <<= 1) v += __shfl_xor(v, o);
    return v;
}

constexpr int TR_STRIDE = 33;
__device__ __forceinline__ void transpose_item(const float* W, const float* gain, int K, int N, bf16* WT, LAS unsigned* scr, int item, int lane, bool gateperm) {
    const int nblk = N / 64, kb = item / nblk, nb = item % nblk, k0 = 64 * kb, n0 = 64 * nb;
    const int h_ = N / 2, nd0 = gateperm ? ((n0 % h_) / 128) * 256 + (n0 / h_) * 128 + (n0 % 128) : n0;
    const int kp = lane >> 4, c = lane & 15;
    f32x4 va[8], vb[8];
#pragma unroll
    for (int i = 0; i < 8; ++i) { const GAS float* src = (const GAS float*)W + (size_t)(k0 + 8 * i + 2 * kp) * N + n0 + 4 * c; va[i] = __builtin_nontemporal_load((const GAS f32x4*)src); vb[i] = __builtin_nontemporal_load((const GAS f32x4*)(src + N)); }
#pragma unroll
    for (int i = 0; i < 8; ++i) { float ga = 1.f, gb = 1.f; if (gain) { ga = gain[k0 + 8 * i + 2 * kp]; gb = gain[k0 + 8 * i + 2 * kp + 1]; }
        LAS unsigned* d = scr + (4 * c) * TR_STRIDE + 4 * i + kp;
        d[0 * TR_STRIDE] = pk2(va[i].x * ga, vb[i].x * gb); d[1 * TR_STRIDE] = pk2(va[i].y * ga, vb[i].y * gb);
        d[2 * TR_STRIDE] = pk2(va[i].z * ga, vb[i].z * gb); d[3 * TR_STRIDE] = pk2(va[i].w * ga, vb[i].w * gb); }
    LDS_WAIT(); asm volatile("" ::: "memory");
    const int c8 = lane & 7, nr = lane >> 3;
#pragma unroll
    for (int j = 0; j < 8; ++j) { const int n = nr + 8 * j; const LAS unsigned* s = scr + n * TR_STRIDE + 4 * c8;
        v4u o; o.x = s[0]; o.y = s[1]; o.z = s[2]; o.w = s[3];
        *(GAS v4u*)(WT + (size_t)(nd0 + n) * K + k0 + 8 * c8) = o; }
    LDS_WAIT(); asm volatile("" ::: "memory");
}
__device__ __forceinline__ void xrow_to_bf16(const float* xrow, bf16* orow, float* prow, int lane) {
    const GAS f32x4* xr = (const GAS f32x4*)xrow + lane;
    float s = 0.f; GAS unsigned long long* o8 = (GAS unsigned long long*)orow + lane;
#pragma unroll
    for (int j = 0; j < 16; ++j) { const f32x4 v = xr[64 * j]; s += (v.x * v.x + v.y * v.y) + (v.z * v.z + v.w * v.w);
        o8[64 * j] = (unsigned long long)pk2(v.x, v.y) | ((unsigned long long)pk2(v.z, v.w) << 32); }
    s = wave_sum(s);
    prow[lane] = lane == 0 ? s : 0.f;
}

__device__ __forceinline__ void cvt8(const v4u w, float (&f)[8]) {
    f[0] = __builtin_bit_cast(float, w.x << 16); f[1] = __builtin_bit_cast(float, w.x & 0xffff0000u); f[2] = __builtin_bit_cast(float, w.y << 16); f[3] = __builtin_bit_cast(float, w.y & 0xffff0000u);
    f[4] = __builtin_bit_cast(float, w.z << 16); f[5] = __builtin_bit_cast(float, w.z & 0xffff0000u); f[6] = __builtin_bit_cast(float, w.w << 16); f[7] = __builtin_bit_cast(float, w.w & 0xffff0000u);
}
constexpr int CG_ROWS = 32, CG_NCG = FF / 8, CG_ITEMS = (MROWS / CG_ROWS) * CG_NCG;
__device__ __forceinline__ void convgate_item(const bf16* U, const float* cw, const float* cb, bf16* ACT, int item) {
    const int chunk = item / CG_NCG, cg = item % CG_NCG, m0 = chunk * CG_ROWS, t0 = m0 % SEQ, j0 = cg * 8;
    float wg[3][8], wv[3][8], bg[8], bv[8];
#pragma unroll
    for (int i = 0; i < 3; ++i)
#pragma unroll
        for (int h = 0; h < 2; ++h) { const f32x4 a = *(const f32x4*)(cw + (size_t)i * FF2 + j0 + 4 * h), b = *(const f32x4*)(cw + (size_t)i * FF2 + FF + j0 + 4 * h);
            wg[i][4 * h] = a.x; wg[i][4 * h + 1] = a.y; wg[i][4 * h + 2] = a.z; wg[i][4 * h + 3] = a.w; wv[i][4 * h] = b.x; wv[i][4 * h + 1] = b.y; wv[i][4 * h + 2] = b.z; wv[i][4 * h + 3] = b.w; }
#pragma unroll
    for (int h = 0; h < 2; ++h) { const f32x4 a = *(const f32x4*)(cb + j0 + 4 * h), b = *(const f32x4*)(cb + FF + j0 + 4 * h);
        bg[4 * h] = a.x; bg[4 * h + 1] = a.y; bg[4 * h + 2] = a.z; bg[4 * h + 3] = a.w; bv[4 * h] = b.x; bv[4 * h + 1] = b.y; bv[4 * h + 2] = b.z; bv[4 * h + 3] = b.w; }
    float g2[8], g1[8], v2[8], v1[8];
    const v4u z4 = {0u, 0u, 0u, 0u};
    { const v4u a = t0 >= 2 ? *(const GAS v4u*)(U + (size_t)(m0 - 2) * FF2 + j0) : z4, b = t0 >= 2 ? *(const GAS v4u*)(U + (size_t)(m0 - 2) * FF2 + FF + j0) : z4; cvt8(a, g2); cvt8(b, v2); }
    { const v4u a = t0 >= 1 ? *(const GAS v4u*)(U + (size_t)(m0 - 1) * FF2 + j0) : z4, b = t0 >= 1 ? *(const GAS v4u*)(U + (size_t)(m0 - 1) * FF2 + FF + j0) : z4; cvt8(a, g1); cvt8(b, v1); }
#pragma unroll 4
    for (int r = 0; r < CG_ROWS; ++r) {
        float g0[8], v0[8]; cvt8(*(const GAS v4u*)(U + (size_t)(m0 + r) * FF2 + j0), g0); cvt8(*(const GAS v4u*)(U + (size_t)(m0 + r) * FF2 + FF + j0), v0);
        float o[8];
#pragma unroll
        for (int e = 0; e < 8; ++e) { const float cgv = bg[e] + wg[0][e] * g2[e] + wg[1][e] * g1[e] + wg[2][e] * g0[e]; const float cvv = bv[e] + wv[0][e] * v2[e] + wv[1][e] * v1[e] + wv[2][e] * v0[e];
            const float sg = cgv * __builtin_amdgcn_rcpf(1.f + __builtin_amdgcn_exp2f(-cgv * LOG2E)); o[e] = sg * cvv; g2[e] = g1[e]; g1[e] = g0[e]; v2[e] = v1[e]; v1[e] = v0[e]; }
        v4u w; w.x = pk2(o[0], o[1]); w.y = pk2(o[2], o[3]); w.z = pk2(o[4], o[5]); w.w = pk2(o[6], o[7]);
        *(GAS v4u*)(ACT + (size_t)(m0 + r) * FF + j0) = w;
    }
}

constexpr int FX_ITEMS = (MROWS / 64) * CG_NCG;
__device__ __forceinline__ void ld8(const float* p, float (&f)[8]) { const f32x4 a = *(const GAS f32x4*)p, b = *(const GAS f32x4*)(p + 4); f[0] = a.x; f[1] = a.y; f[2] = a.z; f[3] = a.w; f[4] = b.x; f[5] = b.y; f[6] = b.z; f[7] = b.w; }
__device__ __forceinline__ void fixup_item(const float* halo, const float* cw, const float* cb, bf16* ACT, int item) {
    const int grp = item / CG_NCG, cg = item % CG_NCG, j0 = cg * 8; const bool first = (grp % (SEQ / 64)) == 0;
    float wg[3][8], wv[3][8], bg[8], bv[8];
#pragma unroll
    for (int i = 0; i < 3; ++i) { ld8(cw + (size_t)i * FF2 + j0, wg[i]); ld8(cw + (size_t)i * FF2 + FF + j0, wv[i]); }
    ld8(cb + j0, bg); ld8(cb + FF + j0, bv);
    float h0g[8], h0v[8], h1g[8], h1v[8], t0g[8], t0v[8], t1g[8], t1v[8];
    const float* hb = halo + (size_t)grp * 4 * FF2 + j0;
    ld8(hb, h0g); ld8(hb + FF, h0v); ld8(hb + FF2, h1g); ld8(hb + FF2 + FF, h1v);
    if (!first) { const float* pb = hb - 4 * (size_t)FF2; ld8(pb + 2 * (size_t)FF2, t0g); ld8(pb + 2 * (size_t)FF2 + FF, t0v); ld8(pb + 3 * (size_t)FF2, t1g); ld8(pb + 3 * (size_t)FF2 + FF, t1v); }
    else {
#pragma unroll
        for (int e = 0; e < 8; ++e) { t0g[e] = 0.f; t0v[e] = 0.f; t1g[e] = 0.f; t1v[e] = 0.f; } }
    float o0[8], o1[8];
#pragma unroll
    for (int e = 0; e < 8; ++e) {
        const float cg0 = bg[e] + wg[0][e] * t0g[e] + wg[1][e] * t1g[e] + wg[2][e] * h0g[e], cv0 = bv[e] + wv[0][e] * t0v[e] + wv[1][e] * t1v[e] + wv[2][e] * h0v[e];
        const float cg1 = bg[e] + wg[0][e] * t1g[e] + wg[1][e] * h0g[e] + wg[2][e] * h1g[e], cv1 = bv[e] + wv[0][e] * t1v[e] + wv[1][e] * h0v[e] + wv[2][e] * h1v[e];
        o0[e] = cg0 * __builtin_amdgcn_rcpf(1.f + __builtin_amdgcn_exp2f(-cg0 * LOG2E)) * cv0; o1[e] = cg1 * __builtin_amdgcn_rcpf(1.f + __builtin_amdgcn_exp2f(-cg1 * LOG2E)) * cv1; }
    v4u w0, w1; w0.x = pk2(o0[0], o0[1]); w0.y = pk2(o0[2], o0[3]); w0.z = pk2(o0[4], o0[5]); w0.w = pk2(o0[6], o0[7]);
    w1.x = pk2(o1[0], o1[1]); w1.y = pk2(o1[2], o1[3]); w1.z = pk2(o1[4], o1[5]); w1.w = pk2(o1[6], o1[7]);
    *(GAS v4u*)(ACT + (size_t)(grp * 64) * FF + j0) = w0; *(GAS v4u*)(ACT + (size_t)(grp * 64 + 1) * FF + j0) = w1;
}

__device__ __forceinline__ void sincos_rev(float ang, float& s, float& c) {
    const float I1 = 0.15915493667125702f, I2 = 6.420638326565253e-09f;
    const float r1 = ang * I1; const float e1 = __builtin_fmaf(ang, I1, -r1); const float r2 = __builtin_fmaf(ang, I2, e1);
    const float fr = (r1 - __builtin_rintf(r1)) + r2;
    s = __builtin_amdgcn_sinf(fr); c = __builtin_amdgcn_cosf(fr);
}
__device__ __forceinline__ void qknorm_row(const bf16* qkv_row, bf16* qkn_row, const float* gq, const float* gk, int t, int lane) {
    const int c = lane & 7, gs = lane >> 3;
    float cs[8], sn[8];
#pragma unroll
    for (int e = 0; e < 8; ++e) { const int i = 8 * c + e; const float invf = __builtin_amdgcn_exp2f(-(float)i * (13.287712379549449f / 64.f));
        sincos_rev((float)t * invf, sn[e], cs[e]); }
    float gA[8], gB[8];
#pragma unroll 1
    for (int qk = 0; qk < 2; ++qk) {
        const float* gn = qk ? gk : gq; const float sc = qk ? 1.f : QSCALE;
#pragma unroll
        for (int e = 0; e < 8; ++e) { gA[e] = gn[8 * c + e]; gB[e] = gn[64 + 8 * c + e]; }
        v4u ra[4], rb[4];
#pragma unroll
        for (int it = 0; it < 4; ++it) { const int col = qk * 4096 + (it * 8 + gs) * 128 + 8 * c; ra[it] = *(const GAS v4u*)(qkv_row + col); rb[it] = *(const GAS v4u*)(qkv_row + col + 64); }
#pragma unroll
        for (int it = 0; it < 4; ++it) {
            const int col = qk * 4096 + (it * 8 + gs) * 128 + 8 * c;
            float xa[8], xb[8]; cvt8(ra[it], xa); cvt8(rb[it], xb);
            float ss = 0.f;
#pragma unroll
            for (int e = 0; e < 8; ++e) ss += xa[e] * xa[e] + xb[e] * xb[e];
            ss += __shfl_xor(ss, 1); ss += __shfl_xor(ss, 2); ss += __shfl_xor(ss, 4);
            const float inv = rsqrtf(ss * (1.f / 128.f) + RMS_EPS);
            float oa[8], ob[8];
#pragma unroll
            for (int e = 0; e < 8; ++e) { const float ya = xa[e] * inv * gA[e], yb = xb[e] * inv * gB[e]; oa[e] = (ya * cs[e] - yb * sn[e]) * sc; ob[e] = (yb * cs[e] + ya * sn[e]) * sc; }
            v4u wa, wb; wa.x = pk2(oa[0], oa[1]); wa.y = pk2(oa[2], oa[3]); wa.z = pk2(oa[4], oa[5]); wa.w = pk2(oa[6], oa[7]);
            wb.x = pk2(ob[0], ob[1]); wb.y = pk2(ob[2], ob[3]); wb.z = pk2(ob[4], ob[5]); wb.w = pk2(ob[6], ob[7]);
            *(GAS v4u*)(qkn_row + col) = wa; *(GAS v4u*)(qkn_row + col + 64) = wb;
        }
    }
}
#ifdef QKN_FAST
__device__ __forceinline__ unsigned qkn_pk(float lo, float hi) { unsigned r; asm volatile("v_cvt_pk_bf16_f32 %0, %1, %2" : "=v"(r) : "v"(lo), "v"(hi)); return r; }
__device__ __forceinline__ void qknorm_rows(const bf16* qkv, bf16* qkn, const float* gq, const float* gk, int gw, int ngw, int lane) {
    const int c = lane & 7, gs = lane >> 3;
    float gA[2][8], gB[2][8];
#pragma unroll
    for (int e = 0; e < 8; ++e) { gA[0][e] = gq[8 * c + e]; gB[0][e] = gq[64 + 8 * c + e]; gA[1][e] = gk[8 * c + e]; gB[1][e] = gk[64 + 8 * c + e]; }
#pragma unroll 1
    for (int m = gw; m < MROWS; m += ngw) {
        const bf16* qkv_row = qkv + (size_t)m * NQKV; bf16* qkn_row = qkn + (size_t)m * 8192; const int t = m % SEQ;
        v4u ra[2][4], rb[2][4];
#pragma unroll
        for (int qk = 0; qk < 2; ++qk)
#pragma unroll
            for (int it = 0; it < 4; ++it) { const int col = qk * 4096 + (it * 8 + gs) * 128 + 8 * c; ra[qk][it] = *(const GAS v4u*)(qkv_row + col); rb[qk][it] = *(const GAS v4u*)(qkv_row + col + 64); }
        float cs[8], sn[8];
#pragma unroll
        for (int e = 0; e < 8; ++e) { const int i = 8 * c + e; const float invf = __builtin_amdgcn_exp2f(-(float)i * (13.287712379549449f / 64.f));
            sincos_rev((float)t * invf, sn[e], cs[e]); }
#pragma unroll
        for (int qk = 0; qk < 2; ++qk) { const float sc = qk ? 1.f : QSCALE;
#pragma unroll
            for (int it = 0; it < 4; ++it) {
                const int col = qk * 4096 + (it * 8 + gs) * 128 + 8 * c;
                float xa[8], xb[8]; cvt8(ra[qk][it], xa); cvt8(rb[qk][it], xb);
                float ss = 0.f;
#pragma unroll
                for (int e = 0; e < 8; ++e) ss += xa[e] * xa[e] + xb[e] * xb[e];
                ss += __shfl_xor(ss, 1); ss += __shfl_xor(ss, 2); ss += __shfl_xor(ss, 4);
                const float inv = rsqrtf(ss * (1.f / 128.f) + RMS_EPS);
                float oa[8], ob[8];
#pragma unroll
                for (int e = 0; e < 8; ++e) { const float ya = xa[e] * inv * gA[qk][e], yb = xb[e] * inv * gB[qk][e]; oa[e] = (ya * cs[e] - yb * sn[e]) * sc; ob[e] = (yb * cs[e] + ya * sn[e]) * sc; }
                v4u wa, wb; wa.x = qkn_pk(oa[0], oa[1]); wa.y = qkn_pk(oa[2], oa[3]); wa.z = qkn_pk(oa[4], oa[5]); wa.w = qkn_pk(oa[6], oa[7]);
                wb.x = qkn_pk(ob[0], ob[1]); wb.y = qkn_pk(ob[2], ob[3]); wb.z = qkn_pk(ob[4], ob[5]); wb.w = qkn_pk(ob[6], ob[7]);
                *(GAS v4u*)(qkn_row + col) = wa; *(GAS v4u*)(qkn_row + col + 64) = wb;
            }
        }
    }
}
#endif
struct Args { const float* in[18]; float* out; unsigned char* ws; int ph_lo, ph_hi; };
static_assert(sizeof(Args) == 18 * 8 + 8 + 8 + 8, "Args has no padding");

struct MatDesc { int in_idx; size_t in_off; int gain_idx; size_t gain_off; int K, N; size_t ws_off; int gateperm; };
__device__ __forceinline__ MatDesc mat_desc(int i) {
    switch (i) {
    case 0: return MatDesc{2, 0, 1, 0, DM, NQKV, WS_WQKV0, 0};
    case 1: return MatDesc{3, 0, -1, 0, DM, DM, WS_WO0, 0};
    case 2: return MatDesc{14, 0, 13, 0, DM, FF2, WS_WUP0, 1};
    case 3: return MatDesc{17, 0, -1, 0, FF, DM, WS_WDN0, 0};
    case 4: return MatDesc{4, 0, 1, (size_t)DM, DM, NQKV, WS_WQKV1, 0};
    case 5: return MatDesc{5, 0, -1, 0, DM, DM, WS_WO1, 0};
    case 6: return MatDesc{14, (size_t)DM * FF2, 13, (size_t)DM, DM, FF2, WS_WUP1, 1};
    default: return MatDesc{17, (size_t)FF * DM, -1, 0, FF, DM, WS_WDN1, 0};
    }
}

__global__ void __launch_bounds__(NWAVES * 64, 2) mk_fwd(Args args) {
    extern __shared__ __attribute__((aligned(16))) unsigned char lds[];
    LAS unsigned char* ldsl = (LAS unsigned char*)lds;
    volatile LAS unsigned* MISC = (volatile LAS unsigned*)(ldsl + MISC_OFF);
    const int tid = threadIdx.x, lane = tid & 63, wave = __builtin_amdgcn_readfirstlane(tid >> 6);
    const int G = gridDim.x, bx = blockIdx.x;
    const int gw = bx * NWAVES + wave, NGW = G * NWAVES;
    unsigned char* ws = args.ws;
    gu32* ctl = (gu32*)(ws + WS_CTL);
    for (int u = tid; u < (LDS_BYTES - LDSCTL_OFF) / 4; u += NWAVES * 64) ((LAS unsigned*)(ldsl + LDSCTL_OFF))[u] = 0u;
    __syncthreads();
    XcdBarrier bar; bar.bar = (unsigned*)(ctl + CW_BAR); bar.x = 0; bar.st = nullptr;
    const int lo = args.ph_lo, hi = args.ph_hi;
    if (hi - lo > 1) bar = xcd_barrier_post((unsigned*)(ctl + CW_BAR), MISC + 8);
#ifndef PH_MASK
#define PH_MASK 0x3fff
#endif
#define IN(k) (((PH_MASK >> (k)) & 1) && lo <= (k) && (k) < hi)
#define RS_TAG_RESET() do { if (tid == 0) ((LAS int*)(ldsl + RS_OFF))[256] = -1; __syncthreads(); } while (0)
#define SEAM(k) do { if (IN(k) && IN((k) + 1)) xcd_barrier(bar); STAMP((k) + 1); } while (0)
#ifndef REPEAT_PHASE
#define REPEAT_PHASE -1
#endif
#ifndef REPEAT_N
#define REPEAT_N 1
#endif
#ifndef LEAK_A
#define LEAK_A -1
#endif
#ifndef LEAK_B
#define LEAK_B 14
#endif
#ifndef LEAK_OFF
#define LEAK_OFF 0
#endif
    unsigned long long tA = 0, tB = 0;
#define STAMP(k) do { if (LEAK_A >= 0 && bx == 0 && tid == 0) { if ((k) == LEAK_A) tA = __builtin_amdgcn_s_memrealtime(); if ((k) == LEAK_B) tB = __builtin_amdgcn_s_memrealtime(); } } while (0)
#define NREP(k) (REPEAT_PHASE == (k) ? 1 + REPEAT_N : 1)
    float* DUMMY = (float*)(ws + WS_END);

    bf16* XN = (bf16*)(ws + WS_XN); float* PART = (float*)(ws + WS_PART);
    bf16* QKV = (bf16*)(ws + WS_QKV); bf16* QKN = (bf16*)(ws + WS_QKN); bf16* AO = (bf16*)(ws + WS_AO);
    bf16* ACT = (bf16*)(ws + WS_ACT); float* HALO = (float*)(ws + WS_HALO);
    const float* x_in = args.in[0];

#ifndef JIT_CONV
#define JIT_CONV 1
#endif
#define CONVERT_MAT(MI) do { const MatDesc md = mat_desc(MI); LAS unsigned* scr_ = (LAS unsigned*)(ldsl + RING_OFF + wave * 16384); \
        const float* W_ = args.in[md.in_idx] + md.in_off; const float* gain_ = md.gain_idx >= 0 ? args.in[md.gain_idx] + md.gain_off : nullptr; \
        bf16* WT_ = (bf16*)(ws + md.ws_off); const int nitems_ = (md.K / 64) * (md.N / 64); \
        for (int it_ = gw; it_ < nitems_; it_ += NGW) transpose_item(W_, gain_, md.K, md.N, WT_, scr_, it_, lane, md.gateperm != 0); } while (0)
#define CONVERT_MAT_RANGE(MI, I0, I1, WG0) do { const MatDesc md = mat_desc(MI); LAS unsigned* scr_ = (LAS unsigned*)(ldsl + RING_OFF + wave * 16384); \
        const float* W_ = args.in[md.in_idx] + md.in_off; const float* gain_ = md.gain_idx >= 0 ? args.in[md.gain_idx] + md.gain_off : nullptr; \
        bf16* WT_ = (bf16*)(ws + md.ws_off); const int i1_ = (I1); \
        for (int it_ = (I0) + (bx - (WG0)) * NWAVES + wave; it_ < i1_; it_ += (G - (WG0)) * NWAVES) transpose_item(W_, gain_, md.K, md.N, WT_, scr_, it_, lane, md.gateperm != 0); } while (0)
#ifndef TAILFILL
#define TAILFILL 1
#endif
#ifndef DN_NUM
#define DN_NUM 52
#endif
constexpr int DN_ITEMS = (FF / 64) * (DM / 64), DN_SPLIT = TAILFILL ? (DN_ITEMS * DN_NUM) / 100 : 0;
#ifndef SPLIT_CONV
#define SPLIT_CONV 1
#endif
#ifdef PROBE_XCC
    if (tid == 0) __hip_atomic_store(ctl + 2048 + bx, 1u + xb_xcc_id(), RLX_AGENT);
#endif
    STAMP(0);
    if (IN(0)) _Pragma("unroll") for (int rep = 0; rep < NREP(0); ++rep) { if (rep) xcd_barrier(bar);
        LAS unsigned* scr = (LAS unsigned*)(ldsl + RING_OFF + wave * 16384);
#pragma unroll 1
#if JIT_CONV
        for (int m = gw; m < MROWS; m += NGW) xrow_to_bf16(x_in + (size_t)m * DM, XN + (size_t)m * DM, PART + (size_t)m * pg8::NPART, lane);
        CONVERT_MAT(0);
    }
#else
        for (int mo = 0; mo < (SPLIT_CONV ? 4 : 8); ++mo) { const int mi = SPLIT_CONV ? ((mo + 1) & 3) : ((mo + 1) & 7); const MatDesc md = mat_desc(mi);
            if (mi == 0) { for (int m = gw; m < MROWS; m += NGW) xrow_to_bf16(x_in + (size_t)m * DM, XN + (size_t)m * DM, PART + (size_t)m * pg8::NPART, lane); }
            const float* W = args.in[md.in_idx] + md.in_off; const float* gain = md.gain_idx >= 0 ? args.in[md.gain_idx] + md.gain_off : nullptr;
            bf16* WT = (bf16*)(ws + md.ws_off); const int nitems = (md.K / 64) * (md.N / 64);
            for (int it = gw; it < nitems; it += NGW) transpose_item(W, gain, md.K, md.N, WT, scr, it, lane, md.gateperm != 0); }
    }
#endif
    SEAM(0);
    if (IN(1)) _Pragma("unroll") for (int rep = 0; rep < NREP(1); ++rep) { if (rep) xcd_barrier(bar);
        pg8::Gemm g{XN, (const bf16*)(ws + WS_WQKV0), MROWS, NQKV, DM}; pg8::StaticOrder S; S.init(MROWS, NQKV, G, bx);
        pg8::EpiScale E{QKV, NQKV, PART, 1.f / DM, RMS_EPS, DM, QSCALE, (LAS float*)(ldsl + RS_OFF)};
        RS_TAG_RESET();
        pg8::gemm_phase<pg8::EpiScale, pg8::StaticOrder, PG8_ALIGN, PG8_SP2>(ldsl + RING_OFF, g, S, E);
    }
    SEAM(1);
    if (IN(2)) _Pragma("unroll") for (int rep = 0; rep < NREP(2); ++rep) { if (rep) xcd_barrier(bar);
        constexpr int NBLK = BATCH * SB_H * (SEQ / 256);
        for (int L = bx; L < NBLK; L += G) { const int qb = L % 16, bh = L / 16, b = bh / SB_H, h = bh % SB_H;
            const bf16* kvbase = QKV + (size_t)(b * SEQ) * NQKV + h * HD;
            att::sb_block<NQKV, NQKV, NQKV, DM>(kvbase + (size_t)(qb * 256) * NQKV, kvbase + DM, kvbase + 2 * DM, AO + (size_t)(b * SEQ + qb * 256) * DM + h * HD, qb * 256, (char*)lds + RING_OFF, (volatile LAS unsigned*)(ldsl + RING_OFF + 65536)); }
        if (JIT_CONV) CONVERT_MAT(1);
    }
    SEAM(2);
    if (IN(3)) _Pragma("unroll") for (int rep = 0; rep < NREP(3); ++rep) { if (rep) xcd_barrier(bar);
        pg8::Gemm g{AO, (const bf16*)(ws + WS_WO0), MROWS, DM, DM}; pg8::StaticOrder S; S.init(MROWS, DM, G, bx);
        pg8::EpiResid<false, false> E{nullptr, nullptr, XN, PART, DM};
        pg8::gemm_phase<pg8::EpiResid<false, false>, pg8::StaticOrder, PG8_ALIGN, PG8_SP2>(ldsl + RING_OFF, g, S, E);
        if (JIT_CONV) CONVERT_MAT(2);
    }
    SEAM(3);
#define UP_PHASE(WOFF, LAYER) do { pg8::Gemm g{XN, (const bf16*)(ws + (WOFF)), MROWS, FF2, DM}; pg8::StaticOrder S; S.init(MROWS, FF2, G, bx); \
        pg8::EpiConvGate E{ACT, FF, PART, 1.f / DM, RMS_EPS, args.in[15] + (size_t)(LAYER) * 3 * FF2, args.in[16] + (size_t)(LAYER) * FF2, HALO, (LAS float*)(ldsl + RS_OFF)}; RS_TAG_RESET(); \
        pg8::gemm_phase<pg8::EpiConvGate, pg8::StaticOrder, PG8_ALIGN, PG8_SP2>(ldsl + RING_OFF, g, S, E); } while (0)
#define CG_PHASE(LAYER) do { const float* cw = args.in[15] + (size_t)(LAYER) * 3 * FF2; const float* cb = args.in[16] + (size_t)(LAYER) * FF2; \
        for (int it = bx * (NWAVES * 64) + tid; it < FX_ITEMS; it += G * NWAVES * 64) fixup_item(HALO, cw, cb, ACT, it); } while (0)
#ifndef DOWN_WGM
#define DOWN_WGM 8
#endif
#define DOWN_PHASE(WOFF, OUT, LAST) do { pg8::Gemm g{ACT, (const bf16*)(ws + (WOFF)), MROWS, DM, FF}; pg8::StaticOrder S; S.init(MROWS, DM, G, bx, DOWN_WGM); \
        pg8::EpiResid<false, LAST> E{nullptr, OUT, XN, PART, DM}; \
        pg8::gemm_phase<pg8::EpiResid<false, LAST>, pg8::StaticOrder, PG8_ALIGN, PG8_SP2>(ldsl + RING_OFF, g, S, E); } while (0)
    const int up_units = (MROWS / 256) * (FF2 / 256), up_full = up_units % G;
    if (IN(4)) _Pragma("unroll") for (int rep = 0; rep < NREP(4); ++rep) { if (rep) xcd_barrier(bar); UP_PHASE(WS_WUP0, 0); if (JIT_CONV && TAILFILL && up_full && bx >= up_full) CONVERT_MAT_RANGE(3, 0, DN_SPLIT, up_full); }
    SEAM(4);
    if (IN(5)) _Pragma("unroll") for (int rep = 0; rep < NREP(5); ++rep) { if (rep) xcd_barrier(bar); CG_PHASE(0); if (JIT_CONV) { if (TAILFILL && up_full) CONVERT_MAT_RANGE(3, DN_SPLIT, DN_ITEMS, 0); else CONVERT_MAT(3); } }
    SEAM(5);
    if (IN(6)) { DOWN_PHASE(WS_WDN0, nullptr, false); for (int rep = 1; rep < NREP(6); ++rep) { xcd_barrier(bar); DOWN_PHASE(WS_WDN0, DUMMY, true); } if (JIT_CONV) CONVERT_MAT(4); }
    SEAM(6);
#ifdef PROBE_LATE_QKV
    { pg8::Gemm g{XN, (const bf16*)(ws + WS_WQKV0), MROWS, NQKV, DM}; pg8::StaticOrder S; S.init(MROWS, NQKV, G, bx);
      pg8::EpiScale E{QKV, NQKV, PART, 1.f / DM, RMS_EPS, DM, QSCALE, (LAS float*)(ldsl + RS_OFF)};
      pg8::gemm_phase<pg8::EpiScale, pg8::StaticOrder, PG8_ALIGN, PG8_SP2>(ldsl + RING_OFF, g, S, E); xcd_barrier(bar); }
#if PROBE_LATE_QKV == 2
    { pg8::Gemm g{XN, (const bf16*)(ws + WS_WQKV0), MROWS, NQKV, DM}; pg8::StaticOrder S; S.init(MROWS, NQKV, G, bx);
      pg8::EpiScale E{QKV, NQKV, PART, 1.f / DM, RMS_EPS, DM, QSCALE, (LAS float*)(ldsl + RS_OFF)};
      pg8::gemm_phase<pg8::EpiScale, pg8::StaticOrder, PG8_ALIGN, PG8_SP2>(ldsl + RING_OFF, g, S, E); xcd_barrier(bar); }
#endif
#endif
    if (IN(7)) _Pragma("unroll") for (int rep = 0; rep < NREP(7); ++rep) { if (rep) xcd_barrier(bar);
        pg8::Gemm g{XN, (const bf16*)(ws + WS_WQKV1), MROWS, NQKV, DM}; pg8::StaticOrder S; S.init(MROWS, NQKV, G, bx);
        pg8::EpiScale E{QKV, NQKV, PART, 1.f / DM, RMS_EPS, 0, 1.f, (LAS float*)(ldsl + RS_OFF)};
        RS_TAG_RESET();
        pg8::gemm_phase<pg8::EpiScale, pg8::StaticOrder, PG8_ALIGN, PG8_SP2>(ldsl + RING_OFF, g, S, E);
    }
    SEAM(7);
    if (IN(8)) _Pragma("unroll") for (int rep = 0; rep < NREP(8); ++rep) { if (rep) xcd_barrier(bar);
#ifdef QKN_FAST
        qknorm_rows(QKV, QKN, args.in[6], args.in[7], gw, NGW, lane); }
#else
        for (int m = gw; m < MROWS; m += NGW) qknorm_row(QKV + (size_t)m * NQKV, QKN + (size_t)m * 8192, args.in[6], args.in[7], m % SEQ, lane); }
#endif
    SEAM(8);
    if (IN(9)) _Pragma("unroll") for (int rep = 0; rep < NREP(9); ++rep) { if (rep) xcd_barrier(bar);
        float lam, omli;
        { const float a1 = wave_sum(args.in[8][lane] * args.in[9][lane] + args.in[8][lane + 64] * args.in[9][lane + 64]);
          const float a2 = wave_sum(args.in[10][lane] * args.in[11][lane] + args.in[10][lane + 64] * args.in[11][lane + 64]);
          const float li = 0.8f - 0.6f * 0.7408182206817179f;
          lam = __expf(a1) - __expf(a2) + li; omli = 1.f - li; }
        float mq = fmaxf(fabsf(args.in[6][lane]), fabsf(args.in[6][lane + 64])), mk = fmaxf(fabsf(args.in[7][lane]), fabsf(args.in[7][lane + 64]));
#pragma unroll
        for (int o_ = 1; o_ < 64; o_ <<= 1) { mq = fmaxf(mq, __shfl_xor(mq, o_)); mk = fmaxf(mk, __shfl_xor(mk, o_)); }
        att::Diff2Const C{lam, omli, RMS_EPS, QSCALE * 128.f * mq * mk * 1.02f, args.in[12]};
        constexpr int NITEM = BATCH * DF_H * 16;
        for (int w = bx; w < NITEM; w += G) {
            const int bh = (w & 7) * 4 + ((w >> 3) >> 4), xq = (w >> 3) & 15, b = bh / DF_H, h = bh % DF_H;
            const bf16* qn = QKN + (size_t)(b * SEQ) * 8192 + h * 256; const bf16* vb = QKV + (size_t)(b * SEQ) * NQKV + 2 * DM + h * 256;
#pragma unroll 1
            for (int ps = 0; ps < 2; ++ps) { const int qb = ps ? 31 - xq : xq;
                att::diff2_block<8192, 8192, NQKV, DM>(qn + (size_t)(qb * 128) * 8192, qn + 4096, vb, AO + (size_t)(b * SEQ + qb * 128) * DM + h * 256, qb * 128, C, (char*)lds + RING_OFF); }
        }
        if (JIT_CONV) CONVERT_MAT(5);
    }
    SEAM(9);
    if (IN(10)) {
        pg8::Gemm g{AO, (const bf16*)(ws + WS_WO1), MROWS, DM, DM}; pg8::StaticOrder S; S.init(MROWS, DM, G, bx);
        pg8::EpiResid<false, false> E{nullptr, nullptr, XN, PART, DM};
        pg8::gemm_phase<pg8::EpiResid<false, false>, pg8::StaticOrder, PG8_ALIGN, PG8_SP2>(ldsl + RING_OFF, g, S, E);
        if (JIT_CONV) CONVERT_MAT(6);
    }
    SEAM(10);
    if (IN(11)) { UP_PHASE(WS_WUP1, 1); if (JIT_CONV && TAILFILL && up_full && bx >= up_full) CONVERT_MAT_RANGE(7, 0, DN_SPLIT, up_full); }
    SEAM(11);
    if (IN(12)) { CG_PHASE(1); if (JIT_CONV) { if (TAILFILL && up_full) CONVERT_MAT_RANGE(7, DN_SPLIT, DN_ITEMS, 0); else CONVERT_MAT(7); } }
    SEAM(12);
    if (IN(13)) DOWN_PHASE(WS_WDN1, args.out, true);
#ifdef PROBE_XCC
    { xcd_barrier(bar);
      if (bx == 0 && tid == 0) { unsigned bad = 0; for (int i = 0; i < G; ++i) { const unsigned xi = __hip_atomic_load(ctl + 2048 + i, RLX_AGENT), xr = __hip_atomic_load(ctl + 2048 + (i & 7), RLX_AGENT); if (xi != xr || xi == 0u) ++bad; }
          for (int r = 0; r < 8; ++r) for (int q = r + 1; q < 8; ++q) if (__hip_atomic_load(ctl + 2048 + r, RLX_AGENT) == __hip_atomic_load(ctl + 2048 + q, RLX_AGENT)) bad += 1000;
          if (bad) args.out[0] = 1000.f * (float)bad; } }
#endif
    if (LEAK_A >= 0) { xcd_barrier(bar); STAMP(14); if (bx == 0 && tid == 0) args.out[0] = 1000.f * ((float)(long long)(tB - tA) * 0.01f - (float)(LEAK_OFF)); }
#undef IN
#undef SEAM
}
#if MK_CHECK
#include "check.inc"
#endif
extern "C" void kernel_launch(void* const* d_in, const int* in_sizes, int n_in, void* d_out, int out_size, void* d_ws, size_t ws_size, hipStream_t stream) {
    static int grid = 0;
    if (grid == 0) {
        if (n_in != 18 || in_sizes[0] != MROWS * DM || out_size != MROWS * DM || ws_size < WS_END) {
            fprintf(stderr, "kernel_launch: built for 18 inputs, x/out of %d floats, >= %zu bytes of workspace; got n_in %d, in0 %d, out %d, ws %zu; nothing launched\n", MROWS * DM, (size_t)WS_END, n_in, n_in > 0 ? in_sizes[0] : -1, out_size, ws_size); grid = -1; return; }
        int dev = 0, cus = 0, per_cu = 0;
        if (hipGetDevice(&dev) != hipSuccess || hipDeviceGetAttribute(&cus, hipDeviceAttributeMultiprocessorCount, dev) != hipSuccess) { fprintf(stderr, "kernel_launch: device query failed\n"); grid = -1; return; }
        if (hipFuncSetAttribute((const void*)mk_fwd, hipFuncAttributeMaxDynamicSharedMemorySize, LDS_BYTES) != hipSuccess) { fprintf(stderr, "kernel_launch: hipFuncSetAttribute failed\n"); grid = -1; return; }
        if (hipOccupancyMaxActiveBlocksPerMultiprocessor(&per_cu, (const void*)mk_fwd, NWAVES * 64, LDS_BYTES) != hipSuccess || per_cu < 1)
            fprintf(stderr, "kernel_launch: note: occupancy query reports %d workgroups per CU\n", per_cu);
        (void)hipGetLastError();
        grid = cus;
    }
    if (grid < 0) return;
    if (hipMemsetAsync((char*)d_ws + WS_CTL, 0, CTL_ZERO_BYTES, stream) != hipSuccess) { fprintf(stderr, "kernel_launch: memset failed\n"); return; }
    Args a{};
    for (int i = 0; i < 18; ++i) a.in[i] = (const float*)d_in[i];
    a.out = (float*)d_out; a.ws = (unsigned char*)d_ws;
#if MK_CHECK
    for (int p = 0; p < NPH; ++p) { a.ph_lo = p; a.ph_hi = p + 1;
        hipLaunchKernelGGL(mk_fwd, dim3(grid), dim3(NWAVES * 64), LDS_BYTES, stream, a);
        hipLaunchKernelGGL(mk_check, dim3(256), dim3(256), 0, stream, a, p); }
    hipLaunchKernelGGL(mk_report, dim3(1), dim3(64), 0, stream, a);
#elif MK_SPLIT
    for (int p = 0; p < NPH; ++p) { a.ph_lo = p; a.ph_hi = p + 1; hipLaunchKernelGGL(mk_fwd, dim3(grid), dim3(NWAVES * 64), LDS_BYTES, stream, a); }
#else
    a.ph_lo = 0; a.ph_hi = NPH;
    hipLaunchKernelGGL(mk_fwd, dim3(grid), dim3(NWAVES * 64), LDS_BYTES, stream, a);
#ifdef PROBE_TWICE
    (void)hipMemsetAsync((char*)d_ws + WS_CTL, 0, CTL_ZERO_BYTES, stream);
    hipLaunchKernelGGL(mk_fwd, dim3(grid), dim3(NWAVES * 64), LDS_BYTES, stream, a);
#endif
#endif
    const hipError_t le = hipPeekAtLastError();
    if (le != hipSuccess) fprintf(stderr, "kernel_launch: launch failed: %s\n", hipGetErrorName(le));
}
```
